# Optimizing an MI355X kernel written in HIP

```python
import numpy as np
import jax
import jax.numpy as jnp
from jax import lax

D_MODEL = 2048
BATCH = 8
SEQ = 2048
DEPTH = 1

GRID_W = 64
CTX_LEN = 256
EPS = 1e-6
NEG_INF = -1e30

NA_HEADS = 16
NA_HEAD_DIM = 64
NA_WIDTH = NA_HEADS * NA_HEAD_DIM
NA_WIN_H = 8
NA_WIN_W = 16
NA_QBLOCK_W = 16
NA_BAND_W = NA_QBLOCK_W + NA_WIN_W
NA_SCALE = NA_HEAD_DIM ** -0.5

MLA_HEADS = 8
MLA_NOPE_DIM = 128
MLA_ROPE_DIM = 64
MLA_V_DIM = 128
MLA_WIDTH = MLA_HEADS * MLA_V_DIM
MLA_Q_RANK = 768
MLA_KV_RANK = 512
MLA_Q_BLOCK = 128
MLA_SCALE = (MLA_NOPE_DIM + MLA_ROPE_DIM) ** -0.5
ROPE_THETA = 10000.0

PEER_HEADS = 8
PEER_N_KEYS = 128
PEER_N_EXPERTS = PEER_N_KEYS * PEER_N_KEYS
PEER_KEY_DIM = 256
PEER_TOPK = 16
PEER_TOKEN_BLOCK = 128

IN_SPLITS = (NA_WIDTH, NA_WIDTH, NA_WIDTH, MLA_Q_RANK, MLA_KV_RANK, MLA_ROPE_DIM, D_MODEL, D_MODEL)
IN_COLS = sum(IN_SPLITS)

kernel_name = 'hybrid_natten_mla_peer_dit_block'


def _rms(x, g):
    xf = x.astype(jnp.float32)
    y = xf * lax.rsqrt(jnp.mean(xf * xf, axis=-1, keepdims=True) + EPS)
    return (y * g.astype(jnp.float32)).astype(x.dtype)


def _modulate(h, shift, scale):
    return h * (1 + scale) + shift


def _split_in(p):
    return jnp.split(p, np.cumsum(IN_SPLITS)[:-1].tolist(), axis=-1)


def _heads(t, n):
    return t.reshape(t.shape[0], t.shape[1], n, -1)


def _axial_rope(n_tokens):
    t = jnp.arange(n_tokens)
    row = (t // GRID_W).astype(jnp.float32)
    col = (t % GRID_W).astype(jnp.float32)
    quarter = MLA_ROPE_DIM // 4
    inv_freq = ROPE_THETA ** (-jnp.arange(quarter, dtype=jnp.float32) / quarter)
    ang = jnp.concatenate([row[:, None] * inv_freq, col[:, None] * inv_freq], axis=-1)
    return jnp.cos(ang), jnp.sin(ang)


def _rope(x, cos, sin):
    xf = x.astype(jnp.float32)
    half = xf.shape[-1] // 2
    x1, x2 = xf[..., :half], xf[..., half:]
    return jnp.concatenate([x1 * cos - x2 * sin, x1 * sin + x2 * cos], axis=-1).astype(x.dtype)


def _neighbourhood_attention(q, k, v, kc, vc, rpb):
    b, s, h, dh = q.shape
    rows = s // GRID_W
    kh = min(NA_WIN_H, rows)
    nqb = GRID_W // NA_QBLOCK_W
    nk = kh * NA_BAND_W
    qcol = np.arange(GRID_W).reshape(nqb, NA_QBLOCK_W)
    band_start = np.clip(np.arange(nqb) * NA_QBLOCK_W - NA_WIN_W // 2, 0, GRID_W - NA_BAND_W)
    band_cols = band_start[:, None] + np.arange(NA_BAND_W)
    win_start = np.clip(qcol - NA_WIN_W // 2, 0, GRID_W - NA_WIN_W)
    off = band_cols[:, None, :] - win_start[:, :, None]
    col_ok = (off >= 0) & (off < NA_WIN_W)
    mask = np.broadcast_to(col_ok[:, :, None, :], (nqb, NA_QBLOCK_W, kh, NA_BAND_W)).reshape(nqb, NA_QBLOCK_W, nk)
    dx_idx = np.clip(band_cols[:, None, :] - qcol[:, :, None] + NA_WIN_W - 1, 0, 2 * NA_WIN_W - 2)
    kg = k.reshape(b, rows, GRID_W, h, dh)
    vg = v.reshape(b, rows, GRID_W, h, dh)
    qg = q.reshape(b, rows, nqb, NA_QBLOCK_W, h, dh).swapaxes(0, 1)

    def row_block(args):
        r, qr = args
        r0 = jnp.clip(r - NA_WIN_H // 2, 0, rows - kh)
        kb = lax.dynamic_slice_in_dim(kg, r0, kh, axis=1)[:, :, band_cols]
        vb = lax.dynamic_slice_in_dim(vg, r0, kh, axis=1)[:, :, band_cols]
        kb = kb.transpose(0, 2, 1, 3, 4, 5).reshape(b, nqb, nk, h, dh)
        vb = vb.transpose(0, 2, 1, 3, 4, 5).reshape(b, nqb, nk, h, dh)
        dy_idx = r0 + jnp.arange(kh) - r + NA_WIN_H - 1
        bias = rpb[:, dy_idx[:, None, None, None], dx_idx[None]]
        bias = bias.transpose(2, 0, 3, 1, 4).reshape(nqb, h, NA_QBLOCK_W, nk)
        s_lat = jnp.einsum('bjqhd,bjkhd->bjhqk', qr, kb).astype(jnp.float32) * NA_SCALE + bias.astype(jnp.float32)
        s_lat = jnp.where(mask[None, :, None], s_lat, NEG_INF)
        s_ctx = jnp.einsum('bjqhd,blhd->bjhql', qr, kc).astype(jnp.float32) * NA_SCALE
        p = jax.nn.softmax(jnp.concatenate([s_lat, s_ctx], axis=-1), axis=-1).astype(v.dtype)
        return (jnp.einsum('bjhqk,bjkhd->bjqhd', p[..., :nk], vb)
                + jnp.einsum('bjhql,blhd->bjqhd', p[..., nk:], vc))

    out = lax.map(row_block, (jnp.arange(rows), qg))
    return out.swapaxes(0, 1).reshape(b, s, h * dh)


def _na_context(q, k, v):
    s = jnp.einsum('bqhd,bkhd->bhqk', q, k).astype(jnp.float32) * NA_SCALE
    p = jax.nn.softmax(s, axis=-1).astype(v.dtype)
    return jnp.einsum('bhqk,bkhd->bqhd', p, v).reshape(q.shape[0], q.shape[1], -1)


def _mla_queries(cq, g_q, w_q_b, rope):
    q = _heads(_rms(cq, g_q) @ w_q_b, MLA_HEADS)
    q_nope, q_pe = q[..., :MLA_NOPE_DIM], q[..., MLA_NOPE_DIM:]
    if rope is not None:
        q_pe = _rope(q_pe, rope[0][:, None], rope[1][:, None])
    return q_nope, q_pe


def _mla_keys(ckv, kpe, g_kv, w_kv_b, rope):
    kv = _heads(_rms(ckv, g_kv) @ w_kv_b, MLA_HEADS)
    k_nope, val = kv[..., :MLA_NOPE_DIM], kv[..., MLA_NOPE_DIM:]
    if rope is not None:
        kpe = _rope(kpe, rope[0], rope[1])
    return k_nope, kpe, val


def _mla_attend(qn, qp, kn, kp, v):
    s = jnp.einsum('bqhn,bkhn->bhqk', qn, kn) + jnp.einsum('bqhr,bkr->bhqk', qp, kp)
    p = jax.nn.softmax(s.astype(jnp.float32) * MLA_SCALE, axis=-1).astype(v.dtype)
    return jnp.einsum('bhqk,bkhv->bqhv', p, v)


def _mla_latent(qn, qp, kn, kp, v):
    b, s = qn.shape[0], qn.shape[1]
    nb = s // MLA_Q_BLOCK
    qn_b = qn.reshape(b, nb, MLA_Q_BLOCK, MLA_HEADS, MLA_NOPE_DIM).swapaxes(0, 1)
    qp_b = qp.reshape(b, nb, MLA_Q_BLOCK, MLA_HEADS, MLA_ROPE_DIM).swapaxes(0, 1)
    out = lax.map(lambda a: _mla_attend(a[0], a[1], kn, kp, v), (qn_b, qp_b))
    return out.swapaxes(0, 1).reshape(b, s, MLA_WIDTH)


def _merge(oa, ob, ga, gb, lp):
    y = jax.nn.sigmoid(ga) * (oa @ lp['w_branch_a']) + jax.nn.sigmoid(gb) * (ob @ lp['w_branch_b'])
    return y @ lp['w_out']


def _token_mixing(h, hc, lp, rope, with_ctx_out):
    qa, ka, va, cq, ckv, kpe, ga, gb = _split_in(h @ lp['w_in'])
    qac, kac, vac, cqc, ckvc, kpec, gac, gbc = _split_in(hc @ lp['w_in'])
    kac_h, vac_h = _heads(kac, NA_HEADS), _heads(vac, NA_HEADS)
    oa = _neighbourhood_attention(_heads(qa, NA_HEADS), _heads(ka, NA_HEADS), _heads(va, NA_HEADS),
                                  kac_h, vac_h, lp['na_rpb'])
    qn, qp = _mla_queries(cq, lp['mla_g_q'], lp['mla_w_q_b'], rope)
    kn, kp, vb = _mla_keys(ckv, kpe, lp['mla_g_kv'], lp['mla_w_kv_b'], rope)
    knc, kpc, vbc = _mla_keys(ckvc, kpec, lp['mla_g_kv'], lp['mla_w_kv_b'], None)
    ob = _mla_latent(qn, qp, jnp.concatenate([kn, knc], axis=1), jnp.concatenate([kp, kpc], axis=1),
                     jnp.concatenate([vb, vbc], axis=1))
    y = _merge(oa, ob, ga, gb, lp)
    if not with_ctx_out:
        return y, None
    oac = _na_context(_heads(qac, NA_HEADS), kac_h, vac_h)
    qnc, qpc = _mla_queries(cqc, lp['mla_g_q'], lp['mla_w_q_b'], None)
    obc = _mla_attend(qnc, qpc, knc, kpc, vbc).reshape(hc.shape[0], hc.shape[1], MLA_WIDTH)
    yc = _merge(oac, obc, gac, gbc, lp)
    return y, yc


def _peer(h, lp):
    b, s, d = h.shape
    t = b * s
    hf = h.reshape(t, d)
    q = (hf @ lp['peer_w_query']).reshape(t, PEER_HEADS, 2, PEER_KEY_DIM // 2)
    sc = jnp.einsum('thpk,hpnk->thpn', q, lp['peer_subkeys']).astype(jnp.float32)
    v1, i1 = lax.top_k(sc[:, :, 0], PEER_TOPK)
    v2, i2 = lax.top_k(sc[:, :, 1], PEER_TOPK)
    cand_s = (v1[..., :, None] + v2[..., None, :]).reshape(t, PEER_HEADS, PEER_TOPK * PEER_TOPK)
    cand_i = (i1[..., :, None] * PEER_N_KEYS + i2[..., None, :]).reshape(t, PEER_HEADS, PEER_TOPK * PEER_TOPK)
    top_s, pos = lax.top_k(cand_s, PEER_TOPK)
    idx = jnp.take_along_axis(cand_i, pos, axis=-1)
    gate = jax.nn.softmax(top_s, axis=-1).astype(h.dtype)
    u, v = lp['peer_u'], lp['peer_v']
    nb = t // PEER_TOKEN_BLOCK

    def blk(args):
        hb, ib, gb = args
        act = jax.nn.gelu(jnp.einsum('td,thkd->thk', hb, u[ib]), approximate=False)
        return jnp.einsum('thk,thkd->td', gb * act, v[ib])

    out = lax.map(blk, (hf.reshape(nb, PEER_TOKEN_BLOCK, d),
                        idx.reshape(nb, PEER_TOKEN_BLOCK, PEER_HEADS, PEER_TOPK),
                        gate.reshape(nb, PEER_TOKEN_BLOCK, PEER_HEADS, PEER_TOPK)))
    return out.reshape(b, s, d)


def _layer(x, xc, c, c_ctx, lp, rope, update_ctx):
    mod = (jax.nn.silu(c) @ lp['w_ada'] + lp['b_ada'])[:, None, :]
    modc = jax.nn.silu(c_ctx) @ lp['w_ada'] + lp['b_ada']
    sh1, sc1, gt1, sh2, sc2, gt2 = jnp.split(mod, 6, axis=-1)
    shc1, scc1, gtc1, shc2, scc2, gtc2 = jnp.split(modc, 6, axis=-1)
    h = _modulate(_rms(x, lp['g_pre_mix']), sh1, sc1)
    hc = _modulate(_rms(xc, lp['g_pre_mix']), shc1, scc1)
    y, yc = _token_mixing(h, hc, lp, rope, update_ctx)
    x = x + gt1 * _rms(y, lp['g_post_mix'])
    h2 = _modulate(_rms(x, lp['g_pre_ffn']), sh2, sc2)
    x = x + gt2 * _rms(_peer(h2, lp), lp['g_post_ffn'])
    if update_ctx:
        xc = xc + gtc1 * _rms(yc, lp['g_post_mix'])
        h2c = _modulate(_rms(xc, lp['g_pre_ffn']), shc2, scc2)
        xc = xc + gtc2 * _rms(_peer(h2c, lp), lp['g_post_ffn'])
    return x, xc


def setup_inputs(seed: int = 0) -> dict:
    key = jax.random.key(seed)
    ks = jax.random.split(key, 24)
    f32 = jnp.float32
    L = DEPTH

    def nrm(k, shape, scale):
        return jax.random.normal(k, shape, f32) * scale

    def gain(k, shape):
        return 1.0 + 0.1 * jax.random.normal(k, shape, f32)

    return {
        'x': nrm(ks[0], (BATCH, SEQ, D_MODEL), 1.0),
        'c': nrm(ks[1], (BATCH, D_MODEL), 1.0),
        'ctx': nrm(ks[2], (BATCH, CTX_LEN, D_MODEL), 1.0),
        'c_ctx': nrm(ks[3], (D_MODEL,), 1.0),
        'w_ada': nrm(ks[4], (L, D_MODEL, 6 * D_MODEL), 0.5 * D_MODEL ** -0.5),
        'b_ada': nrm(ks[5], (L, 6 * D_MODEL), 0.01),
        'g_pre_mix': gain(ks[6], (L, D_MODEL)),
        'g_post_mix': gain(ks[7], (L, D_MODEL)),
        'g_pre_ffn': gain(ks[8], (L, D_MODEL)),
        'g_post_ffn': gain(ks[9], (L, D_MODEL)),
        'w_in': nrm(ks[10], (L, D_MODEL, IN_COLS), D_MODEL ** -0.5),
        'na_rpb': nrm(ks[11], (L, NA_HEADS, 2 * NA_WIN_H - 1, 2 * NA_WIN_W - 1), 0.1),
        'mla_g_q': gain(ks[12], (L, MLA_Q_RANK)),
        'mla_w_q_b': nrm(ks[13], (L, MLA_Q_RANK, MLA_HEADS * (MLA_NOPE_DIM + MLA_ROPE_DIM)), MLA_Q_RANK ** -0.5),
        'mla_g_kv': gain(ks[14], (L, MLA_KV_RANK)),
        'mla_w_kv_b': nrm(ks[15], (L, MLA_KV_RANK, MLA_HEADS * (MLA_NOPE_DIM + MLA_V_DIM)), MLA_KV_RANK ** -0.5),
        'w_branch_a': nrm(ks[16], (L, NA_WIDTH, D_MODEL), NA_WIDTH ** -0.5),
        'w_branch_b': nrm(ks[17], (L, MLA_WIDTH, D_MODEL), MLA_WIDTH ** -0.5),
        'w_out': nrm(ks[18], (L, D_MODEL, D_MODEL), D_MODEL ** -0.5),
        'peer_w_query': nrm(ks[19], (L, D_MODEL, PEER_HEADS * PEER_KEY_DIM), D_MODEL ** -0.5),
        'peer_subkeys': nrm(ks[20], (L, PEER_HEADS, 2, PEER_N_KEYS, PEER_KEY_DIM // 2), (PEER_KEY_DIM // 2) ** -0.5),
        'peer_u': nrm(ks[21], (L, PEER_N_EXPERTS, D_MODEL), D_MODEL ** -0.5),
        'peer_v': nrm(ks[22], (L, PEER_N_EXPERTS, D_MODEL), (PEER_HEADS * PEER_TOPK) ** -0.5),
    }


def reference(x, c, ctx, c_ctx, w_ada, b_ada, g_pre_mix, g_post_mix, g_pre_ffn, g_post_ffn, w_in, na_rpb,
              mla_g_q, mla_w_q_b, mla_g_kv, mla_w_kv_b, w_branch_a, w_branch_b, w_out,
              peer_w_query, peer_subkeys, peer_u, peer_v):
    rope = _axial_rope(x.shape[1])
    xc = ctx
    for l in range(DEPTH):
        lp = {
            'w_ada': w_ada[l], 'b_ada': b_ada[l],
            'g_pre_mix': g_pre_mix[l], 'g_post_mix': g_post_mix[l],
            'g_pre_ffn': g_pre_ffn[l], 'g_post_ffn': g_post_ffn[l],
            'w_in': w_in[l], 'na_rpb': na_rpb[l],
            'mla_g_q': mla_g_q[l], 'mla_w_q_b': mla_w_q_b[l],
            'mla_g_kv': mla_g_kv[l], 'mla_w_kv_b': mla_w_kv_b[l],
            'w_branch_a': w_branch_a[l], 'w_branch_b': w_branch_b[l], 'w_out': w_out[l],
            'peer_w_query': peer_w_query[l], 'peer_subkeys': peer_subkeys[l],
            'peer_u': peer_u[l], 'peer_v': peer_v[l],
        }
        x, xc = _layer(x, xc, c, c_ctx, lp, rope, l < DEPTH - 1)
    return x
```

```cpp
#include <hip/hip_runtime.h>
#include <hip/hip_cooperative_groups.h>
#include <cstdio>
#include <cstdint>
namespace cg = cooperative_groups;

typedef unsigned short bf16_t;
typedef short bf16x8 __attribute__((ext_vector_type(8)));
typedef float f32x4 __attribute__((ext_vector_type(4)));
typedef unsigned u32x4 __attribute__((ext_vector_type(4)));
typedef unsigned u32x2 __attribute__((ext_vector_type(2)));

constexpr int DM = 2048, NB = 8, SEQ = 2048, CTX = 256, GW = 64, GROWS = 32;
constexpr int TL = NB * SEQ;
constexpr int TC = NB * CTX;
constexpr int TA = TL + TC;
constexpr int IN_COLS = 8512;
constexpr int NP = 8704;
constexpr int NPC = 2816;
constexpr int PC_KA = 0, PC_VA = 1024, PC_CKV = 2048, PC_KPE = 2560, PC_QA = 2816, PC_CQ = 3840, PC_GA = 4608, PC_GB = 6656;
constexpr int QR = 768, KVR = 512;
constexpr int MQW = 1536, MKVW = 2048;
constexpr float EPS = 1e-6f;
constexpr float LOG2E = 1.4426950408889634f;
constexpr float MLA_QSCALE = 0.07216878364870322f * LOG2E;
constexpr float NA_SCALE = 0.125f;

constexpr size_t al256(size_t x) { return (x + 255) & ~(size_t)255; }
constexpr size_t WS_MOD = 0;
constexpr size_t WS_ROWSS = al256(WS_MOD + 9 * 12288 * 4);
constexpr size_t WS_ZERO_BYTES = al256(WS_ROWSS + (size_t)TA * 2 * 4);
constexpr size_t WS_WIN = WS_ZERO_BYTES;
constexpr size_t WS_WQB = WS_WIN + (size_t)NP * DM * 2;
constexpr size_t WS_WKVB = WS_WQB + (size_t)MQW * QR * 2;
constexpr size_t WS_WA = WS_WKVB + (size_t)MKVW * KVR * 2;
constexpr size_t WS_WB = WS_WA + (size_t)DM * 1024 * 2;
constexpr size_t WS_WO = WS_WB + (size_t)DM * 1024 * 2;
constexpr size_t WS_WPQ = WS_WO + (size_t)DM * DM * 2;
constexpr size_t WS_SUBK = WS_WPQ + (size_t)DM * DM * 2;
constexpr size_t WS_H = WS_SUBK + (size_t)262144 * 2;
constexpr size_t WS_PL = WS_H + (size_t)TA * DM * 2;
constexpr size_t WS_PC = WS_PL + (size_t)TL * NP * 2;
constexpr size_t WS_QM = WS_PC + (size_t)TC * NPC * 2;
constexpr size_t WS_KVM = WS_QM + (size_t)TL * MQW * 2;
constexpr size_t WS_KPE = WS_KVM + (size_t)TA * MKVW * 2;
constexpr size_t WS_OA = WS_KPE + (size_t)TA * 64 * 2;
constexpr size_t WS_OB = WS_OA + (size_t)TL * 1024 * 2;
constexpr size_t WS_END = WS_OB + (size_t)TL * 1024 * 2;
constexpr size_t WS_Z = WS_PL;
constexpr size_t WS_QP = WS_PL + (size_t)TL * DM * 2;
constexpr size_t WS_TKV = WS_QP + (size_t)TL * DM * 2;
constexpr size_t WS_TKI = WS_TKV + (size_t)TL * 256 * 4;
static_assert(WS_TKI + (size_t)TL * 256 * 4 <= WS_PC, "overlay");
static_assert(WS_END <= 650307648ull, "workspace");

constexpr int NTHREADS = 512, NWAVES = 8;
constexpr int LDS_BYTES = 139264;

struct Params {
    const float* in[23];
    float* out;
    unsigned char* ws;
    int ph_lo, ph_hi;
};

__device__ __forceinline__ float bf2f(bf16_t v) { return __uint_as_float((unsigned)v << 16); }
__device__ __forceinline__ unsigned f2bf(float f) { unsigned u = __float_as_uint(f); return (u + 0x7fffu + ((u >> 16) & 1u)) >> 16; }
__device__ __forceinline__ unsigned pk2(float lo, float hi) { return f2bf(lo) | (f2bf(hi) << 16); }
__device__ __forceinline__ float wave_sum(float v) {
#pragma unroll
    for (int o = 1; o < 64; o <<= 1) v += __shfl_xor(v, o);
    return v;
}
__device__ __forceinline__ float wave_max(float v) {
#pragma unroll
    for (int o = 1; o < 64; o <<= 1) v = fmaxf(v, __shfl_xor(v, o));
    return v;
}
__device__ __forceinline__ float sigmoidf_(float x) { return 1.f / (1.f + __expf(-x)); }
__device__ __forceinline__ float silu_(float x) { return x / (1.f + __expf(-x)); }
__device__ __forceinline__ float gelu_erf(float x) { return 0.5f * x * (1.f + erff(x * 0.70710678118654752f)); }

__device__ __forceinline__ void rope_cs(int s, int j, float& c, float& sn) {
    const int gr = s >> 6, gc = s & 63;
    const int i = j & 15;
    const float invf = exp2f(-(float)i * (13.287712379549449f / 16.f));
    const float ang = (float)(j < 16 ? gr : gc) * invf;
    sincosf(ang, &sn, &c);
}

template <class Epi>
__device__ __forceinline__ void ngemm(const bf16_t* __restrict__ A, int lda, const bf16_t* __restrict__ Bt, int ldb, int M, int N, int K, const Epi& epi, float* rs = nullptr) {
    const int tid = threadIdx.x, wid = tid >> 6, lane = tid & 63, fr = lane & 15, fq = lane >> 4;
    const int tilesM = M / 128, tilesN = N / 256, nt = tilesM * tilesN;
    for (int t = blockIdx.x; t < nt; t += gridDim.x) {
        const int tm = t % tilesM, tn = t / tilesM;
        const int row0 = tm * 128 + (wid >> 2) * 64, col0 = tn * 256 + (wid & 3) * 64;
        if (Epi::PRO) {
            __syncthreads();
            const int r = tid >> 2, part = tid & 3, len = K >> 2;
            const bf16_t* ar = A + (size_t)(tm * 128 + r) * lda + part * len;
            float ss = 0.f;
            for (int k = 0; k < len; k += 8) { const bf16x8 v = *(const bf16x8*)(ar + k);
#pragma unroll
                for (int e = 0; e < 8; ++e) { const float f = bf2f((bf16_t)v[e]); ss += f * f; } }
            ss += __shfl_xor(ss, 1); ss += __shfl_xor(ss, 2);
            if (part == 0) rs[r] = rsqrtf(ss / (float)K + EPS);
            __syncthreads();
        }
        f32x4 acc[4][4];
#pragma unroll
        for (int i = 0; i < 4; ++i)
#pragma unroll
            for (int j = 0; j < 4; ++j) acc[i][j] = (f32x4){0.f, 0.f, 0.f, 0.f};
        const bf16_t* ap = A + (size_t)(row0 + fr) * lda + fq * 8;
        const bf16_t* bp = Bt + (size_t)(col0 + fr) * ldb + fq * 8;
        for (int k0 = 0; k0 < K; k0 += 32) {
            bf16x8 a[4], b[4];
#pragma unroll
            for (int i = 0; i < 4; ++i) a[i] = *(const bf16x8*)(ap + (size_t)i * 16 * lda + k0);
#pragma unroll
            for (int j = 0; j < 4; ++j) b[j] = *(const bf16x8*)(bp + (size_t)j * 16 * ldb + k0);
#pragma unroll
            for (int i = 0; i < 4; ++i)
#pragma unroll
                for (int j = 0; j < 4; ++j) acc[i][j] = __builtin_amdgcn_mfma_f32_16x16x32_bf16(b[j], a[i], acc[i][j], 0, 0, 0);
        }
#pragma unroll
        for (int i = 0; i < 4; ++i) {
            const int row = row0 + i * 16 + fr;
            const float rstd = Epi::PRO ? rs[row - tm * 128] : 1.f;
#pragma unroll
            for (int j = 0; j < 4; ++j) epi.quad(row, col0 + j * 16 + 4 * fq, acc[i][j] * rstd);
        }
    }
}

__device__ __forceinline__ void store_bf4(bf16_t* p, f32x4 v) { u32x2 w; w.x = pk2(v[0], v[1]); w.y = pk2(v[2], v[3]); *(u32x2*)p = w; }

struct EpiInproj {
    static constexpr bool PRO = false;
    bf16_t* P; int ldp; int gate0;
    __device__ __forceinline__ void quad(int row, int col, f32x4 v) const {
        if (col >= gate0) { v[0] = sigmoidf_(v[0]); v[1] = sigmoidf_(v[1]); v[2] = sigmoidf_(v[2]); v[3] = sigmoidf_(v[3]); }
        store_bf4(P + (size_t)row * ldp + col, v);
    }
};
struct EpiMlaQ {
    static constexpr bool PRO = true;
    bf16_t* Q;
    __device__ __forceinline__ void quad(int row, int col, f32x4 v) const {
        v = v * MLA_QSCALE;
        const int d = col % 192;
        if (d >= 128) {
            const int j = (d - 128) >> 1, s = row & (SEQ - 1);
            float c0, s0, c1, s1; rope_cs(s, j, c0, s0); rope_cs(s, j + 1, c1, s1);
            const f32x4 o = {v[0] * c0 - v[1] * s0, v[0] * s0 + v[1] * c0, v[2] * c1 - v[3] * s1, v[2] * s1 + v[3] * c1};
            v = o;
        }
        store_bf4(Q + (size_t)row * MQW + col, v);
    }
};
struct EpiMlaKV {
    static constexpr bool PRO = true;
    bf16_t* KV; int row_off;
    __device__ __forceinline__ void quad(int row, int col, f32x4 v) const { store_bf4(KV + (size_t)(row_off + row) * MKVW + col, v); }
};
template <int STEP> struct EpiMerge {
    static constexpr bool PRO = false;
    bf16_t* Y; const bf16_t* P;
    __device__ __forceinline__ void quad(int row, int col, f32x4 v) const {
        const u32x2 g = *(const u32x2*)(P + (size_t)row * NP + (STEP == 0 ? PC_GA : PC_GB) + col);
        const f32x4 gv = {__uint_as_float(g.x << 16), __uint_as_float(g.x & 0xffff0000u), __uint_as_float(g.y << 16), __uint_as_float(g.y & 0xffff0000u)};
        v = v * gv;
        if (STEP == 1) {
            const u32x2 y = *(const u32x2*)(Y + (size_t)row * DM + col);
            v[0] += __uint_as_float(y.x << 16); v[1] += __uint_as_float(y.x & 0xffff0000u); v[2] += __uint_as_float(y.y << 16); v[3] += __uint_as_float(y.y & 0xffff0000u);
        }
        store_bf4(Y + (size_t)row * DM + col, v);
    }
};
struct EpiStore {
    static constexpr bool PRO = false;
    bf16_t* O; int ldo;
    __device__ __forceinline__ void quad(int row, int col, f32x4 v) const { store_bf4(O + (size_t)row * ldo + col, v); }
};

__device__ __forceinline__ int win_dest_row(int n) {
    if (n < 1024) return PC_QA + n;
    if (n < 2048) return PC_KA + (n - 1024);
    if (n < 3072) return PC_VA + (n - 2048);
    if (n < 3840) return PC_CQ + (n - 3072);
    if (n < 4352) return PC_CKV + (n - 3840);
    if (n < 4416) { const int r = n - 4352; return PC_KPE + (r < 32 ? 2 * r : 2 * (r - 32) + 1); }
    if (n < 6464) return PC_GA + (n - 4416);
    return PC_GB + (n - 6464);
}
__device__ __forceinline__ int wq_dest_row(int n) {
    const int h = n / 192, d = n % 192;
    if (d < 128) return n;
    const int r = d - 128;
    return h * 192 + 128 + (r < 32 ? 2 * r : 2 * (r - 32) + 1);
}
template <int MODE>
__device__ __forceinline__ void transpose_item(const float* __restrict__ W, int K, int N, bf16_t* __restrict__ WT, const float* __restrict__ kscale, float* scr, int item, int lane) {
    const int nblk = N / 32, kb = item / nblk, nb = item % nblk, k0 = 64 * kb, n0 = 32 * nb;
#pragma unroll 8
    for (int i = 0; i < 32; ++i) { const int kk = 2 * i + (lane >> 5); float w = W[(size_t)(k0 + kk) * N + n0 + (lane & 31)]; if (kscale) w *= kscale[k0 + kk]; scr[kk * 33 + (lane & 31)] = w; }
    __builtin_amdgcn_s_waitcnt(0xc07f); asm volatile("" ::: "memory");
    const int c = lane & 7;
#pragma unroll
    for (int j = 0; j < 4; ++j) {
        const int n = (lane >> 3) + 8 * j; const float* s = scr + (8 * c) * 33 + n;
        u32x4 o; o.x = pk2(s[0 * 33], s[1 * 33]); o.y = pk2(s[2 * 33], s[3 * 33]); o.z = pk2(s[4 * 33], s[5 * 33]); o.w = pk2(s[6 * 33], s[7 * 33]);
        const int ns = n0 + n;
        const int dr = MODE == 1 ? win_dest_row(ns) : (MODE == 2 ? wq_dest_row(ns) : ns);
        *(u32x4*)(WT + (size_t)dr * K + k0 + 8 * c) = o;
    }
    __builtin_amdgcn_s_waitcnt(0xc07f); asm volatile("" ::: "memory");
}

__device__ __forceinline__ void phase0(const Params& p, unsigned char* lds) {
    const int tid = threadIdx.x, lane = tid & 63, wid = tid >> 6;
    unsigned char* ws = p.ws;
    {
        float* sl = (float*)lds;
        float* red = sl + 9 * 2048;
        const float* c = p.in[1]; const float* cctx = p.in[3]; const float* wada = p.in[4]; const float* bada = p.in[5];
        float* mod = (float*)(ws + WS_MOD);
        if (blockIdx.x < 192) {
            for (int i = tid; i < 9 * 2048; i += NTHREADS) { const int r = i >> 11, k = i & 2047; const float v = r < 8 ? c[r * DM + k] : cctx[k]; sl[i] = silu_(v); }
            __syncthreads();
            for (int it = blockIdx.x; it < 192; it += gridDim.x) {
                const int kq = tid >> 4, c4 = tid & 15, col = it * 64 + c4 * 4;
                f32x4 acc[9];
#pragma unroll
                for (int r = 0; r < 9; ++r) acc[r] = (f32x4){0.f, 0.f, 0.f, 0.f};
#pragma unroll 8
                for (int i = 0; i < 64; ++i) {
                    const int k = kq + 32 * i;
                    const f32x4 w = *(const f32x4*)(wada + (size_t)k * 12288 + col);
#pragma unroll
                    for (int r = 0; r < 9; ++r) acc[r] += w * sl[r * 2048 + k];
                }
#pragma unroll
                for (int r = 0; r < 9; ++r) {
#pragma unroll
                    for (int e = 0; e < 4; ++e) { float v = acc[r][e]; v += __shfl_xor(v, 16); v += __shfl_xor(v, 32); acc[r][e] = v; }
                    if (lane < 16) *(f32x4*)(red + (wid * 9 + r) * 64 + c4 * 4) = acc[r];
                }
                __syncthreads();
                for (int o = tid; o < 9 * 64; o += NTHREADS) {
                    const int r = o >> 6, cc = o & 63;
                    float sum = bada[it * 64 + cc];
                    for (int q = 0; q < 8; ++q) sum += red[(q * 9 + r) * 64 + cc];
                    mod[(size_t)r * 12288 + it * 64 + cc] = sum;
                }
                __syncthreads();
            }
        }
        __syncthreads();
    }
    {
        float* scr = (float*)lds + wid * (64 * 33);
        const int gw = blockIdx.x * NWAVES + wid, NGW = gridDim.x * NWAVES;
        constexpr int I_IN = 32 * (IN_COLS / 32), I_QB = 12 * 48, I_KVB = 8 * 64, I_AB = 16 * 64, I_OO = 32 * 64;
        constexpr int NITEMS = I_IN + I_QB + I_KVB + 2 * I_AB + 2 * I_OO;
        for (int it = gw; it < NITEMS; it += NGW) {
            int r = it;
            if (r < I_IN) { transpose_item<1>(p.in[10], DM, IN_COLS, (bf16_t*)(ws + WS_WIN), nullptr, scr, r, lane); continue; } r -= I_IN;
            if (r < I_QB) { transpose_item<2>(p.in[13], QR, MQW, (bf16_t*)(ws + WS_WQB), p.in[12], scr, r, lane); continue; } r -= I_QB;
            if (r < I_KVB) { transpose_item<0>(p.in[15], KVR, MKVW, (bf16_t*)(ws + WS_WKVB), p.in[14], scr, r, lane); continue; } r -= I_KVB;
            if (r < I_AB) { transpose_item<0>(p.in[16], 1024, DM, (bf16_t*)(ws + WS_WA), nullptr, scr, r, lane); continue; } r -= I_AB;
            if (r < I_AB) { transpose_item<0>(p.in[17], 1024, DM, (bf16_t*)(ws + WS_WB), nullptr, scr, r, lane); continue; } r -= I_AB;
            if (r < I_OO) { transpose_item<0>(p.in[18], DM, DM, (bf16_t*)(ws + WS_WO), nullptr, scr, r, lane); continue; } r -= I_OO;
            transpose_item<0>(p.in[19], DM, DM, (bf16_t*)(ws + WS_WPQ), nullptr, scr, r, lane);
        }
    }
    {
        const size_t gt = (size_t)blockIdx.x * NTHREADS + tid, NGT = (size_t)gridDim.x * NTHREADS;
        u32x4* padp = (u32x4*)(ws + WS_WIN + (size_t)(PC_KPE + 64) * DM * 2);
        for (size_t i = gt; i < (size_t)192 * DM * 2 / 16; i += NGT) padp[i] = (u32x4){0u, 0u, 0u, 0u};
        const float* sk = p.in[20]; bf16_t* skb = (bf16_t*)(ws + WS_SUBK);
        for (size_t i = gt; i < 262144 / 4; i += NGT) { const f32x4 v = *(const f32x4*)(sk + i * 4); store_bf4(skb + i * 4, v); }
    }
}

__device__ __forceinline__ void phase1(const Params& p) {
    const int tid = threadIdx.x, lane = tid & 63, wid = tid >> 6;
    const int gw = blockIdx.x * NWAVES + wid, NGW = gridDim.x * NWAVES;
    const float* mod = (const float*)(p.ws + WS_MOD); const float* g = p.in[6];
    bf16_t* H = (bf16_t*)(p.ws + WS_H);
    for (int m = gw; m < TA; m += NGW) {
        const float* xr = m < TL ? p.in[0] + (size_t)m * DM : p.in[2] + (size_t)(m - TL) * DM;
        const int mr = m < TL ? m / SEQ : 8;
        const float* sh = mod + (size_t)mr * 12288, * sc = sh + 2048;
        f32x4 v[8]; float ss = 0.f;
#pragma unroll
        for (int j = 0; j < 8; ++j) { v[j] = *(const f32x4*)(xr + j * 256 + lane * 4); ss += v[j][0] * v[j][0] + v[j][1] * v[j][1] + v[j][2] * v[j][2] + v[j][3] * v[j][3]; }
        const float rstd = rsqrtf(wave_sum(ss) * (1.f / DM) + EPS);
#pragma unroll
        for (int j = 0; j < 8; ++j) {
            const int c = j * 256 + lane * 4;
            const f32x4 gg = *(const f32x4*)(g + c), s1 = *(const f32x4*)(sc + c), h1 = *(const f32x4*)(sh + c);
            const f32x4 o = (v[j] * rstd * gg) * (s1 + 1.f) + h1;
            store_bf4(H + (size_t)m * DM + c, o);
        }
    }
}

__device__ __forceinline__ void kpe_pass(const Params& p) {
    const size_t gt = (size_t)blockIdx.x * NTHREADS + threadIdx.x, NGT = (size_t)gridDim.x * NTHREADS;
    const bf16_t* PL = (const bf16_t*)(p.ws + WS_PL); const bf16_t* PCx = (const bf16_t*)(p.ws + WS_PC);
    bf16_t* KPE = (bf16_t*)(p.ws + WS_KPE);
    for (size_t i = gt; i < (size_t)TA * 32; i += NGT) {
        const int m = (int)(i >> 5), j = (int)(i & 31);
        unsigned w;
        if (m < TL) {
            w = *(const unsigned*)(PL + (size_t)m * NP + PC_KPE + 2 * j);
            const float x1 = __uint_as_float(w << 16), x2 = __uint_as_float(w & 0xffff0000u);
            float c, s; rope_cs(m & (SEQ - 1), j, c, s);
            w = pk2(x1 * c - x2 * s, x1 * s + x2 * c);
        } else w = *(const unsigned*)(PCx + (size_t)(m - TL) * NPC + PC_KPE + 2 * j);
        *(unsigned*)(KPE + (size_t)m * 64 + 2 * j) = w;
    }
}

__device__ __forceinline__ float dot_bf16x8(const bf16x8 k, const float* q) {
    float s = 0.f;
#pragma unroll
    for (int e = 0; e < 8; ++e) s += q[e] * bf2f((bf16_t)k[e]);
    return s;
}

__device__ __forceinline__ void na_naive(const Params& p, unsigned char* lds) {
    const int tid = threadIdx.x, lane = tid & 63, wid = tid >> 6;
    const int gw = blockIdx.x * NWAVES + wid, NGW = gridDim.x * NWAVES;
    const bf16_t* PL = (const bf16_t*)(p.ws + WS_PL); const bf16_t* PCx = (const bf16_t*)(p.ws + WS_PC);
    bf16_t* OA = (bf16_t*)(p.ws + WS_OA);
    const float* rpb = p.in[11];
    float* qs = (float*)lds + wid * 512;
    float* ps = qs + 64;
    for (int it = gw; it < TL * 16; it += NGW) {
        const int h = it & 15, m = it >> 4, b = m / SEQ, s = m % SEQ, r = s >> 6, qc = s & 63;
        int r0 = r - 4; r0 = r0 < 0 ? 0 : (r0 > GROWS - 8 ? GROWS - 8 : r0);
        int w0 = qc - 8; w0 = w0 < 0 ? 0 : (w0 > GW - 16 ? GW - 16 : w0);
        qs[lane] = bf2f(PL[(size_t)m * NP + PC_QA + h * 64 + lane]);
        __builtin_amdgcn_s_waitcnt(0xc07f); asm volatile("" ::: "memory");
        float sc[6];
#pragma unroll
        for (int i = 0; i < 6; ++i) {
            const int kk = lane + 64 * i;
            const bf16_t* kp; float bias = 0.f;
            if (i < 2) { const int dy = kk >> 4, dx = kk & 15, kr = r0 + dy, kc = w0 + dx;
                kp = PL + (size_t)(b * SEQ + kr * 64 + kc) * NP + PC_KA + h * 64;
                bias = rpb[(h * 15 + (kr - r + 7)) * 31 + (kc - qc + 15)]; }
            else kp = PCx + (size_t)(b * CTX + (kk - 128)) * NPC + PC_KA + h * 64;
            float d = 0.f;
#pragma unroll
            for (int e = 0; e < 8; ++e) d += dot_bf16x8(*(const bf16x8*)(kp + e * 8), qs + e * 8);
            sc[i] = d * NA_SCALE + bias;
        }
        float mx = sc[0];
#pragma unroll
        for (int i = 1; i < 6; ++i) mx = fmaxf(mx, sc[i]);
        mx = wave_max(mx);
        float sum = 0.f;
#pragma unroll
        for (int i = 0; i < 6; ++i) { sc[i] = __expf(sc[i] - mx); sum += sc[i]; ps[lane + 64 * i] = sc[i]; }
        sum = wave_sum(sum);
        __builtin_amdgcn_s_waitcnt(0xc07f); asm volatile("" ::: "memory");
        float o = 0.f;
        for (int kk = 0; kk < 128; ++kk) { const int kr = r0 + (kk >> 4), kc = w0 + (kk & 15);
            o += ps[kk] * bf2f(PL[(size_t)(b * SEQ + kr * 64 + kc) * NP + PC_VA + h * 64 + lane]); }
        for (int kk = 0; kk < 256; ++kk) o += ps[128 + kk] * bf2f(PCx[(size_t)(b * CTX + kk) * NPC + PC_VA + h * 64 + lane]);
        OA[(size_t)m * 1024 + h * 64 + lane] = (bf16_t)f2bf(o / sum);
        __builtin_amdgcn_s_waitcnt(0xc07f); asm volatile("" ::: "memory");
    }
}

__device__ __forceinline__ void mla_naive(const Params& p, unsigned char* lds) {
    const int tid = threadIdx.x, lane = tid & 63, wid = tid >> 6;
    const bf16_t* QM = (const bf16_t*)(p.ws + WS_QM); const bf16_t* KVM = (const bf16_t*)(p.ws + WS_KVM); const bf16_t* KPE = (const bf16_t*)(p.ws + WS_KPE);
    bf16_t* OB = (bf16_t*)(p.ws + WS_OB);
    float* qs = (float*)lds + wid * (192 + 2304);
    float* ps = qs + 192;
    for (int it = blockIdx.x; it < NB * 8 * (SEQ / 8); it += gridDim.x) {
        const int qg = it % (SEQ / 8), bh = it / (SEQ / 8), h = bh & 7, b = bh >> 3;
        const int m = b * SEQ + qg * 8 + wid;
#pragma unroll
        for (int i = 0; i < 3; ++i) qs[lane + 64 * i] = bf2f(QM[(size_t)m * MQW + h * 192 + lane + 64 * i]);
        __builtin_amdgcn_s_waitcnt(0xc07f); asm volatile("" ::: "memory");
        float mx = -INFINITY;
        for (int i = 0; i < 36; ++i) {
            const int kk = lane + 64 * i;
            const int krow = kk < SEQ ? b * SEQ + kk : TL + b * CTX + (kk - SEQ);
            const bf16_t* kn = KVM + (size_t)krow * MKVW + h * 256; const bf16_t* kp = KPE + (size_t)krow * 64;
            float d = 0.f;
#pragma unroll
            for (int e = 0; e < 16; ++e) d += dot_bf16x8(*(const bf16x8*)(kn + e * 8), qs + e * 8);
#pragma unroll
            for (int e = 0; e < 8; ++e) d += dot_bf16x8(*(const bf16x8*)(kp + e * 8), qs + 128 + e * 8);
            ps[kk] = d; mx = fmaxf(mx, d);
        }
        mx = wave_max(mx);
        float sum = 0.f;
        for (int i = 0; i < 36; ++i) { const float e = exp2f(ps[lane + 64 * i] - mx); sum += e; ps[lane + 64 * i] = e; }
        sum = wave_sum(sum);
        __builtin_amdgcn_s_waitcnt(0xc07f); asm volatile("" ::: "memory");
        float o0 = 0.f, o1 = 0.f;
        const bf16_t* vb = KVM + h * 256 + 128 + lane;
        for (int kk = 0; kk < SEQ; ++kk) { const bf16_t* vp = vb + (size_t)(b * SEQ + kk) * MKVW; const float pp = ps[kk]; o0 += pp * bf2f(vp[0]); o1 += pp * bf2f(vp[64]); }
        for (int kk = 0; kk < CTX; ++kk) { const bf16_t* vp = vb + (size_t)(TL + b * CTX + kk) * MKVW; const float pp = ps[SEQ + kk]; o0 += pp * bf2f(vp[0]); o1 += pp * bf2f(vp[64]); }
        const float inv = 1.f / sum;
        OB[(size_t)m * 1024 + h * 128 + lane] = (bf16_t)f2bf(o0 * inv);
        OB[(size_t)m * 1024 + h * 128 + 64 + lane] = (bf16_t)f2bf(o1 * inv);
        __builtin_amdgcn_s_waitcnt(0xc07f); asm volatile("" ::: "memory");
    }
}

__device__ __forceinline__ void phase7(const Params& p) {
    const int tid = threadIdx.x, lane = tid & 63, wid = tid >> 6;
    const int gw = blockIdx.x * NWAVES + wid, NGW = gridDim.x * NWAVES;
    const float* mod = (const float*)(p.ws + WS_MOD);
    const bf16_t* Z = (const bf16_t*)(p.ws + WS_Z); bf16_t* H = (bf16_t*)(p.ws + WS_H);
    const float* gpm = p.in[7]; const float* gpf = p.in[8];
    for (int m = gw; m < TL; m += NGW) {
        const int b = m / SEQ;
        const float* mb = mod + (size_t)b * 12288;
        const float* gt1 = mb + 4096, * sh2 = mb + 6144, * sc2 = mb + 8192;
        f32x4 z[8]; float ss = 0.f;
#pragma unroll
        for (int j = 0; j < 8; ++j) {
            const u32x2 w = *(const u32x2*)(Z + (size_t)m * DM + j * 256 + lane * 4);
            z[j] = (f32x4){__uint_as_float(w.x << 16), __uint_as_float(w.x & 0xffff0000u), __uint_as_float(w.y << 16), __uint_as_float(w.y & 0xffff0000u)};
            ss += z[j][0] * z[j][0] + z[j][1] * z[j][1] + z[j][2] * z[j][2] + z[j][3] * z[j][3];
        }
        const float rz = rsqrtf(wave_sum(ss) * (1.f / DM) + EPS);
        float s2 = 0.f;
#pragma unroll
        for (int j = 0; j < 8; ++j) {
            const int c = j * 256 + lane * 4;
            const f32x4 xv = *(const f32x4*)(p.in[0] + (size_t)m * DM + c);
            const f32x4 x1 = xv + *(const f32x4*)(gt1 + c) * (z[j] * rz * *(const f32x4*)(gpm + c));
            *(f32x4*)(p.out + (size_t)m * DM + c) = x1;
            z[j] = x1; s2 += x1[0] * x1[0] + x1[1] * x1[1] + x1[2] * x1[2] + x1[3] * x1[3];
        }
        const float rx = rsqrtf(wave_sum(s2) * (1.f / DM) + EPS);
#pragma unroll
        for (int j = 0; j < 8; ++j) {
            const int c = j * 256 + lane * 4;
            const f32x4 o = (z[j] * rx * *(const f32x4*)(gpf + c)) * (*(const f32x4*)(sc2 + c) + 1.f) + *(const f32x4*)(sh2 + c);
            store_bf4(H + (size_t)m * DM + c, o);
        }
    }
}

template <int NPER>
__device__ __forceinline__ void wave_top16(float (&v)[NPER], const int (&idx)[NPER], float& outv, int& outi, int lane) {
    outv = -INFINITY; outi = 0;
    for (int r = 0; r < 16; ++r) {
        float bv = v[0]; int bi = idx[0];
#pragma unroll
        for (int e = 1; e < NPER; ++e) if (v[e] > bv || (v[e] == bv && idx[e] < bi)) { bv = v[e]; bi = idx[e]; }
#pragma unroll
        for (int o = 32; o >= 1; o >>= 1) {
            const float ov = __shfl_xor(bv, o); const int oi = __shfl_xor(bi, o);
            if (ov > bv || (ov == bv && oi < bi)) { bv = ov; bi = oi; }
        }
#pragma unroll
        for (int e = 0; e < NPER; ++e) if (idx[e] == bi) v[e] = -INFINITY;
        if (lane == r) { outv = bv; outi = bi; }
    }
}

__device__ __forceinline__ void peer_topk_naive(const Params& p, unsigned char* lds) {
    const int tid = threadIdx.x, lane = tid & 63, wid = tid >> 6;
    const int gw = blockIdx.x * NWAVES + wid, NGW = gridDim.x * NWAVES;
    const bf16_t* QP = (const bf16_t*)(p.ws + WS_QP); const bf16_t* SK = (const bf16_t*)(p.ws + WS_SUBK);
    float* TKV = (float*)(p.ws + WS_TKV); int* TKI = (int*)(p.ws + WS_TKI);
    float* qs = (float*)lds + wid * 128;
    for (int it = gw; it < TL * 16; it += NGW) {
        const int hp = it & 15, m = it >> 4;
        qs[lane] = bf2f(QP[(size_t)m * DM + hp * 128 + lane]); qs[lane + 64] = bf2f(QP[(size_t)m * DM + hp * 128 + 64 + lane]);
        __builtin_amdgcn_s_waitcnt(0xc07f); asm volatile("" ::: "memory");
        float v[2]; int idx[2];
#pragma unroll
        for (int i = 0; i < 2; ++i) {
            const int n = lane + 64 * i; const bf16_t* kp = SK + (size_t)(hp * 128 + n) * 128;
            float d = 0.f;
#pragma unroll
            for (int e = 0; e < 16; ++e) d += dot_bf16x8(*(const bf16x8*)(kp + e * 8), qs + e * 8);
            v[i] = d; idx[i] = n;
        }
        float ov; int oi; wave_top16<2>(v, idx, ov, oi, lane);
        if (lane < 16) { TKV[(size_t)it * 16 + lane] = ov; TKI[(size_t)it * 16 + lane] = oi; }
        __builtin_amdgcn_s_waitcnt(0xc07f); asm volatile("" ::: "memory");
    }
}

__device__ __forceinline__ void peer_final_naive(const Params& p, unsigned char* lds) {
    const int tid = threadIdx.x, lane = tid & 63, wid = tid >> 6;
    const float* TKV = (const float*)(p.ws + WS_TKV); const int* TKI = (const int*)(p.ws + WS_TKI);
    const bf16_t* H = (const bf16_t*)(p.ws + WS_H);
    const float* U = p.in[21]; const float* V = p.in[22];
    const float* mod = (const float*)(p.ws + WS_MOD); const float* gpo = p.in[9];
    float* part = (float*)lds;
    float* red = part + 8 * 2048;
    for (int m = blockIdx.x; m < TL; m += gridDim.x) {
        const int b = m / SEQ, h = wid;
        const float* v1 = TKV + ((size_t)m * 16 + h * 2) * 16; const float* v2 = v1 + 16;
        const int* i1 = TKI + ((size_t)m * 16 + h * 2) * 16; const int* i2 = i1 + 16;
        float cv[4]; int ci[4];
        const float v2j = v2[lane & 15];
#pragma unroll
        for (int e = 0; e < 4; ++e) { const int i = (lane >> 4) + 4 * e; cv[e] = v1[i] + v2j; ci[e] = i * 16 + (lane & 15); }
        float tv; int tc; wave_top16<4>(cv, ci, tv, tc, lane);
        int eid = 0; float gate = 0.f;
        if (lane < 16) eid = i1[tc >> 4] * 128 + i2[tc & 15];
        const float mx = __shfl(tv, 0);
        const float ex = lane < 16 ? __expf(tv - mx) : 0.f;
        gate = ex / wave_sum(ex);
        f32x4 hv[8];
#pragma unroll
        for (int j = 0; j < 8; ++j) { const u32x2 w = *(const u32x2*)(H + (size_t)m * DM + j * 256 + lane * 4);
            hv[j] = (f32x4){__uint_as_float(w.x << 16), __uint_as_float(w.x & 0xffff0000u), __uint_as_float(w.y << 16), __uint_as_float(w.y & 0xffff0000u)}; }
        f32x4 acc[8];
#pragma unroll
        for (int j = 0; j < 8; ++j) acc[j] = (f32x4){0.f, 0.f, 0.f, 0.f};
        for (int k = 0; k < 16; ++k) {
            const int e = __shfl(eid, k); const float g = __shfl(gate, k);
            const float* ur = U + (size_t)e * DM + lane * 4; const float* vr = V + (size_t)e * DM + lane * 4;
            float d = 0.f;
#pragma unroll
            for (int j = 0; j < 8; ++j) { const f32x4 u = *(const f32x4*)(ur + j * 256); d += u[0] * hv[j][0] + u[1] * hv[j][1] + u[2] * hv[j][2] + u[3] * hv[j][3]; }
            d = wave_sum(d);
            const float coef = g * gelu_erf(d);
#pragma unroll
            for (int j = 0; j < 8; ++j) acc[j] += *(const f32x4*)(vr + j * 256) * coef;
        }
        __syncthreads();
#pragma unroll
        for (int j = 0; j < 8; ++j) *(f32x4*)(part + wid * 2048 + j * 256 + lane * 4) = acc[j];
        __syncthreads();
        f32x4 y = (f32x4){0.f, 0.f, 0.f, 0.f};
#pragma unroll
        for (int w = 0; w < 8; ++w) y += *(const f32x4*)(part + w * 2048 + tid * 4);
        float ss = wave_sum(y[0] * y[0] + y[1] * y[1] + y[2] * y[2] + y[3] * y[3]);
        if (lane == 0) red[wid] = ss;
        __syncthreads();
        float tot = 0.f;
#pragma unroll
        for (int w = 0; w < 8; ++w) tot += red[w];
        const float rstd = rsqrtf(tot * (1.f / DM) + EPS);
        const int c = tid * 4;
        const f32x4 gt2 = *(const f32x4*)(mod + (size_t)b * 12288 + 10240 + c);
        float* op = p.out + (size_t)m * DM + c;
        const f32x4 x1 = *(const f32x4*)op;
        *(f32x4*)op = x1 + gt2 * (y * rstd * *(const f32x4*)(gpo + c));
    }
}

__global__ void __launch_bounds__(NTHREADS, 2) mega(Params p) {
    extern __shared__ __attribute__((aligned(16))) unsigned char lds[];
    cg::grid_group grid = cg::this_grid();
    unsigned char* ws = p.ws;
    bf16_t* H = (bf16_t*)(ws + WS_H); bf16_t* PL = (bf16_t*)(ws + WS_PL); bf16_t* PCx = (bf16_t*)(ws + WS_PC);
    const int lo = p.ph_lo, hi = p.ph_hi;
#ifdef PHONLY
#define IN(k) ((k) == PHONLY && lo <= (k) && (k) < hi)
#else
#define IN(k) (lo <= (k) && (k) < hi)
#endif
#define SEAM(k) do { if (IN(k) && IN((k) + 1)) { asm volatile("s_waitcnt vmcnt(0) lgkmcnt(0)" ::: "memory"); grid.sync(); if (threadIdx.x < 64) { __builtin_amdgcn_fence(__ATOMIC_ACQUIRE, "agent"); asm volatile("s_waitcnt vmcnt(0)" ::: "memory"); } __syncthreads(); } } while (0)
    if (IN(0)) phase0(p, lds);
    SEAM(0);
    if (IN(1)) phase1(p);
    SEAM(1);
    if (IN(2)) {
        { EpiInproj e{PL, NP, PC_GA}; ngemm(H, DM, (const bf16_t*)(ws + WS_WIN), DM, TL, NP, DM, e); }
        { EpiInproj e{PCx, NPC, 1 << 30}; ngemm(H + (size_t)TL * DM, DM, (const bf16_t*)(ws + WS_WIN), DM, TC, NPC, DM, e); }
    }
    SEAM(2);
    if (IN(3)) {
        { EpiMlaQ e{(bf16_t*)(ws + WS_QM)}; ngemm(PL + PC_CQ, NP, (const bf16_t*)(ws + WS_WQB), QR, TL, MQW, QR, e, (float*)lds); }
        { EpiMlaKV e{(bf16_t*)(ws + WS_KVM), 0}; ngemm(PL + PC_CKV, NP, (const bf16_t*)(ws + WS_WKVB), KVR, TL, MKVW, KVR, e, (float*)lds); }
        { EpiMlaKV e{(bf16_t*)(ws + WS_KVM), TL}; ngemm(PCx + PC_CKV, NPC, (const bf16_t*)(ws + WS_WKVB), KVR, TC, MKVW, KVR, e, (float*)lds); __syncthreads(); }
        kpe_pass(p);
        na_naive(p, lds);
    }
    SEAM(3);
    if (IN(4)) mla_naive(p, lds);
    SEAM(4);
    if (IN(5)) {
        { EpiMerge<0> e{H, PL}; ngemm((const bf16_t*)(ws + WS_OA), 1024, (const bf16_t*)(ws + WS_WA), 1024, TL, DM, 1024, e); }
        { EpiMerge<1> e{H, PL}; ngemm((const bf16_t*)(ws + WS_OB), 1024, (const bf16_t*)(ws + WS_WB), 1024, TL, DM, 1024, e); }
    }
    SEAM(5);
    if (IN(6)) { EpiStore e{(bf16_t*)(ws + WS_Z), DM}; ngemm(H, DM, (const bf16_t*)(ws + WS_WO), DM, TL, DM, DM, e); }
    SEAM(6);
    if (IN(7)) phase7(p);
    SEAM(7);
    if (IN(8)) { EpiStore e{(bf16_t*)(ws + WS_QP), DM}; ngemm(H, DM, (const bf16_t*)(ws + WS_WPQ), DM, TL, DM, DM, e); }
    SEAM(8);
    if (IN(9)) peer_topk_naive(p, lds);
    SEAM(9);
    if (IN(10)) peer_final_naive(p, lds);
#undef IN
#undef SEAM
}

extern "C" void kernel_launch(void* const* d_in, const int* in_sizes, int n_in, void* d_out, int out_size, void* d_ws, size_t ws_size, hipStream_t stream) {
    static int grid = 0;
    if (grid == 0) {
        int dev = 0, cus = 0, per_cu = 0;
        (void)hipGetDevice(&dev);
        (void)hipDeviceGetAttribute(&cus, hipDeviceAttributeMultiprocessorCount, dev);
        (void)hipFuncSetAttribute((const void*)mega, hipFuncAttributeMaxDynamicSharedMemorySize, LDS_BYTES);
        (void)hipOccupancyMaxActiveBlocksPerMultiprocessor(&per_cu, (const void*)mega, NTHREADS, LDS_BYTES);
        if (per_cu < 1) { fprintf(stderr, "occupancy query says %d blocks per CU\n", per_cu); per_cu = 1; }
        grid = cus * 1;
        (void)hipGetLastError();
        if (n_in != 23 || ws_size < WS_END) fprintf(stderr, "kernel_launch: unexpected n_in %d or ws %zu\n", n_in, ws_size);
    }
    Params p{};
    for (int i = 0; i < 23; ++i) p.in[i] = (const float*)d_in[i];
    p.out = (float*)d_out; p.ws = (unsigned char*)d_ws; p.ph_lo = 0; p.ph_hi = 11;
    void* args[] = {&p};
    hipError_t e = hipLaunchCooperativeKernel((const void*)mega, dim3(grid), dim3(NTHREADS), args, LDS_BYTES, stream);
    if (e != hipSuccess) fprintf(stderr, "cooperative launch failed: %s (grid %d)\n", hipGetErrorString(e), grid);
}
```

```cpp
#include <hip/hip_runtime.h>
#include <hip/hip_cooperative_groups.h>
#include <cstdio>
#include <cstdint>
namespace cg = cooperative_groups;

typedef unsigned short bf16_t;
typedef short bf16x8 __attribute__((ext_vector_type(8)));
typedef float f32x4 __attribute__((ext_vector_type(4)));
typedef unsigned u32x4 __attribute__((ext_vector_type(4)));
typedef unsigned u32x2 __attribute__((ext_vector_type(2)));

constexpr int DM = 2048, NB = 8, SEQ = 2048, CTX = 256, GW = 64, GROWS = 32;
constexpr int TL = NB * SEQ;
constexpr int TC = NB * CTX;
constexpr int TA = TL + TC;
constexpr int IN_COLS = 8512;
constexpr int NP = 8704;
constexpr int NPC = 2816;
constexpr int PC_KA = 0, PC_VA = 1024, PC_CKV = 2048, PC_KPE = 2560, PC_QA = 2816, PC_CQ = 3840, PC_GA = 4608, PC_GB = 6656;
constexpr int QR = 768, KVR = 512;
constexpr int MQW = 1536, MKVW = 2048;
constexpr float EPS = 1e-6f;
constexpr float LOG2E = 1.4426950408889634f;
constexpr float MLA_QSCALE = 0.07216878364870322f * LOG2E;
constexpr float NA_SCALE = 0.125f;

constexpr size_t al256(size_t x) { return (x + 255) & ~(size_t)255; }
constexpr size_t WS_MOD = 0;
constexpr size_t WS_ROPE = al256(WS_MOD + 9 * 12288 * 4);
constexpr size_t WS_BAR = al256(WS_ROPE + (size_t)SEQ * 32 * 2 * 4);
constexpr size_t WS_WIN = al256(WS_BAR + 3456 * 4);
constexpr size_t WS_WQB = WS_WIN + (size_t)NP * DM * 2;
constexpr size_t WS_WKVB = WS_WQB + (size_t)MQW * QR * 2;
constexpr size_t WS_WA = WS_WKVB + (size_t)MKVW * KVR * 2;
constexpr size_t WS_WB = WS_WA + (size_t)DM * 1024 * 2;
constexpr size_t WS_WO = WS_WB + (size_t)DM * 1024 * 2;
constexpr size_t WS_WPQ = WS_WO + (size_t)DM * DM * 2;
constexpr size_t WS_SUBK = WS_WPQ + (size_t)DM * DM * 2;
constexpr size_t WS_H = WS_SUBK + (size_t)262144 * 2;
constexpr size_t WS_PL = WS_H + (size_t)TA * DM * 2;
constexpr size_t WS_PC = WS_PL + (size_t)TL * NP * 2;
constexpr size_t WS_QM = WS_PC + (size_t)TC * NPC * 2;
constexpr size_t WS_KVM = WS_QM + (size_t)TL * MQW * 2;
constexpr size_t WS_KPE = WS_KVM + (size_t)TA * MKVW * 2;
constexpr size_t WS_OA = WS_KPE + (size_t)TA * 64 * 2;
constexpr size_t WS_OB = WS_OA + 1024 * 2;
constexpr size_t WS_END = WS_OA + (size_t)TL * 2048 * 2;
constexpr size_t WS_Z = WS_PL;
constexpr size_t WS_QP = WS_PL + (size_t)TL * DM * 2;
constexpr size_t WS_TKV = WS_QP + (size_t)TL * DM * 2;
constexpr size_t WS_TKI = WS_TKV + (size_t)TL * 256 * 4;
constexpr size_t WS_UB = WS_QM;
constexpr size_t WS_VB = WS_UB + (size_t)16384 * DM * 2;
constexpr size_t WS_UQ = WS_QM;
constexpr size_t WS_VQ = WS_UQ + (size_t)16384 * DM;
constexpr size_t WS_USC = WS_VQ + (size_t)16384 * DM;
constexpr size_t WS_VSC = WS_USC + 16384 * 4;
static_assert(WS_TKI + (size_t)TL * 256 * 4 <= WS_PC, "overlay");
static_assert(WS_END <= 650307648ull, "workspace");
static_assert(WS_VB + (size_t)16384 * DM * 2 <= WS_END, "expert table overlay");

constexpr int NTHREADS = 512, NWAVES = 8;
constexpr int LDS_BYTES = 139264;

struct Params {
    const float* in[23];
    float* out;
    unsigned char* ws;
    int ph_lo, ph_hi;
};

__device__ __forceinline__ float bf2f(bf16_t v) { return __uint_as_float((unsigned)v << 16); }
__device__ __forceinline__ unsigned f2bf(float f) { unsigned u = __float_as_uint(f); return (u + 0x7fffu + ((u >> 16) & 1u)) >> 16; }
__device__ __forceinline__ unsigned pk2(float lo, float hi) { return f2bf(lo) | (f2bf(hi) << 16); }
__device__ __forceinline__ float wave_sum(float v) {
#pragma unroll
    for (int o = 1; o < 64; o <<= 1) v += __shfl_xor(v, o);
    return v;
}
__device__ __forceinline__ float wave_sum_dpp(float v) {
    v += __builtin_bit_cast(float, __builtin_amdgcn_update_dpp(0, __builtin_bit_cast(int, v), 0xB1, 0xF, 0xF, false));
    v += __builtin_bit_cast(float, __builtin_amdgcn_update_dpp(0, __builtin_bit_cast(int, v), 0x4E, 0xF, 0xF, false));
    v += __builtin_bit_cast(float, __builtin_amdgcn_update_dpp(0, __builtin_bit_cast(int, v), 0x141, 0xF, 0xF, false));
    v += __builtin_bit_cast(float, __builtin_amdgcn_update_dpp(0, __builtin_bit_cast(int, v), 0x140, 0xF, 0xF, false));
    v += __builtin_bit_cast(float, __builtin_amdgcn_update_dpp(0, __builtin_bit_cast(int, v), 0x142, 0xA, 0xF, false));
    v += __builtin_bit_cast(float, __builtin_amdgcn_update_dpp(0, __builtin_bit_cast(int, v), 0x143, 0xC, 0xF, false));
    return __builtin_bit_cast(float, __builtin_amdgcn_readlane(__builtin_bit_cast(int, v), 63));
}
__device__ __forceinline__ float wave_max(float v) {
#pragma unroll
    for (int o = 1; o < 64; o <<= 1) v = fmaxf(v, __shfl_xor(v, o));
    return v;
}
__device__ __forceinline__ float sigmoidf_(float x) { return 1.f / (1.f + __expf(-x)); }
__device__ __forceinline__ float silu_(float x) { return x / (1.f + __expf(-x)); }
__device__ __forceinline__ float gelu_erf(float x) { return 0.5f * x * (1.f + erff(x * 0.70710678118654752f)); }

__device__ __forceinline__ float gelu_as(float v) {
    const float t = __builtin_amdgcn_rcpf(fabsf(v) * 0.2316418882f + 1.0f);
    float q = t * 0.5307027145f + (-0.7265760135f); q = q * t + 0.7107068705f; q = q * t + (-0.142248368f); q = q * t + 0.127414796f; q = q * t;
    const float e = __builtin_amdgcn_exp2f((v * v) * (-0.72134752044f));
    const float mm = v * (q * e);
    return v < 0.f ? mm : v - mm;
}
__device__ __forceinline__ void rope_cs(int s, int j, float& c, float& sn) {
    const int gr = s >> 6, gc = s & 63;
    const int i = j & 15;
    const float invf = exp2f(-(float)i * (13.287712379549449f / 16.f));
    const float ang = (float)(j < 16 ? gr : gc) * invf;
    sincosf(ang, &sn, &c);
}

template <class Epi>
__device__ __forceinline__ void ngemm(const bf16_t* __restrict__ A, int lda, const bf16_t* __restrict__ Bt, int ldb, int M, int N, int K, const Epi& epi, float* rs = nullptr) {
    int tid_ = threadIdx.x; asm volatile("" : "+v"(tid_)); const int tid = tid_, wid = tid >> 6, lane = tid & 63, fr = lane & 15, fq = lane >> 4;
    const int tilesM = M / 128, tilesN = N / 256, nt = tilesM * tilesN;
    for (int t = blockIdx.x; t < nt; t += gridDim.x) {
        const int tm = t % tilesM, tn = t / tilesM;
        const int row0 = tm * 128 + (wid >> 2) * 64, col0 = tn * 256 + (wid & 3) * 64;
        if (Epi::PRO) {
            __syncthreads();
            const int r = tid >> 2, part = tid & 3, len = K >> 2;
            const bf16_t* ar = A + (size_t)(tm * 128 + r) * lda + part * len;
            float ss = 0.f;
            for (int k = 0; k < len; k += 8) { const bf16x8 v = *(const bf16x8*)(ar + k);
#pragma unroll
                for (int e = 0; e < 8; ++e) { const float f = bf2f((bf16_t)v[e]); ss += f * f; } }
            ss += __shfl_xor(ss, 1); ss += __shfl_xor(ss, 2);
            if (part == 0) rs[r] = rsqrtf(ss / (float)K + EPS);
            __syncthreads();
        }
        f32x4 acc[4][4];
#pragma unroll
        for (int i = 0; i < 4; ++i)
#pragma unroll
            for (int j = 0; j < 4; ++j) acc[i][j] = (f32x4){0.f, 0.f, 0.f, 0.f};
        const bf16_t* ap = A + (size_t)(row0 + fr) * lda + fq * 8;
        const bf16_t* bp = Bt + (size_t)(col0 + fr) * ldb + fq * 8;
        for (int k0 = 0; k0 < K; k0 += 32) {
            bf16x8 a[4], b[4];
#pragma unroll
            for (int i = 0; i < 4; ++i) a[i] = *(const bf16x8*)(ap + (size_t)i * 16 * lda + k0);
#pragma unroll
            for (int j = 0; j < 4; ++j) b[j] = *(const bf16x8*)(bp + (size_t)j * 16 * ldb + k0);
#pragma unroll
            for (int i = 0; i < 4; ++i)
#pragma unroll
                for (int j = 0; j < 4; ++j) acc[i][j] = __builtin_amdgcn_mfma_f32_16x16x32_bf16(b[j], a[i], acc[i][j], 0, 0, 0);
        }
#pragma unroll
        for (int i = 0; i < 4; ++i) {
            const int row = row0 + i * 16 + fr;
            const float rstd = Epi::PRO ? rs[row - tm * 128] : 1.f;
#pragma unroll
            for (int j = 0; j < 4; ++j) epi.quad(row, col0 + j * 16 + 4 * fq, acc[i][j] * rstd);
        }
    }
}

__device__ __forceinline__ void store_bf4(bf16_t* p, f32x4 v) { u32x2 w; w.x = pk2(v[0], v[1]); w.y = pk2(v[2], v[3]); *(u32x2*)p = w; }
__device__ __forceinline__ void store_bf8(bf16_t* p, f32x4 a, f32x4 b) { u32x4 w; w.x = pk2(a[0], a[1]); w.y = pk2(a[2], a[3]); w.z = pk2(b[0], b[1]); w.w = pk2(b[2], b[3]); *(u32x4*)p = w; }
__device__ __forceinline__ void load_bf8(const bf16_t* p, f32x4& a, f32x4& b) { const u32x4 g = *(const u32x4*)p;
    a = (f32x4){__uint_as_float(g.x << 16), __uint_as_float(g.x & 0xffff0000u), __uint_as_float(g.y << 16), __uint_as_float(g.y & 0xffff0000u)};
    b = (f32x4){__uint_as_float(g.z << 16), __uint_as_float(g.z & 0xffff0000u), __uint_as_float(g.w << 16), __uint_as_float(g.w & 0xffff0000u)}; }

struct EpiInproj {
    static constexpr bool MID = false, PRO = false;
    bf16_t* P; int ldp; int gate0;
    __device__ __forceinline__ void quad(int row, int col, f32x4 v) const {
        if (col >= gate0) { v[0] = sigmoidf_(v[0]); v[1] = sigmoidf_(v[1]); v[2] = sigmoidf_(v[2]); v[3] = sigmoidf_(v[3]); }
        store_bf4(P + (size_t)row * ldp + col, v);
    }
    __device__ __forceinline__ void oct(int row, int col, f32x4 a, f32x4 b) const {
        if (col >= gate0) {
#pragma unroll
            for (int e = 0; e < 4; ++e) { a[e] = sigmoidf_(a[e]); b[e] = sigmoidf_(b[e]); } }
        store_bf8(P + (size_t)row * ldp + col, a, b);
    }
};
struct EpiMlaQ {
    static constexpr bool MID = false, PRO = true;
    bf16_t* Q; const float* rope;
    __device__ __forceinline__ void quad(int row, int col, f32x4 v) const {
        v = v * MLA_QSCALE;
        const int d = col % 192;
        if (d >= 128) {
            const int j = (d - 128) >> 1, s = row & (SEQ - 1);
            const f32x4 cs = *(const f32x4*)(rope + ((size_t)s * 32 + j) * 2);
            const f32x4 o = {v[0] * cs[0] - v[1] * cs[1], v[0] * cs[1] + v[1] * cs[0], v[2] * cs[2] - v[3] * cs[3], v[2] * cs[3] + v[3] * cs[2]};
            v = o;
        }
        store_bf4(Q + (size_t)row * MQW + col, v);
    }
    __device__ __forceinline__ void oct(int row, int col, f32x4 a, f32x4 b) const {
        a = a * MLA_QSCALE; b = b * MLA_QSCALE;
        const int d = col % 192;
        if (d >= 128) {
            const int j = (d - 128) >> 1, s = row & (SEQ - 1);
            const f32x4 c0 = *(const f32x4*)(rope + ((size_t)s * 32 + j) * 2), c1 = *(const f32x4*)(rope + ((size_t)s * 32 + j + 2) * 2);
            const f32x4 oa = {a[0] * c0[0] - a[1] * c0[1], a[0] * c0[1] + a[1] * c0[0], a[2] * c0[2] - a[3] * c0[3], a[2] * c0[3] + a[3] * c0[2]};
            const f32x4 ob = {b[0] * c1[0] - b[1] * c1[1], b[0] * c1[1] + b[1] * c1[0], b[2] * c1[2] - b[3] * c1[3], b[2] * c1[3] + b[3] * c1[2]};
            a = oa; b = ob;
        }
        store_bf8(Q + (size_t)row * MQW + col, a, b);
    }
};
struct EpiMlaKV {
    static constexpr bool MID = false, PRO = true;
    bf16_t* KV; int row_off;
    __device__ __forceinline__ void quad(int row, int col, f32x4 v) const { store_bf4(KV + (size_t)(row_off + row) * MKVW + col, v); }
    __device__ __forceinline__ void oct(int row, int col, f32x4 a, f32x4 b) const { store_bf8(KV + (size_t)(row_off + row) * MKVW + col, a, b); }
};
template <int STEP> struct EpiMerge {
    static constexpr bool MID = false, PRO = false;
    bf16_t* Y; const bf16_t* P;
    __device__ __forceinline__ void quad(int row, int col, f32x4 v) const {
        const u32x2 g = *(const u32x2*)(P + (size_t)row * NP + (STEP == 0 ? PC_GA : PC_GB) + col);
        const f32x4 gv = {__uint_as_float(g.x << 16), __uint_as_float(g.x & 0xffff0000u), __uint_as_float(g.y << 16), __uint_as_float(g.y & 0xffff0000u)};
        v = v * gv;
        if (STEP == 1) {
            const u32x2 y = *(const u32x2*)(Y + (size_t)row * DM + col);
            v[0] += __uint_as_float(y.x << 16); v[1] += __uint_as_float(y.x & 0xffff0000u); v[2] += __uint_as_float(y.y << 16); v[3] += __uint_as_float(y.y & 0xffff0000u);
        }
        store_bf4(Y + (size_t)row * DM + col, v);
    }
};
struct EpiMergeF {
    static constexpr bool MID = true, PRO = false;
    bf16_t* Y; const bf16_t* P;
    __device__ __forceinline__ static f32x4 ld4(const bf16_t* q) { const u32x2 g = *(const u32x2*)q;
        return (f32x4){__uint_as_float(g.x << 16), __uint_as_float(g.x & 0xffff0000u), __uint_as_float(g.y << 16), __uint_as_float(g.y & 0xffff0000u)}; }
    __device__ __forceinline__ void midquad(int row, int col, f32x4& v) const {
        const f32x4 ga = ld4(P + (size_t)row * NP + PC_GA + col), gb = ld4(P + (size_t)row * NP + PC_GB + col);
#pragma unroll
        for (int e = 0; e < 4; ++e) v[e] *= ga[e] * __builtin_amdgcn_rcpf(fmaxf(gb[e], 1e-30f));
    }
    __device__ __forceinline__ void quad(int row, int col, f32x4 v) const { store_bf4(Y + (size_t)row * DM + col, v * ld4(P + (size_t)row * NP + PC_GB + col)); }
    __device__ __forceinline__ void midload(int row, int col, u32x4& ga, u32x4& gb) const { ga = *(const u32x4*)(P + (size_t)row * NP + PC_GA + col); gb = *(const u32x4*)(P + (size_t)row * NP + PC_GB + col); }
    __device__ __forceinline__ static void midapply(const u32x4 ga, const u32x4 gb, f32x4& a, f32x4& b) {
        const unsigned a0 = ga[0], a1 = ga[1], a2 = ga[2], a3 = ga[3], b0 = gb[0], b1 = gb[1], b2 = gb[2], b3 = gb[3];
        const f32x4 sa0 = {__uint_as_float(a0 << 16), __uint_as_float(a0 & 0xffff0000u), __uint_as_float(a1 << 16), __uint_as_float(a1 & 0xffff0000u)};
        const f32x4 sa1 = {__uint_as_float(a2 << 16), __uint_as_float(a2 & 0xffff0000u), __uint_as_float(a3 << 16), __uint_as_float(a3 & 0xffff0000u)};
        const f32x4 sb0 = {__uint_as_float(b0 << 16), __uint_as_float(b0 & 0xffff0000u), __uint_as_float(b1 << 16), __uint_as_float(b1 & 0xffff0000u)};
        const f32x4 sb1 = {__uint_as_float(b2 << 16), __uint_as_float(b2 & 0xffff0000u), __uint_as_float(b3 << 16), __uint_as_float(b3 & 0xffff0000u)};
#pragma unroll
        for (int e = 0; e < 4; ++e) { a[e] *= sa0[e] * __builtin_amdgcn_rcpf(fmaxf(sb0[e], 1e-30f)); b[e] *= sa1[e] * __builtin_amdgcn_rcpf(fmaxf(sb1[e], 1e-30f)); }
    }
    __device__ __forceinline__ void oct(int row, int col, f32x4 a, f32x4 b) const { f32x4 g0, g1; load_bf8(P + (size_t)row * NP + PC_GB + col, g0, g1); store_bf8(Y + (size_t)row * DM + col, a * g0, b * g1); }
};
struct EpiStore {
    static constexpr bool MID = false, PRO = false;
    bf16_t* O; int ldo;
    __device__ __forceinline__ void quad(int row, int col, f32x4 v) const { store_bf4(O + (size_t)row * ldo + col, v); }
    __device__ __forceinline__ void oct(int row, int col, f32x4 a, f32x4 b) const { store_bf8(O + (size_t)row * ldo + col, a, b); }
};

namespace pg8 {
#define PG8_LAS __attribute__((address_space(3)))
constexpr int BM = 256, BK = 64, HALF = 128, HTB = HALF * BK * 2  , STAGE_BYTES = 8 * HTB, NXCD = 8, WGM = 8;

__host__ __device__ __forceinline__ int lds_byte(int r, int c) { const int st = (r >> 4) * 2 + (c >> 5), rr = r & 15, cc = c & 31, ob = rr * 64 + cc * 2; return st * 1024 + (ob ^ (((ob >> 9) & 1) << 5)); }
__host__ __device__ __forceinline__ void stage_rc(int b, int& R, int& C) { const int st = b / 1024, sb = b % 1024, swz = sb ^ (((sb >> 9) & 1) << 5); R = (st >> 1) * 16 + swz / 64; C = (st & 1) * 32 + (swz % 64) / 2; }
__host__ __device__ __forceinline__ int perm32(int rho) { const int n = rho >> 4, i = rho & 15; return 8 * (i >> 2) + 4 * n + (i & 3); }

struct Unit { int pm, pn, ui; };
struct Gemm { const bf16_t* A; const bf16_t* Bt; int M, N, K, lda, ldb; };

struct StaticOrder {
    int nM, nN, nwg, G, c;
    __host__ __device__ void init(int M, int N, int G_, int c_) { nM = M / BM; nN = N / BM; nwg = nM * nN; G = G_; c = c_; }
    __host__ __device__ bool next(int i, Unit& u) const {
        const long L = (long)i * G + c; if (L >= nwg) return false;
        int wgid = (int)L; { const int q = nwg / NXCD, r = nwg % NXCD, xcd = wgid % NXCD, off = wgid / NXCD; wgid = (xcd < r ? xcd * (q + 1) : r * (q + 1) + (xcd - r) * q) + off; }
        const int nig = WGM * nN, gid = wgid / nig, fm = gid * WGM, gsz = (nM - fm) < WGM ? (nM - fm) : WGM;
        u.pm = fm + ((wgid % nig) % gsz); u.pn = (wgid % nig) / gsz; u.ui = i; return true;
    }
    __device__ __forceinline__ void a_ready(const Unit&) const {}
    __device__ __forceinline__ void done(const Unit&) const {}
};
template <class Epi, class Sched, bool ALIGN_EPI = false, bool SP2 = false>
__device__ __forceinline__ void gemm_phase(PG8_LAS unsigned char* lds, const Gemm g, const Sched& S, const Epi& E) {
    int tid_ = threadIdx.x; asm volatile("" : "+v"(tid_)); const int tid = tid_, wid = __builtin_amdgcn_readfirstlane(tid >> 6), lane = tid & 63, wr = wid >> 2, wc = wid & 3, fr = lane & 15, fq = lane >> 4;
    const int K = g.K, nt = K / BK;
    unsigned voffA[2], voffB[2];
#pragma unroll
    for (int i = 0; i < 2; ++i) { int R, C; stage_rc(tid * 16 + i * 8192, R, C); const int Rb = Epi::PERM ? ((R & ~31) + perm32(R & 31)) : R;
        voffA[i] = (unsigned)(R * g.lda + C) * 2u; voffB[i] = (unsigned)(Rb * g.ldb + C) * 2u; }
    const size_t kstep = (size_t)(BK * 2);
    const size_t hstepA = (size_t)HALF * g.lda * 2, hstepB = (size_t)HALF * g.ldb * 2;
    const size_t tstepA = 2 * hstepA, tstepB = 2 * hstepB;
    const unsigned ldsw = (unsigned)wid * 1024u;
    const int aoff = lds_byte(wr * 64 + fr, fq * 8), boff = lds_byte(wc * 32 + fr, fq * 8);
#define PG8_SA(b, h) (((b) * 2 + (h)) * HTB)
#define PG8_SB(b, h) ((4 + (b) * 2 + (h)) * HTB)
#define PG8_STAGE(bufoff, gbase, voff) do { _Pragma("unroll") for (int _i = 0; _i < 2; ++_i) \
        __builtin_amdgcn_global_load_lds((const unsigned*)((const char*)(gbase) + (voff)[_i]), (PG8_LAS unsigned*)(lds + (bufoff) + ldsw + _i * 8192), 16, 0, 0); } while (0)
#define PG8_LDA(dst, b, h) do { _Pragma("unroll") for (int m = 0; m < 4; ++m) _Pragma("unroll") for (int k = 0; k < 2; ++k) dst[m][k] = *(const PG8_LAS bf16x8*)(lds + PG8_SA(b, h) + aoff + m * 2048 + k * 1024); } while (0)
#define PG8_LDB(dst, b, h) do { _Pragma("unroll") for (int n = 0; n < 2; ++n) _Pragma("unroll") for (int k = 0; k < 2; ++k) dst[n][k] = *(const PG8_LAS bf16x8*)(lds + PG8_SB(b, h) + boff + n * 2048 + k * 1024); } while (0)
#define PG8_MMA(ai, bj, At, Bt) do { __builtin_amdgcn_s_setprio(1); _Pragma("unroll") for (int m = 0; m < 4; ++m) _Pragma("unroll") for (int n = 0; n < 2; ++n) _Pragma("unroll") for (int k = 0; k < 2; ++k) \
        acc[ai][bj][m][n] = __builtin_amdgcn_mfma_f32_16x16x32_bf16(Bt[n][k], At[m][k], acc[ai][bj][m][n], 0, 0, 0); __builtin_amdgcn_s_setprio(0); } while (0)
#define PG8_WAIT_V(n) asm volatile("s_waitcnt vmcnt(" #n ")" ::: "memory")
#define PG8_WAIT_L(n) asm volatile("s_waitcnt lgkmcnt(" #n ")" ::: "memory")
#define PG8_BAR __builtin_amdgcn_s_barrier()
#define PG8_SCHED __builtin_amdgcn_sched_barrier(0)
    Unit cur, nxt; int ui = 0;
    if (!S.next(0, cur)) return;
    f32x4 acc[2][2][4][2];
#pragma unroll
    for (int a = 0; a < 2; ++a)
#pragma unroll
        for (int b = 0; b < 2; ++b)
#pragma unroll
            for (int m = 0; m < 4; ++m)
#pragma unroll
                for (int n = 0; n < 2; ++n) acc[a][b][m][n] = (f32x4){0.f, 0.f, 0.f, 0.f};
    bf16x8 At[4][2], B0[2][2], B1[2][2];
    const char* cA = (const char*)g.A + (size_t)cur.pm * tstepA; const char* cB = (const char*)g.Bt + (size_t)cur.pn * tstepB;
    S.a_ready(cur);
    if constexpr (SP2) {
        PG8_STAGE(PG8_SB(0, 0), cB, voffB); PG8_STAGE(PG8_SB(0, 1), cB + hstepB, voffB); PG8_STAGE(PG8_SA(0, 0), cA, voffA); PG8_STAGE(PG8_SA(0, 1), cA + hstepA, voffA);
        if (wr == 1) PG8_BAR;
        PG8_WAIT_V(2); PG8_BAR;
        PG8_STAGE(PG8_SB(1, 0), cB + kstep, voffB); PG8_STAGE(PG8_SA(1, 0), cA + kstep, voffA); PG8_STAGE(PG8_SB(1, 1), cB + hstepB + kstep, voffB);
        PG8_WAIT_V(6); PG8_BAR;
    } else {
        PG8_STAGE(PG8_SB(0, 0), cB, voffB); PG8_STAGE(PG8_SA(0, 0), cA, voffA); PG8_STAGE(PG8_SB(0, 1), cB + hstepB, voffB); PG8_STAGE(PG8_SA(0, 1), cA + hstepA, voffA);
        if (wr == 1) PG8_BAR;
        PG8_WAIT_V(4); PG8_BAR;
        PG8_STAGE(PG8_SB(1, 0), cB + kstep, voffB); PG8_STAGE(PG8_SA(1, 0), cA + kstep, voffA); PG8_STAGE(PG8_SB(1, 1), cB + hstepB + kstep, voffB);
        PG8_WAIT_V(6); PG8_BAR;
    }
    for (;;) {
        const bool has_next = S.next(ui + 1, nxt);
        const char* nA = has_next ? (const char*)g.A + (size_t)nxt.pm * tstepA : cA; const char* nB = has_next ? (const char*)g.Bt + (size_t)nxt.pn * tstepB : cB;
        for (int t = 0; t < nt; t += 2) {
            if constexpr (Epi::MID) { if (t == (nt >> 1)) { E.mid(acc, cur, wr, wc, fr, fq); } }
            const bool last = (t == nt - 2);
            const char* a1 = cA + (size_t)(t + 1) * kstep;
            const char* a2 = last ? nA : cA + (size_t)(t + 2) * kstep; const char* b2 = last ? nB : cB + (size_t)(t + 2) * kstep;
            const char* a3 = a2 + kstep; const char* b3 = b2 + kstep;
            if (last && has_next) S.a_ready(nxt);
            if constexpr (SP2) {
            PG8_LDB(B0, 0, 0); PG8_LDB(B1, 0, 1); PG8_SCHED; PG8_LDA(At, 0, 0); PG8_STAGE(PG8_SA(1, 1), a1 + hstepA, voffA);
            PG8_WAIT_V(8); PG8_WAIT_L(0); PG8_BAR; PG8_MMA(0, 0, At, B0); PG8_MMA(0, 1, At, B1); PG8_BAR; PG8_SCHED;
            PG8_LDA(At, 0, 1); PG8_STAGE(PG8_SB(0, 0), b2, voffB); PG8_STAGE(PG8_SB(0, 1), b2 + hstepB, voffB); PG8_STAGE(PG8_SA(0, 0), a2, voffA);
            PG8_WAIT_V(8); PG8_WAIT_L(0); PG8_BAR; PG8_MMA(1, 0, At, B0); PG8_MMA(1, 1, At, B1); PG8_BAR; PG8_SCHED;
            PG8_LDB(B0, 1, 0); PG8_LDB(B1, 1, 1); PG8_SCHED; PG8_LDA(At, 1, 0); PG8_STAGE(PG8_SA(0, 1), a2 + hstepA, voffA);
            PG8_WAIT_V(8); PG8_WAIT_L(0); PG8_BAR; PG8_MMA(0, 0, At, B0); PG8_MMA(0, 1, At, B1); PG8_BAR; PG8_SCHED;
            PG8_LDA(At, 1, 1); PG8_STAGE(PG8_SB(1, 0), b3, voffB); PG8_STAGE(PG8_SB(1, 1), b3 + hstepB, voffB); PG8_STAGE(PG8_SA(1, 0), a3, voffA);
            PG8_WAIT_V(8); PG8_WAIT_L(0); PG8_BAR; PG8_MMA(1, 0, At, B0); PG8_MMA(1, 1, At, B1); PG8_BAR; PG8_SCHED;
            } else {
            PG8_LDB(B0, 0, 0); PG8_SCHED; PG8_LDA(At, 0, 0); PG8_STAGE(PG8_SA(1, 1), a1 + hstepA, voffA);
            PG8_WAIT_L(8); PG8_BAR; PG8_WAIT_L(0); PG8_MMA(0, 0, At, B0); PG8_BAR; PG8_SCHED;
            PG8_LDB(B1, 0, 1); PG8_STAGE(PG8_SB(0, 0), b2, voffB);
            PG8_BAR; PG8_WAIT_L(0); PG8_MMA(0, 1, At, B1); PG8_BAR;
            PG8_LDA(At, 0, 1); PG8_STAGE(PG8_SA(0, 0), a2, voffA);
            PG8_BAR; PG8_WAIT_L(0); PG8_MMA(1, 0, At, B0); PG8_BAR; PG8_SCHED;
            PG8_STAGE(PG8_SB(0, 1), b2 + hstepB, voffB);
            PG8_WAIT_V(6); PG8_BAR; PG8_MMA(1, 1, At, B1); PG8_BAR;
            PG8_LDB(B0, 1, 0); PG8_SCHED; PG8_LDA(At, 1, 0); PG8_STAGE(PG8_SA(0, 1), a2 + hstepA, voffA);
            PG8_WAIT_L(8); PG8_BAR; PG8_WAIT_L(0); PG8_MMA(0, 0, At, B0); PG8_BAR; PG8_SCHED;
            PG8_LDB(B1, 1, 1); PG8_STAGE(PG8_SB(1, 0), b3, voffB);
            PG8_BAR; PG8_WAIT_L(0); PG8_MMA(0, 1, At, B1); PG8_BAR;
            PG8_LDA(At, 1, 1); PG8_STAGE(PG8_SA(1, 0), a3, voffA);
            PG8_BAR; PG8_WAIT_L(0); PG8_MMA(1, 0, At, B0); PG8_BAR; PG8_SCHED;
            PG8_STAGE(PG8_SB(1, 1), b3 + hstepB, voffB);
            PG8_WAIT_V(6); PG8_BAR; PG8_MMA(1, 1, At, B1); PG8_BAR;
            }
        }
        if constexpr (ALIGN_EPI) { if (wr == 0) PG8_BAR; }
        if constexpr (!Epi::AFTER_DRAIN) { E(acc, cur, wr, wc, fr, fq); S.done(cur); }
        if (!has_next) break;
#pragma unroll
        for (int a = 0; a < 2; ++a)
#pragma unroll
            for (int b = 0; b < 2; ++b)
#pragma unroll
                for (int m = 0; m < 4; ++m)
#pragma unroll
                    for (int n = 0; n < 2; ++n) acc[a][b][m][n] = (f32x4){0.f, 0.f, 0.f, 0.f};
        cur = nxt; cA = nA; cB = nB; ++ui;
        if constexpr (ALIGN_EPI) { if (wr == 1) PG8_BAR; }
    }
    PG8_WAIT_V(0);
    if constexpr (!ALIGN_EPI) { if (wr == 0) PG8_BAR; }
    PG8_BAR;
    if constexpr (Epi::AFTER_DRAIN) { E.fused(acc, cur, wr, wc, fr, fq, lds, wid, lane); S.done(cur); }
#undef PG8_SA
#undef PG8_SB
#undef PG8_STAGE
#undef PG8_LDA
#undef PG8_LDB
#undef PG8_MMA
#undef PG8_WAIT_V
#undef PG8_WAIT_L
#undef PG8_BAR
#undef PG8_SCHED
}
}

template <class Q, bool RS> struct EpiQuad {
    static constexpr bool PERM = true, AFTER_DRAIN = false, MID = Q::MID;
    Q q; const float* rs;
    __device__ __forceinline__ void mid(f32x4 (&acc)[2][2][4][2], const pg8::Unit& u, int wr, int wc, int fr, int fq, bool inv = false) const {
        if constexpr (Q::MID) {
            asm volatile("" : "+v"(fr), "+v"(fq));
#pragma unroll
            for (int ai = 0; ai < 2; ++ai) {
                u32x4 ga[4][2], gb[4][2];
#pragma unroll
                for (int m = 0; m < 4; ++m)
#pragma unroll
                    for (int bj = 0; bj < 2; ++bj) q.midload(u.pm * 256 + ai * 128 + wr * 64 + m * 16 + fr, u.pn * 256 + bj * 128 + wc * 32 + 8 * fq, ga[m][bj], gb[m][bj]);
#pragma unroll
                for (int m = 0; m < 4; ++m)
#pragma unroll
                    for (int bj = 0; bj < 2; ++bj) { if (!inv) q.midapply(ga[m][bj], gb[m][bj], acc[ai][bj][m][0], acc[ai][bj][m][1]); else q.midapply(gb[m][bj], ga[m][bj], acc[ai][bj][m][0], acc[ai][bj][m][1]); }
                __builtin_amdgcn_sched_barrier(0);
            }
        }
    }
    __device__ __forceinline__ void operator()(const f32x4 (&acc)[2][2][4][2], const pg8::Unit& u, int wr, int wc, int fr, int fq) const {
        if constexpr (Q::MID) asm volatile("" : "+v"(fr), "+v"(fq));
#pragma unroll
        for (int ai = 0; ai < 2; ++ai)
#pragma unroll
            for (int m = 0; m < 4; ++m) {
                const int rl = ai * 128 + wr * 64 + m * 16 + fr, row = u.pm * 256 + rl;
                const float r = RS ? rs[u.ui * 256 + rl] : 1.f;
#pragma unroll
                for (int bj = 0; bj < 2; ++bj) q.oct(row, u.pn * 256 + bj * 128 + wc * 32 + 8 * fq, acc[ai][bj][m][0] * r, acc[ai][bj][m][1] * r);
            }
    }
};
__device__ __forceinline__ void unit_row_rstd(const bf16_t* __restrict__ A, int lda, int K, const pg8::StaticOrder& S, float* rs) {
    pg8::Unit u;
    int tid_ = threadIdx.x; asm volatile("" : "+v"(tid_)); const int tid = tid_, r = tid >> 1, part = tid & 1, len = K >> 1;
    for (int i = 0; S.next(i, u); ++i) {
        const bf16_t* ar = A + (size_t)(u.pm * 256 + r) * lda + part * len;
        float ss = 0.f;
        for (int k = 0; k < len; k += 8) { const bf16x8 v = *(const bf16x8*)(ar + k);
#pragma unroll
            for (int e = 0; e < 8; ++e) { const float f = bf2f((bf16_t)v[e]); ss += f * f; } }
        ss += __shfl_xor(ss, 1);
        if (part == 0) rs[i * 256 + r] = rsqrtf(ss / (float)K + EPS);
    }
    __syncthreads();
}
template <class Q, bool RS>
__device__ __forceinline__ void run_gemm(unsigned char* lds, const bf16_t* A, int lda, const bf16_t* Bt, int ldb, int M, int N, int K, const Q& q, int rot = 0) {
    pg8::Gemm g{A, Bt, M, N, K, lda, ldb};
    pg8::StaticOrder S; S.init(M, N, (int)gridDim.x, (int)((blockIdx.x + gridDim.x - (unsigned)rot % gridDim.x) % gridDim.x));
    float* rs = (float*)(lds + 131072);
    if (RS) unit_row_rstd(A, lda, K, S, rs);
    EpiQuad<Q, RS> E{q, rs};
    pg8::gemm_phase<EpiQuad<Q, RS>, pg8::StaticOrder, true, true>((PG8_LAS unsigned char*)lds, g, S, E);
}

__device__ __forceinline__ int win_dest_row(int n) {
    if (n < 1024) return PC_QA + n;
    if (n < 2048) return PC_KA + (n - 1024);
    if (n < 3072) return PC_VA + (n - 2048);
    if (n < 3840) return PC_CQ + (n - 3072);
    if (n < 4352) return PC_CKV + (n - 3840);
    if (n < 4416) { const int r = n - 4352; return PC_KPE + (r < 32 ? 2 * r : 2 * (r - 32) + 1); }
    if (n < 6464) return PC_GA + (n - 4416);
    return PC_GB + (n - 6464);
}
__device__ __forceinline__ int wq_dest_row(int n) {
    const int h = n / 192, d = n % 192;
    if (d < 128) return n;
    const int r = d - 128;
    return h * 192 + 128 + (r < 32 ? 2 * r : 2 * (r - 32) + 1);
}
template <int MODE>
__device__ __forceinline__ void transpose_item(const float* __restrict__ W, int K, int N, bf16_t* __restrict__ WT, const float* __restrict__ kscale, float* scr, int item, int lane, int ldt = 0, int koff = 0) {
    if (ldt == 0) ldt = K;
    const int nblk = N / 32, kb = item / nblk, nb = item % nblk, k0 = 64 * kb, n0 = 32 * nb;
#pragma unroll
    for (int i = 0; i < 8; ++i) { const int kk = 8 * i + (lane >> 3), n4 = (lane & 7) * 4;
        f32x4 w = *(const f32x4*)(W + (size_t)(k0 + kk) * N + n0 + n4); if (kscale) w = w * kscale[k0 + kk];
        scr[kk * 33 + n4] = w[0]; scr[kk * 33 + n4 + 1] = w[1]; scr[kk * 33 + n4 + 2] = w[2]; scr[kk * 33 + n4 + 3] = w[3]; }
    __builtin_amdgcn_s_waitcnt(0xc07f); asm volatile("" ::: "memory");
    const int c = lane & 7;
#pragma unroll
    for (int j = 0; j < 4; ++j) {
        const int n = (lane >> 3) + 8 * j; const float* s = scr + (8 * c) * 33 + n;
        u32x4 o; o.x = pk2(s[0 * 33], s[1 * 33]); o.y = pk2(s[2 * 33], s[3 * 33]); o.z = pk2(s[4 * 33], s[5 * 33]); o.w = pk2(s[6 * 33], s[7 * 33]);
        const int ns = n0 + n;
        const int dr = MODE == 1 ? win_dest_row(ns) : (MODE == 2 ? wq_dest_row(ns) : ns);
        *(u32x4*)(WT + (size_t)dr * ldt + koff + k0 + 8 * c) = o;
    }
    __builtin_amdgcn_s_waitcnt(0xc07f); asm volatile("" ::: "memory");
}

__device__ __forceinline__ void phase0(const Params& p, unsigned char* lds) {
    int tid_ = threadIdx.x; asm volatile("" : "+v"(tid_)); const int tid = tid_, lane = tid & 63, wid = tid >> 6;
    unsigned char* ws = p.ws;
    {
        float* sl = (float*)lds;
        float* red = sl + 9 * 2048;
        const float* c = p.in[1]; const float* cctx = p.in[3]; const float* wada = p.in[4]; const float* bada = p.in[5];
        float* mod = (float*)(ws + WS_MOD);
        if (blockIdx.x < 192) {
            for (int i = tid; i < 9 * 2048; i += NTHREADS) { const int r = i >> 11, k = i & 2047; const float v = r < 8 ? c[r * DM + k] : cctx[k]; sl[i] = silu_(v); }
            __syncthreads();
            for (int it = blockIdx.x; it < 192; it += gridDim.x) {
                const int kq = tid >> 4, c4 = tid & 15, col = it * 64 + c4 * 4;
                f32x4 acc[9];
#pragma unroll
                for (int r = 0; r < 9; ++r) acc[r] = (f32x4){0.f, 0.f, 0.f, 0.f};
#pragma unroll 8
                for (int i = 0; i < 64; ++i) {
                    const int k = kq + 32 * i;
                    const f32x4 w = *(const f32x4*)(wada + (size_t)k * 12288 + col);
#pragma unroll
                    for (int r = 0; r < 9; ++r) acc[r] += w * sl[r * 2048 + k];
                }
#pragma unroll
                for (int r = 0; r < 9; ++r) {
#pragma unroll
                    for (int e = 0; e < 4; ++e) { float v = acc[r][e]; v += __shfl_xor(v, 16); v += __shfl_xor(v, 32); acc[r][e] = v; }
                    if (lane < 16) *(f32x4*)(red + (wid * 9 + r) * 64 + c4 * 4) = acc[r];
                }
                __syncthreads();
                for (int o = tid; o < 9 * 64; o += NTHREADS) {
                    const int r = o >> 6, cc = o & 63;
                    float sum = bada[it * 64 + cc];
                    for (int q = 0; q < 8; ++q) sum += red[(q * 9 + r) * 64 + cc];
                    mod[(size_t)r * 12288 + it * 64 + cc] = sum;
                }
                __syncthreads();
            }
        }
        __syncthreads();
    }
    {
        float* scr = (float*)lds + wid * (64 * 33);
        const int gw = blockIdx.x * NWAVES + wid, NGW = gridDim.x * NWAVES;
        constexpr int I_IN = 32 * (IN_COLS / 32), I_QB = 12 * 48, I_KVB = 8 * 64, I_AB = 16 * 64, I_OO = 32 * 64;
        constexpr int NITEMS = I_IN + I_QB + I_KVB + 2 * I_AB + 2 * I_OO;
        for (int it = gw; it < NITEMS; it += NGW) {
            int r = it;
            if (r < I_IN) { transpose_item<1>(p.in[10], DM, IN_COLS, (bf16_t*)(ws + WS_WIN), nullptr, scr, r, lane); continue; } r -= I_IN;
            if (r < I_QB) { transpose_item<2>(p.in[13], QR, MQW, (bf16_t*)(ws + WS_WQB), p.in[12], scr, r, lane); continue; } r -= I_QB;
            if (r < I_KVB) { transpose_item<0>(p.in[15], KVR, MKVW, (bf16_t*)(ws + WS_WKVB), p.in[14], scr, r, lane); continue; } r -= I_KVB;
            if (r < I_AB) { transpose_item<0>(p.in[16], 1024, DM, (bf16_t*)(ws + WS_WA), nullptr, scr, r, lane, 2048, 0); continue; } r -= I_AB;
            if (r < I_AB) { transpose_item<0>(p.in[17], 1024, DM, (bf16_t*)(ws + WS_WA), nullptr, scr, r, lane, 2048, 1024); continue; } r -= I_AB;
            if (r < I_OO) { transpose_item<0>(p.in[18], DM, DM, (bf16_t*)(ws + WS_WO), nullptr, scr, r, lane); continue; } r -= I_OO;
            transpose_item<0>(p.in[19], DM, DM, (bf16_t*)(ws + WS_WPQ), nullptr, scr, r, lane);
        }
    }
    {
        const size_t gt = (size_t)blockIdx.x * NTHREADS + tid, NGT = (size_t)gridDim.x * NTHREADS;
        u32x4* padp = (u32x4*)(ws + WS_WIN + (size_t)(PC_KPE + 64) * DM * 2);
        for (size_t i = gt; i < (size_t)192 * DM * 2 / 16; i += NGT) padp[i] = (u32x4){0u, 0u, 0u, 0u};
        float* rope = (float*)(ws + WS_ROPE);
        for (size_t i = gt; i < (size_t)SEQ * 32; i += NGT) { float c, sn; rope_cs((int)(i >> 5), (int)(i & 31), c, sn); rope[i * 2] = c; rope[i * 2 + 1] = sn; }
        const float* sk = p.in[20]; bf16_t* skb = (bf16_t*)(ws + WS_SUBK);
        for (size_t i = gt; i < 262144 / 4; i += NGT) { const f32x4 v = *(const f32x4*)(sk + i * 4); store_bf4(skb + i * 4, v); }
    }
}

__device__ __forceinline__ void phase1(const Params& p) {
    int tid_ = threadIdx.x; asm volatile("" : "+v"(tid_)); const int tid = tid_, lane = tid & 63, wid = tid >> 6;
    const int gw = blockIdx.x * NWAVES + wid, NGW = gridDim.x * NWAVES;
    const float* mod = (const float*)(p.ws + WS_MOD); const float* g = p.in[6];
    bf16_t* H = (bf16_t*)(p.ws + WS_H);
    const int per = (TA + NGW - 1) / NGW;
    int curb = -1; f32x4 G[8], S[8];
    for (int i = 0; i < per; ++i) {
        const int m = gw * per + i; if (m >= TA) break;
        const float* xr = m < TL ? p.in[0] + (size_t)m * DM : p.in[2] + (size_t)(m - TL) * DM;
        const int mr = m < TL ? m / SEQ : 8;
        if (mr != curb) { curb = mr; const float* sh = mod + (size_t)mr * 12288, * sc = sh + 2048;
#pragma unroll
            for (int j = 0; j < 8; ++j) { const int c = j * 256 + lane * 4; G[j] = *(const f32x4*)(g + c) * (*(const f32x4*)(sc + c) + 1.f); S[j] = *(const f32x4*)(sh + c); } }
        f32x4 v[8]; float ss = 0.f;
#pragma unroll
        for (int j = 0; j < 8; ++j) { v[j] = *(const f32x4*)(xr + j * 256 + lane * 4); ss += v[j][0] * v[j][0] + v[j][1] * v[j][1] + v[j][2] * v[j][2] + v[j][3] * v[j][3]; }
        const float rstd = rsqrtf(wave_sum_dpp(ss) * (1.f / DM) + EPS);
#pragma unroll
        for (int j = 0; j < 8; ++j) store_bf4(H + (size_t)m * DM + j * 256 + lane * 4, (v[j] * rstd) * G[j] + S[j]);
    }
}

__device__ __forceinline__ void kpe_pass(const Params& p) {
    const size_t gt = (size_t)blockIdx.x * NTHREADS + threadIdx.x, NGT = (size_t)gridDim.x * NTHREADS;
    const bf16_t* PL = (const bf16_t*)(p.ws + WS_PL); const bf16_t* PCx = (const bf16_t*)(p.ws + WS_PC);
    bf16_t* KPE = (bf16_t*)(p.ws + WS_KPE); const float* rope = (const float*)(p.ws + WS_ROPE);
    for (size_t i = gt; i < (size_t)TA * 32; i += NGT) {
        const int m = (int)(i >> 5), j = (int)(i & 31);
        unsigned w;
        if (m < TL) {
            w = *(const unsigned*)(PL + (size_t)m * NP + PC_KPE + 2 * j);
            const float x1 = __uint_as_float(w << 16), x2 = __uint_as_float(w & 0xffff0000u);
            const float c = rope[((size_t)(m & (SEQ - 1)) * 32 + j) * 2], s = rope[((size_t)(m & (SEQ - 1)) * 32 + j) * 2 + 1];
            w = pk2(x1 * c - x2 * s, x1 * s + x2 * c);
        } else w = *(const unsigned*)(PCx + (size_t)(m - TL) * NPC + PC_KPE + 2 * j);
        *(unsigned*)(KPE + (size_t)m * 64 + 2 * j) = w;
    }
}

__device__ __forceinline__ float dot_bf16x8(const bf16x8 k, const float* q) {
    float s = 0.f;
#pragma unroll
    for (int e = 0; e < 8; ++e) s += q[e] * bf2f((bf16_t)k[e]);
    return s;
}

__device__ __forceinline__ void na_naive(const Params& p, unsigned char* lds) {
    int tid_ = threadIdx.x; asm volatile("" : "+v"(tid_)); const int tid = tid_, lane = tid & 63, wid = tid >> 6;
    const int gw = blockIdx.x * NWAVES + wid, NGW = gridDim.x * NWAVES;
    const bf16_t* PL = (const bf16_t*)(p.ws + WS_PL); const bf16_t* PCx = (const bf16_t*)(p.ws + WS_PC);
    bf16_t* OA = (bf16_t*)(p.ws + WS_OA);
    const float* rpb = p.in[11];
    float* qs = (float*)lds + wid * 512;
    float* ps = qs + 64;
    for (int it = gw; it < TL * 16; it += NGW) {
        const int h = it & 15, m = it >> 4, b = m / SEQ, s = m % SEQ, r = s >> 6, qc = s & 63;
        int r0 = r - 4; r0 = r0 < 0 ? 0 : (r0 > GROWS - 8 ? GROWS - 8 : r0);
        int w0 = qc - 8; w0 = w0 < 0 ? 0 : (w0 > GW - 16 ? GW - 16 : w0);
        qs[lane] = bf2f(PL[(size_t)m * NP + PC_QA + h * 64 + lane]);
        __builtin_amdgcn_s_waitcnt(0xc07f); asm volatile("" ::: "memory");
        float sc[6];
#pragma unroll
        for (int i = 0; i < 6; ++i) {
            const int kk = lane + 64 * i;
            const bf16_t* kp; float bias = 0.f;
            if (i < 2) { const int dy = kk >> 4, dx = kk & 15, kr = r0 + dy, kc = w0 + dx;
                kp = PL + (size_t)(b * SEQ + kr * 64 + kc) * NP + PC_KA + h * 64;
                bias = rpb[(h * 15 + (kr - r + 7)) * 31 + (kc - qc + 15)]; }
            else kp = PCx + (size_t)(b * CTX + (kk - 128)) * NPC + PC_KA + h * 64;
            float d = 0.f;
#pragma unroll
            for (int e = 0; e < 8; ++e) d += dot_bf16x8(*(const bf16x8*)(kp + e * 8), qs + e * 8);
            sc[i] = d * NA_SCALE + bias;
        }
        float mx = sc[0];
#pragma unroll
        for (int i = 1; i < 6; ++i) mx = fmaxf(mx, sc[i]);
        mx = wave_max(mx);
        float sum = 0.f;
#pragma unroll
        for (int i = 0; i < 6; ++i) { sc[i] = __expf(sc[i] - mx); sum += sc[i]; ps[lane + 64 * i] = sc[i]; }
        sum = wave_sum(sum);
        __builtin_amdgcn_s_waitcnt(0xc07f); asm volatile("" ::: "memory");
        float o = 0.f;
        for (int kk = 0; kk < 128; ++kk) { const int kr = r0 + (kk >> 4), kc = w0 + (kk & 15);
            o += ps[kk] * bf2f(PL[(size_t)(b * SEQ + kr * 64 + kc) * NP + PC_VA + h * 64 + lane]); }
        for (int kk = 0; kk < 256; ++kk) o += ps[128 + kk] * bf2f(PCx[(size_t)(b * CTX + kk) * NPC + PC_VA + h * 64 + lane]);
        OA[(size_t)m * 2048 + h * 64 + lane] = (bf16_t)f2bf(o / sum);
        __builtin_amdgcn_s_waitcnt(0xc07f); asm volatile("" ::: "memory");
    }
}

__device__ __forceinline__ void mla_naive(const Params& p, unsigned char* lds) {
    int tid_ = threadIdx.x; asm volatile("" : "+v"(tid_)); const int tid = tid_, lane = tid & 63, wid = tid >> 6;
    const bf16_t* QM = (const bf16_t*)(p.ws + WS_QM); const bf16_t* KVM = (const bf16_t*)(p.ws + WS_KVM); const bf16_t* KPE = (const bf16_t*)(p.ws + WS_KPE);
    bf16_t* OB = (bf16_t*)(p.ws + WS_OB);
    float* qs = (float*)lds + wid * (192 + 2304);
    float* ps = qs + 192;
    for (int it = blockIdx.x; it < NB * 8 * (SEQ / 8); it += gridDim.x) {
        const int qg = it % (SEQ / 8), bh = it / (SEQ / 8), h = bh & 7, b = bh >> 3;
        const int m = b * SEQ + qg * 8 + wid;
#pragma unroll
        for (int i = 0; i < 3; ++i) qs[lane + 64 * i] = bf2f(QM[(size_t)m * MQW + h * 192 + lane + 64 * i]);
        __builtin_amdgcn_s_waitcnt(0xc07f); asm volatile("" ::: "memory");
        float mx = -INFINITY;
        for (int i = 0; i < 36; ++i) {
            const int kk = lane + 64 * i;
            const int krow = kk < SEQ ? b * SEQ + kk : TL + b * CTX + (kk - SEQ);
            const bf16_t* kn = KVM + (size_t)krow * MKVW + h * 256; const bf16_t* kp = KPE + (size_t)krow * 64;
            float d = 0.f;
#pragma unroll
            for (int e = 0; e < 16; ++e) d += dot_bf16x8(*(const bf16x8*)(kn + e * 8), qs + e * 8);
#pragma unroll
            for (int e = 0; e < 8; ++e) d += dot_bf16x8(*(const bf16x8*)(kp + e * 8), qs + 128 + e * 8);
            ps[kk] = d; mx = fmaxf(mx, d);
        }
        mx = wave_max(mx);
        float sum = 0.f;
        for (int i = 0; i < 36; ++i) { const float e = exp2f(ps[lane + 64 * i] - mx); sum += e; ps[lane + 64 * i] = e; }
        sum = wave_sum(sum);
        __builtin_amdgcn_s_waitcnt(0xc07f); asm volatile("" ::: "memory");
        float o0 = 0.f, o1 = 0.f;
        const bf16_t* vb = KVM + h * 256 + 128 + lane;
        for (int kk = 0; kk < SEQ; ++kk) { const bf16_t* vp = vb + (size_t)(b * SEQ + kk) * MKVW; const float pp = ps[kk]; o0 += pp * bf2f(vp[0]); o1 += pp * bf2f(vp[64]); }
        for (int kk = 0; kk < CTX; ++kk) { const bf16_t* vp = vb + (size_t)(TL + b * CTX + kk) * MKVW; const float pp = ps[SEQ + kk]; o0 += pp * bf2f(vp[0]); o1 += pp * bf2f(vp[64]); }
        const float inv = 1.f / sum;
        OB[(size_t)m * 2048 + h * 128 + lane] = (bf16_t)f2bf(o0 * inv);
        OB[(size_t)m * 2048 + h * 128 + 64 + lane] = (bf16_t)f2bf(o1 * inv);
        __builtin_amdgcn_s_waitcnt(0xc07f); asm volatile("" ::: "memory");
    }
}


typedef float f32x16 __attribute__((ext_vector_type(16)));
typedef short s16x4 __attribute__((ext_vector_type(4)));
typedef float f32x2_t __attribute__((ext_vector_type(2)));
typedef __bf16 bf16x2_t __attribute__((ext_vector_type(2)));
#define LAS3 __attribute__((address_space(3)))
__device__ __forceinline__ unsigned cvtpk(float lo, float hi) { f32x2_t v = {lo, hi}; bf16x2_t b = __builtin_convertvector(v, bf16x2_t); return __builtin_bit_cast(unsigned, b); }
__device__ __forceinline__ s16x4 vtr(const LAS3 unsigned char* p) { return __builtin_bit_cast(s16x4, __builtin_amdgcn_ds_read_tr16_b64_v4i16((LAS3 s16x4*)p)); }
__device__ __forceinline__ float max16(const f32x16& a) {
    float m0 = fmaxf(fmaxf(a[0], a[1]), fmaxf(a[2], a[3])), m1 = fmaxf(fmaxf(a[4], a[5]), fmaxf(a[6], a[7]));
    float m2 = fmaxf(fmaxf(a[8], a[9]), fmaxf(a[10], a[11])), m3 = fmaxf(fmaxf(a[12], a[13]), fmaxf(a[14], a[15]));
    return fmaxf(fmaxf(m0, m1), fmaxf(m2, m3));
}
__device__ __forceinline__ bf16x8 pfrag(const f32x16& a, int s) {
    u32x4 w; w.x = cvtpk(a[8 * s + 0], a[8 * s + 1]); w.y = cvtpk(a[8 * s + 2], a[8 * s + 3]); w.z = cvtpk(a[8 * s + 4], a[8 * s + 5]); w.w = cvtpk(a[8 * s + 6], a[8 * s + 7]);
    return __builtin_bit_cast(bf16x8, w);
}

__device__ __forceinline__ void mla_flash(const Params& p, unsigned char* lds_) {
    int tid_ = threadIdx.x; asm volatile("" : "+v"(tid_)); const int tid = tid_, lane = tid & 63, wid = tid >> 6, r32 = lane & 31, hi = lane >> 5;
    LAS3 unsigned char* lds = (LAS3 unsigned char*)lds_;
    constexpr int KP = 400, VP = 320, KBYTES = 64 * KP, VBYTES = 64 * VP, STG = KBYTES + VBYTES, NT = (SEQ + CTX) / 64;
    const bf16_t* QM = (const bf16_t*)(p.ws + WS_QM); const bf16_t* KVM = (const bf16_t*)(p.ws + WS_KVM); const bf16_t* KPE = (const bf16_t*)(p.ws + WS_KPE);
    bf16_t* OB = (bf16_t*)(p.ws + WS_OB);
    const int G = gridDim.x, vcu = (G % 8 == 0) ? (blockIdx.x % 8) * (G / 8) + blockIdx.x / 8 : blockIdx.x;
    const int skey = tid >> 4, spc = tid & 15, pkey = tid >> 3, ppc = tid & 7;
    const int vb = (4 * hi + ((lane & 15) >> 2)) * VP + (16 * ((lane >> 4) & 1) + 4 * (lane & 3)) * 2;
    for (int unit = vcu; unit < NB * 8 * 8; unit += G) {
        const int bh = unit >> 3, qt = unit & 7, b = bh >> 3, h = bh & 7;
        const int qrow = b * SEQ + qt * 256 + wid * 32 + r32;
        bf16x8 qf[12];
#pragma unroll
        for (int s = 0; s < 12; ++s) qf[s] = *(const bf16x8*)(QM + (size_t)qrow * MQW + h * 192 + 16 * s + 8 * hi);
        f32x16 o[4];
#pragma unroll
        for (int d = 0; d < 4; ++d)
#pragma unroll
            for (int r = 0; r < 16; ++r) o[d][r] = 0.f;
        float m = -1e30f, l = 0.f;
        u32x4 g0, g1, g2, g3, g4;
#define MLA_LOAD(t) do { const int kr_ = (t) < 32 ? b * SEQ + 64 * (t) : TL + b * CTX + 64 * ((t) - 32); \
            const bf16_t* kp_ = KVM + (size_t)(kr_ + skey) * MKVW + h * 256 + spc * 8; \
            g0 = *(const u32x4*)kp_; g1 = *(const u32x4*)(kp_ + (size_t)32 * MKVW); g2 = *(const u32x4*)(kp_ + 128); g3 = *(const u32x4*)(kp_ + (size_t)32 * MKVW + 128); \
            g4 = *(const u32x4*)(KPE + (size_t)(kr_ + pkey) * 64 + ppc * 8); } while (0)
#define MLA_STORE(buf) do { LAS3 unsigned char* kb_ = lds + (buf) * STG; LAS3 unsigned char* vb_ = kb_ + KBYTES; \
            *(LAS3 u32x4*)(kb_ + skey * KP + spc * 16) = g0; *(LAS3 u32x4*)(kb_ + (skey + 32) * KP + spc * 16) = g1; \
            *(LAS3 u32x4*)(vb_ + skey * VP + spc * 16) = g2; *(LAS3 u32x4*)(vb_ + (skey + 32) * VP + spc * 16) = g3; \
            *(LAS3 u32x4*)(kb_ + pkey * KP + 256 + ppc * 16) = g4; } while (0)
        MLA_LOAD(0); MLA_STORE(0);
#pragma unroll
        for (int s = 0; s < 12; ++s) asm volatile("" : "+v"(qf[s]));
        __syncthreads();
        for (int t = 0; t < NT; ++t) {
            const int cur = t & 1;
            if (t + 1 < NT) MLA_LOAD(t + 1);
            const LAS3 unsigned char* Kb = lds + cur * STG; const LAS3 unsigned char* Vb = Kb + KBYTES;
            f32x16 s0, s1;
#pragma unroll
            for (int r = 0; r < 16; ++r) { s0[r] = 0.f; s1[r] = 0.f; }
            const LAS3 unsigned char* ka = Kb + r32 * KP + 16 * hi;
#pragma unroll
            for (int s = 0; s < 12; ++s) {
                const bf16x8 a0 = *(const LAS3 bf16x8*)(ka + 32 * s), a1 = *(const LAS3 bf16x8*)(ka + 32 * KP + 32 * s);
                s0 = __builtin_amdgcn_mfma_f32_32x32x16_bf16(a0, qf[s], s0, 0, 0, 0);
                s1 = __builtin_amdgcn_mfma_f32_32x32x16_bf16(a1, qf[s], s1, 0, 0, 0);
            }
            float mx = fmaxf(max16(s0), max16(s1));
            mx = fmaxf(mx, __shfl_xor(mx, 32));
            const float mn = fmaxf(m, mx);
            if (__builtin_amdgcn_ballot_w64(mx > m) != 0ull) {
                const float alpha = __builtin_amdgcn_exp2f(m - mn);
                l *= alpha;
#pragma unroll
                for (int d = 0; d < 4; ++d) o[d] = o[d] * alpha;
            }
            m = mn;
            float rs = 0.f;
#pragma unroll
            for (int r = 0; r < 16; ++r) { s0[r] = __builtin_amdgcn_exp2f(s0[r] - mn); s1[r] = __builtin_amdgcn_exp2f(s1[r] - mn); rs += s0[r] + s1[r]; }
            l += rs;
            bf16x8 pf[4];
            pf[0] = pfrag(s0, 0); pf[1] = pfrag(s0, 1); pf[2] = pfrag(s1, 0); pf[3] = pfrag(s1, 1);
            const LAS3 unsigned char* va = Vb + vb;
#pragma unroll
            for (int ks = 0; ks < 4; ++ks)
#pragma unroll
                for (int d = 0; d < 4; ++d) {
                    const s16x4 lo = vtr(va + (16 * ks) * VP + 64 * d), hh = vtr(va + (16 * ks + 8) * VP + 64 * d);
                    const bf16x8 vf = {lo[0], lo[1], lo[2], lo[3], hh[0], hh[1], hh[2], hh[3]};
                    o[d] = __builtin_amdgcn_mfma_f32_32x32x16_bf16(vf, pf[ks], o[d], 0, 0, 0);
                }
            if (t + 1 < NT) MLA_STORE(cur ^ 1);
            __syncthreads();
        }
#undef MLA_LOAD
#undef MLA_STORE
        l += __shfl_xor(l, 32);
        const float inv = 1.f / l;
        bf16_t* op = OB + (size_t)qrow * 2048 + h * 128 + 4 * hi;
#pragma unroll
        for (int d = 0; d < 4; ++d)
#pragma unroll
            for (int g = 0; g < 4; ++g) {
                const f32x4 v = {o[d][4 * g] * inv, o[d][4 * g + 1] * inv, o[d][4 * g + 2] * inv, o[d][4 * g + 3] * inv};
                store_bf4(op + 32 * d + 8 * g, v);
            }
    }
}


__device__ __forceinline__ void na_flash(const Params& p, unsigned char* lds_) {
    int tid_ = threadIdx.x; asm volatile("" : "+v"(tid_)); const int tid = tid_, lane = tid & 63, wid = tid >> 6, r32 = lane & 31, hi = lane >> 5;
    constexpr int VP = 192, WB = 12800;
    LAS3 unsigned char* vl = (LAS3 unsigned char*)lds_ + wid * WB;
    LAS3 float* tbl = (LAS3 float*)(vl + 64 * VP);
    tbl[lane] = 0.f; tbl[lane + 64] = 0.f;
    const bf16_t* PL = (const bf16_t*)(p.ws + WS_PL); const bf16_t* PCx = (const bf16_t*)(p.ws + WS_PC);
    bf16_t* OA = (bf16_t*)(p.ws + WS_OA);
    const float* rpb = p.in[11];
    const int G = gridDim.x, vcu = (G % 8 == 0) ? (blockIdx.x % 8) * (G / 8) + blockIdx.x / 8 : blockIdx.x;
    const int vb = (4 * hi + ((lane & 15) >> 2)) * VP + (16 * ((lane >> 4) & 1) + 4 * (lane & 3)) * 2;
    constexpr float SC = NA_SCALE * LOG2E;
    for (int wu = vcu * NWAVES + wid; wu < NB * GROWS * 16 * 2; wu += G * NWAVES) {
        const int half = wu & 1, h = (wu >> 1) & 15, br = wu >> 5, r = br & 31, b = br >> 5;
        const int qc = 32 * half + r32;
        int w0 = qc - 8; w0 = w0 < 0 ? 0 : (w0 > GW - 16 ? GW - 16 : w0);
        int r0 = r - 4; r0 = r0 < 0 ? 0 : (r0 > GROWS - 8 ? GROWS - 8 : r0);
        const int qtok = b * SEQ + r * 64 + qc;
        bf16x8 qf[4];
#pragma unroll
        for (int s = 0; s < 4; ++s) qf[s] = *(const bf16x8*)(PL + (size_t)qtok * NP + PC_QA + h * 64 + 16 * s + 8 * hi);
        f32x16 o[2];
#pragma unroll
        for (int d = 0; d < 2; ++d)
#pragma unroll
            for (int e = 0; e < 16; ++e) o[d][e] = 0.f;
        float m = -1e30f, l = 0.f;
        bf16x8 kf[2][4]; u32x4 vg[8];
#define NA_LOAD(t, WHAT) do { const bf16_t* kb_; size_t pitch_; \
            if ((t) < 8) { kb_ = PL + (size_t)(b * SEQ + (r0 + (t)) * 64) * NP + PC_KA + h * 64; pitch_ = NP; } \
            else { kb_ = PCx + (size_t)(b * CTX + 64 * ((t) - 8)) * NPC + PC_KA + h * 64; pitch_ = NPC; } \
            if (WHAT & 1) { _Pragma("unroll") for (int kb = 0; kb < 2; ++kb) _Pragma("unroll") for (int s = 0; s < 4; ++s) kf[kb][s] = *(const bf16x8*)(kb_ + (size_t)(32 * kb + r32) * pitch_ + 16 * s + 8 * hi); } \
            if (WHAT & 2) { _Pragma("unroll") for (int i = 0; i < 8; ++i) vg[i] = *(const u32x4*)(kb_ + (size_t)((lane >> 3) + 8 * i) * pitch_ + 1024 + (lane & 7) * 8); } } while (0)
#define NA_STORE(t) do { _Pragma("unroll") for (int i = 0; i < 8; ++i) *(LAS3 u32x4*)(vl + ((lane >> 3) + 8 * i) * VP + (lane & 7) * 16) = vg[i]; \
            if ((t) < 8 && lane < 31) tbl[48 + lane] = rpb[(h * 15 + (r0 + (t) - r + 7)) * 31 + lane] * LOG2E; } while (0)
        NA_LOAD(0, 3); NA_STORE(0);
#pragma nounroll
        for (int t = 0; t < 12; ++t) {
            f32x16 s0, s1;
#pragma unroll
            for (int e = 0; e < 16; ++e) { s0[e] = 0.f; s1[e] = 0.f; }
#pragma unroll
            for (int s = 0; s < 4; ++s) {
                s0 = __builtin_amdgcn_mfma_f32_32x32x16_bf16(kf[0][s], qf[s], s0, 0, 0, 0);
                s1 = __builtin_amdgcn_mfma_f32_32x32x16_bf16(kf[1][s], qf[s], s1, 0, 0, 0);
            }
            __builtin_amdgcn_sched_barrier(0);
            if (t + 1 < 12) NA_LOAD(t + 1, 1);
            __builtin_amdgcn_sched_barrier(0);
            if (t < 8) {
                int w0v = w0 - 4 * hi, tb = 4 * hi - qc + 63; asm volatile("" : "+v"(w0v), "+v"(tb));
                const LAS3 float* tp = tbl + tb;
#pragma unroll
                for (int e = 0; e < 16; ++e) {
                    const int c0 = (e & 3) + 8 * (e >> 2), c1 = c0 + 32;
                    const bool ok0 = (unsigned)(c0 - w0v) < 16u, ok1 = (unsigned)(c1 - w0v) < 16u;
                    const float v0 = s0[e] * SC + tp[c0], v1 = s1[e] * SC + tp[c1];
                    s0[e] = ok0 ? v0 : -1e30f;
                    s1[e] = ok1 ? v1 : -1e30f;
                }
            } else {
#pragma unroll
                for (int e = 0; e < 16; ++e) { s0[e] *= SC; s1[e] *= SC; }
            }
            float mx = fmaxf(max16(s0), max16(s1));
            mx = fmaxf(mx, __shfl_xor(mx, 32));
            const float mn = fmaxf(m, mx), alpha = __builtin_amdgcn_exp2f(m - mn);
            m = mn; l *= alpha;
            o[0] = o[0] * alpha; o[1] = o[1] * alpha;
            float rs = 0.f;
#pragma unroll
            for (int e = 0; e < 16; ++e) { s0[e] = __builtin_amdgcn_exp2f(s0[e] - mn); s1[e] = __builtin_amdgcn_exp2f(s1[e] - mn); rs += s0[e] + s1[e]; }
            l += rs;
            __builtin_amdgcn_sched_barrier(0);
            if (t + 1 < 12) NA_LOAD(t + 1, 2);
            bf16x8 pf[4];
            pf[0] = pfrag(s0, 0); pf[1] = pfrag(s0, 1); pf[2] = pfrag(s1, 0); pf[3] = pfrag(s1, 1);
            const LAS3 unsigned char* va = vl + vb;
#pragma unroll
            for (int ks = 0; ks < 4; ++ks)
#pragma unroll
                for (int d = 0; d < 2; ++d) {
                    const s16x4 lo = vtr(va + (16 * ks) * VP + 64 * d), hh = vtr(va + (16 * ks + 8) * VP + 64 * d);
                    const bf16x8 vf = {lo[0], lo[1], lo[2], lo[3], hh[0], hh[1], hh[2], hh[3]};
                    o[d] = __builtin_amdgcn_mfma_f32_32x32x16_bf16(vf, pf[ks], o[d], 0, 0, 0);
                }
            __builtin_amdgcn_sched_barrier(0);
            if (t + 1 < 12) NA_STORE(t + 1);
        }
#undef NA_LOAD
#undef NA_STORE
        l += __shfl_xor(l, 32);
        const float inv = 1.f / l;
        bf16_t* op = OA + (size_t)qtok * 2048 + h * 64 + 4 * hi;
#pragma unroll
        for (int d = 0; d < 2; ++d)
#pragma unroll
            for (int g = 0; g < 4; ++g) {
                const f32x4 v = {o[d][4 * g] * inv, o[d][4 * g + 1] * inv, o[d][4 * g + 2] * inv, o[d][4 * g + 3] * inv};
                store_bf4(op + 32 * d + 8 * g, v);
            }
    }
}


template <bool LAT, int HALF>
__device__ __forceinline__ void na_tile(const LAS3 unsigned char* Kb, const LAS3 unsigned char* Vb, const LAS3 float* tbl, const bf16x8 (&qf)[4], f32x16 (&o)[2], float& m, float& l,
                                        int r32, int hi, int qc, int w0, int vb) {
    constexpr int KP = 144, VP = 192;
    constexpr float SC = NA_SCALE * LOG2E;
    constexpr int L0 = (LAT && HALF == 1) ? 12 : 0;
    constexpr int H1 = (LAT && HALF == 0) ? 4 : 16;
    f32x16 s0, s1;
#pragma unroll
    for (int e = 0; e < 16; ++e) { s0[e] = 0.f; s1[e] = 0.f; }
    const LAS3 unsigned char* ka = Kb + r32 * KP + 16 * hi;
#pragma unroll
    for (int s = 0; s < 4; ++s) {
        const bf16x8 a0 = *(const LAS3 bf16x8*)(ka + 32 * s), a1 = *(const LAS3 bf16x8*)(ka + 32 * KP + 32 * s);
        s0 = __builtin_amdgcn_mfma_f32_32x32x16_bf16(a0, qf[s], s0, 0, 0, 0);
        s1 = __builtin_amdgcn_mfma_f32_32x32x16_bf16(a1, qf[s], s1, 0, 0, 0);
    }
    if constexpr (LAT) {
        int w0v = w0 - 4 * hi, tb = 4 * hi - qc + 63; asm volatile("" : "+v"(w0v), "+v"(tb));
        const LAS3 float* tp = tbl + tb;
#pragma unroll
        for (int e = 0; e < 16; ++e) {
            const int c0 = (e & 3) + 8 * (e >> 2), c1 = c0 + 32;
            if (e >= L0) { const float p0 = (float)((unsigned)(c0 - w0v) & 0xFFFFFFF0u); s0[e] = fmaf(p0, -1e28f, fmaf(s0[e], SC, tp[c0])); }
            if (e < H1) { const float p1 = (float)((unsigned)(c1 - w0v) & 0xFFFFFFF0u); s1[e] = fmaf(p1, -1e28f, fmaf(s1[e], SC, tp[c1])); }
        }
    } else {
#pragma unroll
        for (int e = 0; e < 16; ++e) { s0[e] *= SC; s1[e] *= SC; }
    }
    float mx = -1e30f;
#pragma unroll
    for (int e = 0; e < 16; ++e) { if (e >= L0) mx = fmaxf(mx, s0[e]); if (e < H1) mx = fmaxf(mx, s1[e]); }
    mx = fmaxf(mx, __shfl_xor(mx, 32));
    const float mn = fmaxf(m, mx);
    if (__builtin_amdgcn_ballot_w64(mx > m) != 0ull) {
        const float alpha = __builtin_amdgcn_exp2f(m - mn);
        l *= alpha; o[0] = o[0] * alpha; o[1] = o[1] * alpha;
    }
    m = mn;
    float rs = 0.f;
#pragma unroll
    for (int e = 0; e < 16; ++e) {
        if (e >= L0) { s0[e] = __builtin_amdgcn_exp2f(s0[e] - mn); rs += s0[e]; } else s0[e] = 0.f;
        if (e < H1) { s1[e] = __builtin_amdgcn_exp2f(s1[e] - mn); rs += s1[e]; } else s1[e] = 0.f;
    }
    l += rs;
    bf16x8 pf[4];
    pf[0] = pfrag(s0, 0); pf[1] = pfrag(s0, 1); pf[2] = pfrag(s1, 0); pf[3] = pfrag(s1, 1);
    const LAS3 unsigned char* va = Vb + vb;
#pragma unroll
    for (int ks = 0; ks < 4; ++ks) {
        if (LAT && ((HALF == 0 && ks == 3) || (HALF == 1 && ks == 0))) continue;
#pragma unroll
        for (int d = 0; d < 2; ++d) {
            const s16x4 lo = vtr(va + (16 * ks) * VP + 64 * d), hh = vtr(va + (16 * ks + 8) * VP + 64 * d);
            const bf16x8 vf = {lo[0], lo[1], lo[2], lo[3], hh[0], hh[1], hh[2], hh[3]};
            o[d] = __builtin_amdgcn_mfma_f32_32x32x16_bf16(vf, pf[ks], o[d], 0, 0, 0);
        }
    }
}
__device__ __forceinline__ void na_coop(const Params& p, unsigned char* lds_) {
    int tid_ = threadIdx.x; asm volatile("" : "+v"(tid_)); const int tid = tid_, lane = tid & 63, wid = tid >> 6, r32 = lane & 31, hi = lane >> 5;
    constexpr int KP = 144, VP = 192, KT = 64 * KP, VT = 64 * VP, STG = KT + VT;
    LAS3 unsigned char* lds = (LAS3 unsigned char*)lds_;
    LAS3 float* tbl = (LAS3 float*)(lds + 2 * STG) + wid * 128;
    tbl[lane] = 0.f; tbl[lane + 64] = 0.f;
    const bf16_t* PL = (const bf16_t*)(p.ws + WS_PL); const bf16_t* PCx = (const bf16_t*)(p.ws + WS_PC);
    bf16_t* OA = (bf16_t*)(p.ws + WS_OA);
    const float* rpb = p.in[11];
    const int G = gridDim.x, vcu = (G % 8 == 0) ? (blockIdx.x % 8) * (G / 8) + blockIdx.x / 8 : blockIdx.x;
    const int vb = (4 * hi + ((lane & 15) >> 2)) * VP + (16 * ((lane >> 4) & 1) + 4 * (lane & 3)) * 2;
    const int half = wid & 1, rw = wid >> 1, skey = tid >> 3, spc = tid & 7;
    constexpr float SC = NA_SCALE * LOG2E;
    for (int unit = vcu; unit < NB * 16 * (GROWS / 4); unit += G) {
        const int rg = unit & 7, h = (unit >> 3) & 15, b = unit >> 7;
        const int R = rg * 4, r = R + rw;
        int r0w = r - 4; r0w = r0w < 0 ? 0 : (r0w > GROWS - 8 ? GROWS - 8 : r0w);
        int kr_lo = R - 4; kr_lo = kr_lo < 0 ? 0 : (kr_lo > GROWS - 8 ? GROWS - 8 : kr_lo);
        int kr_hi = R - 1; kr_hi = (kr_hi < 0 ? 0 : (kr_hi > GROWS - 8 ? GROWS - 8 : kr_hi)) + 7;
        const int nlat = kr_hi - kr_lo + 1, NT = nlat + 4;
        const int qc = 32 * half + r32;
        int w0 = qc - 8; w0 = w0 < 0 ? 0 : (w0 > GW - 16 ? GW - 16 : w0);
        const int qtok = b * SEQ + r * 64 + qc;
        bf16x8 qf[4];
#pragma unroll
        for (int s = 0; s < 4; ++s) qf[s] = *(const bf16x8*)(PL + (size_t)qtok * NP + PC_QA + h * 64 + 16 * s + 8 * hi);
        f32x16 o[2];
#pragma unroll
        for (int d = 0; d < 2; ++d)
#pragma unroll
            for (int e = 0; e < 16; ++e) o[d][e] = 0.f;
        float m = -1e30f, l = 0.f;
        float brow[8];
#pragma unroll
        for (int i = 0; i < 8; ++i) brow[i] = lane < 31 ? rpb[(h * 15 + (r0w - r + 7 + i)) * 31 + lane] * LOG2E : 0.f;
        u32x4 gk, gv;
#define NC_LOAD(t) do { const bf16_t* kp_ = (t) < nlat ? PL + (size_t)(b * SEQ + (kr_lo + (t)) * 64 + skey) * NP + PC_KA + h * 64 + spc * 8 \
                                                      : PCx + (size_t)(b * CTX + 64 * ((t) - nlat) + skey) * NPC + PC_KA + h * 64 + spc * 8; \
            gk = *(const u32x4*)kp_; gv = *(const u32x4*)(kp_ + 1024); } while (0)
#define NC_STORE(buf) do { *(LAS3 u32x4*)(lds + (buf) * STG + skey * KP + spc * 16) = gk; *(LAS3 u32x4*)(lds + (buf) * STG + KT + skey * VP + spc * 16) = gv; } while (0)
        __syncthreads();
        NC_LOAD(0); NC_STORE(0);
#pragma unroll
        for (int s = 0; s < 4; ++s) asm volatile("" : "+v"(qf[s]));
#pragma unroll
        for (int i = 0; i < 8; ++i) asm volatile("" : "+v"(brow[i]));
        __syncthreads();
#pragma nounroll
        for (int t = 0; t < NT; ++t) {
            const int cur = t & 1;
            if (t + 1 < NT) NC_LOAD(t + 1);
            const bool lat = t < nlat; const int kr = kr_lo + t;
            if (!lat || (kr >= r0w && kr < r0w + 8)) {
                const LAS3 unsigned char* Kb = lds + cur * STG; const LAS3 unsigned char* Vb = Kb + KT;
                if (lat) { const int bi_ = kr - r0w; float bv = brow[0];
#pragma unroll
                    for (int i = 1; i < 8; ++i) bv = bi_ == i ? brow[i] : bv;
                    if (lane < 31) tbl[48 + lane] = bv; }
                if (!lat) na_tile<false, 0>(Kb, Vb, tbl, qf, o, m, l, r32, hi, qc, w0, vb);
                else if (half == 0) na_tile<true, 0>(Kb, Vb, tbl, qf, o, m, l, r32, hi, qc, w0, vb);
                else na_tile<true, 1>(Kb, Vb, tbl, qf, o, m, l, r32, hi, qc, w0, vb);
            }
            if (t + 1 < NT) NC_STORE(cur ^ 1);
            __syncthreads();
        }
#undef NC_LOAD
#undef NC_STORE
        l += __shfl_xor(l, 32);
        const float inv = 1.f / l;
        bf16_t* op = OA + (size_t)qtok * 2048 + h * 64 + 4 * hi;
#pragma unroll
        for (int d = 0; d < 2; ++d)
#pragma unroll
            for (int g = 0; g < 4; ++g) {
                const f32x4 v = {o[d][4 * g] * inv, o[d][4 * g + 1] * inv, o[d][4 * g + 2] * inv, o[d][4 * g + 3] * inv};
                store_bf4(op + 32 * d + 8 * g, v);
            }
    }
}

__device__ __forceinline__ void phase7(const Params& p) {
    int tid_ = threadIdx.x; asm volatile("" : "+v"(tid_)); const int tid = tid_, lane = tid & 63, wid = tid >> 6;
    const int gw = blockIdx.x * NWAVES + wid, NGW = gridDim.x * NWAVES;
    const float* mod = (const float*)(p.ws + WS_MOD);
    const bf16_t* Z = (const bf16_t*)(p.ws + WS_Z); bf16_t* H = (bf16_t*)(p.ws + WS_H);
    const float* gpm = p.in[7]; const float* gpf = p.in[8];
    const int per = (TL + NGW - 1) / NGW;
    int curb = -1; f32x4 A[8], B[8], C[8];
    for (int i = 0; i < per; ++i) {
        const int m = gw * per + i; if (m >= TL) break;
        const int b = m / SEQ;
        if (b != curb) { curb = b; const float* mb = mod + (size_t)b * 12288;
#pragma unroll
            for (int j = 0; j < 8; ++j) { const int c = j * 256 + lane * 4;
                A[j] = *(const f32x4*)(mb + 4096 + c) * *(const f32x4*)(gpm + c); B[j] = *(const f32x4*)(gpf + c) * (*(const f32x4*)(mb + 8192 + c) + 1.f); C[j] = *(const f32x4*)(mb + 6144 + c); } }
        f32x4 z[8]; float ss = 0.f;
#pragma unroll
        for (int j = 0; j < 8; ++j) {
            const u32x2 w = *(const u32x2*)(Z + (size_t)m * DM + j * 256 + lane * 4);
            z[j] = (f32x4){__uint_as_float(w.x << 16), __uint_as_float(w.x & 0xffff0000u), __uint_as_float(w.y << 16), __uint_as_float(w.y & 0xffff0000u)};
            ss += z[j][0] * z[j][0] + z[j][1] * z[j][1] + z[j][2] * z[j][2] + z[j][3] * z[j][3];
        }
        f32x4 xv[8];
#pragma unroll
        for (int j = 0; j < 8; ++j) xv[j] = *(const f32x4*)(p.in[0] + (size_t)m * DM + j * 256 + lane * 4);
        const float rz = rsqrtf(wave_sum_dpp(ss) * (1.f / DM) + EPS);
        float s2 = 0.f;
#pragma unroll
        for (int j = 0; j < 8; ++j) {
            const f32x4 x1 = xv[j] + (z[j] * rz) * A[j];
            *(f32x4*)(p.out + (size_t)m * DM + j * 256 + lane * 4) = x1;
            z[j] = x1; s2 += x1[0] * x1[0] + x1[1] * x1[1] + x1[2] * x1[2] + x1[3] * x1[3];
        }
        const float rx = rsqrtf(wave_sum_dpp(s2) * (1.f / DM) + EPS);
#pragma unroll
        for (int j = 0; j < 8; ++j) store_bf4(H + (size_t)m * DM + j * 256 + lane * 4, (z[j] * rx) * B[j] + C[j]);
    }
}

template <int NPER>
__device__ __forceinline__ void wave_top16(float (&v)[NPER], const int (&idx)[NPER], float& outv, int& outi, int lane) {
    outv = -INFINITY; outi = 0;
#pragma nounroll
    for (int r = 0; r < 16; ++r) {
        float bv = v[0]; int bi = idx[0];
#pragma unroll
        for (int e = 1; e < NPER; ++e) if (v[e] > bv || (v[e] == bv && idx[e] < bi)) { bv = v[e]; bi = idx[e]; }
#pragma unroll
        for (int o = 32; o >= 1; o >>= 1) {
            const float ov = __shfl_xor(bv, o); const int oi = __shfl_xor(bi, o);
            if (ov > bv || (ov == bv && oi < bi)) { bv = ov; bi = oi; }
        }
#pragma unroll
        for (int e = 0; e < NPER; ++e) if (idx[e] == bi) v[e] = -INFINITY;
        if (lane == r) { outv = bv; outi = bi; }
    }
}

__device__ __forceinline__ void peer_topk_naive(const Params& p, unsigned char* lds) {
    int tid_ = threadIdx.x; asm volatile("" : "+v"(tid_)); const int tid = tid_, lane = tid & 63, wid = tid >> 6;
    const int gw = blockIdx.x * NWAVES + wid, NGW = gridDim.x * NWAVES;
    const bf16_t* QP = (const bf16_t*)(p.ws + WS_QP); const bf16_t* SK = (const bf16_t*)(p.ws + WS_SUBK);
    float* TKV = (float*)(p.ws + WS_TKV); int* TKI = (int*)(p.ws + WS_TKI);
    float* qs = (float*)lds + wid * 128;
    for (int it = gw; it < TL * 16; it += NGW) {
        const int hp = it & 15, m = it >> 4;
        qs[lane] = bf2f(QP[(size_t)m * DM + hp * 128 + lane]); qs[lane + 64] = bf2f(QP[(size_t)m * DM + hp * 128 + 64 + lane]);
        __builtin_amdgcn_s_waitcnt(0xc07f); asm volatile("" ::: "memory");
        float v[2]; int idx[2];
#pragma unroll
        for (int i = 0; i < 2; ++i) {
            const int n = lane + 64 * i; const bf16_t* kp = SK + (size_t)(hp * 128 + n) * 128;
            float d = 0.f;
#pragma unroll
            for (int e = 0; e < 16; ++e) d += dot_bf16x8(*(const bf16x8*)(kp + e * 8), qs + e * 8);
            v[i] = d; idx[i] = n;
        }
        float ov; int oi; wave_top16<2>(v, idx, ov, oi, lane);
        if (lane < 16) { TKV[(size_t)it * 16 + lane] = ov; TKI[(size_t)it * 16 + lane] = oi; }
        __builtin_amdgcn_s_waitcnt(0xc07f); asm volatile("" ::: "memory");
    }
}

__device__ __forceinline__ void peer_final_naive(const Params& p, unsigned char* lds) {
    int tid_ = threadIdx.x; asm volatile("" : "+v"(tid_)); const int tid = tid_, lane = tid & 63, wid = tid >> 6;
    const float* TKV = (const float*)(p.ws + WS_TKV); const int* TKI = (const int*)(p.ws + WS_TKI);
    const bf16_t* H = (const bf16_t*)(p.ws + WS_H);
    const float* U = p.in[21]; const float* V = p.in[22];
    const float* mod = (const float*)(p.ws + WS_MOD); const float* gpo = p.in[9];
    float* part = (float*)lds;
    float* red = part + 8 * 2048;
    for (int m = blockIdx.x; m < TL; m += gridDim.x) {
        const int b = m / SEQ, h = wid;
        const float* v1 = TKV + ((size_t)m * 16 + h * 2) * 16; const float* v2 = v1 + 16;
        const int* i1 = TKI + ((size_t)m * 16 + h * 2) * 16; const int* i2 = i1 + 16;
        float cv[4]; int ci[4];
        const float v2j = v2[lane & 15];
#pragma unroll
        for (int e = 0; e < 4; ++e) { const int i = (lane >> 4) + 4 * e; cv[e] = v1[i] + v2j; ci[e] = i * 16 + (lane & 15); }
        float tv; int tc; wave_top16<4>(cv, ci, tv, tc, lane);
        int eid = 0; float gate = 0.f;
        if (lane < 16) eid = i1[tc >> 4] * 128 + i2[tc & 15];
        const float mx = __shfl(tv, 0);
        const float ex = lane < 16 ? __expf(tv - mx) : 0.f;
        gate = ex / wave_sum(ex);
        f32x4 hv[8];
#pragma unroll
        for (int j = 0; j < 8; ++j) { const u32x2 w = *(const u32x2*)(H + (size_t)m * DM + j * 256 + lane * 4);
            hv[j] = (f32x4){__uint_as_float(w.x << 16), __uint_as_float(w.x & 0xffff0000u), __uint_as_float(w.y << 16), __uint_as_float(w.y & 0xffff0000u)}; }
        f32x4 acc[8];
#pragma unroll
        for (int j = 0; j < 8; ++j) acc[j] = (f32x4){0.f, 0.f, 0.f, 0.f};
        for (int k = 0; k < 16; ++k) {
            const int e = __shfl(eid, k); const float g = __shfl(gate, k);
#ifdef PEER_NAIVE_BF16
            const bf16_t* ur = (const bf16_t*)(p.ws + WS_UB) + (size_t)e * DM + lane * 4; const bf16_t* vr = (const bf16_t*)(p.ws + WS_VB) + (size_t)e * DM + lane * 4;
            float d = 0.f;
#pragma unroll
            for (int j = 0; j < 8; ++j) { const u32x2 w = *(const u32x2*)(ur + j * 256); const f32x4 u = {__uint_as_float(w.x << 16), __uint_as_float(w.x & 0xffff0000u), __uint_as_float(w.y << 16), __uint_as_float(w.y & 0xffff0000u)};
                d += u[0] * hv[j][0] + u[1] * hv[j][1] + u[2] * hv[j][2] + u[3] * hv[j][3]; }
            d = wave_sum(d);
            const float coef = g * gelu_as(d);
#pragma unroll
            for (int j = 0; j < 8; ++j) { const u32x2 w = *(const u32x2*)(vr + j * 256); const f32x4 vv = {__uint_as_float(w.x << 16), __uint_as_float(w.x & 0xffff0000u), __uint_as_float(w.y << 16), __uint_as_float(w.y & 0xffff0000u)};
                acc[j] += vv * coef; }
#else
            const float* ur = U + (size_t)e * DM + lane * 4; const float* vr = V + (size_t)e * DM + lane * 4;
            float d = 0.f;
#pragma unroll
            for (int j = 0; j < 8; ++j) { const f32x4 u = *(const f32x4*)(ur + j * 256); d += u[0] * hv[j][0] + u[1] * hv[j][1] + u[2] * hv[j][2] + u[3] * hv[j][3]; }
            d = wave_sum(d);
            const float coef = g * gelu_erf(d);
#pragma unroll
            for (int j = 0; j < 8; ++j) acc[j] += *(const f32x4*)(vr + j * 256) * coef;
#endif
        }
        __syncthreads();
#pragma unroll
        for (int j = 0; j < 8; ++j) *(f32x4*)(part + wid * 2048 + j * 256 + lane * 4) = acc[j];
        __syncthreads();
        f32x4 y = (f32x4){0.f, 0.f, 0.f, 0.f};
#pragma unroll
        for (int w = 0; w < 8; ++w) y += *(const f32x4*)(part + w * 2048 + tid * 4);
        float ss = wave_sum(y[0] * y[0] + y[1] * y[1] + y[2] * y[2] + y[3] * y[3]);
        if (lane == 0) red[wid] = ss;
        __syncthreads();
        float tot = 0.f;
#pragma unroll
        for (int w = 0; w < 8; ++w) tot += red[w];
        const float rstd = rsqrtf(tot * (1.f / DM) + EPS);
        const int c = tid * 4;
        const f32x4 gt2 = *(const f32x4*)(mod + (size_t)b * 12288 + 10240 + c);
        float* op = p.out + (size_t)m * DM + c;
        const f32x4 x1 = *(const f32x4*)op;
        *(f32x4*)op = x1 + gt2 * (y * rstd * *(const f32x4*)(gpo + c));
    }
}


__device__ __forceinline__ void peer_topk_mfma(const Params& p, unsigned char* lds_) {
    int tid_ = threadIdx.x; asm volatile("" : "+v"(tid_)); const int tid = tid_, lane = tid & 63, wid = tid >> 6, r32 = lane & 31, hi = lane >> 5;
    LAS3 unsigned char* lds = (LAS3 unsigned char*)lds_;
    constexpr int SP = 272;
    const bf16_t* QP = (const bf16_t*)(p.ws + WS_QP); const bf16_t* SK = (const bf16_t*)(p.ws + WS_SUBK);
    float* TKV = (float*)(p.ws + WS_TKV); int* TKI = (int*)(p.ws + WS_TKI);
    for (int bi = blockIdx.x; bi < 256; bi += gridDim.x) {
        const int hp = bi & 15, sub = bi >> 4;
        __syncthreads();
        for (int c = tid; c < 2048; c += NTHREADS) { const int row = c >> 4, pc = c & 15;
            *(LAS3 u32x4*)(lds + row * SP + pc * 16) = *(const u32x4*)(SK + ((size_t)hp * 128 + row) * 128 + pc * 8); }
        __syncthreads();
        for (int g = wid; g < 32; g += NWAVES) {
            const int tok = (sub * 32 + g) * 32 + r32;
            bf16x8 qf[8];
#pragma unroll
            for (int s = 0; s < 8; ++s) qf[s] = *(const bf16x8*)(QP + (size_t)tok * DM + hp * 128 + 16 * s + 8 * hi);
            f32x16 sc[4];
#pragma unroll
            for (int kb = 0; kb < 4; ++kb) {
#pragma unroll
                for (int e = 0; e < 16; ++e) sc[kb][e] = 0.f;
#pragma unroll
                for (int s = 0; s < 8; ++s) {
                    const bf16x8 a = *(const LAS3 bf16x8*)(lds + (32 * kb + r32) * SP + 32 * s + 16 * hi);
                    sc[kb] = __builtin_amdgcn_mfma_f32_32x32x16_bf16(a, qf[s], sc[kb], 0, 0, 0);
                }
            }
#pragma unroll
            for (int kb = 0; kb < 4; ++kb)
#pragma unroll
                for (int e = 0; e < 16; ++e) {
                    const unsigned key = 32 * kb + (e & 3) + 8 * (e >> 2) + 4 * hi;
                    sc[kb][e] = __uint_as_float((__float_as_uint(sc[kb][e]) & 0xFFFFFF80u) | key);
                }
            float ov[16];
#pragma unroll
            for (int r = 0; r < 16; ++r) {
                float mx = -INFINITY;
#pragma unroll
                for (int kb = 0; kb < 4; ++kb) mx = fmaxf(mx, max16(sc[kb]));
                const float w = fmaxf(mx, __shfl_xor(mx, 32));
                ov[r] = w;
#pragma unroll
                for (int kb = 0; kb < 4; ++kb)
#pragma unroll
                    for (int e = 0; e < 16; ++e) sc[kb][e] = sc[kb][e] == w ? -INFINITY : sc[kb][e];
            }
            if (hi == 0) {
                float* vp = TKV + ((size_t)tok * 16 + hp) * 16; int* ip = TKI + ((size_t)tok * 16 + hp) * 16;
#pragma unroll
                for (int q = 0; q < 4; ++q) {
                    f32x4 vv; u32x4 ii;
#pragma unroll
                    for (int e = 0; e < 4; ++e) { const unsigned u = __float_as_uint(ov[4 * q + e]); vv[e] = __uint_as_float(u & 0xFFFFFF80u); ii[e] = u & 127u; }
                    *(f32x4*)(vp + 4 * q) = vv; *(u32x4*)(ip + 4 * q) = ii;
                }
            }
        }
    }
}


constexpr int cand_jmax(int i) { return 16 / (i + 1); }
constexpr int cand_off(int i) { int t = 0; for (int k = 0; k < i; ++k) t += 16 / (k + 1); return t; }
static_assert(cand_off(16) == 50, "candidate count");
template <int N> __device__ __forceinline__ void bitonic_sort_desc(float (&a)[N]) {
#pragma unroll
    for (int k = 2; k <= N; k <<= 1)
#pragma unroll
        for (int j = k >> 1; j > 0; j >>= 1)
#pragma unroll
            for (int i = 0; i < N; ++i) { const int l = i ^ j; if (l > i) { const bool up = (i & k) == 0; const float x = a[i], y = a[l];
                a[i] = up ? fmaxf(x, y) : fminf(x, y); a[l] = up ? fminf(x, y) : fmaxf(x, y); } }
}
template <int N> __device__ __forceinline__ void bitonic_merge_desc(float (&a)[N]) {
#pragma unroll
    for (int j = N >> 1; j > 0; j >>= 1)
#pragma unroll
        for (int i = 0; i < N; ++i) { const int l = i ^ j; if (l > i) { const float x = a[i], y = a[l]; a[i] = fmaxf(x, y); a[l] = fminf(x, y); } }
}
__device__ __forceinline__ void top16_merge(float (&a)[16], const float (&b)[16]) {
#pragma unroll
    for (int i = 0; i < 16; ++i) a[i] = fmaxf(a[i], b[15 - i]);
    bitonic_merge_desc<16>(a);
}
__device__ __forceinline__ void top16_of_64(float (&g0)[16], float (&g1)[16], float (&g2)[16], float (&g3)[16]) {
    bitonic_sort_desc<16>(g0); bitonic_sort_desc<16>(g1); bitonic_sort_desc<16>(g2); bitonic_sort_desc<16>(g3);
    top16_merge(g0, g1); top16_merge(g2, g3); top16_merge(g0, g2);
}
__device__ __forceinline__ void topk_stage1(const LAS3 unsigned char* skl, const bf16_t* __restrict__ qrow, int r32, int hi, float (&ov)[16]) {
    constexpr int SP = 272;
    bf16x8 qf[8];
#pragma unroll
    for (int s = 0; s < 8; ++s) qf[s] = *(const bf16x8*)(qrow + 16 * s + 8 * hi);
    f32x16 sc[4];
#pragma unroll
    for (int kb = 0; kb < 4; ++kb) {
#pragma unroll
        for (int e = 0; e < 16; ++e) sc[kb][e] = 0.f;
#pragma unroll
        for (int s = 0; s < 8; ++s) {
            const bf16x8 a = *(const LAS3 bf16x8*)(skl + (32 * kb + r32) * SP + 32 * s + 16 * hi);
            sc[kb] = __builtin_amdgcn_mfma_f32_32x32x16_bf16(a, qf[s], sc[kb], 0, 0, 0);
        }
    }
    float g1[16], g2[16], g3[16];
#pragma unroll
    for (int e = 0; e < 16; ++e) {
        const unsigned key = (e & 3) + 8 * (e >> 2) + 4 * hi;
        ov[e] = __uint_as_float((__float_as_uint(sc[0][e]) & 0xFFFFFF80u) | key);
        g1[e] = __uint_as_float((__float_as_uint(sc[1][e]) & 0xFFFFFF80u) | (key + 32u));
        g2[e] = __uint_as_float((__float_as_uint(sc[2][e]) & 0xFFFFFF80u) | (key + 64u));
        g3[e] = __uint_as_float((__float_as_uint(sc[3][e]) & 0xFFFFFF80u) | (key + 96u));
    }
    top16_of_64(ov, g1, g2, g3);
    float pb[16];
#pragma unroll
    for (int e = 0; e < 16; ++e) pb[e] = __shfl_xor(ov[e], 32);
    top16_merge(ov, pb);
}
__device__ __forceinline__ void peer_tables_q8(const Params& p, int gw, int NGW, int lane);
__device__ __forceinline__ void peer_select_mfma(const Params& p, unsigned char* lds_, int mode = 0) {
    int tid_ = threadIdx.x; asm volatile("" : "+v"(tid_)); const int tid = tid_, lane = tid & 63, wid = tid >> 6, r32 = lane & 31, hi = lane >> 5;
    LAS3 unsigned char* lds = (LAS3 unsigned char*)lds_;
    constexpr int SP = 272;
    LAS3 unsigned* ktab = (LAS3 unsigned*)(lds + 256 * SP) + wid * 2048 + lane;
    const bf16_t* QP = (const bf16_t*)(p.ws + WS_QP); const bf16_t* SK = (const bf16_t*)(p.ws + WS_SUBK);
    int* SE = (int*)(p.ws + WS_TKI); float* SG = (float*)(p.ws + WS_TKV);
    for (int bi = blockIdx.x; bi < 256; bi += gridDim.x) {
        const int h = bi & 7, sub = bi >> 3;
        __syncthreads();
        for (int c = tid; c < 4096; c += NTHREADS) { const int row = c >> 4, pc = c & 15;
            *(LAS3 u32x4*)(lds + row * SP + pc * 16) = *(const u32x4*)(SK + ((size_t)h * 256 + row) * 128 + pc * 8); }
        __syncthreads();
#ifdef SEL_SPLIT
        if (wid >= 4) { if (bi == (int)blockIdx.x && mode != 1) peer_tables_q8(p, blockIdx.x * 4 + (wid - 4), gridDim.x * 4, lane); continue; }
        if (mode == 2) continue;
        for (int g = wid; g < 16; g += 4) {
#else
        if (mode == 2) continue;
        for (int g = wid; g < 16; g += NWAVES) {
#endif
            const int tok = (sub * 16 + g) * 32 + r32;
            float ov0[16], ov1[16];
            int lo0 = 0, lo1 = 128 * SP; asm volatile("" : "+v"(lo0), "+v"(lo1));
            topk_stage1(lds + lo0, QP + (size_t)tok * DM + h * 256, r32, hi, ov0);
            topk_stage1(lds + lo1, QP + (size_t)tok * DM + h * 256 + 128, r32, hi, ov1);
#pragma unroll
            for (int q = 0; q < 16; ++q) { ktab[q * 64] = __float_as_uint(ov0[q]) & 127u; ktab[(16 + q) * 64] = __float_as_uint(ov1[q]) & 127u; }
            float c0[16], c1[16], c2[16], c3[16];
#pragma unroll
            for (int e = 0; e < 16; ++e) { c0[e] = -INFINITY; c1[e] = -INFINITY; c2[e] = -INFINITY; c3[e] = -INFINITY; }
#pragma unroll
            for (int i = 0; i < 16; ++i) {
                const float a = __uint_as_float(__float_as_uint(ov0[i]) & 0xFFFFFF80u);
#pragma unroll
                for (int j = 0; j < 16; ++j) if (j < cand_jmax(i)) {
                    const float bb = __uint_as_float(__float_as_uint(ov1[j]) & 0xFFFFFF80u);
                    const float cv = __uint_as_float((__float_as_uint(a + bb) & 0xFFFFFF00u) | (unsigned)(i * 16 + j));
                    const int n = cand_off(i) + j;
                    if (n < 16) c0[n & 15] = cv; else if (n < 32) c1[n & 15] = cv; else if (n < 48) c2[n & 15] = cv; else c3[n & 15] = cv;
                }
            }
            top16_of_64(c0, c1, c2, c3);
            float tv[16]; unsigned te[16];
#pragma unroll
            for (int r = 0; r < 16; ++r) {
                const unsigned ij = __float_as_uint(c0[r]) & 255u;
                te[r] = ktab[(ij >> 4) * 64] * 128u + ktab[(16 + (ij & 15u)) * 64];
                tv[r] = __uint_as_float(__float_as_uint(c0[r]) & 0xFFFFFF00u);
            }
            const float tmax = tv[0]; float sum = 0.f;
#pragma unroll
            for (int r = 0; r < 16; ++r) { tv[r] = __expf(tv[r] - tmax); sum += tv[r]; }
            const float rinv = 1.f / sum;
#pragma unroll
            for (int r = 0; r < 16; ++r) tv[r] *= rinv;
            if (hi == 0) {
                int* ep = SE + (size_t)tok * 128 + h * 16; float* gp = SG + (size_t)tok * 128 + h * 16;
#pragma unroll
                for (int q = 0; q < 4; ++q) { *(u32x4*)(ep + 4 * q) = (u32x4){te[4 * q], te[4 * q + 1], te[4 * q + 2], te[4 * q + 3]}; *(f32x4*)(gp + 4 * q) = (f32x4){tv[4 * q], tv[4 * q + 1], tv[4 * q + 2], tv[4 * q + 3]}; }
            }
        }
#ifndef SEL_SPLIT
        if (bi == (int)blockIdx.x && mode != 1) peer_tables_q8(p, blockIdx.x * NWAVES + wid, gridDim.x * NWAVES, lane);
#endif
    }
}

__device__ __forceinline__ void peer_tables_bf16(const Params& p) {
    const size_t gt = (size_t)blockIdx.x * NTHREADS + threadIdx.x, NGT = (size_t)gridDim.x * NTHREADS;
    const float* U = p.in[21]; const float* V = p.in[22];
    bf16_t* UB = (bf16_t*)(p.ws + WS_UB); bf16_t* VB = (bf16_t*)(p.ws + WS_VB);
    for (size_t i = gt; i < (size_t)16384 * DM / 8; i += NGT) {
        const f32x4 a0 = *(const f32x4*)(U + i * 8), a1 = *(const f32x4*)(U + i * 8 + 4), b0 = *(const f32x4*)(V + i * 8), b1 = *(const f32x4*)(V + i * 8 + 4);
        u32x4 w; w.x = pk2(a0[0], a0[1]); w.y = pk2(a0[2], a0[3]); w.z = pk2(a1[0], a1[1]); w.w = pk2(a1[2], a1[3]);
        *(u32x4*)(UB + i * 8) = w;
        w.x = pk2(b0[0], b0[1]); w.y = pk2(b0[2], b0[3]); w.z = pk2(b1[0], b1[1]); w.w = pk2(b1[2], b1[3]);
        *(u32x4*)(VB + i * 8) = w;
    }
}

typedef short s16x2 __attribute__((ext_vector_type(2)));
__device__ __forceinline__ float dot2_bf16(unsigned a, unsigned b, float acc) { return __builtin_amdgcn_fdot2_f32_bf16(__builtin_bit_cast(s16x2, a), __builtin_bit_cast(s16x2, b), acc, false); }
__device__ __forceinline__ float dot8_bf16(const u32x4 a, const u32x4 b, float acc) {
    const unsigned a0 = a[0], a1 = a[1], a2 = a[2], a3 = a[3], b0 = b[0], b1 = b[1], b2 = b[2], b3 = b[3];
    acc = dot2_bf16(a0, b0, acc); acc = dot2_bf16(a1, b1, acc); acc = dot2_bf16(a2, b2, acc); acc = dot2_bf16(a3, b3, acc);
    return acc;
}
__device__ __forceinline__ void peer_select(const float* __restrict__ TKV, const int* __restrict__ TKI, int m, int lane, int& eA, int& eB, float& gA, float& gB) {
    eA = 0; eB = 0; gA = 0.f; gB = 0.f;
#pragma nounroll
    for (int h = 0; h < 8; ++h) {
        const float* v1 = TKV + ((size_t)m * 16 + h * 2) * 16; const float* v2 = v1 + 16;
        const int* i1 = TKI + ((size_t)m * 16 + h * 2) * 16; const int* i2 = i1 + 16;
        float cv[4]; int ci[4];
        const float v2j = v2[lane & 15];
#pragma unroll
        for (int e = 0; e < 4; ++e) { const int i = (lane >> 4) + 4 * e; cv[e] = v1[i] + v2j; ci[e] = i * 16 + (lane & 15); }
        float tv; int tc; wave_top16<4>(cv, ci, tv, tc, lane);
        int eid = 0;
        if (lane < 16) eid = i1[tc >> 4] * 128 + i2[tc & 15];
        const float mx = __shfl(tv, 0);
        const float ex = lane < 16 ? __expf(tv - mx) : 0.f;
        const float gate = ex / wave_sum(ex);
        const int es = __shfl(eid, lane & 15); const float gs = __shfl(gate, lane & 15);
        if ((lane >> 4) == (h & 3)) { if (h < 4) { eA = es; gA = gs; } else { eB = es; gB = gs; } }
    }
}
__device__ __forceinline__ void peer_gather(const Params& p, bool dry = false) {
    int tid_ = threadIdx.x; asm volatile("" : "+v"(tid_)); const int tid = tid_, lane = tid & 63, wid = tid >> 6;
    const int gw = blockIdx.x * NWAVES + wid, NGW = gridDim.x * NWAVES;
    const float* TKV = (const float*)(p.ws + WS_TKV); const int* TKI = (const int*)(p.ws + WS_TKI);
    const bf16_t* H = (const bf16_t*)(p.ws + WS_H);
    const bf16_t* UB = (const bf16_t*)(p.ws + WS_UB); const bf16_t* VB = (const bf16_t*)(p.ws + WS_VB);
    const float* mod = (const float*)(p.ws + WS_MOD); const float* gpo = p.in[9];
    for (int m = gw; m < TL; m += NGW) {
        int eA, eB; float gA, gB;
        peer_select(TKV, TKI, m, lane, eA, eB, gA, gB);
        asm volatile("" : "+v"(eA), "+v"(eB), "+v"(gA), "+v"(gB));
        u32x4 us[2][4], vs[2][4];
#define PG_LOAD(S, k) do { const int e_ = __builtin_amdgcn_readlane((k) < 64 ? eA : eB, (k) & 63); \
            const bf16_t* up_ = UB + (size_t)e_ * DM + lane * 8; const bf16_t* vp_ = VB + (size_t)e_ * DM + lane * 8; \
            _Pragma("unroll") for (int i = 0; i < 4; ++i) { us[S][i] = *(const u32x4*)(up_ + i * 512); vs[S][i] = *(const u32x4*)(vp_ + i * 512); } } while (0)
        PG_LOAD(0, 0); PG_LOAD(1, 1);
        u32x4 hq[4];
#pragma unroll
        for (int i = 0; i < 4; ++i) hq[i] = *(const u32x4*)(H + (size_t)m * DM + i * 512 + lane * 8);
        float acc[4][8];
#pragma unroll
        for (int i = 0; i < 4; ++i)
#pragma unroll
            for (int e = 0; e < 8; ++e) acc[i][e] = 0.f;
#define PG_USE(S, k) do { float d_ = 0.f; \
            _Pragma("unroll") for (int i = 0; i < 4; ++i) d_ = dot8_bf16(us[S][i], hq[i], d_); \
            d_ = wave_sum(d_); \
            const float g_ = __uint_as_float((unsigned)__builtin_amdgcn_readlane((int)__float_as_uint((k) < 64 ? gA : gB), (k) & 63)); \
            const float cf_ = g_ * gelu_as(d_); \
            _Pragma("unroll") for (int i = 0; i < 4; ++i) { const u32x4 w_ = vs[S][i]; \
                acc[i][0] += cf_ * __uint_as_float(w_.x << 16); acc[i][1] += cf_ * __uint_as_float(w_.x & 0xffff0000u); \
                acc[i][2] += cf_ * __uint_as_float(w_.y << 16); acc[i][3] += cf_ * __uint_as_float(w_.y & 0xffff0000u); \
                acc[i][4] += cf_ * __uint_as_float(w_.z << 16); acc[i][5] += cf_ * __uint_as_float(w_.z & 0xffff0000u); \
                acc[i][6] += cf_ * __uint_as_float(w_.w << 16); acc[i][7] += cf_ * __uint_as_float(w_.w & 0xffff0000u); } } while (0)
#pragma nounroll
        for (int k = 0; k < 128; k += 2) {
            PG_USE(0, k);     if (k + 2 < 128) PG_LOAD(0, k + 2);
            PG_USE(1, k + 1); if (k + 3 < 128) PG_LOAD(1, k + 3);
        }
#undef PG_LOAD
#undef PG_USE
        float ss = 0.f;
#pragma unroll
        for (int i = 0; i < 4; ++i)
#pragma unroll
            for (int e = 0; e < 8; ++e) ss += acc[i][e] * acc[i][e];
        const float rstd = rsqrtf(wave_sum(ss) * (1.f / DM) + EPS);
        const int b = m / SEQ;
#pragma unroll
        for (int i = 0; i < 4; ++i)
#pragma unroll
            for (int q = 0; q < 2; ++q) {
                const int c = i * 512 + lane * 8 + q * 4;
                const f32x4 gt2 = *(const f32x4*)(mod + (size_t)b * 12288 + 10240 + c), gg = *(const f32x4*)(gpo + c);
                float* op = p.out + (size_t)m * DM + c;
                const f32x4 x1 = *(const f32x4*)op;
                const f32x4 y = {acc[i][4 * q], acc[i][4 * q + 1], acc[i][4 * q + 2], acc[i][4 * q + 3]};
                const f32x4 res = x1 + gt2 * (y * rstd * gg);
                if (!dry) *(f32x4*)op = res; else asm volatile("" :: "v"(res));
            }
    }
}


__device__ __forceinline__ void peer_q8_row(const Params& p, int r, const f32x4 (&v)[8], int lane) {
    unsigned char* UQ = p.ws + WS_UQ; unsigned char* VQ = p.ws + WS_VQ; float* USC = (float*)(p.ws + WS_USC); float* VSC = (float*)(p.ws + WS_VSC);
    const bool isv = r >= 16384; const int e = isv ? r - 16384 : r;
    float mx = 0.f;
#pragma unroll
    for (int j = 0; j < 8; ++j) mx = fmaxf(mx, fmaxf(fmaxf(fabsf(v[j][0]), fabsf(v[j][1])), fmaxf(fabsf(v[j][2]), fabsf(v[j][3]))));
    mx = fmaxf(wave_max(mx), 1e-30f);
    const float sc = mx * (1.f / 127.f), inv = 127.f / mx;
    unsigned char* dst = (isv ? VQ : UQ) + (size_t)e * DM;
    const int zp = isv ? 128 : 0;
#pragma unroll
    for (int j = 0; j < 8; ++j) {
        unsigned w = 0;
#pragma unroll
        for (int c = 0; c < 4; ++c) { const int q = (int)rintf(v[j][c] * inv) + zp; w |= ((unsigned)q & 0xffu) << (8 * c); }
        *(unsigned*)(dst + j * 256 + lane * 4) = w;
    }
    if (lane == 0) (isv ? VSC : USC)[e] = sc;
}
__device__ __forceinline__ void peer_tables_q8(const Params& p, int gw, int NGW, int lane) {
    f32x4 va[8], vb[8];
#define Q8_LOAD(dst, r) do { const float* s_ = ((r) >= 16384 ? p.in[22] + (size_t)((r) - 16384) * DM : p.in[21] + (size_t)(r) * DM); \
        _Pragma("unroll") for (int j = 0; j < 8; ++j) dst[j] = *(const f32x4*)(s_ + j * 256 + lane * 4); } while (0)
    int r = gw;
    if (r < 2 * 16384) Q8_LOAD(va, r);
    for (; r < 2 * 16384; r += 2 * NGW) {
        const int r1 = r + NGW, r2 = r + 2 * NGW;
        if (r1 < 2 * 16384) Q8_LOAD(vb, r1);
        peer_q8_row(p, r, va, lane);
        if (r2 < 2 * 16384) Q8_LOAD(va, r2);
        if (r1 < 2 * 16384) peer_q8_row(p, r1, vb, lane);
    }
#undef Q8_LOAD
}

__device__ __forceinline__ void peer_gather_q8(const Params& p, unsigned char* lds_, bool dry = false, int emask = 0x3fff) {
    int tid_ = threadIdx.x; asm volatile("" : "+v"(tid_)); const int tid = tid_, lane = tid & 63, wid = tid >> 6;
    LAS3 int* srt = (LAS3 int*)lds_ + wid * 256;
    const int gw = blockIdx.x * NWAVES + wid, NGW = gridDim.x * NWAVES;
    const float* TKV = (const float*)(p.ws + WS_TKV); const int* TKI = (const int*)(p.ws + WS_TKI);
    const bf16_t* H = (const bf16_t*)(p.ws + WS_H);
    const unsigned char* UQ = p.ws + WS_UQ; const unsigned char* VQ = p.ws + WS_VQ; const float* USC = (const float*)(p.ws + WS_USC); const float* VSC = (const float*)(p.ws + WS_VSC);
    const float* mod = (const float*)(p.ws + WS_MOD); const float* gpo = p.in[9];
    const int rounds = (TL + NGW - 1) / NGW;
    for (int it = 0; it < rounds; ++it) {
        const int m = gw + it * NGW;
#ifndef GATHER_UNSORTED
        __syncthreads();
#endif
        if (m >= TL) continue;
        int eA, eB; float gA, gB;
#if defined(TOPK_NAIVE) || defined(TOPK_STAGE1)
        peer_select(TKV, TKI, m, lane, eA, eB, gA, gB);
#else
        eA = TKI[(size_t)m * 128 + lane]; eB = TKI[(size_t)m * 128 + 64 + lane]; gA = TKV[(size_t)m * 128 + lane]; gB = TKV[(size_t)m * 128 + 64 + lane];
#endif
#ifndef GATHER_UNSORTED
        {
            int rA = 0, rB = 0;
#pragma nounroll
            for (int j = 0; j < 64; ++j) {
                const int ea = __builtin_amdgcn_readlane(eA, j), eb = __builtin_amdgcn_readlane(eB, j);
                rA += (ea < eA || (ea == eA && j < lane)) ? 1 : 0; rA += (eb < eA) ? 1 : 0;
                rB += (ea < eB || ea == eB) ? 1 : 0; rB += (eb < eB || (eb == eB && j < lane)) ? 1 : 0;
            }
            srt[rA] = eA; srt[128 + rA] = __float_as_int(gA); srt[rB] = eB; srt[128 + rB] = __float_as_int(gB);
            eA = srt[lane]; eB = srt[64 + lane]; gA = __int_as_float(srt[128 + lane]); gB = __int_as_float(srt[192 + lane]);
        }
#endif
        asm volatile("" : "+v"(eA), "+v"(eB), "+v"(gA), "+v"(gB));
        unsigned hq[2][4]; float hscale;
        {
            u32x4 hw[2][2]; float mx = 0.f;
#pragma unroll
            for (int i = 0; i < 2; ++i)
#pragma unroll
                for (int q = 0; q < 2; ++q) { hw[i][q] = *(const u32x4*)(H + (size_t)m * DM + i * 1024 + lane * 16 + q * 8);
#pragma unroll
                    for (int c = 0; c < 4; ++c) { const unsigned w = hw[i][q][c]; mx = fmaxf(mx, fmaxf(fabsf(__uint_as_float(w << 16)), fabsf(__uint_as_float(w & 0xffff0000u)))); } }
            mx = fmaxf(wave_max(mx), 1e-30f);
            hscale = mx * (1.f / 127.f); const float inv = 127.f / mx;
#pragma unroll
            for (int i = 0; i < 2; ++i)
#pragma unroll
                for (int q = 0; q < 2; ++q)
#pragma unroll
                    for (int c2 = 0; c2 < 2; ++c2) {
                        const unsigned w0 = hw[i][q][2 * c2], w1 = hw[i][q][2 * c2 + 1];
                        const int q0 = (int)rintf(__uint_as_float(w0 << 16) * inv), q1 = (int)rintf(__uint_as_float(w0 & 0xffff0000u) * inv);
                        const int q2 = (int)rintf(__uint_as_float(w1 << 16) * inv), q3 = (int)rintf(__uint_as_float(w1 & 0xffff0000u) * inv);
                        hq[i][2 * q + c2] = ((unsigned)q0 & 0xffu) | (((unsigned)q1 & 0xffu) << 8) | (((unsigned)q2 & 0xffu) << 16) | (((unsigned)q3 & 0xffu) << 24);
                    }
        }
        float cA = 0.f, cB = 0.f; float csum = 0.f;
        {
            u32x4 us[8][2]; float usc[8], vsc[8];
#define PU_LOAD(S, k) do { const int e_ = __builtin_amdgcn_readlane((k) < 64 ? eA : eB, (k) & 63) & emask; int ev_ = e_; asm volatile("" : "+v"(ev_)); \
                const unsigned char* up_ = UQ + (size_t)e_ * DM + lane * 16; us[S][0] = *(const u32x4*)up_; us[S][1] = *(const u32x4*)(up_ + 1024); usc[S] = USC[ev_]; vsc[S] = VSC[ev_]; } while (0)
#define PU_COEF(S, k) do { int id_ = 0; \
                _Pragma("unroll") for (int i = 0; i < 2; ++i) _Pragma("unroll") for (int c = 0; c < 4; ++c) { const unsigned uw_ = us[S][i][c]; id_ = __builtin_amdgcn_sdot4((int)uw_, (int)hq[i][c], id_, false); } \
                const float d_ = wave_sum_dpp((float)id_) * (hscale * usc[S]); \
                const float g_ = __uint_as_float((unsigned)__builtin_amdgcn_readlane((int)__float_as_uint((k) < 64 ? gA : gB), (k) & 63)); \
                const float cf_ = g_ * gelu_as(d_) * vsc[S]; csum += cf_; \
                if ((k) < 64) cA = lane == ((k) & 63) ? cf_ : cA; else cB = lane == ((k) & 63) ? cf_ : cB; } while (0)
            PU_LOAD(0, 0); PU_LOAD(1, 1); PU_LOAD(2, 2); PU_LOAD(3, 3); PU_LOAD(4, 4); PU_LOAD(5, 5); PU_LOAD(6, 6); PU_LOAD(7, 7);
#pragma nounroll
            for (int k = 0; k < 128; k += 8) {
                const int kn = k + 8 < 128 ? k + 8 : 120;
                PU_COEF(0, k); PU_COEF(1, k + 1); PU_COEF(2, k + 2); PU_COEF(3, k + 3);
                PU_LOAD(0, kn); PU_LOAD(1, kn + 1); PU_LOAD(2, kn + 2); PU_LOAD(3, kn + 3);
                PU_COEF(4, k + 4); PU_COEF(5, k + 5); PU_COEF(6, k + 6); PU_COEF(7, k + 7);
                PU_LOAD(4, kn + 4); PU_LOAD(5, kn + 5); PU_LOAD(6, kn + 6); PU_LOAD(7, kn + 7);
            }
#undef PU_LOAD
#undef PU_COEF
        }
        float acc[2][16];
#pragma unroll
        for (int i = 0; i < 2; ++i)
#pragma unroll
            for (int e = 0; e < 16; ++e) acc[i][e] = 0.f;
        {
            u32x4 vs[8][2];
#define PV_LOAD(S, k) do { const int e_ = __builtin_amdgcn_readlane((k) < 64 ? eA : eB, (k) & 63) & emask; \
                const unsigned char* vp_ = VQ + (size_t)e_ * DM + lane * 16; vs[S][0] = *(const u32x4*)vp_; vs[S][1] = *(const u32x4*)(vp_ + 1024); } while (0)
#define PV_ACC(S, k) do { const float cf_ = __uint_as_float((unsigned)__builtin_amdgcn_readlane((int)__float_as_uint((k) < 64 ? cA : cB), (k) & 63)); \
                _Pragma("unroll") for (int i = 0; i < 2; ++i) _Pragma("unroll") for (int c = 0; c < 4; ++c) { const unsigned w_ = vs[S][i][c]; \
                    acc[i][4 * c + 0] += cf_ * (float)(w_ & 0xffu); acc[i][4 * c + 1] += cf_ * (float)((w_ >> 8) & 0xffu); \
                    acc[i][4 * c + 2] += cf_ * (float)((w_ >> 16) & 0xffu); acc[i][4 * c + 3] += cf_ * (float)(w_ >> 24); } } while (0)
            PV_LOAD(0, 0); PV_LOAD(1, 1); PV_LOAD(2, 2); PV_LOAD(3, 3); PV_LOAD(4, 4); PV_LOAD(5, 5); PV_LOAD(6, 6); PV_LOAD(7, 7);
#pragma nounroll
            for (int k = 0; k < 128; k += 8) {
                const int kn = k + 8 < 128 ? k + 8 : 120;
                PV_ACC(0, k); PV_ACC(1, k + 1); PV_ACC(2, k + 2); PV_ACC(3, k + 3);
                PV_LOAD(0, kn); PV_LOAD(1, kn + 1); PV_LOAD(2, kn + 2); PV_LOAD(3, kn + 3);
                PV_ACC(4, k + 4); PV_ACC(5, k + 5); PV_ACC(6, k + 6); PV_ACC(7, k + 7);
                PV_LOAD(4, kn + 4); PV_LOAD(5, kn + 5); PV_LOAD(6, kn + 6); PV_LOAD(7, kn + 7);
            }
#undef PV_LOAD
#undef PV_ACC
        }
        const float zoff = 128.f * csum;
        float ss = 0.f;
#pragma unroll
        for (int i = 0; i < 2; ++i)
#pragma unroll
            for (int e = 0; e < 16; ++e) { acc[i][e] -= zoff; ss += acc[i][e] * acc[i][e]; }
        const float rstd = rsqrtf(wave_sum(ss) * (1.f / DM) + EPS);
        const int b = m / SEQ;
#pragma unroll
        for (int i = 0; i < 2; ++i)
#pragma unroll
            for (int q = 0; q < 4; ++q) {
                const int c = i * 1024 + lane * 16 + q * 4;
                const f32x4 gt2 = *(const f32x4*)(mod + (size_t)b * 12288 + 10240 + c), gg = *(const f32x4*)(gpo + c);
                float* op = p.out + (size_t)m * DM + c;
                const f32x4 x1 = *(const f32x4*)op;
                const f32x4 y = {acc[i][4 * q], acc[i][4 * q + 1], acc[i][4 * q + 2], acc[i][4 * q + 3]};
                const f32x4 res = x1 + gt2 * (y * rstd * gg);
                if (!dry) *(f32x4*)op = res; else asm volatile("" :: "v"(res));
            }
    }
}


#define LAS __attribute__((address_space(3)))
#define XB_TMO      128
#define XB_XCNT(j)  (256  + 64 * (j))
#define XB_XSUB(j)  (1280 + 64 * (j))
#define XB_XGEN(j)  (2304 + 64 * (j))
#define XB_TOP      3328
#define XB_TOPGEN   3392
#define XCD_BAR_WORDS 3456
#define XB_SPIN_CAP (1u << 18)

__device__ __forceinline__ unsigned xb_ld(unsigned* p)              { return __hip_atomic_load(p, __ATOMIC_RELAXED, __HIP_MEMORY_SCOPE_AGENT); }
__device__ __forceinline__ unsigned xb_add(unsigned* p, unsigned v) { return __hip_atomic_fetch_add(p, v, __ATOMIC_RELAXED, __HIP_MEMORY_SCOPE_AGENT); }
__device__ __forceinline__ unsigned xb_xcc_id() { return (unsigned)__builtin_amdgcn_s_getreg((3 << 11) | 20) & 0xFu; }
#define XB_SPIN(cond, bar) do { unsigned _sp = 0; while (cond) { __builtin_amdgcn_s_sleep(1); \
    if ((++_sp & 255u) == 0u) { if (xb_ld(&(bar)[XB_TMO])) break; if (_sp > XB_SPIN_CAP) { atomicAdd(&(bar)[XB_TMO], 1u); break; } } } } while (0)

struct XcdBarrier {
    unsigned* bar; unsigned x;
    volatile LAS unsigned* st;
};

__device__ __forceinline__ XcdBarrier xcd_barrier_post(unsigned* bar, volatile LAS unsigned* st) {
    XcdBarrier b; b.bar = bar; b.x = xb_xcc_id(); b.st = st;
    if (threadIdx.x == 0) (void)xb_add(&bar[XB_XCNT(b.x)], 1u);
    return b;
}
__device__ __forceinline__ void xcd_barrier_complete(unsigned* bar, unsigned x, unsigned& nloc, unsigned& nx) {
    const unsigned G = gridDim.x * gridDim.y * gridDim.z;
    unsigned sum, cnt, mine, sp = 0u;
    for (;;) {
        sum = 0u; cnt = 0u; mine = 0u;
#pragma unroll
        for (unsigned j = 0; j < 16; ++j) { const unsigned c = xb_ld(&bar[XB_XCNT(j)]); sum += c; cnt += (c > 0u) ? 1u : 0u; mine = (j == x) ? c : mine; }
        if (sum == G) break;
        __builtin_amdgcn_s_sleep(1);
        if ((++sp & 255u) == 0u) { if (xb_ld(&bar[XB_TMO])) break; if (sp > XB_SPIN_CAP) { atomicAdd(&bar[XB_TMO], 1u); break; } }
    }
    nloc = mine > 0u ? mine : 1u; nx = cnt > 0u ? cnt : 1u;
}

__device__ __forceinline__ void xcd_barrier(const XcdBarrier& b) {
    asm volatile("s_waitcnt vmcnt(0)" ::: "memory");
    __syncthreads();
    if (threadIdx.x == 0) {
        unsigned* bar = b.bar;
        __builtin_amdgcn_s_waitcnt(0);
        unsigned nloc = b.st[0], nx = b.st[1];
        if (nloc == 0u) { xcd_barrier_complete(bar, b.x, nloc, nx); b.st[0] = nloc; b.st[1] = nx; }
        const unsigned old = xb_add(&bar[XB_XSUB(b.x)], 1u);
        const unsigned gen = old / nloc;
        if (old + 1u == (gen + 1u) * nloc) {
            __builtin_amdgcn_fence(__ATOMIC_RELEASE, "agent");
            asm volatile("s_waitcnt vmcnt(0)" ::: "memory");
            const unsigned og = xb_add(&bar[XB_TOP], 1u);
            const unsigned tg = og / nx;
            if (og + 1u == (tg + 1u) * nx) xb_add(&bar[XB_TOPGEN], 1u);
            else XB_SPIN(xb_ld(&bar[XB_TOPGEN]) == tg, bar);
            __builtin_amdgcn_fence(__ATOMIC_ACQUIRE, "agent");
            xb_add(&bar[XB_XGEN(b.x)], 1u);
            asm volatile("s_waitcnt vmcnt(0)" ::: "memory");
        } else {
            XB_SPIN(xb_ld(&bar[XB_XGEN(b.x)]) == gen, bar);
            __builtin_amdgcn_fence(__ATOMIC_ACQUIRE, "agent");
            asm volatile("s_waitcnt vmcnt(0)" ::: "memory");
        }
    }
    __syncthreads();
}


__global__ void __launch_bounds__(NTHREADS, 2) mega(Params p) {
    extern __shared__ __attribute__((aligned(16))) unsigned char lds[];
    cg::grid_group grid = cg::this_grid();
    unsigned char* ws = p.ws;
    bf16_t* H = (bf16_t*)(ws + WS_H); bf16_t* PL = (bf16_t*)(ws + WS_PL); bf16_t* PCx = (bf16_t*)(ws + WS_PC);
    const int lo = p.ph_lo, hi = p.ph_hi;
    volatile LAS unsigned* bst = (volatile LAS unsigned*)((LAS unsigned char*)lds + (LDS_BYTES - 64));
    unsigned* barw = (unsigned*)(ws + WS_BAR);
    if (threadIdx.x < 2) bst[threadIdx.x] = 0u;
    if (blockIdx.x == 0) for (int i = threadIdx.x; i < XCD_BAR_WORDS; i += NTHREADS) barw[i] = 0u;
    __syncthreads();
    XcdBarrier xbar; xbar.bar = barw; xbar.x = 0; xbar.st = bst;
#ifdef PHONLY
#define IN(k) ((k) == PHONLY && lo <= (k) && (k) < hi)
#else
#define IN(k) (lo <= (k) && (k) < hi)
#endif
#ifndef DUP
#define DUP -1
#endif
#define REP(k) for (int rep_ = 0; rep_ < ((k) == DUP ? 2 : 1); ++rep_)
#define SEAM(k) do { if (IN(k) && IN((k) + 1)) { \
        if ((k) == 0) { asm volatile("s_waitcnt vmcnt(0) lgkmcnt(0)" ::: "memory"); grid.sync(); \
            if (threadIdx.x < 64) { __builtin_amdgcn_fence(__ATOMIC_ACQUIRE, "agent"); asm volatile("s_waitcnt vmcnt(0)" ::: "memory"); } __syncthreads(); \
            xbar = xcd_barrier_post(barw, bst); } \
        else xcd_barrier(xbar); } } while (0)
    if (IN(0)) { phase0(p, lds); __syncthreads(); if (DUP == 0) { phase0(p, lds); __syncthreads(); } }
    SEAM(0);
    if (IN(1)) REP(1) phase1(p);
    SEAM(1);
    if (IN(2)) REP(2) {
        { EpiInproj e{PL, NP, PC_GA}; run_gemm<EpiInproj, false>(lds, H, DM, (const bf16_t*)(ws + WS_WIN), DM, TL, NP, DM, e); }
        { EpiInproj e{PCx, NPC, 1 << 30}; run_gemm<EpiInproj, false>(lds, H + (size_t)TL * DM, DM, (const bf16_t*)(ws + WS_WIN), DM, TC, NPC, DM, e, 128); }
    }
    SEAM(2);
    if (IN(3)) {
#ifndef NO_P3_GEMM
        { EpiMlaQ e{(bf16_t*)(ws + WS_QM), (const float*)(ws + WS_ROPE)}; run_gemm<EpiMlaQ, true>(lds, PL + PC_CQ, NP, (const bf16_t*)(ws + WS_WQB), QR, TL, MQW, QR, e); }
        { EpiMlaKV e{(bf16_t*)(ws + WS_KVM), 0}; run_gemm<EpiMlaKV, true>(lds, PL + PC_CKV, NP, (const bf16_t*)(ws + WS_WKVB), KVR, TL, MKVW, KVR, e); }
        { EpiMlaKV e{(bf16_t*)(ws + WS_KVM), TL}; run_gemm<EpiMlaKV, true>(lds, PCx + PC_CKV, NPC, (const bf16_t*)(ws + WS_WKVB), KVR, TC, MKVW, KVR, e, 128); __syncthreads(); }
        if (DUP == 31) {
        { EpiMlaQ e{(bf16_t*)(ws + WS_QM), (const float*)(ws + WS_ROPE)}; run_gemm<EpiMlaQ, true>(lds, PL + PC_CQ, NP, (const bf16_t*)(ws + WS_WQB), QR, TL, MQW, QR, e); }
        { EpiMlaKV e{(bf16_t*)(ws + WS_KVM), 0}; run_gemm<EpiMlaKV, true>(lds, PL + PC_CKV, NP, (const bf16_t*)(ws + WS_WKVB), KVR, TL, MKVW, KVR, e); }
        { EpiMlaKV e{(bf16_t*)(ws + WS_KVM), TL}; run_gemm<EpiMlaKV, true>(lds, PCx + PC_CKV, NPC, (const bf16_t*)(ws + WS_WKVB), KVR, TC, MKVW, KVR, e, 128); __syncthreads(); }
        }
#endif
        kpe_pass(p);
#ifdef NA_NAIVE
        na_naive(p, lds);
#else
#ifdef NA_PERWAVE
        na_flash(p, lds);
        if (DUP == 30) na_flash(p, lds);
#else
        na_coop(p, lds);
        if (DUP == 30) na_coop(p, lds);
#endif
#endif
    }
    SEAM(3);
#ifdef MLA_NAIVE
    if (IN(4)) mla_naive(p, lds);
#else
    if (IN(4)) REP(4) mla_flash(p, lds);
#endif
    SEAM(4);
    if (IN(5)) REP(5) {
        { EpiMergeF e{H, PL}; run_gemm<EpiMergeF, false>(lds, (const bf16_t*)(ws + WS_OA), DM, (const bf16_t*)(ws + WS_WA), DM, TL, DM, DM, e); }
    }
    SEAM(5);
    if (IN(6)) REP(6) { EpiStore e{(bf16_t*)(ws + WS_Z), DM}; run_gemm<EpiStore, false>(lds, H, DM, (const bf16_t*)(ws + WS_WO), DM, TL, DM, DM, e); }
    SEAM(6);
    if (IN(7)) REP(7) phase7(p);
    SEAM(7);
    if (IN(8)) REP(8) { EpiStore e{(bf16_t*)(ws + WS_QP), DM}; run_gemm<EpiStore, false>(lds, H, DM, (const bf16_t*)(ws + WS_WPQ), DM, TL, DM, DM, e); }
    SEAM(8);
    if (IN(9)) REP(9) {
#if defined(TOPK_NAIVE)
        peer_topk_naive(p, lds);
#elif defined(TOPK_STAGE1)
        peer_topk_mfma(p, lds);
#else
        peer_select_mfma(p, lds);
        if (DUP == 90) peer_select_mfma(p, lds, 1);
        if (DUP == 91) peer_select_mfma(p, lds, 2);
#endif
#ifdef PEER_BF16
        peer_tables_bf16(p);
#endif
    }
    SEAM(9);
#ifdef PEER_NAIVE
    if (IN(10)) peer_final_naive(p, lds);
#else
#ifdef PEER_BF16
    if (IN(10)) { if (DUP == 10) peer_gather(p, true); peer_gather(p); }
#else
    if (IN(10)) { if (DUP == 10) peer_gather_q8(p, lds, true); if (DUP == 100) peer_gather_q8(p, lds, true, 1023); if (DUP == 101) peer_gather_q8(p, lds, true, 127); peer_gather_q8(p, lds); }
#endif
#endif
#undef IN
#undef SEAM
}

extern "C" void kernel_launch(void* const* d_in, const int* in_sizes, int n_in, void* d_out, int out_size, void* d_ws, size_t ws_size, hipStream_t stream) {
    static int grid = 0;
    if (grid == 0) {
        int dev = 0, cus = 0, per_cu = 0;
        (void)hipGetDevice(&dev);
        (void)hipDeviceGetAttribute(&cus, hipDeviceAttributeMultiprocessorCount, dev);
        (void)hipFuncSetAttribute((const void*)mega, hipFuncAttributeMaxDynamicSharedMemorySize, LDS_BYTES);
        (void)hipOccupancyMaxActiveBlocksPerMultiprocessor(&per_cu, (const void*)mega, NTHREADS, LDS_BYTES);
        if (per_cu < 1) { fprintf(stderr, "occupancy query says %d blocks per CU\n", per_cu); per_cu = 1; }
        grid = cus * 1;
        (void)hipGetLastError();
        if (n_in != 23 || ws_size < WS_END) fprintf(stderr, "kernel_launch: unexpected n_in %d or ws %zu\n", n_in, ws_size);
    }
    Params p{};
    for (int i = 0; i < 23; ++i) p.in[i] = (const float*)d_in[i];
    p.out = (float*)d_out; p.ws = (unsigned char*)d_ws; p.ph_lo = 0; p.ph_hi = 11;
    void* args[] = {&p};
    hipError_t e = hipLaunchCooperativeKernel((const void*)mega, dim3(grid), dim3(NTHREADS), args, LDS_BYTES, stream);
    if (e != hipSuccess) fprintf(stderr, "cooperative launch failed: %s (grid %d)\n", hipGetErrorString(e), grid);
}
```

```cpp
#include <hip/hip_runtime.h>
#include <hip/hip_cooperative_groups.h>
#include <cstdio>
#include <cstdint>
namespace cg = cooperative_groups;

typedef unsigned short bf16_t;
typedef short bf16x8 __attribute__((ext_vector_type(8)));
typedef float f32x4 __attribute__((ext_vector_type(4)));
typedef unsigned u32x4 __attribute__((ext_vector_type(4)));
typedef unsigned u32x2 __attribute__((ext_vector_type(2)));

constexpr int DM = 2048, NB = 8, SEQ = 2048, CTX = 256, GW = 64, GROWS = 32;
constexpr int TL = NB * SEQ;
constexpr int TC = NB * CTX;
constexpr int TA = TL + TC;
constexpr int IN_COLS = 8512;
constexpr int NP = 8704;
constexpr int NPC = 2816;
constexpr int PC_KA = 0, PC_VA = 1024, PC_CKV = 2048, PC_KPE = 2560, PC_QA = 2816, PC_CQ = 3840, PC_GA = 4608, PC_GB = 6656;
constexpr int QR = 768, KVR = 512;
constexpr int MQW = 1536, MKVW = 2048;
constexpr float EPS = 1e-6f;
constexpr float LOG2E = 1.4426950408889634f;
constexpr float MLA_QSCALE = 0.07216878364870322f * LOG2E;
constexpr float NA_SCALE = 0.125f;

constexpr size_t al256(size_t x) { return (x + 255) & ~(size_t)255; }
constexpr size_t WS_MOD = 0;
constexpr size_t WS_ROPE = al256(WS_MOD + 9 * 12288 * 4);
constexpr size_t WS_BAR = al256(WS_ROPE + (size_t)SEQ * 32 * 2 * 4);
constexpr size_t WS_WIN = al256(WS_BAR + 3456 * 4);
constexpr size_t WS_WQB = WS_WIN + (size_t)NP * DM * 2;
constexpr size_t WS_WKVB = WS_WQB + (size_t)MQW * QR * 2;
constexpr size_t WS_WA = WS_WKVB + (size_t)MKVW * KVR * 2;
constexpr size_t WS_WB = WS_WA + (size_t)DM * 1024 * 2;
constexpr size_t WS_WO = WS_WB + (size_t)DM * 1024 * 2;
constexpr size_t WS_WPQ = WS_WO + (size_t)DM * DM * 2;
constexpr size_t WS_SUBK = WS_WPQ + (size_t)DM * DM * 2;
constexpr size_t WS_H = WS_SUBK + (size_t)262144 * 2;
constexpr size_t WS_PL = WS_H + (size_t)TA * DM * 2;
constexpr size_t WS_PC = WS_PL + (size_t)TL * NP * 2;
constexpr size_t WS_QM = WS_PC + (size_t)TC * NPC * 2;
constexpr size_t WS_KVM = WS_QM + (size_t)TL * MQW * 2;
constexpr size_t WS_KPE = WS_KVM + (size_t)TA * MKVW * 2;
constexpr size_t WS_OA = WS_KPE + (size_t)TA * 64 * 2;
constexpr size_t WS_OB = WS_OA + 1024 * 2;
constexpr size_t WS_END = WS_OA + (size_t)TL * 2048 * 2;
constexpr size_t WS_Z = WS_PL;
constexpr size_t WS_QP = WS_PL + (size_t)TL * DM * 2;
constexpr size_t WS_TKV = WS_QP + (size_t)TL * DM * 2;
constexpr size_t WS_TKI = WS_TKV + (size_t)TL * 256 * 4;
constexpr size_t WS_UB = WS_QM;
constexpr size_t WS_VB = WS_UB + (size_t)16384 * DM * 2;
constexpr size_t WS_UQ = WS_QM;
constexpr size_t WS_VQ = WS_UQ + (size_t)16384 * DM;
constexpr size_t WS_USC = WS_VQ + (size_t)16384 * DM;
constexpr size_t WS_VSC = WS_USC + 16384 * 4;
static_assert(WS_TKI + (size_t)TL * 256 * 4 <= WS_PC, "overlay");
static_assert(WS_END <= 650307648ull, "workspace");
static_assert(WS_VB + (size_t)16384 * DM * 2 <= WS_END, "expert table overlay");

constexpr int NTHREADS = 512, NWAVES = 8;
constexpr int LDS_BYTES = 139264;

struct Params {
    const float* in[23];
    float* out;
    unsigned char* ws;
    int ph_lo, ph_hi;
};

__device__ __forceinline__ float bf2f(bf16_t v) { return __uint_as_float((unsigned)v << 16); }
__device__ __forceinline__ unsigned f2bf(float f) { unsigned u = __float_as_uint(f); return (u + 0x7fffu + ((u >> 16) & 1u)) >> 16; }
__device__ __forceinline__ unsigned pk2(float lo, float hi) { return f2bf(lo) | (f2bf(hi) << 16); }
__device__ __forceinline__ float wave_sum(float v) {
#pragma unroll
    for (int o = 1; o < 64; o <<= 1) v += __shfl_xor(v, o);
    return v;
}
__device__ __forceinline__ float wave_sum_dpp(float v) {
    v += __builtin_bit_cast(float, __builtin_amdgcn_update_dpp(0, __builtin_bit_cast(int, v), 0xB1, 0xF, 0xF, false));
    v += __builtin_bit_cast(float, __builtin_amdgcn_update_dpp(0, __builtin_bit_cast(int, v), 0x4E, 0xF, 0xF, false));
    v += __builtin_bit_cast(float, __builtin_amdgcn_update_dpp(0, __builtin_bit_cast(int, v), 0x141, 0xF, 0xF, false));
    v += __builtin_bit_cast(float, __builtin_amdgcn_update_dpp(0, __builtin_bit_cast(int, v), 0x140, 0xF, 0xF, false));
    v += __builtin_bit_cast(float, __builtin_amdgcn_update_dpp(0, __builtin_bit_cast(int, v), 0x142, 0xA, 0xF, false));
    v += __builtin_bit_cast(float, __builtin_amdgcn_update_dpp(0, __builtin_bit_cast(int, v), 0x143, 0xC, 0xF, false));
    return __builtin_bit_cast(float, __builtin_amdgcn_readlane(__builtin_bit_cast(int, v), 63));
}
__device__ __forceinline__ float wave_max(float v) {
#pragma unroll
    for (int o = 1; o < 64; o <<= 1) v = fmaxf(v, __shfl_xor(v, o));
    return v;
}
__device__ __forceinline__ float sigmoidf_(float x) { return 1.f / (1.f + __expf(-x)); }
__device__ __forceinline__ float silu_(float x) { return x / (1.f + __expf(-x)); }
__device__ __forceinline__ float gelu_erf(float x) { return 0.5f * x * (1.f + erff(x * 0.70710678118654752f)); }

__device__ __forceinline__ float gelu_as(float v) {
    const float t = __builtin_amdgcn_rcpf(fabsf(v) * 0.2316418882f + 1.0f);
    float q = t * 0.5307027145f + (-0.7265760135f); q = q * t + 0.7107068705f; q = q * t + (-0.142248368f); q = q * t + 0.127414796f; q = q * t;
    const float e = __builtin_amdgcn_exp2f((v * v) * (-0.72134752044f));
    const float mm = v * (q * e);
    return v < 0.f ? mm : v - mm;
}
__device__ __forceinline__ void rope_cs(int s, int j, float& c, float& sn) {
    const int gr = s >> 6, gc = s & 63;
    const int i = j & 15;
    const float invf = exp2f(-(float)i * (13.287712379549449f / 16.f));
    const float ang = (float)(j < 16 ? gr : gc) * invf;
    sincosf(ang, &sn, &c);
}

template <class Epi>
__device__ __forceinline__ void ngemm(const bf16_t* __restrict__ A, int lda, const bf16_t* __restrict__ Bt, int ldb, int M, int N, int K, const Epi& epi, float* rs = nullptr) {
    int tid_ = threadIdx.x; asm volatile("" : "+v"(tid_)); const int tid = tid_, wid = tid >> 6, lane = tid & 63, fr = lane & 15, fq = lane >> 4;
    const int tilesM = M / 128, tilesN = N / 256, nt = tilesM * tilesN;
    for (int t = blockIdx.x; t < nt; t += gridDim.x) {
        const int tm = t % tilesM, tn = t / tilesM;
        const int row0 = tm * 128 + (wid >> 2) * 64, col0 = tn * 256 + (wid & 3) * 64;
        if (Epi::PRO) {
            __syncthreads();
            const int r = tid >> 2, part = tid & 3, len = K >> 2;
            const bf16_t* ar = A + (size_t)(tm * 128 + r) * lda + part * len;
            float ss = 0.f;
            for (int k = 0; k < len; k += 8) { const bf16x8 v = *(const bf16x8*)(ar + k);
#pragma unroll
                for (int e = 0; e < 8; ++e) { const float f = bf2f((bf16_t)v[e]); ss += f * f; } }
            ss += __shfl_xor(ss, 1); ss += __shfl_xor(ss, 2);
            if (part == 0) rs[r] = rsqrtf(ss / (float)K + EPS);
            __syncthreads();
        }
        f32x4 acc[4][4];
#pragma unroll
        for (int i = 0; i < 4; ++i)
#pragma unroll
            for (int j = 0; j < 4; ++j) acc[i][j] = (f32x4){0.f, 0.f, 0.f, 0.f};
        const bf16_t* ap = A + (size_t)(row0 + fr) * lda + fq * 8;
        const bf16_t* bp = Bt + (size_t)(col0 + fr) * ldb + fq * 8;
        for (int k0 = 0; k0 < K; k0 += 32) {
            bf16x8 a[4], b[4];
#pragma unroll
            for (int i = 0; i < 4; ++i) a[i] = *(const bf16x8*)(ap + (size_t)i * 16 * lda + k0);
#pragma unroll
            for (int j = 0; j < 4; ++j) b[j] = *(const bf16x8*)(bp + (size_t)j * 16 * ldb + k0);
#pragma unroll
            for (int i = 0; i < 4; ++i)
#pragma unroll
                for (int j = 0; j < 4; ++j) acc[i][j] = __builtin_amdgcn_mfma_f32_16x16x32_bf16(b[j], a[i], acc[i][j], 0, 0, 0);
        }
#pragma unroll
        for (int i = 0; i < 4; ++i) {
            const int row = row0 + i * 16 + fr;
            const float rstd = Epi::PRO ? rs[row - tm * 128] : 1.f;
#pragma unroll
            for (int j = 0; j < 4; ++j) epi.quad(row, col0 + j * 16 + 4 * fq, acc[i][j] * rstd);
        }
    }
}

__device__ __forceinline__ void store_bf4(bf16_t* p, f32x4 v) { u32x2 w; w.x = pk2(v[0], v[1]); w.y = pk2(v[2], v[3]); *(u32x2*)p = w; }
__device__ __forceinline__ void store_bf8(bf16_t* p, f32x4 a, f32x4 b) { u32x4 w; w.x = pk2(a[0], a[1]); w.y = pk2(a[2], a[3]); w.z = pk2(b[0], b[1]); w.w = pk2(b[2], b[3]); *(u32x4*)p = w; }
__device__ __forceinline__ void load_bf8(const bf16_t* p, f32x4& a, f32x4& b) { const u32x4 g = *(const u32x4*)p;
    a = (f32x4){__uint_as_float(g.x << 16), __uint_as_float(g.x & 0xffff0000u), __uint_as_float(g.y << 16), __uint_as_float(g.y & 0xffff0000u)};
    b = (f32x4){__uint_as_float(g.z << 16), __uint_as_float(g.z & 0xffff0000u), __uint_as_float(g.w << 16), __uint_as_float(g.w & 0xffff0000u)}; }

struct EpiInproj {
    static constexpr bool MID = false, PRO = false;
    bf16_t* P; int ldp; int gate0;
    __device__ __forceinline__ void quad(int row, int col, f32x4 v) const {
        if (col >= gate0) { v[0] = sigmoidf_(v[0]); v[1] = sigmoidf_(v[1]); v[2] = sigmoidf_(v[2]); v[3] = sigmoidf_(v[3]); }
        store_bf4(P + (size_t)row * ldp + col, v);
    }
    __device__ __forceinline__ void oct(int row, int col, f32x4 a, f32x4 b) const {
        if (col >= gate0) {
#pragma unroll
            for (int e = 0; e < 4; ++e) { a[e] = sigmoidf_(a[e]); b[e] = sigmoidf_(b[e]); } }
        store_bf8(P + (size_t)row * ldp + col, a, b);
    }
};
struct EpiMlaQ {
    static constexpr bool MID = false, PRO = true;
    bf16_t* Q; const float* rope;
    __device__ __forceinline__ void quad(int row, int col, f32x4 v) const {
        v = v * MLA_QSCALE;
        const int d = col % 192;
        if (d >= 128) {
            const int j = (d - 128) >> 1, s = row & (SEQ - 1);
            const f32x4 cs = *(const f32x4*)(rope + ((size_t)s * 32 + j) * 2);
            const f32x4 o = {v[0] * cs[0] - v[1] * cs[1], v[0] * cs[1] + v[1] * cs[0], v[2] * cs[2] - v[3] * cs[3], v[2] * cs[3] + v[3] * cs[2]};
            v = o;
        }
        store_bf4(Q + (size_t)row * MQW + col, v);
    }
    __device__ __forceinline__ void oct(int row, int col, f32x4 a, f32x4 b) const {
        a = a * MLA_QSCALE; b = b * MLA_QSCALE;
        const int d = col % 192;
        if (d >= 128) {
            const int j = (d - 128) >> 1, s = row & (SEQ - 1);
            const f32x4 c0 = *(const f32x4*)(rope + ((size_t)s * 32 + j) * 2), c1 = *(const f32x4*)(rope + ((size_t)s * 32 + j + 2) * 2);
            const f32x4 oa = {a[0] * c0[0] - a[1] * c0[1], a[0] * c0[1] + a[1] * c0[0], a[2] * c0[2] - a[3] * c0[3], a[2] * c0[3] + a[3] * c0[2]};
            const f32x4 ob = {b[0] * c1[0] - b[1] * c1[1], b[0] * c1[1] + b[1] * c1[0], b[2] * c1[2] - b[3] * c1[3], b[2] * c1[3] + b[3] * c1[2]};
            a = oa; b = ob;
        }
        store_bf8(Q + (size_t)row * MQW + col, a, b);
    }
};
struct EpiMlaKV {
    static constexpr bool MID = false, PRO = true;
    bf16_t* KV; int row_off;
    __device__ __forceinline__ void quad(int row, int col, f32x4 v) const { store_bf4(KV + (size_t)(row_off + row) * MKVW + col, v); }
    __device__ __forceinline__ void oct(int row, int col, f32x4 a, f32x4 b) const { store_bf8(KV + (size_t)(row_off + row) * MKVW + col, a, b); }
};
template <int STEP> struct EpiMerge {
    static constexpr bool MID = false, PRO = false;
    bf16_t* Y; const bf16_t* P;
    __device__ __forceinline__ void quad(int row, int col, f32x4 v) const {
        const u32x2 g = *(const u32x2*)(P + (size_t)row * NP + (STEP == 0 ? PC_GA : PC_GB) + col);
        const f32x4 gv = {__uint_as_float(g.x << 16), __uint_as_float(g.x & 0xffff0000u), __uint_as_float(g.y << 16), __uint_as_float(g.y & 0xffff0000u)};
        v = v * gv;
        if (STEP == 1) {
            const u32x2 y = *(const u32x2*)(Y + (size_t)row * DM + col);
            v[0] += __uint_as_float(y.x << 16); v[1] += __uint_as_float(y.x & 0xffff0000u); v[2] += __uint_as_float(y.y << 16); v[3] += __uint_as_float(y.y & 0xffff0000u);
        }
        store_bf4(Y + (size_t)row * DM + col, v);
    }
};
struct EpiMergeF {
    static constexpr bool MID = true, PRO = false;
    bf16_t* Y; const bf16_t* P;
    __device__ __forceinline__ static f32x4 ld4(const bf16_t* q) { const u32x2 g = *(const u32x2*)q;
        return (f32x4){__uint_as_float(g.x << 16), __uint_as_float(g.x & 0xffff0000u), __uint_as_float(g.y << 16), __uint_as_float(g.y & 0xffff0000u)}; }
    __device__ __forceinline__ void midquad(int row, int col, f32x4& v) const {
        const f32x4 ga = ld4(P + (size_t)row * NP + PC_GA + col), gb = ld4(P + (size_t)row * NP + PC_GB + col);
#pragma unroll
        for (int e = 0; e < 4; ++e) v[e] *= ga[e] * __builtin_amdgcn_rcpf(fmaxf(gb[e], 1e-30f));
    }
    __device__ __forceinline__ void quad(int row, int col, f32x4 v) const { store_bf4(Y + (size_t)row * DM + col, v * ld4(P + (size_t)row * NP + PC_GB + col)); }
    __device__ __forceinline__ void midload(int row, int col, u32x4& ga, u32x4& gb) const { ga = *(const u32x4*)(P + (size_t)row * NP + PC_GA + col); gb = *(const u32x4*)(P + (size_t)row * NP + PC_GB + col); }
    __device__ __forceinline__ static void midapply(const u32x4 ga, const u32x4 gb, f32x4& a, f32x4& b) {
        const unsigned a0 = ga[0], a1 = ga[1], a2 = ga[2], a3 = ga[3], b0 = gb[0], b1 = gb[1], b2 = gb[2], b3 = gb[3];
        const f32x4 sa0 = {__uint_as_float(a0 << 16), __uint_as_float(a0 & 0xffff0000u), __uint_as_float(a1 << 16), __uint_as_float(a1 & 0xffff0000u)};
        const f32x4 sa1 = {__uint_as_float(a2 << 16), __uint_as_float(a2 & 0xffff0000u), __uint_as_float(a3 << 16), __uint_as_float(a3 & 0xffff0000u)};
        const f32x4 sb0 = {__uint_as_float(b0 << 16), __uint_as_float(b0 & 0xffff0000u), __uint_as_float(b1 << 16), __uint_as_float(b1 & 0xffff0000u)};
        const f32x4 sb1 = {__uint_as_float(b2 << 16), __uint_as_float(b2 & 0xffff0000u), __uint_as_float(b3 << 16), __uint_as_float(b3 & 0xffff0000u)};
#pragma unroll
        for (int e = 0; e < 4; ++e) { a[e] *= sa0[e] * __builtin_amdgcn_rcpf(fmaxf(sb0[e], 1e-30f)); b[e] *= sa1[e] * __builtin_amdgcn_rcpf(fmaxf(sb1[e], 1e-30f)); }
    }
    __device__ __forceinline__ void oct(int row, int col, f32x4 a, f32x4 b) const { f32x4 g0, g1; load_bf8(P + (size_t)row * NP + PC_GB + col, g0, g1); store_bf8(Y + (size_t)row * DM + col, a * g0, b * g1); }
};
struct EpiStore {
    static constexpr bool MID = false, PRO = false;
    bf16_t* O; int ldo;
    __device__ __forceinline__ void quad(int row, int col, f32x4 v) const { store_bf4(O + (size_t)row * ldo + col, v); }
    __device__ __forceinline__ void oct(int row, int col, f32x4 a, f32x4 b) const { store_bf8(O + (size_t)row * ldo + col, a, b); }
};

namespace pg8 {
#define PG8_LAS __attribute__((address_space(3)))
constexpr int BM = 256, BK = 64, HALF = 128, HTB = HALF * BK * 2  , STAGE_BYTES = 8 * HTB, NXCD = 8, WGM = 8;

__host__ __device__ __forceinline__ int lds_byte(int r, int c) { const int st = (r >> 4) * 2 + (c >> 5), rr = r & 15, cc = c & 31, ob = rr * 64 + cc * 2; return st * 1024 + (ob ^ (((ob >> 9) & 1) << 5)); }
__host__ __device__ __forceinline__ void stage_rc(int b, int& R, int& C) { const int st = b / 1024, sb = b % 1024, swz = sb ^ (((sb >> 9) & 1) << 5); R = (st >> 1) * 16 + swz / 64; C = (st & 1) * 32 + (swz % 64) / 2; }
__host__ __device__ __forceinline__ int perm32(int rho) { const int n = rho >> 4, i = rho & 15; return 8 * (i >> 2) + 4 * n + (i & 3); }

struct Unit { int pm, pn, ui; };
struct Gemm { const bf16_t* A; const bf16_t* Bt; int M, N, K, lda, ldb; };

struct StaticOrder {
    int nM, nN, nwg, G, c;
    __host__ __device__ void init(int M, int N, int G_, int c_) { nM = M / BM; nN = N / BM; nwg = nM * nN; G = G_; c = c_; }
    __host__ __device__ bool next(int i, Unit& u) const {
        const long L = (long)i * G + c; if (L >= nwg) return false;
        int wgid = (int)L; { const int q = nwg / NXCD, r = nwg % NXCD, xcd = wgid % NXCD, off = wgid / NXCD; wgid = (xcd < r ? xcd * (q + 1) : r * (q + 1) + (xcd - r) * q) + off; }
        const int nig = WGM * nN, gid = wgid / nig, fm = gid * WGM, gsz = (nM - fm) < WGM ? (nM - fm) : WGM;
        u.pm = fm + ((wgid % nig) % gsz); u.pn = (wgid % nig) / gsz; u.ui = i; return true;
    }
    __device__ __forceinline__ void a_ready(const Unit&) const {}
    __device__ __forceinline__ void done(const Unit&) const {}
};
template <class Epi, class Sched, bool ALIGN_EPI = false, bool SP2 = false>
__device__ __forceinline__ void gemm_phase(PG8_LAS unsigned char* lds, const Gemm g, const Sched& S, const Epi& E) {
    int tid_ = threadIdx.x; asm volatile("" : "+v"(tid_)); const int tid = tid_, wid = __builtin_amdgcn_readfirstlane(tid >> 6), lane = tid & 63, wr = wid >> 2, wc = wid & 3, fr = lane & 15, fq = lane >> 4;
    const int K = g.K, nt = K / BK;
    unsigned voffA[2], voffB[2];
#pragma unroll
    for (int i = 0; i < 2; ++i) { int R, C; stage_rc(tid * 16 + i * 8192, R, C); const int Rb = Epi::PERM ? ((R & ~31) + perm32(R & 31)) : R;
        voffA[i] = (unsigned)(R * g.lda + C) * 2u; voffB[i] = (unsigned)(Rb * g.ldb + C) * 2u; }
    const size_t kstep = (size_t)(BK * 2);
    const size_t hstepA = (size_t)HALF * g.lda * 2, hstepB = (size_t)HALF * g.ldb * 2;
    const size_t tstepA = 2 * hstepA, tstepB = 2 * hstepB;
    const unsigned ldsw = (unsigned)wid * 1024u;
    const int aoff = lds_byte(wr * 64 + fr, fq * 8), boff = lds_byte(wc * 32 + fr, fq * 8);
#define PG8_SA(b, h) (((b) * 2 + (h)) * HTB)
#define PG8_SB(b, h) ((4 + (b) * 2 + (h)) * HTB)
#define PG8_STAGE(bufoff, gbase, voff) do { _Pragma("unroll") for (int _i = 0; _i < 2; ++_i) \
        __builtin_amdgcn_global_load_lds((const unsigned*)((const char*)(gbase) + (voff)[_i]), (PG8_LAS unsigned*)(lds + (bufoff) + ldsw + _i * 8192), 16, 0, 0); } while (0)
#define PG8_LDA(dst, b, h) do { _Pragma("unroll") for (int m = 0; m < 4; ++m) _Pragma("unroll") for (int k = 0; k < 2; ++k) dst[m][k] = *(const PG8_LAS bf16x8*)(lds + PG8_SA(b, h) + aoff + m * 2048 + k * 1024); } while (0)
#define PG8_LDB(dst, b, h) do { _Pragma("unroll") for (int n = 0; n < 2; ++n) _Pragma("unroll") for (int k = 0; k < 2; ++k) dst[n][k] = *(const PG8_LAS bf16x8*)(lds + PG8_SB(b, h) + boff + n * 2048 + k * 1024); } while (0)
#define PG8_MMA(ai, bj, At, Bt) do { __builtin_amdgcn_s_setprio(1); _Pragma("unroll") for (int m = 0; m < 4; ++m) _Pragma("unroll") for (int n = 0; n < 2; ++n) _Pragma("unroll") for (int k = 0; k < 2; ++k) \
        acc[ai][bj][m][n] = __builtin_amdgcn_mfma_f32_16x16x32_bf16(Bt[n][k], At[m][k], acc[ai][bj][m][n], 0, 0, 0); __builtin_amdgcn_s_setprio(0); } while (0)
#define PG8_WAIT_V(n) asm volatile("s_waitcnt vmcnt(" #n ")" ::: "memory")
#define PG8_WAIT_L(n) asm volatile("s_waitcnt lgkmcnt(" #n ")" ::: "memory")
#define PG8_BAR __builtin_amdgcn_s_barrier()
#define PG8_SCHED __builtin_amdgcn_sched_barrier(0)
    Unit cur, nxt; int ui = 0;
    if (!S.next(0, cur)) return;
    f32x4 acc[2][2][4][2];
#pragma unroll
    for (int a = 0; a < 2; ++a)
#pragma unroll
        for (int b = 0; b < 2; ++b)
#pragma unroll
            for (int m = 0; m < 4; ++m)
#pragma unroll
                for (int n = 0; n < 2; ++n) acc[a][b][m][n] = (f32x4){0.f, 0.f, 0.f, 0.f};
    bf16x8 At[4][2], B0[2][2], B1[2][2];
    const char* cA = (const char*)g.A + (size_t)cur.pm * tstepA; const char* cB = (const char*)g.Bt + (size_t)cur.pn * tstepB;
    S.a_ready(cur);
    if constexpr (SP2) {
        PG8_STAGE(PG8_SB(0, 0), cB, voffB); PG8_STAGE(PG8_SB(0, 1), cB + hstepB, voffB); PG8_STAGE(PG8_SA(0, 0), cA, voffA); PG8_STAGE(PG8_SA(0, 1), cA + hstepA, voffA);
        if (wr == 1) PG8_BAR;
        PG8_WAIT_V(2); PG8_BAR;
        PG8_STAGE(PG8_SB(1, 0), cB + kstep, voffB); PG8_STAGE(PG8_SA(1, 0), cA + kstep, voffA); PG8_STAGE(PG8_SB(1, 1), cB + hstepB + kstep, voffB);
        PG8_WAIT_V(6); PG8_BAR;
    } else {
        PG8_STAGE(PG8_SB(0, 0), cB, voffB); PG8_STAGE(PG8_SA(0, 0), cA, voffA); PG8_STAGE(PG8_SB(0, 1), cB + hstepB, voffB); PG8_STAGE(PG8_SA(0, 1), cA + hstepA, voffA);
        if (wr == 1) PG8_BAR;
        PG8_WAIT_V(4); PG8_BAR;
        PG8_STAGE(PG8_SB(1, 0), cB + kstep, voffB); PG8_STAGE(PG8_SA(1, 0), cA + kstep, voffA); PG8_STAGE(PG8_SB(1, 1), cB + hstepB + kstep, voffB);
        PG8_WAIT_V(6); PG8_BAR;
    }
    for (;;) {
        const bool has_next = S.next(ui + 1, nxt);
        const char* nA = has_next ? (const char*)g.A + (size_t)nxt.pm * tstepA : cA; const char* nB = has_next ? (const char*)g.Bt + (size_t)nxt.pn * tstepB : cB;
        for (int t = 0; t < nt; t += 2) {
            if constexpr (Epi::MID) { if (t == (nt >> 1)) { E.mid(acc, cur, wr, wc, fr, fq); } }
            const bool last = (t == nt - 2);
            const char* a1 = cA + (size_t)(t + 1) * kstep;
            const char* a2 = last ? nA : cA + (size_t)(t + 2) * kstep; const char* b2 = last ? nB : cB + (size_t)(t + 2) * kstep;
            const char* a3 = a2 + kstep; const char* b3 = b2 + kstep;
            if (last && has_next) S.a_ready(nxt);
            if constexpr (SP2) {
            PG8_LDB(B0, 0, 0); PG8_LDB(B1, 0, 1); PG8_SCHED; PG8_LDA(At, 0, 0); PG8_STAGE(PG8_SA(1, 1), a1 + hstepA, voffA);
            PG8_WAIT_V(8); PG8_WAIT_L(0); PG8_BAR; PG8_MMA(0, 0, At, B0); PG8_MMA(0, 1, At, B1); PG8_BAR; PG8_SCHED;
            PG8_LDA(At, 0, 1); PG8_STAGE(PG8_SB(0, 0), b2, voffB); PG8_STAGE(PG8_SB(0, 1), b2 + hstepB, voffB); PG8_STAGE(PG8_SA(0, 0), a2, voffA);
            PG8_WAIT_V(8); PG8_WAIT_L(0); PG8_BAR; PG8_MMA(1, 0, At, B0); PG8_MMA(1, 1, At, B1); PG8_BAR; PG8_SCHED;
            PG8_LDB(B0, 1, 0); PG8_LDB(B1, 1, 1); PG8_SCHED; PG8_LDA(At, 1, 0); PG8_STAGE(PG8_SA(0, 1), a2 + hstepA, voffA);
            PG8_WAIT_V(8); PG8_WAIT_L(0); PG8_BAR; PG8_MMA(0, 0, At, B0); PG8_MMA(0, 1, At, B1); PG8_BAR; PG8_SCHED;
            PG8_LDA(At, 1, 1); PG8_STAGE(PG8_SB(1, 0), b3, voffB); PG8_STAGE(PG8_SB(1, 1), b3 + hstepB, voffB); PG8_STAGE(PG8_SA(1, 0), a3, voffA);
            PG8_WAIT_V(8); PG8_WAIT_L(0); PG8_BAR; PG8_MMA(1, 0, At, B0); PG8_MMA(1, 1, At, B1); PG8_BAR; PG8_SCHED;
            } else {
            PG8_LDB(B0, 0, 0); PG8_SCHED; PG8_LDA(At, 0, 0); PG8_STAGE(PG8_SA(1, 1), a1 + hstepA, voffA);
            PG8_WAIT_L(8); PG8_BAR; PG8_WAIT_L(0); PG8_MMA(0, 0, At, B0); PG8_BAR; PG8_SCHED;
            PG8_LDB(B1, 0, 1); PG8_STAGE(PG8_SB(0, 0), b2, voffB);
            PG8_BAR; PG8_WAIT_L(0); PG8_MMA(0, 1, At, B1); PG8_BAR;
            PG8_LDA(At, 0, 1); PG8_STAGE(PG8_SA(0, 0), a2, voffA);
            PG8_BAR; PG8_WAIT_L(0); PG8_MMA(1, 0, At, B0); PG8_BAR; PG8_SCHED;
            PG8_STAGE(PG8_SB(0, 1), b2 + hstepB, voffB);
            PG8_WAIT_V(6); PG8_BAR; PG8_MMA(1, 1, At, B1); PG8_BAR;
            PG8_LDB(B0, 1, 0); PG8_SCHED; PG8_LDA(At, 1, 0); PG8_STAGE(PG8_SA(0, 1), a2 + hstepA, voffA);
            PG8_WAIT_L(8); PG8_BAR; PG8_WAIT_L(0); PG8_MMA(0, 0, At, B0); PG8_BAR; PG8_SCHED;
            PG8_LDB(B1, 1, 1); PG8_STAGE(PG8_SB(1, 0), b3, voffB);
            PG8_BAR; PG8_WAIT_L(0); PG8_MMA(0, 1, At, B1); PG8_BAR;
            PG8_LDA(At, 1, 1); PG8_STAGE(PG8_SA(1, 0), a3, voffA);
            PG8_BAR; PG8_WAIT_L(0); PG8_MMA(1, 0, At, B0); PG8_BAR; PG8_SCHED;
            PG8_STAGE(PG8_SB(1, 1), b3 + hstepB, voffB);
            PG8_WAIT_V(6); PG8_BAR; PG8_MMA(1, 1, At, B1); PG8_BAR;
            }
        }
        if constexpr (ALIGN_EPI) { if (wr == 0) PG8_BAR; }
        if constexpr (!Epi::AFTER_DRAIN) { E(acc, cur, wr, wc, fr, fq); S.done(cur); }
        if (!has_next) break;
#pragma unroll
        for (int a = 0; a < 2; ++a)
#pragma unroll
            for (int b = 0; b < 2; ++b)
#pragma unroll
                for (int m = 0; m < 4; ++m)
#pragma unroll
                    for (int n = 0; n < 2; ++n) acc[a][b][m][n] = (f32x4){0.f, 0.f, 0.f, 0.f};
        cur = nxt; cA = nA; cB = nB; ++ui;
        if constexpr (ALIGN_EPI) { if (wr == 1) PG8_BAR; }
    }
    PG8_WAIT_V(0);
    if constexpr (!ALIGN_EPI) { if (wr == 0) PG8_BAR; }
    PG8_BAR;
    if constexpr (Epi::AFTER_DRAIN) { E.fused(acc, cur, wr, wc, fr, fq, lds, wid, lane); S.done(cur); }
#undef PG8_SA
#undef PG8_SB
#undef PG8_STAGE
#undef PG8_LDA
#undef PG8_LDB
#undef PG8_MMA
#undef PG8_WAIT_V
#undef PG8_WAIT_L
#undef PG8_BAR
#undef PG8_SCHED
}
}

template <class Q, bool RS> struct EpiQuad {
    static constexpr bool PERM = true, AFTER_DRAIN = false, MID = Q::MID;
    Q q; const float* rs;
    __device__ __forceinline__ void mid(f32x4 (&acc)[2][2][4][2], const pg8::Unit& u, int wr, int wc, int fr, int fq, bool inv = false) const {
        if constexpr (Q::MID) {
            asm volatile("" : "+v"(fr), "+v"(fq));
#pragma unroll
            for (int ai = 0; ai < 2; ++ai) {
                u32x4 ga[4][2], gb[4][2];
#pragma unroll
                for (int m = 0; m < 4; ++m)
#pragma unroll
                    for (int bj = 0; bj < 2; ++bj) q.midload(u.pm * 256 + ai * 128 + wr * 64 + m * 16 + fr, u.pn * 256 + bj * 128 + wc * 32 + 8 * fq, ga[m][bj], gb[m][bj]);
#pragma unroll
                for (int m = 0; m < 4; ++m)
#pragma unroll
                    for (int bj = 0; bj < 2; ++bj) { if (!inv) q.midapply(ga[m][bj], gb[m][bj], acc[ai][bj][m][0], acc[ai][bj][m][1]); else q.midapply(gb[m][bj], ga[m][bj], acc[ai][bj][m][0], acc[ai][bj][m][1]); }
                __builtin_amdgcn_sched_barrier(0);
            }
        }
    }
    __device__ __forceinline__ void operator()(const f32x4 (&acc)[2][2][4][2], const pg8::Unit& u, int wr, int wc, int fr, int fq) const {
        if constexpr (Q::MID) asm volatile("" : "+v"(fr), "+v"(fq));
#pragma unroll
        for (int ai = 0; ai < 2; ++ai)
#pragma unroll
            for (int m = 0; m < 4; ++m) {
                const int rl = ai * 128 + wr * 64 + m * 16 + fr, row = u.pm * 256 + rl;
                const float r = RS ? rs[u.ui * 256 + rl] : 1.f;
#pragma unroll
                for (int bj = 0; bj < 2; ++bj) q.oct(row, u.pn * 256 + bj * 128 + wc * 32 + 8 * fq, acc[ai][bj][m][0] * r, acc[ai][bj][m][1] * r);
            }
    }
};
__device__ __forceinline__ void unit_row_rstd(const bf16_t* __restrict__ A, int lda, int K, const pg8::StaticOrder& S, float* rs) {
    pg8::Unit u;
    int tid_ = threadIdx.x; asm volatile("" : "+v"(tid_)); const int tid = tid_, r = tid >> 1, part = tid & 1, len = K >> 1;
    for (int i = 0; S.next(i, u); ++i) {
        const bf16_t* ar = A + (size_t)(u.pm * 256 + r) * lda + part * len;
        float ss = 0.f;
        for (int k = 0; k < len; k += 8) { const bf16x8 v = *(const bf16x8*)(ar + k);
#pragma unroll
            for (int e = 0; e < 8; ++e) { const float f = bf2f((bf16_t)v[e]); ss += f * f; } }
        ss += __shfl_xor(ss, 1);
        if (part == 0) rs[i * 256 + r] = rsqrtf(ss / (float)K + EPS);
    }
    __syncthreads();
}
template <class Q, bool RS>
__device__ __forceinline__ void run_gemm(unsigned char* lds, const bf16_t* A, int lda, const bf16_t* Bt, int ldb, int M, int N, int K, const Q& q, int rot = 0) {
    pg8::Gemm g{A, Bt, M, N, K, lda, ldb};
    pg8::StaticOrder S; S.init(M, N, (int)gridDim.x, (int)((blockIdx.x + gridDim.x - (unsigned)rot % gridDim.x) % gridDim.x));
    float* rs = (float*)(lds + 131072);
    if (RS) unit_row_rstd(A, lda, K, S, rs);
    EpiQuad<Q, RS> E{q, rs};
    pg8::gemm_phase<EpiQuad<Q, RS>, pg8::StaticOrder, true, true>((PG8_LAS unsigned char*)lds, g, S, E);
}

__device__ __forceinline__ int win_dest_row(int n) {
    if (n < 1024) return PC_QA + n;
    if (n < 2048) return PC_KA + (n - 1024);
    if (n < 3072) return PC_VA + (n - 2048);
    if (n < 3840) return PC_CQ + (n - 3072);
    if (n < 4352) return PC_CKV + (n - 3840);
    if (n < 4416) { const int r = n - 4352; return PC_KPE + (r < 32 ? 2 * r : 2 * (r - 32) + 1); }
    if (n < 6464) return PC_GA + (n - 4416);
    return PC_GB + (n - 6464);
}
__device__ __forceinline__ int wq_dest_row(int n) {
    const int h = n / 192, d = n % 192;
    if (d < 128) return n;
    const int r = d - 128;
    return h * 192 + 128 + (r < 32 ? 2 * r : 2 * (r - 32) + 1);
}
template <int MODE>
__device__ __forceinline__ void transpose_item(const float* __restrict__ W, int K, int N, bf16_t* __restrict__ WT, const float* __restrict__ kscale, float* scr, int item, int lane, int ldt = 0, int koff = 0) {
    if (ldt == 0) ldt = K;
    const int nblk = N / 32, kb = item / nblk, nb = item % nblk, k0 = 64 * kb, n0 = 32 * nb;
#pragma unroll
    for (int i = 0; i < 8; ++i) { const int kk = 8 * i + (lane >> 3), n4 = (lane & 7) * 4;
        f32x4 w = *(const f32x4*)(W + (size_t)(k0 + kk) * N + n0 + n4); if (kscale) w = w * kscale[k0 + kk];
        scr[kk * 33 + n4] = w[0]; scr[kk * 33 + n4 + 1] = w[1]; scr[kk * 33 + n4 + 2] = w[2]; scr[kk * 33 + n4 + 3] = w[3]; }
    __builtin_amdgcn_s_waitcnt(0xc07f); asm volatile("" ::: "memory");
    const int c = lane & 7;
#pragma unroll
    for (int j = 0; j < 4; ++j) {
        const int n = (lane >> 3) + 8 * j; const float* s = scr + (8 * c) * 33 + n;
        u32x4 o; o.x = pk2(s[0 * 33], s[1 * 33]); o.y = pk2(s[2 * 33], s[3 * 33]); o.z = pk2(s[4 * 33], s[5 * 33]); o.w = pk2(s[6 * 33], s[7 * 33]);
        const int ns = n0 + n;
        const int dr = MODE == 1 ? win_dest_row(ns) : (MODE == 2 ? wq_dest_row(ns) : ns);
        *(u32x4*)(WT + (size_t)dr * ldt + koff + k0 + 8 * c) = o;
    }
    __builtin_amdgcn_s_waitcnt(0xc07f); asm volatile("" ::: "memory");
}

__device__ __forceinline__ void phase0(const Params& p, unsigned char* lds) {
    int tid_ = threadIdx.x; asm volatile("" : "+v"(tid_)); const int tid = tid_, lane = tid & 63, wid = tid >> 6;
    unsigned char* ws = p.ws;
    {
        float* sl = (float*)lds;
        float* red = sl + 9 * 2048;
        const float* c = p.in[1]; const float* cctx = p.in[3]; const float* wada = p.in[4]; const float* bada = p.in[5];
        float* mod = (float*)(ws + WS_MOD);
        if (blockIdx.x < 192) {
            for (int i = tid; i < 9 * 2048; i += NTHREADS) { const int r = i >> 11, k = i & 2047; const float v = r < 8 ? c[r * DM + k] : cctx[k]; sl[i] = silu_(v); }
            __syncthreads();
            for (int it = blockIdx.x; it < 192; it += gridDim.x) {
                const int kq = tid >> 4, c4 = tid & 15, col = it * 64 + c4 * 4;
                f32x4 acc[9];
#pragma unroll
                for (int r = 0; r < 9; ++r) acc[r] = (f32x4){0.f, 0.f, 0.f, 0.f};
#pragma unroll 8
                for (int i = 0; i < 64; ++i) {
                    const int k = kq + 32 * i;
                    const f32x4 w = *(const f32x4*)(wada + (size_t)k * 12288 + col);
#pragma unroll
                    for (int r = 0; r < 9; ++r) acc[r] += w * sl[r * 2048 + k];
                }
#pragma unroll
                for (int r = 0; r < 9; ++r) {
#pragma unroll
                    for (int e = 0; e < 4; ++e) { float v = acc[r][e]; v += __shfl_xor(v, 16); v += __shfl_xor(v, 32); acc[r][e] = v; }
                    if (lane < 16) *(f32x4*)(red + (wid * 9 + r) * 64 + c4 * 4) = acc[r];
                }
                __syncthreads();
                for (int o = tid; o < 9 * 64; o += NTHREADS) {
                    const int r = o >> 6, cc = o & 63;
                    float sum = bada[it * 64 + cc];
                    for (int q = 0; q < 8; ++q) sum += red[(q * 9 + r) * 64 + cc];
                    mod[(size_t)r * 12288 + it * 64 + cc] = sum;
                }
                __syncthreads();
            }
        }
        __syncthreads();
    }
    {
        float* scr = (float*)lds + wid * (64 * 33);
        const int gw = blockIdx.x * NWAVES + wid, NGW = gridDim.x * NWAVES;
        constexpr int I_IN = 32 * (IN_COLS / 32), I_QB = 12 * 48, I_KVB = 8 * 64, I_AB = 16 * 64, I_OO = 32 * 64;
        constexpr int NITEMS = I_IN + I_QB + I_KVB + 2 * I_AB + 2 * I_OO;
        for (int it = gw; it < NITEMS; it += NGW) {
            int r = it;
            if (r < I_IN) { transpose_item<1>(p.in[10], DM, IN_COLS, (bf16_t*)(ws + WS_WIN), nullptr, scr, r, lane); continue; } r -= I_IN;
            if (r < I_QB) { transpose_item<2>(p.in[13], QR, MQW, (bf16_t*)(ws + WS_WQB), p.in[12], scr, r, lane); continue; } r -= I_QB;
            if (r < I_KVB) { transpose_item<0>(p.in[15], KVR, MKVW, (bf16_t*)(ws + WS_WKVB), p.in[14], scr, r, lane); continue; } r -= I_KVB;
            if (r < I_AB) { transpose_item<0>(p.in[16], 1024, DM, (bf16_t*)(ws + WS_WA), nullptr, scr, r, lane, 2048, 0); continue; } r -= I_AB;
            if (r < I_AB) { transpose_item<0>(p.in[17], 1024, DM, (bf16_t*)(ws + WS_WA), nullptr, scr, r, lane, 2048, 1024); continue; } r -= I_AB;
            if (r < I_OO) { transpose_item<0>(p.in[18], DM, DM, (bf16_t*)(ws + WS_WO), nullptr, scr, r, lane); continue; } r -= I_OO;
            transpose_item<0>(p.in[19], DM, DM, (bf16_t*)(ws + WS_WPQ), nullptr, scr, r, lane);
        }
    }
    {
        const size_t gt = (size_t)blockIdx.x * NTHREADS + tid, NGT = (size_t)gridDim.x * NTHREADS;
        u32x4* padp = (u32x4*)(ws + WS_WIN + (size_t)(PC_KPE + 64) * DM * 2);
        for (size_t i = gt; i < (size_t)192 * DM * 2 / 16; i += NGT) padp[i] = (u32x4){0u, 0u, 0u, 0u};
        float* rope = (float*)(ws + WS_ROPE);
        for (size_t i = gt; i < (size_t)SEQ * 32; i += NGT) { float c, sn; rope_cs((int)(i >> 5), (int)(i & 31), c, sn); rope[i * 2] = c; rope[i * 2 + 1] = sn; }
        const float* sk = p.in[20]; bf16_t* skb = (bf16_t*)(ws + WS_SUBK);
        for (size_t i = gt; i < 262144 / 4; i += NGT) { const f32x4 v = *(const f32x4*)(sk + i * 4); store_bf4(skb + i * 4, v); }
    }
}

__device__ __forceinline__ void phase1(const Params& p) {
    int tid_ = threadIdx.x; asm volatile("" : "+v"(tid_)); const int tid = tid_, lane = tid & 63, wid = tid >> 6;
    const int gw = blockIdx.x * NWAVES + wid, NGW = gridDim.x * NWAVES;
    const float* mod = (const float*)(p.ws + WS_MOD); const float* g = p.in[6];
    bf16_t* H = (bf16_t*)(p.ws + WS_H);
    const int per = (TA + NGW - 1) / NGW;
    int curb = -1; f32x4 G[8], S[8];
    for (int i = 0; i < per; ++i) {
        const int m = gw * per + i; if (m >= TA) break;
        const float* xr = m < TL ? p.in[0] + (size_t)m * DM : p.in[2] + (size_t)(m - TL) * DM;
        const int mr = m < TL ? m / SEQ : 8;
        if (mr != curb) { curb = mr; const float* sh = mod + (size_t)mr * 12288, * sc = sh + 2048;
#pragma unroll
            for (int j = 0; j < 8; ++j) { const int c = j * 256 + lane * 4; G[j] = *(const f32x4*)(g + c) * (*(const f32x4*)(sc + c) + 1.f); S[j] = *(const f32x4*)(sh + c); } }
        f32x4 v[8]; float ss = 0.f;
#pragma unroll
        for (int j = 0; j < 8; ++j) { v[j] = *(const f32x4*)(xr + j * 256 + lane * 4); ss += v[j][0] * v[j][0] + v[j][1] * v[j][1] + v[j][2] * v[j][2] + v[j][3] * v[j][3]; }
        const float rstd = rsqrtf(wave_sum_dpp(ss) * (1.f / DM) + EPS);
#pragma unroll
        for (int j = 0; j < 8; ++j) store_bf4(H + (size_t)m * DM + j * 256 + lane * 4, (v[j] * rstd) * G[j] + S[j]);
    }
}

__device__ __forceinline__ void kpe_pass(const Params& p) {
    const size_t gt = (size_t)blockIdx.x * NTHREADS + threadIdx.x, NGT = (size_t)gridDim.x * NTHREADS;
    const bf16_t* PL = (const bf16_t*)(p.ws + WS_PL); const bf16_t* PCx = (const bf16_t*)(p.ws + WS_PC);
    bf16_t* KPE = (bf16_t*)(p.ws + WS_KPE); const float* rope = (const float*)(p.ws + WS_ROPE);
    for (size_t i = gt; i < (size_t)TA * 32; i += NGT) {
        const int m = (int)(i >> 5), j = (int)(i & 31);
        unsigned w;
        if (m < TL) {
            w = *(const unsigned*)(PL + (size_t)m * NP + PC_KPE + 2 * j);
            const float x1 = __uint_as_float(w << 16), x2 = __uint_as_float(w & 0xffff0000u);
            const float c = rope[((size_t)(m & (SEQ - 1)) * 32 + j) * 2], s = rope[((size_t)(m & (SEQ - 1)) * 32 + j) * 2 + 1];
            w = pk2(x1 * c - x2 * s, x1 * s + x2 * c);
        } else w = *(const unsigned*)(PCx + (size_t)(m - TL) * NPC + PC_KPE + 2 * j);
        *(unsigned*)(KPE + (size_t)m * 64 + 2 * j) = w;
    }
}

__device__ __forceinline__ float dot_bf16x8(const bf16x8 k, const float* q) {
    float s = 0.f;
#pragma unroll
    for (int e = 0; e < 8; ++e) s += q[e] * bf2f((bf16_t)k[e]);
    return s;
}

__device__ __forceinline__ void na_naive(const Params& p, unsigned char* lds) {
    int tid_ = threadIdx.x; asm volatile("" : "+v"(tid_)); const int tid = tid_, lane = tid & 63, wid = tid >> 6;
    const int gw = blockIdx.x * NWAVES + wid, NGW = gridDim.x * NWAVES;
    const bf16_t* PL = (const bf16_t*)(p.ws + WS_PL); const bf16_t* PCx = (const bf16_t*)(p.ws + WS_PC);
    bf16_t* OA = (bf16_t*)(p.ws + WS_OA);
    const float* rpb = p.in[11];
    float* qs = (float*)lds + wid * 512;
    float* ps = qs + 64;
    for (int it = gw; it < TL * 16; it += NGW) {
        const int h = it & 15, m = it >> 4, b = m / SEQ, s = m % SEQ, r = s >> 6, qc = s & 63;
        int r0 = r - 4; r0 = r0 < 0 ? 0 : (r0 > GROWS - 8 ? GROWS - 8 : r0);
        int w0 = qc - 8; w0 = w0 < 0 ? 0 : (w0 > GW - 16 ? GW - 16 : w0);
        qs[lane] = bf2f(PL[(size_t)m * NP + PC_QA + h * 64 + lane]);
        __builtin_amdgcn_s_waitcnt(0xc07f); asm volatile("" ::: "memory");
        float sc[6];
#pragma unroll
        for (int i = 0; i < 6; ++i) {
            const int kk = lane + 64 * i;
            const bf16_t* kp; float bias = 0.f;
            if (i < 2) { const int dy = kk >> 4, dx = kk & 15, kr = r0 + dy, kc = w0 + dx;
                kp = PL + (size_t)(b * SEQ + kr * 64 + kc) * NP + PC_KA + h * 64;
                bias = rpb[(h * 15 + (kr - r + 7)) * 31 + (kc - qc + 15)]; }
            else kp = PCx + (size_t)(b * CTX + (kk - 128)) * NPC + PC_KA + h * 64;
            float d = 0.f;
#pragma unroll
            for (int e = 0; e < 8; ++e) d += dot_bf16x8(*(const bf16x8*)(kp + e * 8), qs + e * 8);
            sc[i] = d * NA_SCALE + bias;
        }
        float mx = sc[0];
#pragma unroll
        for (int i = 1; i < 6; ++i) mx = fmaxf(mx, sc[i]);
        mx = wave_max(mx);
        float sum = 0.f;
#pragma unroll
        for (int i = 0; i < 6; ++i) { sc[i] = __expf(sc[i] - mx); sum += sc[i]; ps[lane + 64 * i] = sc[i]; }
        sum = wave_sum(sum);
        __builtin_amdgcn_s_waitcnt(0xc07f); asm volatile("" ::: "memory");
        float o = 0.f;
        for (int kk = 0; kk < 128; ++kk) { const int kr = r0 + (kk >> 4), kc = w0 + (kk & 15);
            o += ps[kk] * bf2f(PL[(size_t)(b * SEQ + kr * 64 + kc) * NP + PC_VA + h * 64 + lane]); }
        for (int kk = 0; kk < 256; ++kk) o += ps[128 + kk] * bf2f(PCx[(size_t)(b * CTX + kk) * NPC + PC_VA + h * 64 + lane]);
        OA[(size_t)m * 2048 + h * 64 + lane] = (bf16_t)f2bf(o / sum);
        __builtin_amdgcn_s_waitcnt(0xc07f); asm volatile("" ::: "memory");
    }
}

__device__ __forceinline__ void mla_naive(const Params& p, unsigned char* lds) {
    int tid_ = threadIdx.x; asm volatile("" : "+v"(tid_)); const int tid = tid_, lane = tid & 63, wid = tid >> 6;
    const bf16_t* QM = (const bf16_t*)(p.ws + WS_QM); const bf16_t* KVM = (const bf16_t*)(p.ws + WS_KVM); const bf16_t* KPE = (const bf16_t*)(p.ws + WS_KPE);
    bf16_t* OB = (bf16_t*)(p.ws + WS_OB);
    float* qs = (float*)lds + wid * (192 + 2304);
    float* ps = qs + 192;
    for (int it = blockIdx.x; it < NB * 8 * (SEQ / 8); it += gridDim.x) {
        const int qg = it % (SEQ / 8), bh = it / (SEQ / 8), h = bh & 7, b = bh >> 3;
        const int m = b * SEQ + qg * 8 + wid;
#pragma unroll
        for (int i = 0; i < 3; ++i) qs[lane + 64 * i] = bf2f(QM[(size_t)m * MQW + h * 192 + lane + 64 * i]);
        __builtin_amdgcn_s_waitcnt(0xc07f); asm volatile("" ::: "memory");
        float mx = -INFINITY;
        for (int i = 0; i < 36; ++i) {
            const int kk = lane + 64 * i;
            const int krow = kk < SEQ ? b * SEQ + kk : TL + b * CTX + (kk - SEQ);
            const bf16_t* kn = KVM + (size_t)krow * MKVW + h * 256; const bf16_t* kp = KPE + (size_t)krow * 64;
            float d = 0.f;
#pragma unroll
            for (int e = 0; e < 16; ++e) d += dot_bf16x8(*(const bf16x8*)(kn + e * 8), qs + e * 8);
#pragma unroll
            for (int e = 0; e < 8; ++e) d += dot_bf16x8(*(const bf16x8*)(kp + e * 8), qs + 128 + e * 8);
            ps[kk] = d; mx = fmaxf(mx, d);
        }
        mx = wave_max(mx);
        float sum = 0.f;
        for (int i = 0; i < 36; ++i) { const float e = exp2f(ps[lane + 64 * i] - mx); sum += e; ps[lane + 64 * i] = e; }
        sum = wave_sum(sum);
        __builtin_amdgcn_s_waitcnt(0xc07f); asm volatile("" ::: "memory");
        float o0 = 0.f, o1 = 0.f;
        const bf16_t* vb = KVM + h * 256 + 128 + lane;
        for (int kk = 0; kk < SEQ; ++kk) { const bf16_t* vp = vb + (size_t)(b * SEQ + kk) * MKVW; const float pp = ps[kk]; o0 += pp * bf2f(vp[0]); o1 += pp * bf2f(vp[64]); }
        for (int kk = 0; kk < CTX; ++kk) { const bf16_t* vp = vb + (size_t)(TL + b * CTX + kk) * MKVW; const float pp = ps[SEQ + kk]; o0 += pp * bf2f(vp[0]); o1 += pp * bf2f(vp[64]); }
        const float inv = 1.f / sum;
        OB[(size_t)m * 2048 + h * 128 + lane] = (bf16_t)f2bf(o0 * inv);
        OB[(size_t)m * 2048 + h * 128 + 64 + lane] = (bf16_t)f2bf(o1 * inv);
        __builtin_amdgcn_s_waitcnt(0xc07f); asm volatile("" ::: "memory");
    }
}


typedef float f32x16 __attribute__((ext_vector_type(16)));
typedef short s16x4 __attribute__((ext_vector_type(4)));
typedef float f32x2_t __attribute__((ext_vector_type(2)));
typedef __bf16 bf16x2_t __attribute__((ext_vector_type(2)));
#define LAS3 __attribute__((address_space(3)))
__device__ __forceinline__ unsigned cvtpk(float lo, float hi) { f32x2_t v = {lo, hi}; bf16x2_t b = __builtin_convertvector(v, bf16x2_t); return __builtin_bit_cast(unsigned, b); }
__device__ __forceinline__ s16x4 vtr(const LAS3 unsigned char* p) { return __builtin_bit_cast(s16x4, __builtin_amdgcn_ds_read_tr16_b64_v4i16((LAS3 s16x4*)p)); }
__device__ __forceinline__ float max16(const f32x16& a) {
    float m0 = fmaxf(fmaxf(a[0], a[1]), fmaxf(a[2], a[3])), m1 = fmaxf(fmaxf(a[4], a[5]), fmaxf(a[6], a[7]));
    float m2 = fmaxf(fmaxf(a[8], a[9]), fmaxf(a[10], a[11])), m3 = fmaxf(fmaxf(a[12], a[13]), fmaxf(a[14], a[15]));
    return fmaxf(fmaxf(m0, m1), fmaxf(m2, m3));
}
__device__ __forceinline__ bf16x8 pfrag(const f32x16& a, int s) {
    u32x4 w; w.x = cvtpk(a[8 * s + 0], a[8 * s + 1]); w.y = cvtpk(a[8 * s + 2], a[8 * s + 3]); w.z = cvtpk(a[8 * s + 4], a[8 * s + 5]); w.w = cvtpk(a[8 * s + 6], a[8 * s + 7]);
    return __builtin_bit_cast(bf16x8, w);
}

__device__ __forceinline__ void mla_flash(const Params& p, unsigned char* lds_) {
    int tid_ = threadIdx.x; asm volatile("" : "+v"(tid_)); const int tid = tid_, lane = tid & 63, wid = tid >> 6, r32 = lane & 31, hi = lane >> 5;
    LAS3 unsigned char* lds = (LAS3 unsigned char*)lds_;
    constexpr int KP = 400, VP = 320, KBYTES = 64 * KP, VBYTES = 64 * VP, STG = KBYTES + VBYTES, NT = (SEQ + CTX) / 64;
    const bf16_t* QM = (const bf16_t*)(p.ws + WS_QM); const bf16_t* KVM = (const bf16_t*)(p.ws + WS_KVM); const bf16_t* KPE = (const bf16_t*)(p.ws + WS_KPE);
    bf16_t* OB = (bf16_t*)(p.ws + WS_OB);
    const int G = gridDim.x, vcu = (G % 8 == 0) ? (blockIdx.x % 8) * (G / 8) + blockIdx.x / 8 : blockIdx.x;
    const int skey = tid >> 4, spc = tid & 15, pkey = tid >> 3, ppc = tid & 7;
    const int vb = (4 * hi + ((lane & 15) >> 2)) * VP + (16 * ((lane >> 4) & 1) + 4 * (lane & 3)) * 2;
    for (int unit = vcu; unit < NB * 8 * 8; unit += G) {
        const int bh = unit >> 3, qt = unit & 7, b = bh >> 3, h = bh & 7;
        const int qrow = b * SEQ + qt * 256 + wid * 32 + r32;
        bf16x8 qf[12];
#pragma unroll
        for (int s = 0; s < 12; ++s) qf[s] = *(const bf16x8*)(QM + (size_t)qrow * MQW + h * 192 + 16 * s + 8 * hi);
        f32x16 o[4];
#pragma unroll
        for (int d = 0; d < 4; ++d)
#pragma unroll
            for (int r = 0; r < 16; ++r) o[d][r] = 0.f;
        float m = -1e30f, l = 0.f;
        u32x4 g0, g1, g2, g3, g4;
#define MLA_LOAD(t) do { const int kr_ = (t) < 32 ? b * SEQ + 64 * (t) : TL + b * CTX + 64 * ((t) - 32); \
            const bf16_t* kp_ = KVM + (size_t)(kr_ + skey) * MKVW + h * 256 + spc * 8; \
            g0 = *(const u32x4*)kp_; g1 = *(const u32x4*)(kp_ + (size_t)32 * MKVW); g2 = *(const u32x4*)(kp_ + 128); g3 = *(const u32x4*)(kp_ + (size_t)32 * MKVW + 128); \
            g4 = *(const u32x4*)(KPE + (size_t)(kr_ + pkey) * 64 + ppc * 8); } while (0)
#define MLA_STORE(buf) do { LAS3 unsigned char* kb_ = lds + (buf) * STG; LAS3 unsigned char* vb_ = kb_ + KBYTES; \
            *(LAS3 u32x4*)(kb_ + skey * KP + spc * 16) = g0; *(LAS3 u32x4*)(kb_ + (skey + 32) * KP + spc * 16) = g1; \
            *(LAS3 u32x4*)(vb_ + skey * VP + spc * 16) = g2; *(LAS3 u32x4*)(vb_ + (skey + 32) * VP + spc * 16) = g3; \
            *(LAS3 u32x4*)(kb_ + pkey * KP + 256 + ppc * 16) = g4; } while (0)
        MLA_LOAD(0); MLA_STORE(0);
#pragma unroll
        for (int s = 0; s < 12; ++s) asm volatile("" : "+v"(qf[s]));
        __syncthreads();
        for (int t = 0; t < NT; ++t) {
            const int cur = t & 1;
            if (t + 1 < NT) MLA_LOAD(t + 1);
            const LAS3 unsigned char* Kb = lds + cur * STG; const LAS3 unsigned char* Vb = Kb + KBYTES;
            f32x16 s0, s1;
#pragma unroll
            for (int r = 0; r < 16; ++r) { s0[r] = 0.f; s1[r] = 0.f; }
            const LAS3 unsigned char* ka = Kb + r32 * KP + 16 * hi;
#pragma unroll
            for (int s = 0; s < 12; ++s) {
                const bf16x8 a0 = *(const LAS3 bf16x8*)(ka + 32 * s), a1 = *(const LAS3 bf16x8*)(ka + 32 * KP + 32 * s);
                s0 = __builtin_amdgcn_mfma_f32_32x32x16_bf16(a0, qf[s], s0, 0, 0, 0);
                s1 = __builtin_amdgcn_mfma_f32_32x32x16_bf16(a1, qf[s], s1, 0, 0, 0);
            }
            float mx = fmaxf(max16(s0), max16(s1));
            mx = fmaxf(mx, __shfl_xor(mx, 32));
            const float mn = fmaxf(m, mx);
            if (__builtin_amdgcn_ballot_w64(mx > m) != 0ull) {
                const float alpha = __builtin_amdgcn_exp2f(m - mn);
                l *= alpha;
#pragma unroll
                for (int d = 0; d < 4; ++d) o[d] = o[d] * alpha;
            }
            m = mn;
            float rs = 0.f;
#pragma unroll
            for (int r = 0; r < 16; ++r) { s0[r] = __builtin_amdgcn_exp2f(s0[r] - mn); s1[r] = __builtin_amdgcn_exp2f(s1[r] - mn); rs += s0[r] + s1[r]; }
            l += rs;
            bf16x8 pf[4];
            pf[0] = pfrag(s0, 0); pf[1] = pfrag(s0, 1); pf[2] = pfrag(s1, 0); pf[3] = pfrag(s1, 1);
            const LAS3 unsigned char* va = Vb + vb;
#pragma unroll
            for (int ks = 0; ks < 4; ++ks)
#pragma unroll
                for (int d = 0; d < 4; ++d) {
                    const s16x4 lo = vtr(va + (16 * ks) * VP + 64 * d), hh = vtr(va + (16 * ks + 8) * VP + 64 * d);
                    const bf16x8 vf = {lo[0], lo[1], lo[2], lo[3], hh[0], hh[1], hh[2], hh[3]};
                    o[d] = __builtin_amdgcn_mfma_f32_32x32x16_bf16(vf, pf[ks], o[d], 0, 0, 0);
                }
            if (t + 1 < NT) MLA_STORE(cur ^ 1);
            __syncthreads();
        }
#undef MLA_LOAD
#undef MLA_STORE
        l += __shfl_xor(l, 32);
        const float inv = 1.f / l;
        bf16_t* op = OB + (size_t)qrow * 2048 + h * 128 + 4 * hi;
#pragma unroll
        for (int d = 0; d < 4; ++d)
#pragma unroll
            for (int g = 0; g < 4; ++g) {
                const f32x4 v = {o[d][4 * g] * inv, o[d][4 * g + 1] * inv, o[d][4 * g + 2] * inv, o[d][4 * g + 3] * inv};
                store_bf4(op + 32 * d + 8 * g, v);
            }
    }
}


__device__ __forceinline__ void na_flash(const Params& p, unsigned char* lds_) {
    int tid_ = threadIdx.x; asm volatile("" : "+v"(tid_)); const int tid = tid_, lane = tid & 63, wid = tid >> 6, r32 = lane & 31, hi = lane >> 5;
    constexpr int VP = 192, WB = 12800;
    LAS3 unsigned char* vl = (LAS3 unsigned char*)lds_ + wid * WB;
    LAS3 float* tbl = (LAS3 float*)(vl + 64 * VP);
    tbl[lane] = 0.f; tbl[lane + 64] = 0.f;
    const bf16_t* PL = (const bf16_t*)(p.ws + WS_PL); const bf16_t* PCx = (const bf16_t*)(p.ws + WS_PC);
    bf16_t* OA = (bf16_t*)(p.ws + WS_OA);
    const float* rpb = p.in[11];
    const int G = gridDim.x, vcu = (G % 8 == 0) ? (blockIdx.x % 8) * (G / 8) + blockIdx.x / 8 : blockIdx.x;
    const int vb = (4 * hi + ((lane & 15) >> 2)) * VP + (16 * ((lane >> 4) & 1) + 4 * (lane & 3)) * 2;
    constexpr float SC = NA_SCALE * LOG2E;
    for (int wu = vcu * NWAVES + wid; wu < NB * GROWS * 16 * 2; wu += G * NWAVES) {
        const int half = wu & 1, h = (wu >> 1) & 15, br = wu >> 5, r = br & 31, b = br >> 5;
        const int qc = 32 * half + r32;
        int w0 = qc - 8; w0 = w0 < 0 ? 0 : (w0 > GW - 16 ? GW - 16 : w0);
        int r0 = r - 4; r0 = r0 < 0 ? 0 : (r0 > GROWS - 8 ? GROWS - 8 : r0);
        const int qtok = b * SEQ + r * 64 + qc;
        bf16x8 qf[4];
#pragma unroll
        for (int s = 0; s < 4; ++s) qf[s] = *(const bf16x8*)(PL + (size_t)qtok * NP + PC_QA + h * 64 + 16 * s + 8 * hi);
        f32x16 o[2];
#pragma unroll
        for (int d = 0; d < 2; ++d)
#pragma unroll
            for (int e = 0; e < 16; ++e) o[d][e] = 0.f;
        float m = -1e30f, l = 0.f;
        bf16x8 kf[2][4]; u32x4 vg[8];
#define NA_LOAD(t, WHAT) do { const bf16_t* kb_; size_t pitch_; \
            if ((t) < 8) { kb_ = PL + (size_t)(b * SEQ + (r0 + (t)) * 64) * NP + PC_KA + h * 64; pitch_ = NP; } \
            else { kb_ = PCx + (size_t)(b * CTX + 64 * ((t) - 8)) * NPC + PC_KA + h * 64; pitch_ = NPC; } \
            if (WHAT & 1) { _Pragma("unroll") for (int kb = 0; kb < 2; ++kb) _Pragma("unroll") for (int s = 0; s < 4; ++s) kf[kb][s] = *(const bf16x8*)(kb_ + (size_t)(32 * kb + r32) * pitch_ + 16 * s + 8 * hi); } \
            if (WHAT & 2) { _Pragma("unroll") for (int i = 0; i < 8; ++i) vg[i] = *(const u32x4*)(kb_ + (size_t)((lane >> 3) + 8 * i) * pitch_ + 1024 + (lane & 7) * 8); } } while (0)
#define NA_STORE(t) do { _Pragma("unroll") for (int i = 0; i < 8; ++i) *(LAS3 u32x4*)(vl + ((lane >> 3) + 8 * i) * VP + (lane & 7) * 16) = vg[i]; \
            if ((t) < 8 && lane < 31) tbl[48 + lane] = rpb[(h * 15 + (r0 + (t) - r + 7)) * 31 + lane] * LOG2E; } while (0)
        NA_LOAD(0, 3); NA_STORE(0);
#pragma nounroll
        for (int t = 0; t < 12; ++t) {
            f32x16 s0, s1;
#pragma unroll
            for (int e = 0; e < 16; ++e) { s0[e] = 0.f; s1[e] = 0.f; }
#pragma unroll
            for (int s = 0; s < 4; ++s) {
                s0 = __builtin_amdgcn_mfma_f32_32x32x16_bf16(kf[0][s], qf[s], s0, 0, 0, 0);
                s1 = __builtin_amdgcn_mfma_f32_32x32x16_bf16(kf[1][s], qf[s], s1, 0, 0, 0);
            }
            __builtin_amdgcn_sched_barrier(0);
            if (t + 1 < 12) NA_LOAD(t + 1, 1);
            __builtin_amdgcn_sched_barrier(0);
            if (t < 8) {
                int w0v = w0 - 4 * hi, tb = 4 * hi - qc + 63; asm volatile("" : "+v"(w0v), "+v"(tb));
                const LAS3 float* tp = tbl + tb;
#pragma unroll
                for (int e = 0; e < 16; ++e) {
                    const int c0 = (e & 3) + 8 * (e >> 2), c1 = c0 + 32;
                    const bool ok0 = (unsigned)(c0 - w0v) < 16u, ok1 = (unsigned)(c1 - w0v) < 16u;
                    const float v0 = s0[e] * SC + tp[c0], v1 = s1[e] * SC + tp[c1];
                    s0[e] = ok0 ? v0 : -1e30f;
                    s1[e] = ok1 ? v1 : -1e30f;
                }
            } else {
#pragma unroll
                for (int e = 0; e < 16; ++e) { s0[e] *= SC; s1[e] *= SC; }
            }
            float mx = fmaxf(max16(s0), max16(s1));
            mx = fmaxf(mx, __shfl_xor(mx, 32));
            const float mn = fmaxf(m, mx), alpha = __builtin_amdgcn_exp2f(m - mn);
            m = mn; l *= alpha;
            o[0] = o[0] * alpha; o[1] = o[1] * alpha;
            float rs = 0.f;
#pragma unroll
            for (int e = 0; e < 16; ++e) { s0[e] = __builtin_amdgcn_exp2f(s0[e] - mn); s1[e] = __builtin_amdgcn_exp2f(s1[e] - mn); rs += s0[e] + s1[e]; }
            l += rs;
            __builtin_amdgcn_sched_barrier(0);
            if (t + 1 < 12) NA_LOAD(t + 1, 2);
            bf16x8 pf[4];
            pf[0] = pfrag(s0, 0); pf[1] = pfrag(s0, 1); pf[2] = pfrag(s1, 0); pf[3] = pfrag(s1, 1);
            const LAS3 unsigned char* va = vl + vb;
#pragma unroll
            for (int ks = 0; ks < 4; ++ks)
#pragma unroll
                for (int d = 0; d < 2; ++d) {
                    const s16x4 lo = vtr(va + (16 * ks) * VP + 64 * d), hh = vtr(va + (16 * ks + 8) * VP + 64 * d);
                    const bf16x8 vf = {lo[0], lo[1], lo[2], lo[3], hh[0], hh[1], hh[2], hh[3]};
                    o[d] = __builtin_amdgcn_mfma_f32_32x32x16_bf16(vf, pf[ks], o[d], 0, 0, 0);
                }
            __builtin_amdgcn_sched_barrier(0);
            if (t + 1 < 12) NA_STORE(t + 1);
        }
#undef NA_LOAD
#undef NA_STORE
        l += __shfl_xor(l, 32);
        const float inv = 1.f / l;
        bf16_t* op = OA + (size_t)qtok * 2048 + h * 64 + 4 * hi;
#pragma unroll
        for (int d = 0; d < 2; ++d)
#pragma unroll
            for (int g = 0; g < 4; ++g) {
                const f32x4 v = {o[d][4 * g] * inv, o[d][4 * g + 1] * inv, o[d][4 * g + 2] * inv, o[d][4 * g + 3] * inv};
                store_bf4(op + 32 * d + 8 * g, v);
            }
    }
}


template <bool LAT, int HALF>
__device__ __forceinline__ void na_tile(const LAS3 unsigned char* Kb, const LAS3 unsigned char* Vb, const LAS3 float* tbl, const bf16x8 (&qf)[4], f32x16 (&o)[2], float& m, float& l,
                                        int r32, int hi, int qc, int w0, int vb) {
    constexpr int KP = 144, VP = 192;
    constexpr float SC = NA_SCALE * LOG2E;
    constexpr int L0 = (LAT && HALF == 1) ? 12 : 0;
    constexpr int H1 = (LAT && HALF == 0) ? 4 : 16;
    f32x16 s0, s1;
#pragma unroll
    for (int e = 0; e < 16; ++e) { s0[e] = 0.f; s1[e] = 0.f; }
    const LAS3 unsigned char* ka = Kb + r32 * KP + 16 * hi;
#pragma unroll
    for (int s = 0; s < 4; ++s) {
        const bf16x8 a0 = *(const LAS3 bf16x8*)(ka + 32 * s), a1 = *(const LAS3 bf16x8*)(ka + 32 * KP + 32 * s);
        s0 = __builtin_amdgcn_mfma_f32_32x32x16_bf16(a0, qf[s], s0, 0, 0, 0);
        s1 = __builtin_amdgcn_mfma_f32_32x32x16_bf16(a1, qf[s], s1, 0, 0, 0);
    }
    if constexpr (LAT) {
        int w0v = w0 - 4 * hi, tb = 4 * hi - qc + 63; asm volatile("" : "+v"(w0v), "+v"(tb));
        const LAS3 float* tp = tbl + tb;
#pragma unroll
        for (int e = 0; e < 16; ++e) {
            const int c0 = (e & 3) + 8 * (e >> 2), c1 = c0 + 32;
            if (e >= L0) { const float p0 = (float)((unsigned)(c0 - w0v) & 0xFFFFFFF0u); s0[e] = fmaf(p0, -1e28f, fmaf(s0[e], SC, tp[c0])); }
            if (e < H1) { const float p1 = (float)((unsigned)(c1 - w0v) & 0xFFFFFFF0u); s1[e] = fmaf(p1, -1e28f, fmaf(s1[e], SC, tp[c1])); }
        }
    } else {
#pragma unroll
        for (int e = 0; e < 16; ++e) { s0[e] *= SC; s1[e] *= SC; }
    }
    float mx = -1e30f;
#pragma unroll
    for (int e = 0; e < 16; ++e) { if (e >= L0) mx = fmaxf(mx, s0[e]); if (e < H1) mx = fmaxf(mx, s1[e]); }
    mx = fmaxf(mx, __shfl_xor(mx, 32));
    const float mn = fmaxf(m, mx);
    if (__builtin_amdgcn_ballot_w64(mx > m) != 0ull) {
        const float alpha = __builtin_amdgcn_exp2f(m - mn);
        l *= alpha; o[0] = o[0] * alpha; o[1] = o[1] * alpha;
    }
    m = mn;
    float rs = 0.f;
#pragma unroll
    for (int e = 0; e < 16; ++e) {
        if (e >= L0) { s0[e] = __builtin_amdgcn_exp2f(s0[e] - mn); rs += s0[e]; } else s0[e] = 0.f;
        if (e < H1) { s1[e] = __builtin_amdgcn_exp2f(s1[e] - mn); rs += s1[e]; } else s1[e] = 0.f;
    }
    l += rs;
    bf16x8 pf[4];
    pf[0] = pfrag(s0, 0); pf[1] = pfrag(s0, 1); pf[2] = pfrag(s1, 0); pf[3] = pfrag(s1, 1);
    const LAS3 unsigned char* va = Vb + vb;
#pragma unroll
    for (int ks = 0; ks < 4; ++ks) {
        if (LAT && ((HALF == 0 && ks == 3) || (HALF == 1 && ks == 0))) continue;
#pragma unroll
        for (int d = 0; d < 2; ++d) {
            const s16x4 lo = vtr(va + (16 * ks) * VP + 64 * d), hh = vtr(va + (16 * ks + 8) * VP + 64 * d);
            const bf16x8 vf = {lo[0], lo[1], lo[2], lo[3], hh[0], hh[1], hh[2], hh[3]};
            o[d] = __builtin_amdgcn_mfma_f32_32x32x16_bf16(vf, pf[ks], o[d], 0, 0, 0);
        }
    }
}
__device__ __forceinline__ void na_coop(const Params& p, unsigned char* lds_) {
    int tid_ = threadIdx.x; asm volatile("" : "+v"(tid_)); const int tid = tid_, lane = tid & 63, wid = tid >> 6, r32 = lane & 31, hi = lane >> 5;
    constexpr int KP = 144, VP = 192, KT = 64 * KP, VT = 64 * VP, STG = KT + VT;
    LAS3 unsigned char* lds = (LAS3 unsigned char*)lds_;
    LAS3 float* tbl = (LAS3 float*)(lds + 2 * STG) + wid * 128;
    tbl[lane] = 0.f; tbl[lane + 64] = 0.f;
    const bf16_t* PL = (const bf16_t*)(p.ws + WS_PL); const bf16_t* PCx = (const bf16_t*)(p.ws + WS_PC);
    bf16_t* OA = (bf16_t*)(p.ws + WS_OA);
    const float* rpb = p.in[11];
    const int G = gridDim.x, vcu = (G % 8 == 0) ? (blockIdx.x % 8) * (G / 8) + blockIdx.x / 8 : blockIdx.x;
    const int vb = (4 * hi + ((lane & 15) >> 2)) * VP + (16 * ((lane >> 4) & 1) + 4 * (lane & 3)) * 2;
    const int half = wid & 1, rw = wid >> 1, skey = tid >> 3, spc = tid & 7;
    constexpr float SC = NA_SCALE * LOG2E;
    for (int unit = vcu; unit < NB * 16 * (GROWS / 4); unit += G) {
        const int rg = unit & 7, h = (unit >> 3) & 15, b = unit >> 7;
        const int R = rg * 4, r = R + rw;
        int r0w = r - 4; r0w = r0w < 0 ? 0 : (r0w > GROWS - 8 ? GROWS - 8 : r0w);
        int kr_lo = R - 4; kr_lo = kr_lo < 0 ? 0 : (kr_lo > GROWS - 8 ? GROWS - 8 : kr_lo);
        int kr_hi = R - 1; kr_hi = (kr_hi < 0 ? 0 : (kr_hi > GROWS - 8 ? GROWS - 8 : kr_hi)) + 7;
        const int nlat = kr_hi - kr_lo + 1, NT = nlat + 4;
        const int qc = 32 * half + r32;
        int w0 = qc - 8; w0 = w0 < 0 ? 0 : (w0 > GW - 16 ? GW - 16 : w0);
        const int qtok = b * SEQ + r * 64 + qc;
        bf16x8 qf[4];
#pragma unroll
        for (int s = 0; s < 4; ++s) qf[s] = *(const bf16x8*)(PL + (size_t)qtok * NP + PC_QA + h * 64 + 16 * s + 8 * hi);
        f32x16 o[2];
#pragma unroll
        for (int d = 0; d < 2; ++d)
#pragma unroll
            for (int e = 0; e < 16; ++e) o[d][e] = 0.f;
        float m = -1e30f, l = 0.f;
        float brow[8];
#pragma unroll
        for (int i = 0; i < 8; ++i) brow[i] = lane < 31 ? rpb[(h * 15 + (r0w - r + 7 + i)) * 31 + lane] * LOG2E : 0.f;
        u32x4 gk, gv;
#define NC_LOAD(t) do { const bf16_t* kp_ = (t) < nlat ? PL + (size_t)(b * SEQ + (kr_lo + (t)) * 64 + skey) * NP + PC_KA + h * 64 + spc * 8 \
                                                      : PCx + (size_t)(b * CTX + 64 * ((t) - nlat) + skey) * NPC + PC_KA + h * 64 + spc * 8; \
            gk = *(const u32x4*)kp_; gv = *(const u32x4*)(kp_ + 1024); } while (0)
#define NC_STORE(buf) do { *(LAS3 u32x4*)(lds + (buf) * STG + skey * KP + spc * 16) = gk; *(LAS3 u32x4*)(lds + (buf) * STG + KT + skey * VP + spc * 16) = gv; } while (0)
        __syncthreads();
        NC_LOAD(0); NC_STORE(0);
#pragma unroll
        for (int s = 0; s < 4; ++s) asm volatile("" : "+v"(qf[s]));
#pragma unroll
        for (int i = 0; i < 8; ++i) asm volatile("" : "+v"(brow[i]));
        __syncthreads();
#pragma nounroll
        for (int t = 0; t < NT; ++t) {
            const int cur = t & 1;
            if (t + 1 < NT) NC_LOAD(t + 1);
            const bool lat = t < nlat; const int kr = kr_lo + t;
            if (!lat || (kr >= r0w && kr < r0w + 8)) {
                const LAS3 unsigned char* Kb = lds + cur * STG; const LAS3 unsigned char* Vb = Kb + KT;
                if (lat) { const int bi_ = kr - r0w; float bv = brow[0];
#pragma unroll
                    for (int i = 1; i < 8; ++i) bv = bi_ == i ? brow[i] : bv;
                    if (lane < 31) tbl[48 + lane] = bv; }
                if (!lat) na_tile<false, 0>(Kb, Vb, tbl, qf, o, m, l, r32, hi, qc, w0, vb);
                else if (half == 0) na_tile<true, 0>(Kb, Vb, tbl, qf, o, m, l, r32, hi, qc, w0, vb);
                else na_tile<true, 1>(Kb, Vb, tbl, qf, o, m, l, r32, hi, qc, w0, vb);
            }
            if (t + 1 < NT) NC_STORE(cur ^ 1);
            __syncthreads();
        }
#undef NC_LOAD
#undef NC_STORE
        l += __shfl_xor(l, 32);
        const float inv = 1.f / l;
        bf16_t* op = OA + (size_t)qtok * 2048 + h * 64 + 4 * hi;
#pragma unroll
        for (int d = 0; d < 2; ++d)
#pragma unroll
            for (int g = 0; g < 4; ++g) {
                const f32x4 v = {o[d][4 * g] * inv, o[d][4 * g + 1] * inv, o[d][4 * g + 2] * inv, o[d][4 * g + 3] * inv};
                store_bf4(op + 32 * d + 8 * g, v);
            }
    }
}

__device__ __forceinline__ void phase7(const Params& p) {
    int tid_ = threadIdx.x; asm volatile("" : "+v"(tid_)); const int tid = tid_, lane = tid & 63, wid = tid >> 6;
    const int gw = blockIdx.x * NWAVES + wid, NGW = gridDim.x * NWAVES;
    const float* mod = (const float*)(p.ws + WS_MOD);
    const bf16_t* Z = (const bf16_t*)(p.ws + WS_Z); bf16_t* H = (bf16_t*)(p.ws + WS_H);
    const float* gpm = p.in[7]; const float* gpf = p.in[8];
    const int per = (TL + NGW - 1) / NGW;
    int curb = -1; f32x4 A[8], B[8], C[8];
    for (int i = 0; i < per; ++i) {
        const int m = gw * per + i; if (m >= TL) break;
        const int b = m / SEQ;
        if (b != curb) { curb = b; const float* mb = mod + (size_t)b * 12288;
#pragma unroll
            for (int j = 0; j < 8; ++j) { const int c = j * 256 + lane * 4;
                A[j] = *(const f32x4*)(mb + 4096 + c) * *(const f32x4*)(gpm + c); B[j] = *(const f32x4*)(gpf + c) * (*(const f32x4*)(mb + 8192 + c) + 1.f); C[j] = *(const f32x4*)(mb + 6144 + c); } }
        f32x4 z[8]; float ss = 0.f;
#pragma unroll
        for (int j = 0; j < 8; ++j) {
            const u32x2 w = *(const u32x2*)(Z + (size_t)m * DM + j * 256 + lane * 4);
            z[j] = (f32x4){__uint_as_float(w.x << 16), __uint_as_float(w.x & 0xffff0000u), __uint_as_float(w.y << 16), __uint_as_float(w.y & 0xffff0000u)};
            ss += z[j][0] * z[j][0] + z[j][1] * z[j][1] + z[j][2] * z[j][2] + z[j][3] * z[j][3];
        }
        f32x4 xv[8];
#pragma unroll
        for (int j = 0; j < 8; ++j) xv[j] = *(const f32x4*)(p.in[0] + (size_t)m * DM + j * 256 + lane * 4);
        const float rz = rsqrtf(wave_sum_dpp(ss) * (1.f / DM) + EPS);
        float s2 = 0.f;
#pragma unroll
        for (int j = 0; j < 8; ++j) {
            const f32x4 x1 = xv[j] + (z[j] * rz) * A[j];
            *(f32x4*)(p.out + (size_t)m * DM + j * 256 + lane * 4) = x1;
            z[j] = x1; s2 += x1[0] * x1[0] + x1[1] * x1[1] + x1[2] * x1[2] + x1[3] * x1[3];
        }
        const float rx = rsqrtf(wave_sum_dpp(s2) * (1.f / DM) + EPS);
#pragma unroll
        for (int j = 0; j < 8; ++j) store_bf4(H + (size_t)m * DM + j * 256 + lane * 4, (z[j] * rx) * B[j] + C[j]);
    }
}

template <int NPER>
__device__ __forceinline__ void wave_top16(float (&v)[NPER], const int (&idx)[NPER], float& outv, int& outi, int lane) {
    outv = -INFINITY; outi = 0;
#pragma nounroll
    for (int r = 0; r < 16; ++r) {
        float bv = v[0]; int bi = idx[0];
#pragma unroll
        for (int e = 1; e < NPER; ++e) if (v[e] > bv || (v[e] == bv && idx[e] < bi)) { bv = v[e]; bi = idx[e]; }
#pragma unroll
        for (int o = 32; o >= 1; o >>= 1) {
            const float ov = __shfl_xor(bv, o); const int oi = __shfl_xor(bi, o);
            if (ov > bv || (ov == bv && oi < bi)) { bv = ov; bi = oi; }
        }
#pragma unroll
        for (int e = 0; e < NPER; ++e) if (idx[e] == bi) v[e] = -INFINITY;
        if (lane == r) { outv = bv; outi = bi; }
    }
}

__device__ __forceinline__ void peer_topk_naive(const Params& p, unsigned char* lds) {
    int tid_ = threadIdx.x; asm volatile("" : "+v"(tid_)); const int tid = tid_, lane = tid & 63, wid = tid >> 6;
    const int gw = blockIdx.x * NWAVES + wid, NGW = gridDim.x * NWAVES;
    const bf16_t* QP = (const bf16_t*)(p.ws + WS_QP); const bf16_t* SK = (const bf16_t*)(p.ws + WS_SUBK);
    float* TKV = (float*)(p.ws + WS_TKV); int* TKI = (int*)(p.ws + WS_TKI);
    float* qs = (float*)lds + wid * 128;
    for (int it = gw; it < TL * 16; it += NGW) {
        const int hp = it & 15, m = it >> 4;
        qs[lane] = bf2f(QP[(size_t)m * DM + hp * 128 + lane]); qs[lane + 64] = bf2f(QP[(size_t)m * DM + hp * 128 + 64 + lane]);
        __builtin_amdgcn_s_waitcnt(0xc07f); asm volatile("" ::: "memory");
        float v[2]; int idx[2];
#pragma unroll
        for (int i = 0; i < 2; ++i) {
            const int n = lane + 64 * i; const bf16_t* kp = SK + (size_t)(hp * 128 + n) * 128;
            float d = 0.f;
#pragma unroll
            for (int e = 0; e < 16; ++e) d += dot_bf16x8(*(const bf16x8*)(kp + e * 8), qs + e * 8);
            v[i] = d; idx[i] = n;
        }
        float ov; int oi; wave_top16<2>(v, idx, ov, oi, lane);
        if (lane < 16) { TKV[(size_t)it * 16 + lane] = ov; TKI[(size_t)it * 16 + lane] = oi; }
        __builtin_amdgcn_s_waitcnt(0xc07f); asm volatile("" ::: "memory");
    }
}

__device__ __forceinline__ void peer_final_naive(const Params& p, unsigned char* lds) {
    int tid_ = threadIdx.x; asm volatile("" : "+v"(tid_)); const int tid = tid_, lane = tid & 63, wid = tid >> 6;
    const float* TKV = (const float*)(p.ws + WS_TKV); const int* TKI = (const int*)(p.ws + WS_TKI);
    const bf16_t* H = (const bf16_t*)(p.ws + WS_H);
    const float* U = p.in[21]; const float* V = p.in[22];
    const float* mod = (const float*)(p.ws + WS_MOD); const float* gpo = p.in[9];
    float* part = (float*)lds;
    float* red = part + 8 * 2048;
    for (int m = blockIdx.x; m < TL; m += gridDim.x) {
        const int b = m / SEQ, h = wid;
        const float* v1 = TKV + ((size_t)m * 16 + h * 2) * 16; const float* v2 = v1 + 16;
        const int* i1 = TKI + ((size_t)m * 16 + h * 2) * 16; const int* i2 = i1 + 16;
        float cv[4]; int ci[4];
        const float v2j = v2[lane & 15];
#pragma unroll
        for (int e = 0; e < 4; ++e) { const int i = (lane >> 4) + 4 * e; cv[e] = v1[i] + v2j; ci[e] = i * 16 + (lane & 15); }
        float tv; int tc; wave_top16<4>(cv, ci, tv, tc, lane);
        int eid = 0; float gate = 0.f;
        if (lane < 16) eid = i1[tc >> 4] * 128 + i2[tc & 15];
        const float mx = __shfl(tv, 0);
        const float ex = lane < 16 ? __expf(tv - mx) : 0.f;
        gate = ex / wave_sum(ex);
        f32x4 hv[8];
#pragma unroll
        for (int j = 0; j < 8; ++j) { const u32x2 w = *(const u32x2*)(H + (size_t)m * DM + j * 256 + lane * 4);
            hv[j] = (f32x4){__uint_as_float(w.x << 16), __uint_as_float(w.x & 0xffff0000u), __uint_as_float(w.y << 16), __uint_as_float(w.y & 0xffff0000u)}; }
        f32x4 acc[8];
#pragma unroll
        for (int j = 0; j < 8; ++j) acc[j] = (f32x4){0.f, 0.f, 0.f, 0.f};
        for (int k = 0; k < 16; ++k) {
            const int e = __shfl(eid, k); const float g = __shfl(gate, k);
#ifdef PEER_NAIVE_BF16
            const bf16_t* ur = (const bf16_t*)(p.ws + WS_UB) + (size_t)e * DM + lane * 4; const bf16_t* vr = (const bf16_t*)(p.ws + WS_VB) + (size_t)e * DM + lane * 4;
            float d = 0.f;
#pragma unroll
            for (int j = 0; j < 8; ++j) { const u32x2 w = *(const u32x2*)(ur + j * 256); const f32x4 u = {__uint_as_float(w.x << 16), __uint_as_float(w.x & 0xffff0000u), __uint_as_float(w.y << 16), __uint_as_float(w.y & 0xffff0000u)};
                d += u[0] * hv[j][0] + u[1] * hv[j][1] + u[2] * hv[j][2] + u[3] * hv[j][3]; }
            d = wave_sum(d);
            const float coef = g * gelu_as(d);
#pragma unroll
            for (int j = 0; j < 8; ++j) { const u32x2 w = *(const u32x2*)(vr + j * 256); const f32x4 vv = {__uint_as_float(w.x << 16), __uint_as_float(w.x & 0xffff0000u), __uint_as_float(w.y << 16), __uint_as_float(w.y & 0xffff0000u)};
                acc[j] += vv * coef; }
#else
            const float* ur = U + (size_t)e * DM + lane * 4; const float* vr = V + (size_t)e * DM + lane * 4;
            float d = 0.f;
#pragma unroll
            for (int j = 0; j < 8; ++j) { const f32x4 u = *(const f32x4*)(ur + j * 256); d += u[0] * hv[j][0] + u[1] * hv[j][1] + u[2] * hv[j][2] + u[3] * hv[j][3]; }
            d = wave_sum(d);
            const float coef = g * gelu_erf(d);
#pragma unroll
            for (int j = 0; j < 8; ++j) acc[j] += *(const f32x4*)(vr + j * 256) * coef;
#endif
        }
        __syncthreads();
#pragma unroll
        for (int j = 0; j < 8; ++j) *(f32x4*)(part + wid * 2048 + j * 256 + lane * 4) = acc[j];
        __syncthreads();
        f32x4 y = (f32x4){0.f, 0.f, 0.f, 0.f};
#pragma unroll
        for (int w = 0; w < 8; ++w) y += *(const f32x4*)(part + w * 2048 + tid * 4);
        float ss = wave_sum(y[0] * y[0] + y[1] * y[1] + y[2] * y[2] + y[3] * y[3]);
        if (lane == 0) red[wid] = ss;
        __syncthreads();
        float tot = 0.f;
#pragma unroll
        for (int w = 0; w < 8; ++w) tot += red[w];
        const float rstd = rsqrtf(tot * (1.f / DM) + EPS);
        const int c = tid * 4;
        const f32x4 gt2 = *(const f32x4*)(mod + (size_t)b * 12288 + 10240 + c);
        float* op = p.out + (size_t)m * DM + c;
        const f32x4 x1 = *(const f32x4*)op;
        *(f32x4*)op = x1 + gt2 * (y * rstd * *(const f32x4*)(gpo + c));
    }
}


__device__ __forceinline__ void peer_topk_mfma(const Params& p, unsigned char* lds_) {
    int tid_ = threadIdx.x; asm volatile("" : "+v"(tid_)); const int tid = tid_, lane = tid & 63, wid = tid >> 6, r32 = lane & 31, hi = lane >> 5;
    LAS3 unsigned char* lds = (LAS3 unsigned char*)lds_;
    constexpr int SP = 272;
    const bf16_t* QP = (const bf16_t*)(p.ws + WS_QP); const bf16_t* SK = (const bf16_t*)(p.ws + WS_SUBK);
    float* TKV = (float*)(p.ws + WS_TKV); int* TKI = (int*)(p.ws + WS_TKI);
    for (int bi = blockIdx.x; bi < 256; bi += gridDim.x) {
        const int hp = bi & 15, sub = bi >> 4;
        __syncthreads();
        for (int c = tid; c < 2048; c += NTHREADS) { const int row = c >> 4, pc = c & 15;
            *(LAS3 u32x4*)(lds + row * SP + pc * 16) = *(const u32x4*)(SK + ((size_t)hp * 128 + row) * 128 + pc * 8); }
        __syncthreads();
        for (int g = wid; g < 32; g += NWAVES) {
            const int tok = (sub * 32 + g) * 32 + r32;
            bf16x8 qf[8];
#pragma unroll
            for (int s = 0; s < 8; ++s) qf[s] = *(const bf16x8*)(QP + (size_t)tok * DM + hp * 128 + 16 * s + 8 * hi);
            f32x16 sc[4];
#pragma unroll
            for (int kb = 0; kb < 4; ++kb) {
#pragma unroll
                for (int e = 0; e < 16; ++e) sc[kb][e] = 0.f;
#pragma unroll
                for (int s = 0; s < 8; ++s) {
                    const bf16x8 a = *(const LAS3 bf16x8*)(lds + (32 * kb + r32) * SP + 32 * s + 16 * hi);
                    sc[kb] = __builtin_amdgcn_mfma_f32_32x32x16_bf16(a, qf[s], sc[kb], 0, 0, 0);
                }
            }
#pragma unroll
            for (int kb = 0; kb < 4; ++kb)
#pragma unroll
                for (int e = 0; e < 16; ++e) {
                    const unsigned key = 32 * kb + (e & 3) + 8 * (e >> 2) + 4 * hi;
                    sc[kb][e] = __uint_as_float((__float_as_uint(sc[kb][e]) & 0xFFFFFF80u) | key);
                }
            float ov[16];
#pragma unroll
            for (int r = 0; r < 16; ++r) {
                float mx = -INFINITY;
#pragma unroll
                for (int kb = 0; kb < 4; ++kb) mx = fmaxf(mx, max16(sc[kb]));
                const float w = fmaxf(mx, __shfl_xor(mx, 32));
                ov[r] = w;
#pragma unroll
                for (int kb = 0; kb < 4; ++kb)
#pragma unroll
                    for (int e = 0; e < 16; ++e) sc[kb][e] = sc[kb][e] == w ? -INFINITY : sc[kb][e];
            }
            if (hi == 0) {
                float* vp = TKV + ((size_t)tok * 16 + hp) * 16; int* ip = TKI + ((size_t)tok * 16 + hp) * 16;
#pragma unroll
                for (int q = 0; q < 4; ++q) {
                    f32x4 vv; u32x4 ii;
#pragma unroll
                    for (int e = 0; e < 4; ++e) { const unsigned u = __float_as_uint(ov[4 * q + e]); vv[e] = __uint_as_float(u & 0xFFFFFF80u); ii[e] = u & 127u; }
                    *(f32x4*)(vp + 4 * q) = vv; *(u32x4*)(ip + 4 * q) = ii;
                }
            }
        }
    }
}


constexpr int cand_jmax(int i) { return 16 / (i + 1); }
constexpr int cand_off(int i) { int t = 0; for (int k = 0; k < i; ++k) t += 16 / (k + 1); return t; }
static_assert(cand_off(16) == 50, "candidate count");
template <int N> __device__ __forceinline__ void bitonic_sort_desc(float (&a)[N]) {
#pragma unroll
    for (int k = 2; k <= N; k <<= 1)
#pragma unroll
        for (int j = k >> 1; j > 0; j >>= 1)
#pragma unroll
            for (int i = 0; i < N; ++i) { const int l = i ^ j; if (l > i) { const bool up = (i & k) == 0; const float x = a[i], y = a[l];
                a[i] = up ? fmaxf(x, y) : fminf(x, y); a[l] = up ? fminf(x, y) : fmaxf(x, y); } }
}
template <int N> __device__ __forceinline__ void bitonic_merge_desc(float (&a)[N]) {
#pragma unroll
    for (int j = N >> 1; j > 0; j >>= 1)
#pragma unroll
        for (int i = 0; i < N; ++i) { const int l = i ^ j; if (l > i) { const float x = a[i], y = a[l]; a[i] = fmaxf(x, y); a[l] = fminf(x, y); } }
}
__device__ __forceinline__ void top16_merge(float (&a)[16], const float (&b)[16]) {
#pragma unroll
    for (int i = 0; i < 16; ++i) a[i] = fmaxf(a[i], b[15 - i]);
    bitonic_merge_desc<16>(a);
}
__device__ __forceinline__ void top16_of_64(float (&g0)[16], float (&g1)[16], float (&g2)[16], float (&g3)[16]) {
    bitonic_sort_desc<16>(g0); bitonic_sort_desc<16>(g1); bitonic_sort_desc<16>(g2); bitonic_sort_desc<16>(g3);
    top16_merge(g0, g1); top16_merge(g2, g3); top16_merge(g0, g2);
}
__device__ __forceinline__ void topk_stage1(const LAS3 unsigned char* skl, const bf16_t* __restrict__ qrow, int r32, int hi, float (&ov)[16]) {
    constexpr int SP = 272;
    bf16x8 qf[8];
#pragma unroll
    for (int s = 0; s < 8; ++s) qf[s] = *(const bf16x8*)(qrow + 16 * s + 8 * hi);
    f32x16 sc[4];
#pragma unroll
    for (int kb = 0; kb < 4; ++kb) {
#pragma unroll
        for (int e = 0; e < 16; ++e) sc[kb][e] = 0.f;
#pragma unroll
        for (int s = 0; s < 8; ++s) {
            const bf16x8 a = *(const LAS3 bf16x8*)(skl + (32 * kb + r32) * SP + 32 * s + 16 * hi);
            sc[kb] = __builtin_amdgcn_mfma_f32_32x32x16_bf16(a, qf[s], sc[kb], 0, 0, 0);
        }
    }
    float g1[16], g2[16], g3[16];
#pragma unroll
    for (int e = 0; e < 16; ++e) {
        const unsigned key = (e & 3) + 8 * (e >> 2) + 4 * hi;
        ov[e] = __uint_as_float((__float_as_uint(sc[0][e]) & 0xFFFFFF80u) | key);
        g1[e] = __uint_as_float((__float_as_uint(sc[1][e]) & 0xFFFFFF80u) | (key + 32u));
        g2[e] = __uint_as_float((__float_as_uint(sc[2][e]) & 0xFFFFFF80u) | (key + 64u));
        g3[e] = __uint_as_float((__float_as_uint(sc[3][e]) & 0xFFFFFF80u) | (key + 96u));
    }
    top16_of_64(ov, g1, g2, g3);
    float pb[16];
#pragma unroll
    for (int e = 0; e < 16; ++e) pb[e] = __shfl_xor(ov[e], 32);
    top16_merge(ov, pb);
}
__device__ __forceinline__ void peer_tables_q8(const Params& p, int gw, int NGW, int lane);
__device__ __forceinline__ void peer_select_mfma(const Params& p, unsigned char* lds_, int mode = 0) {
    int tid_ = threadIdx.x; asm volatile("" : "+v"(tid_)); const int tid = tid_, lane = tid & 63, wid = tid >> 6, r32 = lane & 31, hi = lane >> 5;
    LAS3 unsigned char* lds = (LAS3 unsigned char*)lds_;
    constexpr int SP = 272;
    LAS3 unsigned* ktab = (LAS3 unsigned*)(lds + 256 * SP) + wid * 2048 + lane;
    const bf16_t* QP = (const bf16_t*)(p.ws + WS_QP); const bf16_t* SK = (const bf16_t*)(p.ws + WS_SUBK);
    int* SE = (int*)(p.ws + WS_TKI); float* SG = (float*)(p.ws + WS_TKV);
    for (int bi = blockIdx.x; bi < 256; bi += gridDim.x) {
        const int h = bi & 7, sub = bi >> 3;
        __syncthreads();
        for (int c = tid; c < 4096; c += NTHREADS) { const int row = c >> 4, pc = c & 15;
            *(LAS3 u32x4*)(lds + row * SP + pc * 16) = *(const u32x4*)(SK + ((size_t)h * 256 + row) * 128 + pc * 8); }
        __syncthreads();
#ifdef SEL_SPLIT
        if (wid >= 4) { if (bi == (int)blockIdx.x && mode != 1) peer_tables_q8(p, blockIdx.x * 4 + (wid - 4), gridDim.x * 4, lane); continue; }
        if (mode == 2) continue;
        for (int g = wid; g < 16; g += 4) {
#else
        if (mode == 2) continue;
        for (int g = wid; g < 16; g += NWAVES) {
#endif
            const int tok = (sub * 16 + g) * 32 + r32;
            float ov0[16], ov1[16];
            int lo0 = 0, lo1 = 128 * SP; asm volatile("" : "+v"(lo0), "+v"(lo1));
            topk_stage1(lds + lo0, QP + (size_t)tok * DM + h * 256, r32, hi, ov0);
            topk_stage1(lds + lo1, QP + (size_t)tok * DM + h * 256 + 128, r32, hi, ov1);
#pragma unroll
            for (int q = 0; q < 16; ++q) { ktab[q * 64] = __float_as_uint(ov0[q]) & 127u; ktab[(16 + q) * 64] = __float_as_uint(ov1[q]) & 127u; }
            float c0[16], c1[16], c2[16], c3[16];
#pragma unroll
            for (int e = 0; e < 16; ++e) { c0[e] = -INFINITY; c1[e] = -INFINITY; c2[e] = -INFINITY; c3[e] = -INFINITY; }
#pragma unroll
            for (int i = 0; i < 16; ++i) {
                const float a = __uint_as_float(__float_as_uint(ov0[i]) & 0xFFFFFF80u);
#pragma unroll
                for (int j = 0; j < 16; ++j) if (j < cand_jmax(i)) {
                    const float bb = __uint_as_float(__float_as_uint(ov1[j]) & 0xFFFFFF80u);
                    const float cv = __uint_as_float((__float_as_uint(a + bb) & 0xFFFFFF00u) | (unsigned)(i * 16 + j));
                    const int n = cand_off(i) + j;
                    if (n < 16) c0[n & 15] = cv; else if (n < 32) c1[n & 15] = cv; else if (n < 48) c2[n & 15] = cv; else c3[n & 15] = cv;
                }
            }
            top16_of_64(c0, c1, c2, c3);
            float tv[16]; unsigned te[16];
#pragma unroll
            for (int r = 0; r < 16; ++r) {
                const unsigned ij = __float_as_uint(c0[r]) & 255u;
                te[r] = ktab[(ij >> 4) * 64] * 128u + ktab[(16 + (ij & 15u)) * 64];
                tv[r] = __uint_as_float(__float_as_uint(c0[r]) & 0xFFFFFF00u);
            }
            const float tmax = tv[0]; float sum = 0.f;
#pragma unroll
            for (int r = 0; r < 16; ++r) { tv[r] = __expf(tv[r] - tmax); sum += tv[r]; }
            const float rinv = 1.f / sum;
#pragma unroll
            for (int r = 0; r < 16; ++r) tv[r] *= rinv;
            if (hi == 0) {
                int* ep = SE + (size_t)tok * 128 + h * 16; float* gp = SG + (size_t)tok * 128 + h * 16;
#pragma unroll
                for (int q = 0; q < 4; ++q) { *(u32x4*)(ep + 4 * q) = (u32x4){te[4 * q], te[4 * q + 1], te[4 * q + 2], te[4 * q + 3]}; *(f32x4*)(gp + 4 * q) = (f32x4){tv[4 * q], tv[4 * q + 1], tv[4 * q + 2], tv[4 * q + 3]}; }
            }
        }
#ifndef SEL_SPLIT
        if (bi == (int)blockIdx.x && mode != 1) peer_tables_q8(p, blockIdx.x * NWAVES + wid, gridDim.x * NWAVES, lane);
#endif
    }
}

__device__ __forceinline__ void peer_tables_bf16(const Params& p) {
    const size_t gt = (size_t)blockIdx.x * NTHREADS + threadIdx.x, NGT = (size_t)gridDim.x * NTHREADS;
    const float* U = p.in[21]; const float* V = p.in[22];
    bf16_t* UB = (bf16_t*)(p.ws + WS_UB); bf16_t* VB = (bf16_t*)(p.ws + WS_VB);
    for (size_t i = gt; i < (size_t)16384 * DM / 8; i += NGT) {
        const f32x4 a0 = *(const f32x4*)(U + i * 8), a1 = *(const f32x4*)(U + i * 8 + 4), b0 = *(const f32x4*)(V + i * 8), b1 = *(const f32x4*)(V + i * 8 + 4);
        u32x4 w; w.x = pk2(a0[0], a0[1]); w.y = pk2(a0[2], a0[3]); w.z = pk2(a1[0], a1[1]); w.w = pk2(a1[2], a1[3]);
        *(u32x4*)(UB + i * 8) = w;
        w.x = pk2(b0[0], b0[1]); w.y = pk2(b0[2], b0[3]); w.z = pk2(b1[0], b1[1]); w.w = pk2(b1[2], b1[3]);
        *(u32x4*)(VB + i * 8) = w;
    }
}

typedef short s16x2 __attribute__((ext_vector_type(2)));
__device__ __forceinline__ float dot2_bf16(unsigned a, unsigned b, float acc) { return __builtin_amdgcn_fdot2_f32_bf16(__builtin_bit_cast(s16x2, a), __builtin_bit_cast(s16x2, b), acc, false); }
__device__ __forceinline__ float dot8_bf16(const u32x4 a, const u32x4 b, float acc) {
    const unsigned a0 = a[0], a1 = a[1], a2 = a[2], a3 = a[3], b0 = b[0], b1 = b[1], b2 = b[2], b3 = b[3];
    acc = dot2_bf16(a0, b0, acc); acc = dot2_bf16(a1, b1, acc); acc = dot2_bf16(a2, b2, acc); acc = dot2_bf16(a3, b3, acc);
    return acc;
}
__device__ __forceinline__ void peer_select(const float* __restrict__ TKV, const int* __restrict__ TKI, int m, int lane, int& eA, int& eB, float& gA, float& gB) {
    eA = 0; eB = 0; gA = 0.f; gB = 0.f;
#pragma nounroll
    for (int h = 0; h < 8; ++h) {
        const float* v1 = TKV + ((size_t)m * 16 + h * 2) * 16; const float* v2 = v1 + 16;
        const int* i1 = TKI + ((size_t)m * 16 + h * 2) * 16; const int* i2 = i1 + 16;
        float cv[4]; int ci[4];
        const float v2j = v2[lane & 15];
#pragma unroll
        for (int e = 0; e < 4; ++e) { const int i = (lane >> 4) + 4 * e; cv[e] = v1[i] + v2j; ci[e] = i * 16 + (lane & 15); }
        float tv; int tc; wave_top16<4>(cv, ci, tv, tc, lane);
        int eid = 0;
        if (lane < 16) eid = i1[tc >> 4] * 128 + i2[tc & 15];
        const float mx = __shfl(tv, 0);
        const float ex = lane < 16 ? __expf(tv - mx) : 0.f;
        const float gate = ex / wave_sum(ex);
        const int es = __shfl(eid, lane & 15); const float gs = __shfl(gate, lane & 15);
        if ((lane >> 4) == (h & 3)) { if (h < 4) { eA = es; gA = gs; } else { eB = es; gB = gs; } }
    }
}
__device__ __forceinline__ void peer_gather(const Params& p, bool dry = false) {
    int tid_ = threadIdx.x; asm volatile("" : "+v"(tid_)); const int tid = tid_, lane = tid & 63, wid = tid >> 6;
    const int gw = blockIdx.x * NWAVES + wid, NGW = gridDim.x * NWAVES;
    const float* TKV = (const float*)(p.ws + WS_TKV); const int* TKI = (const int*)(p.ws + WS_TKI);
    const bf16_t* H = (const bf16_t*)(p.ws + WS_H);
    const bf16_t* UB = (const bf16_t*)(p.ws + WS_UB); const bf16_t* VB = (const bf16_t*)(p.ws + WS_VB);
    const float* mod = (const float*)(p.ws + WS_MOD); const float* gpo = p.in[9];
    for (int m = gw; m < TL; m += NGW) {
        int eA, eB; float gA, gB;
        peer_select(TKV, TKI, m, lane, eA, eB, gA, gB);
        asm volatile("" : "+v"(eA), "+v"(eB), "+v"(gA), "+v"(gB));
        u32x4 us[2][4], vs[2][4];
#define PG_LOAD(S, k) do { const int e_ = __builtin_amdgcn_readlane((k) < 64 ? eA : eB, (k) & 63); \
            const bf16_t* up_ = UB + (size_t)e_ * DM + lane * 8; const bf16_t* vp_ = VB + (size_t)e_ * DM + lane * 8; \
            _Pragma("unroll") for (int i = 0; i < 4; ++i) { us[S][i] = *(const u32x4*)(up_ + i * 512); vs[S][i] = *(const u32x4*)(vp_ + i * 512); } } while (0)
        PG_LOAD(0, 0); PG_LOAD(1, 1);
        u32x4 hq[4];
#pragma unroll
        for (int i = 0; i < 4; ++i) hq[i] = *(const u32x4*)(H + (size_t)m * DM + i * 512 + lane * 8);
        float acc[4][8];
#pragma unroll
        for (int i = 0; i < 4; ++i)
#pragma unroll
            for (int e = 0; e < 8; ++e) acc[i][e] = 0.f;
#define PG_USE(S, k) do { float d_ = 0.f; \
            _Pragma("unroll") for (int i = 0; i < 4; ++i) d_ = dot8_bf16(us[S][i], hq[i], d_); \
            d_ = wave_sum(d_); \
            const float g_ = __uint_as_float((unsigned)__builtin_amdgcn_readlane((int)__float_as_uint((k) < 64 ? gA : gB), (k) & 63)); \
            const float cf_ = g_ * gelu_as(d_); \
            _Pragma("unroll") for (int i = 0; i < 4; ++i) { const u32x4 w_ = vs[S][i]; \
                acc[i][0] += cf_ * __uint_as_float(w_.x << 16); acc[i][1] += cf_ * __uint_as_float(w_.x & 0xffff0000u); \
                acc[i][2] += cf_ * __uint_as_float(w_.y << 16); acc[i][3] += cf_ * __uint_as_float(w_.y & 0xffff0000u); \
                acc[i][4] += cf_ * __uint_as_float(w_.z << 16); acc[i][5] += cf_ * __uint_as_float(w_.z & 0xffff0000u); \
                acc[i][6] += cf_ * __uint_as_float(w_.w << 16); acc[i][7] += cf_ * __uint_as_float(w_.w & 0xffff0000u); } } while (0)
#pragma nounroll
        for (int k = 0; k < 128; k += 2) {
            PG_USE(0, k);     if (k + 2 < 128) PG_LOAD(0, k + 2);
            PG_USE(1, k + 1); if (k + 3 < 128) PG_LOAD(1, k + 3);
        }
#undef PG_LOAD
#undef PG_USE
        float ss = 0.f;
#pragma unroll
        for (int i = 0; i < 4; ++i)
#pragma unroll
            for (int e = 0; e < 8; ++e) ss += acc[i][e] * acc[i][e];
        const float rstd = rsqrtf(wave_sum(ss) * (1.f / DM) + EPS);
        const int b = m / SEQ;
#pragma unroll
        for (int i = 0; i < 4; ++i)
#pragma unroll
            for (int q = 0; q < 2; ++q) {
                const int c = i * 512 + lane * 8 + q * 4;
                const f32x4 gt2 = *(const f32x4*)(mod + (size_t)b * 12288 + 10240 + c), gg = *(const f32x4*)(gpo + c);
                float* op = p.out + (size_t)m * DM + c;
                const f32x4 x1 = *(const f32x4*)op;
                const f32x4 y = {acc[i][4 * q], acc[i][4 * q + 1], acc[i][4 * q + 2], acc[i][4 * q + 3]};
                const f32x4 res = x1 + gt2 * (y * rstd * gg);
                if (!dry) *(f32x4*)op = res; else asm volatile("" :: "v"(res));
            }
    }
}


__device__ __forceinline__ void peer_q8_row(const Params& p, int r, const f32x4 (&v)[8], int lane) {
    unsigned char* UQ = p.ws + WS_UQ; unsigned char* VQ = p.ws + WS_VQ; float* USC = (float*)(p.ws + WS_USC); float* VSC = (float*)(p.ws + WS_VSC);
    const bool isv = r >= 16384; const int e = isv ? r - 16384 : r;
    float mx = 0.f;
#pragma unroll
    for (int j = 0; j < 8; ++j) mx = fmaxf(mx, fmaxf(fmaxf(fabsf(v[j][0]), fabsf(v[j][1])), fmaxf(fabsf(v[j][2]), fabsf(v[j][3]))));
    mx = fmaxf(wave_max(mx), 1e-30f);
    const float sc = mx * (1.f / 127.f), inv = 127.f / mx;
    unsigned char* dst = (isv ? VQ : UQ) + (size_t)e * DM;
    const int zp = isv ? 128 : 0;
#pragma unroll
    for (int j = 0; j < 8; ++j) {
        unsigned w = 0;
#pragma unroll
        for (int c = 0; c < 4; ++c) { const int q = (int)rintf(v[j][c] * inv) + zp; w |= ((unsigned)q & 0xffu) << (8 * c); }
        *(unsigned*)(dst + j * 256 + lane * 4) = w;
    }
    if (lane == 0) (isv ? VSC : USC)[e] = sc;
}
__device__ __forceinline__ void peer_tables_q8(const Params& p, int gw, int NGW, int lane) {
    f32x4 va[8], vb[8];
#define Q8_LOAD(dst, r) do { const float* s_ = ((r) >= 16384 ? p.in[22] + (size_t)((r) - 16384) * DM : p.in[21] + (size_t)(r) * DM); \
        _Pragma("unroll") for (int j = 0; j < 8; ++j) dst[j] = *(const f32x4*)(s_ + j * 256 + lane * 4); } while (0)
    int r = gw;
    if (r < 2 * 16384) Q8_LOAD(va, r);
    for (; r < 2 * 16384; r += 2 * NGW) {
        const int r1 = r + NGW, r2 = r + 2 * NGW;
        if (r1 < 2 * 16384) Q8_LOAD(vb, r1);
        peer_q8_row(p, r, va, lane);
        if (r2 < 2 * 16384) Q8_LOAD(va, r2);
        if (r1 < 2 * 16384) peer_q8_row(p, r1, vb, lane);
    }
#undef Q8_LOAD
}

__device__ __forceinline__ void peer_gather_q8(const Params& p, unsigned char* lds_, bool dry = false, int emask = 0x3fff) {
    int tid_ = threadIdx.x; asm volatile("" : "+v"(tid_)); const int tid = tid_, lane = tid & 63, wid = tid >> 6;
    LAS3 int* srt = (LAS3 int*)lds_ + wid * 256;
    const int gw = blockIdx.x * NWAVES + wid, NGW = gridDim.x * NWAVES;
    const float* TKV = (const float*)(p.ws + WS_TKV); const int* TKI = (const int*)(p.ws + WS_TKI);
    const bf16_t* H = (const bf16_t*)(p.ws + WS_H);
    const unsigned char* UQ = p.ws + WS_UQ; const unsigned char* VQ = p.ws + WS_VQ; const float* USC = (const float*)(p.ws + WS_USC); const float* VSC = (const float*)(p.ws + WS_VSC);
    const float* mod = (const float*)(p.ws + WS_MOD); const float* gpo = p.in[9];
    const int rounds = (TL + NGW - 1) / NGW;
    for (int it = 0; it < rounds; ++it) {
        const int m = gw + it * NGW;
#ifndef GATHER_UNSORTED
        __syncthreads();
#endif
        if (m >= TL) continue;
        int eA, eB; float gA, gB;
#if defined(TOPK_NAIVE) || defined(TOPK_STAGE1)
        peer_select(TKV, TKI, m, lane, eA, eB, gA, gB);
#else
        eA = TKI[(size_t)m * 128 + lane]; eB = TKI[(size_t)m * 128 + 64 + lane]; gA = TKV[(size_t)m * 128 + lane]; gB = TKV[(size_t)m * 128 + 64 + lane];
#endif
#ifndef GATHER_UNSORTED
        {
            int rA = 0, rB = 0;
#pragma nounroll
            for (int j = 0; j < 64; ++j) {
                const int ea = __builtin_amdgcn_readlane(eA, j), eb = __builtin_amdgcn_readlane(eB, j);
                rA += (ea < eA || (ea == eA && j < lane)) ? 1 : 0; rA += (eb < eA) ? 1 : 0;
                rB += (ea < eB || ea == eB) ? 1 : 0; rB += (eb < eB || (eb == eB && j < lane)) ? 1 : 0;
            }
            srt[rA] = eA; srt[128 + rA] = __float_as_int(gA); srt[rB] = eB; srt[128 + rB] = __float_as_int(gB);
            eA = srt[lane]; eB = srt[64 + lane]; gA = __int_as_float(srt[128 + lane]); gB = __int_as_float(srt[192 + lane]);
        }
#endif
        asm volatile("" : "+v"(eA), "+v"(eB), "+v"(gA), "+v"(gB));
        unsigned hq[2][4]; float hscale;
        {
            u32x4 hw[2][2]; float mx = 0.f;
#pragma unroll
            for (int i = 0; i < 2; ++i)
#pragma unroll
                for (int q = 0; q < 2; ++q) { hw[i][q] = *(const u32x4*)(H + (size_t)m * DM + i * 1024 + lane * 16 + q * 8);
#pragma unroll
                    for (int c = 0; c < 4; ++c) { const unsigned w = hw[i][q][c]; mx = fmaxf(mx, fmaxf(fabsf(__uint_as_float(w << 16)), fabsf(__uint_as_float(w & 0xffff0000u)))); } }
            mx = fmaxf(wave_max(mx), 1e-30f);
            hscale = mx * (1.f / 127.f); const float inv = 127.f / mx;
#pragma unroll
            for (int i = 0; i < 2; ++i)
#pragma unroll
                for (int q = 0; q < 2; ++q)
#pragma unroll
                    for (int c2 = 0; c2 < 2; ++c2) {
                        const unsigned w0 = hw[i][q][2 * c2], w1 = hw[i][q][2 * c2 + 1];
                        const int q0 = (int)rintf(__uint_as_float(w0 << 16) * inv), q1 = (int)rintf(__uint_as_float(w0 & 0xffff0000u) * inv);
                        const int q2 = (int)rintf(__uint_as_float(w1 << 16) * inv), q3 = (int)rintf(__uint_as_float(w1 & 0xffff0000u) * inv);
                        hq[i][2 * q + c2] = ((unsigned)q0 & 0xffu) | (((unsigned)q1 & 0xffu) << 8) | (((unsigned)q2 & 0xffu) << 16) | (((unsigned)q3 & 0xffu) << 24);
                    }
        }
        float cA = 0.f, cB = 0.f; float csum = 0.f;
        {
            u32x4 us[8][2]; float usc[8], vsc[8];
#define PU_LOAD(S, k) do { const int e_ = __builtin_amdgcn_readlane((k) < 64 ? eA : eB, (k) & 63) & emask; int ev_ = e_; asm volatile("" : "+v"(ev_)); \
                const unsigned char* up_ = UQ + (size_t)e_ * DM + lane * 16; us[S][0] = *(const u32x4*)up_; us[S][1] = *(const u32x4*)(up_ + 1024); usc[S] = USC[ev_]; vsc[S] = VSC[ev_]; } while (0)
#define PU_COEF(S, k) do { int id_ = 0; \
                _Pragma("unroll") for (int i = 0; i < 2; ++i) _Pragma("unroll") for (int c = 0; c < 4; ++c) { const unsigned uw_ = us[S][i][c]; id_ = __builtin_amdgcn_sdot4((int)uw_, (int)hq[i][c], id_, false); } \
                const float d_ = wave_sum_dpp((float)id_) * (hscale * usc[S]); \
                const float g_ = __uint_as_float((unsigned)__builtin_amdgcn_readlane((int)__float_as_uint((k) < 64 ? gA : gB), (k) & 63)); \
                const float cf_ = g_ * gelu_as(d_) * vsc[S]; csum += cf_; \
                if ((k) < 64) cA = lane == ((k) & 63) ? cf_ : cA; else cB = lane == ((k) & 63) ? cf_ : cB; } while (0)
            PU_LOAD(0, 0); PU_LOAD(1, 1); PU_LOAD(2, 2); PU_LOAD(3, 3);
#pragma nounroll
            for (int k = 0; k < 128; k += 4) {
                const int kn = k + 4 < 128 ? k + 4 : 124;
                PU_COEF(0, k + 0); PU_COEF(1, k + 1); PU_COEF(2, k + 2); PU_COEF(3, k + 3);
                PU_LOAD(0, kn + 0); PU_LOAD(1, kn + 1); PU_LOAD(2, kn + 2); PU_LOAD(3, kn + 3);
            }
#undef PU_LOAD
#undef PU_COEF
        }
        float acc[2][16];
#pragma unroll
        for (int i = 0; i < 2; ++i)
#pragma unroll
            for (int e = 0; e < 16; ++e) acc[i][e] = 0.f;
        {
            u32x4 vs[8][2];
#define PV_LOAD(S, k) do { const int e_ = __builtin_amdgcn_readlane((k) < 64 ? eA : eB, (k) & 63) & emask; \
                const unsigned char* vp_ = VQ + (size_t)e_ * DM + lane * 16; vs[S][0] = *(const u32x4*)vp_; vs[S][1] = *(const u32x4*)(vp_ + 1024); } while (0)
#define PV_ACC(S, k) do { const float cf_ = __uint_as_float((unsigned)__builtin_amdgcn_readlane((int)__float_as_uint((k) < 64 ? cA : cB), (k) & 63)); \
                _Pragma("unroll") for (int i = 0; i < 2; ++i) _Pragma("unroll") for (int c = 0; c < 4; ++c) { const unsigned w_ = vs[S][i][c]; \
                    acc[i][4 * c + 0] += cf_ * (float)(w_ & 0xffu); acc[i][4 * c + 1] += cf_ * (float)((w_ >> 8) & 0xffu); \
                    acc[i][4 * c + 2] += cf_ * (float)((w_ >> 16) & 0xffu); acc[i][4 * c + 3] += cf_ * (float)(w_ >> 24); } } while (0)
            PV_LOAD(0, 0); PV_LOAD(1, 1); PV_LOAD(2, 2); PV_LOAD(3, 3);
#pragma nounroll
            for (int k = 0; k < 128; k += 4) {
                const int kn = k + 4 < 128 ? k + 4 : 124;
                PV_ACC(0, k + 0); PV_ACC(1, k + 1); PV_ACC(2, k + 2); PV_ACC(3, k + 3);
                PV_LOAD(0, kn + 0); PV_LOAD(1, kn + 1); PV_LOAD(2, kn + 2); PV_LOAD(3, kn + 3);
            }
#undef PV_LOAD
#undef PV_ACC
        }
        const float zoff = 128.f * csum;
        float ss = 0.f;
#pragma unroll
        for (int i = 0; i < 2; ++i)
#pragma unroll
            for (int e = 0; e < 16; ++e) { acc[i][e] -= zoff; ss += acc[i][e] * acc[i][e]; }
        const float rstd = rsqrtf(wave_sum(ss) * (1.f / DM) + EPS);
        const int b = m / SEQ;
#pragma unroll
        for (int i = 0; i < 2; ++i)
#pragma unroll
            for (int q = 0; q < 4; ++q) {
                const int c = i * 1024 + lane * 16 + q * 4;
                const f32x4 gt2 = *(const f32x4*)(mod + (size_t)b * 12288 + 10240 + c), gg = *(const f32x4*)(gpo + c);
                float* op = p.out + (size_t)m * DM + c;
                const f32x4 x1 = *(const f32x4*)op;
                const f32x4 y = {acc[i][4 * q], acc[i][4 * q + 1], acc[i][4 * q + 2], acc[i][4 * q + 3]};
                const f32x4 res = x1 + gt2 * (y * rstd * gg);
                if (!dry) *(f32x4*)op = res; else asm volatile("" :: "v"(res));
            }
    }
}


#define LAS __attribute__((address_space(3)))
#define XB_TMO      128
#define XB_XCNT(j)  (256  + 64 * (j))
#define XB_XSUB(j)  (1280 + 64 * (j))
#define XB_XGEN(j)  (2304 + 64 * (j))
#define XB_TOP      3328
#define XB_TOPGEN   3392
#define XCD_BAR_WORDS 3456
#define XB_SPIN_CAP (1u << 18)

__device__ __forceinline__ unsigned xb_ld(unsigned* p)              { return __hip_atomic_load(p, __ATOMIC_RELAXED, __HIP_MEMORY_SCOPE_AGENT); }
__device__ __forceinline__ unsigned xb_add(unsigned* p, unsigned v) { return __hip_atomic_fetch_add(p, v, __ATOMIC_RELAXED, __HIP_MEMORY_SCOPE_AGENT); }
__device__ __forceinline__ unsigned xb_xcc_id() { return (unsigned)__builtin_amdgcn_s_getreg((3 << 11) | 20) & 0xFu; }
#define XB_SPIN(cond, bar) do { unsigned _sp = 0; while (cond) { __builtin_amdgcn_s_sleep(1); \
    if ((++_sp & 255u) == 0u) { if (xb_ld(&(bar)[XB_TMO])) break; if (_sp > XB_SPIN_CAP) { atomicAdd(&(bar)[XB_TMO], 1u); break; } } } } while (0)

struct XcdBarrier {
    unsigned* bar; unsigned x;
    volatile LAS unsigned* st;
};

__device__ __forceinline__ XcdBarrier xcd_barrier_post(unsigned* bar, volatile LAS unsigned* st) {
    XcdBarrier b; b.bar = bar; b.x = xb_xcc_id(); b.st = st;
    if (threadIdx.x == 0) (void)xb_add(&bar[XB_XCNT(b.x)], 1u);
    return b;
}
__device__ __forceinline__ void xcd_barrier_complete(unsigned* bar, unsigned x, unsigned& nloc, unsigned& nx) {
    const unsigned G = gridDim.x * gridDim.y * gridDim.z;
    unsigned sum, cnt, mine, sp = 0u;
    for (;;) {
        sum = 0u; cnt = 0u; mine = 0u;
#pragma unroll
        for (unsigned j = 0; j < 16; ++j) { const unsigned c = xb_ld(&bar[XB_XCNT(j)]); sum += c; cnt += (c > 0u) ? 1u : 0u; mine = (j == x) ? c : mine; }
        if (sum == G) break;
        __builtin_amdgcn_s_sleep(1);
        if ((++sp & 255u) == 0u) { if (xb_ld(&bar[XB_TMO])) break; if (sp > XB_SPIN_CAP) { atomicAdd(&bar[XB_TMO], 1u); break; } }
    }
    nloc = mine > 0u ? mine : 1u; nx = cnt > 0u ? cnt : 1u;
}

__device__ __forceinline__ void xcd_barrier(const XcdBarrier& b) {
    asm volatile("s_waitcnt vmcnt(0)" ::: "memory");
    __syncthreads();
    if (threadIdx.x == 0) {
        unsigned* bar = b.bar;
        __builtin_amdgcn_s_waitcnt(0);
        unsigned nloc = b.st[0], nx = b.st[1];
        if (nloc == 0u) { xcd_barrier_complete(bar, b.x, nloc, nx); b.st[0] = nloc; b.st[1] = nx; }
        const unsigned old = xb_add(&bar[XB_XSUB(b.x)], 1u);
        const unsigned gen = old / nloc;
        if (old + 1u == (gen + 1u) * nloc) {
            __builtin_amdgcn_fence(__ATOMIC_RELEASE, "agent");
            asm volatile("s_waitcnt vmcnt(0)" ::: "memory");
            const unsigned og = xb_add(&bar[XB_TOP], 1u);
            const unsigned tg = og / nx;
            if (og + 1u == (tg + 1u) * nx) xb_add(&bar[XB_TOPGEN], 1u);
            else XB_SPIN(xb_ld(&bar[XB_TOPGEN]) == tg, bar);
            __builtin_amdgcn_fence(__ATOMIC_ACQUIRE, "agent");
            xb_add(&bar[XB_XGEN(b.x)], 1u);
            asm volatile("s_waitcnt vmcnt(0)" ::: "memory");
        } else {
            XB_SPIN(xb_ld(&bar[XB_XGEN(b.x)]) == gen, bar);
            __builtin_amdgcn_fence(__ATOMIC_ACQUIRE, "agent");
            asm volatile("s_waitcnt vmcnt(0)" ::: "memory");
        }
    }
    __syncthreads();
}


__global__ void __launch_bounds__(NTHREADS, 2) mega(Params p) {
    extern __shared__ __attribute__((aligned(16))) unsigned char lds[];
    cg::grid_group grid = cg::this_grid();
    unsigned char* ws = p.ws;
    bf16_t* H = (bf16_t*)(ws + WS_H); bf16_t* PL = (bf16_t*)(ws + WS_PL); bf16_t* PCx = (bf16_t*)(ws + WS_PC);
    const int lo = p.ph_lo, hi = p.ph_hi;
    volatile LAS unsigned* bst = (volatile LAS unsigned*)((LAS unsigned char*)lds + (LDS_BYTES - 64));
    unsigned* barw = (unsigned*)(ws + WS_BAR);
    if (threadIdx.x < 2) bst[threadIdx.x] = 0u;
    if (blockIdx.x == 0) for (int i = threadIdx.x; i < XCD_BAR_WORDS; i += NTHREADS) barw[i] = 0u;
    __syncthreads();
    XcdBarrier xbar; xbar.bar = barw; xbar.x = 0; xbar.st = bst;
#ifdef PHONLY
#define IN(k) ((k) == PHONLY && lo <= (k) && (k) < hi)
#else
#define IN(k) (lo <= (k) && (k) < hi)
#endif
#ifndef DUP
#define DUP -1
#endif
#define REP(k) for (int rep_ = 0; rep_ < ((k) == DUP ? 2 : 1); ++rep_)
#define SEAM(k) do { if (IN(k) && IN((k) + 1)) { \
        if ((k) == 0) { asm volatile("s_waitcnt vmcnt(0) lgkmcnt(0)" ::: "memory"); grid.sync(); \
            if (threadIdx.x < 64) { __builtin_amdgcn_fence(__ATOMIC_ACQUIRE, "agent"); asm volatile("s_waitcnt vmcnt(0)" ::: "memory"); } __syncthreads(); \
            xbar = xcd_barrier_post(barw, bst); } \
        else xcd_barrier(xbar); } } while (0)
    if (IN(0)) { phase0(p, lds); __syncthreads(); if (DUP == 0) { phase0(p, lds); __syncthreads(); } }
    SEAM(0);
    if (IN(1)) REP(1) phase1(p);
    SEAM(1);
    if (IN(2)) REP(2) {
        { EpiInproj e{PL, NP, PC_GA}; run_gemm<EpiInproj, false>(lds, H, DM, (const bf16_t*)(ws + WS_WIN), DM, TL, NP, DM, e); }
        { EpiInproj e{PCx, NPC, 1 << 30}; run_gemm<EpiInproj, false>(lds, H + (size_t)TL * DM, DM, (const bf16_t*)(ws + WS_WIN), DM, TC, NPC, DM, e, 128); }
    }
    SEAM(2);
    if (IN(3)) {
#ifndef NO_P3_GEMM
        { EpiMlaQ e{(bf16_t*)(ws + WS_QM), (const float*)(ws + WS_ROPE)}; run_gemm<EpiMlaQ, true>(lds, PL + PC_CQ, NP, (const bf16_t*)(ws + WS_WQB), QR, TL, MQW, QR, e); }
        { EpiMlaKV e{(bf16_t*)(ws + WS_KVM), 0}; run_gemm<EpiMlaKV, true>(lds, PL + PC_CKV, NP, (const bf16_t*)(ws + WS_WKVB), KVR, TL, MKVW, KVR, e); }
        { EpiMlaKV e{(bf16_t*)(ws + WS_KVM), TL}; run_gemm<EpiMlaKV, true>(lds, PCx + PC_CKV, NPC, (const bf16_t*)(ws + WS_WKVB), KVR, TC, MKVW, KVR, e, 128); __syncthreads(); }
        if (DUP == 31) {
        { EpiMlaQ e{(bf16_t*)(ws + WS_QM), (const float*)(ws + WS_ROPE)}; run_gemm<EpiMlaQ, true>(lds, PL + PC_CQ, NP, (const bf16_t*)(ws + WS_WQB), QR, TL, MQW, QR, e); }
        { EpiMlaKV e{(bf16_t*)(ws + WS_KVM), 0}; run_gemm<EpiMlaKV, true>(lds, PL + PC_CKV, NP, (const bf16_t*)(ws + WS_WKVB), KVR, TL, MKVW, KVR, e); }
        { EpiMlaKV e{(bf16_t*)(ws + WS_KVM), TL}; run_gemm<EpiMlaKV, true>(lds, PCx + PC_CKV, NPC, (const bf16_t*)(ws + WS_WKVB), KVR, TC, MKVW, KVR, e, 128); __syncthreads(); }
        }
#endif
        kpe_pass(p);
#ifdef NA_NAIVE
        na_naive(p, lds);
#else
#ifdef NA_PERWAVE
        na_flash(p, lds);
        if (DUP == 30) na_flash(p, lds);
#else
        na_coop(p, lds);
        if (DUP == 30) na_coop(p, lds);
#endif
#endif
    }
    SEAM(3);
#ifdef MLA_NAIVE
    if (IN(4)) mla_naive(p, lds);
#else
    if (IN(4)) REP(4) mla_flash(p, lds);
#endif
    SEAM(4);
    if (IN(5)) REP(5) {
        { EpiMergeF e{H, PL}; run_gemm<EpiMergeF, false>(lds, (const bf16_t*)(ws + WS_OA), DM, (const bf16_t*)(ws + WS_WA), DM, TL, DM, DM, e); }
    }
    SEAM(5);
    if (IN(6)) REP(6) { EpiStore e{(bf16_t*)(ws + WS_Z), DM}; run_gemm<EpiStore, false>(lds, H, DM, (const bf16_t*)(ws + WS_WO), DM, TL, DM, DM, e); }
    SEAM(6);
    if (IN(7)) REP(7) phase7(p);
    SEAM(7);
    if (IN(8)) REP(8) { EpiStore e{(bf16_t*)(ws + WS_QP), DM}; run_gemm<EpiStore, false>(lds, H, DM, (const bf16_t*)(ws + WS_WPQ), DM, TL, DM, DM, e); }
    SEAM(8);
    if (IN(9)) REP(9) {
#if defined(TOPK_NAIVE)
        peer_topk_naive(p, lds);
#elif defined(TOPK_STAGE1)
        peer_topk_mfma(p, lds);
#else
        peer_select_mfma(p, lds);
        if (DUP == 90) peer_select_mfma(p, lds, 1);
        if (DUP == 91) peer_select_mfma(p, lds, 2);
#endif
#ifdef PEER_BF16
        peer_tables_bf16(p);
#endif
    }
    SEAM(9);
#ifdef PEER_NAIVE
    if (IN(10)) peer_final_naive(p, lds);
#else
#ifdef PEER_BF16
    if (IN(10)) { if (DUP == 10) peer_gather(p, true); peer_gather(p); }
#else
    if (IN(10)) { if (DUP == 10) peer_gather_q8(p, lds, true); if (DUP == 100) peer_gather_q8(p, lds, true, 1023); if (DUP == 101) peer_gather_q8(p, lds, true, 127); peer_gather_q8(p, lds); }
#endif
#endif
#undef IN
#undef SEAM
}

extern "C" void kernel_launch(void* const* d_in, const int* in_sizes, int n_in, void* d_out, int out_size, void* d_ws, size_t ws_size, hipStream_t stream) {
    static int grid = 0;
    if (grid == 0) {
        int dev = 0, cus = 0, per_cu = 0;
        (void)hipGetDevice(&dev);
        (void)hipDeviceGetAttribute(&cus, hipDeviceAttributeMultiprocessorCount, dev);
        (void)hipFuncSetAttribute((const void*)mega, hipFuncAttributeMaxDynamicSharedMemorySize, LDS_BYTES);
        (void)hipOccupancyMaxActiveBlocksPerMultiprocessor(&per_cu, (const void*)mega, NTHREADS, LDS_BYTES);
        if (per_cu < 1) { fprintf(stderr, "occupancy query says %d blocks per CU\n", per_cu); per_cu = 1; }
        grid = cus * 1;
        (void)hipGetLastError();
        if (n_in != 23 || ws_size < WS_END) fprintf(stderr, "kernel_launch: unexpected n_in %d or ws %zu\n", n_in, ws_size);
    }
    Params p{};
    for (int i = 0; i < 23; ++i) p.in[i] = (const float*)d_in[i];
    p.out = (float*)d_out; p.ws = (unsigned char*)d_ws; p.ph_lo = 0; p.ph_hi = 11;
    void* args[] = {&p};
    hipError_t e = hipLaunchCooperativeKernel((const void*)mega, dim3(grid), dim3(NTHREADS), args, LDS_BYTES, stream);
    if (e != hipSuccess) fprintf(stderr, "cooperative launch failed: %s (grid %d)\n", hipGetErrorString(e), grid);
}
```

```cpp
#include <hip/hip_runtime.h>
#include <hip/hip_cooperative_groups.h>
#include <cstdio>
#include <cstdint>
namespace cg = cooperative_groups;

typedef unsigned short bf16_t;
typedef short bf16x8 __attribute__((ext_vector_type(8)));
typedef float f32x4 __attribute__((ext_vector_type(4)));
typedef unsigned u32x4 __attribute__((ext_vector_type(4)));
typedef unsigned u32x2 __attribute__((ext_vector_type(2)));

constexpr int DM = 2048, NB = 8, SEQ = 2048, CTX = 256, GW = 64, GROWS = 32;
constexpr int TL = NB * SEQ;
constexpr int TC = NB * CTX;
constexpr int TA = TL + TC;
constexpr int IN_COLS = 8512;
constexpr int NP = 8704;
constexpr int NPC = 2816;
constexpr int PC_KA = 0, PC_VA = 1024, PC_CKV = 2048, PC_KPE = 2560, PC_QA = 2816, PC_CQ = 3840, PC_GA = 4608, PC_GB = 6656;
constexpr int QR = 768, KVR = 512;
constexpr int MQW = 1536, MKVW = 2048;
constexpr float EPS = 1e-6f;
constexpr float LOG2E = 1.4426950408889634f;
constexpr float MLA_QSCALE = 0.07216878364870322f * LOG2E;
constexpr float NA_SCALE = 0.125f;

constexpr size_t al256(size_t x) { return (x + 255) & ~(size_t)255; }
constexpr size_t WS_MOD = 0;
constexpr size_t WS_ROPE = al256(WS_MOD + 9 * 12288 * 4);
constexpr size_t WS_BAR = al256(WS_ROPE + (size_t)SEQ * 32 * 2 * 4);
constexpr size_t WS_WIN = al256(WS_BAR + 3456 * 4);
constexpr size_t WS_WQB = WS_WIN + (size_t)NP * DM * 2;
constexpr size_t WS_WKVB = WS_WQB + (size_t)MQW * QR * 2;
constexpr size_t WS_WA = WS_WKVB + (size_t)MKVW * KVR * 2;
constexpr size_t WS_WB = WS_WA + (size_t)DM * 1024 * 2;
constexpr size_t WS_WO = WS_WB + (size_t)DM * 1024 * 2;
constexpr size_t WS_WPQ = WS_WO + (size_t)DM * DM * 2;
constexpr size_t WS_SUBK = WS_WPQ + (size_t)DM * DM * 2;
constexpr size_t WS_H = WS_SUBK + (size_t)262144 * 2;
constexpr size_t WS_PL = WS_H + (size_t)TA * DM * 2;
constexpr size_t WS_PC = WS_PL + (size_t)TL * NP * 2;
constexpr size_t WS_QM = WS_PC + (size_t)TC * NPC * 2;
constexpr size_t WS_KVM = WS_QM + (size_t)TL * MQW * 2;
constexpr size_t WS_KPE = WS_KVM + (size_t)TA * MKVW * 2;
constexpr size_t WS_OA = WS_KPE + (size_t)TA * 64 * 2;
constexpr size_t WS_OB = WS_OA + 1024 * 2;
constexpr size_t WS_END = WS_OA + (size_t)TL * 2048 * 2;
constexpr size_t WS_Z = WS_PL;
constexpr size_t WS_QP = WS_PL + (size_t)TL * DM * 2;
constexpr size_t WS_TKV = WS_QP + (size_t)TL * DM * 2;
constexpr size_t WS_TKI = WS_TKV + (size_t)TL * 256 * 4;
constexpr size_t WS_UB = WS_QM;
constexpr size_t WS_VB = WS_UB + (size_t)16384 * DM * 2;
constexpr size_t WS_UQ = WS_QM;
constexpr size_t WS_VQ = WS_UQ + (size_t)16384 * DM;
constexpr size_t WS_USC = WS_VQ + (size_t)16384 * DM;
constexpr size_t WS_VSC = WS_USC + 16384 * 4;
static_assert(WS_TKI + (size_t)TL * 256 * 4 <= WS_PC, "overlay");
static_assert(WS_END <= 650307648ull, "workspace");
static_assert(WS_VB + (size_t)16384 * DM * 2 <= WS_END, "expert table overlay");

constexpr int NTHREADS = 512, NWAVES = 8;
constexpr int LDS_BYTES = 139264;

struct Params {
    const float* in[23];
    float* out;
    unsigned char* ws;
    int ph_lo, ph_hi;
};

__device__ __forceinline__ float bf2f(bf16_t v) { return __uint_as_float((unsigned)v << 16); }
__device__ __forceinline__ unsigned f2bf(float f) { unsigned u = __float_as_uint(f); return (u + 0x7fffu + ((u >> 16) & 1u)) >> 16; }
typedef float pk_f32x2 __attribute__((ext_vector_type(2)));
typedef __bf16 pk_bf16x2 __attribute__((ext_vector_type(2)));
__device__ __forceinline__ unsigned pk2(float lo, float hi) { pk_f32x2 v = {lo, hi}; pk_bf16x2 b = __builtin_convertvector(v, pk_bf16x2); return __builtin_bit_cast(unsigned, b); }
__device__ __forceinline__ float wave_sum(float v) {
#pragma unroll
    for (int o = 1; o < 64; o <<= 1) v += __shfl_xor(v, o);
    return v;
}
__device__ __forceinline__ float wave_sum_dpp(float v) {
    v += __builtin_bit_cast(float, __builtin_amdgcn_update_dpp(0, __builtin_bit_cast(int, v), 0xB1, 0xF, 0xF, false));
    v += __builtin_bit_cast(float, __builtin_amdgcn_update_dpp(0, __builtin_bit_cast(int, v), 0x4E, 0xF, 0xF, false));
    v += __builtin_bit_cast(float, __builtin_amdgcn_update_dpp(0, __builtin_bit_cast(int, v), 0x141, 0xF, 0xF, false));
    v += __builtin_bit_cast(float, __builtin_amdgcn_update_dpp(0, __builtin_bit_cast(int, v), 0x140, 0xF, 0xF, false));
    v += __builtin_bit_cast(float, __builtin_amdgcn_update_dpp(0, __builtin_bit_cast(int, v), 0x142, 0xA, 0xF, false));
    v += __builtin_bit_cast(float, __builtin_amdgcn_update_dpp(0, __builtin_bit_cast(int, v), 0x143, 0xC, 0xF, false));
    return __builtin_bit_cast(float, __builtin_amdgcn_readlane(__builtin_bit_cast(int, v), 63));
}
__device__ __forceinline__ float wave_max(float v) {
#pragma unroll
    for (int o = 1; o < 64; o <<= 1) v = fmaxf(v, __shfl_xor(v, o));
    return v;
}
__device__ __forceinline__ float sigmoidf_(float x) { return __builtin_amdgcn_rcpf(1.f + __expf(-x)); }
__device__ __forceinline__ float silu_(float x) { return x / (1.f + __expf(-x)); }
__device__ __forceinline__ float gelu_erf(float x) { return 0.5f * x * (1.f + erff(x * 0.70710678118654752f)); }

__device__ __forceinline__ float gelu_as(float v) {
    const float t = __builtin_amdgcn_rcpf(fabsf(v) * 0.2316418882f + 1.0f);
    float q = t * 0.5307027145f + (-0.7265760135f); q = q * t + 0.7107068705f; q = q * t + (-0.142248368f); q = q * t + 0.127414796f; q = q * t;
    const float e = __builtin_amdgcn_exp2f((v * v) * (-0.72134752044f));
    const float mm = v * (q * e);
    return v < 0.f ? mm : v - mm;
}
__device__ __forceinline__ void rope_cs(int s, int j, float& c, float& sn) {
    const int gr = s >> 6, gc = s & 63;
    const int i = j & 15;
    const float invf = exp2f(-(float)i * (13.287712379549449f / 16.f));
    const float ang = (float)(j < 16 ? gr : gc) * invf;
    sincosf(ang, &sn, &c);
}

template <class Epi>
__device__ __forceinline__ void ngemm(const bf16_t* __restrict__ A, int lda, const bf16_t* __restrict__ Bt, int ldb, int M, int N, int K, const Epi& epi, float* rs = nullptr) {
    int tid_ = threadIdx.x; asm volatile("" : "+v"(tid_)); const int tid = tid_, wid = tid >> 6, lane = tid & 63, fr = lane & 15, fq = lane >> 4;
    const int tilesM = M / 128, tilesN = N / 256, nt = tilesM * tilesN;
    for (int t = blockIdx.x; t < nt; t += gridDim.x) {
        const int tm = t % tilesM, tn = t / tilesM;
        const int row0 = tm * 128 + (wid >> 2) * 64, col0 = tn * 256 + (wid & 3) * 64;
        if (Epi::PRO) {
            __syncthreads();
            const int r = tid >> 2, part = tid & 3, len = K >> 2;
            const bf16_t* ar = A + (size_t)(tm * 128 + r) * lda + part * len;
            float ss = 0.f;
            for (int k = 0; k < len; k += 8) { const bf16x8 v = *(const bf16x8*)(ar + k);
#pragma unroll
                for (int e = 0; e < 8; ++e) { const float f = bf2f((bf16_t)v[e]); ss += f * f; } }
            ss += __shfl_xor(ss, 1); ss += __shfl_xor(ss, 2);
            if (part == 0) rs[r] = rsqrtf(ss / (float)K + EPS);
            __syncthreads();
        }
        f32x4 acc[4][4];
#pragma unroll
        for (int i = 0; i < 4; ++i)
#pragma unroll
            for (int j = 0; j < 4; ++j) acc[i][j] = (f32x4){0.f, 0.f, 0.f, 0.f};
        const bf16_t* ap = A + (size_t)(row0 + fr) * lda + fq * 8;
        const bf16_t* bp = Bt + (size_t)(col0 + fr) * ldb + fq * 8;
        for (int k0 = 0; k0 < K; k0 += 32) {
            bf16x8 a[4], b[4];
#pragma unroll
            for (int i = 0; i < 4; ++i) a[i] = *(const bf16x8*)(ap + (size_t)i * 16 * lda + k0);
#pragma unroll
            for (int j = 0; j < 4; ++j) b[j] = *(const bf16x8*)(bp + (size_t)j * 16 * ldb + k0);
#pragma unroll
            for (int i = 0; i < 4; ++i)
#pragma unroll
                for (int j = 0; j < 4; ++j) acc[i][j] = __builtin_amdgcn_mfma_f32_16x16x32_bf16(b[j], a[i], acc[i][j], 0, 0, 0);
        }
#pragma unroll
        for (int i = 0; i < 4; ++i) {
            const int row = row0 + i * 16 + fr;
            const float rstd = Epi::PRO ? rs[row - tm * 128] : 1.f;
#pragma unroll
            for (int j = 0; j < 4; ++j) epi.quad(row, col0 + j * 16 + 4 * fq, acc[i][j] * rstd);
        }
    }
}

__device__ __forceinline__ void store_bf4(bf16_t* p, f32x4 v) { u32x2 w; w.x = pk2(v[0], v[1]); w.y = pk2(v[2], v[3]); *(u32x2*)p = w; }
__device__ __forceinline__ void store_bf8(bf16_t* p, f32x4 a, f32x4 b) { u32x4 w; w.x = pk2(a[0], a[1]); w.y = pk2(a[2], a[3]); w.z = pk2(b[0], b[1]); w.w = pk2(b[2], b[3]); *(u32x4*)p = w; }
__device__ __forceinline__ void load_bf8(const bf16_t* p, f32x4& a, f32x4& b) { const u32x4 g = *(const u32x4*)p;
    a = (f32x4){__uint_as_float(g.x << 16), __uint_as_float(g.x & 0xffff0000u), __uint_as_float(g.y << 16), __uint_as_float(g.y & 0xffff0000u)};
    b = (f32x4){__uint_as_float(g.z << 16), __uint_as_float(g.z & 0xffff0000u), __uint_as_float(g.w << 16), __uint_as_float(g.w & 0xffff0000u)}; }

struct EpiInproj {
    static constexpr bool MID = false, PRO = false;
    bf16_t* P; int ldp; int gate0;
    __device__ __forceinline__ void quad(int row, int col, f32x4 v) const {
        if (col >= gate0) { v[0] = sigmoidf_(v[0]); v[1] = sigmoidf_(v[1]); v[2] = sigmoidf_(v[2]); v[3] = sigmoidf_(v[3]); }
        store_bf4(P + (size_t)row * ldp + col, v);
    }
    __device__ __forceinline__ void oct(int row, int col, f32x4 a, f32x4 b) const {
        if (col >= gate0) {
#pragma unroll
            for (int e = 0; e < 4; ++e) { a[e] = sigmoidf_(a[e]); b[e] = sigmoidf_(b[e]); } }
        store_bf8(P + (size_t)row * ldp + col, a, b);
    }
};
struct EpiMlaQ {
    static constexpr bool MID = false, PRO = true;
    bf16_t* Q; const float* rope;
    __device__ __forceinline__ void quad(int row, int col, f32x4 v) const {
        v = v * MLA_QSCALE;
        const int d = col % 192;
        if (d >= 128) {
            const int j = (d - 128) >> 1, s = row & (SEQ - 1);
            const f32x4 cs = *(const f32x4*)(rope + ((size_t)s * 32 + j) * 2);
            const f32x4 o = {v[0] * cs[0] - v[1] * cs[1], v[0] * cs[1] + v[1] * cs[0], v[2] * cs[2] - v[3] * cs[3], v[2] * cs[3] + v[3] * cs[2]};
            v = o;
        }
        store_bf4(Q + (size_t)row * MQW + col, v);
    }
    __device__ __forceinline__ void oct(int row, int col, f32x4 a, f32x4 b) const {
        a = a * MLA_QSCALE; b = b * MLA_QSCALE;
        const int d = col % 192;
        if (d >= 128) {
            const int j = (d - 128) >> 1, s = row & (SEQ - 1);
            const f32x4 c0 = *(const f32x4*)(rope + ((size_t)s * 32 + j) * 2), c1 = *(const f32x4*)(rope + ((size_t)s * 32 + j + 2) * 2);
            const f32x4 oa = {a[0] * c0[0] - a[1] * c0[1], a[0] * c0[1] + a[1] * c0[0], a[2] * c0[2] - a[3] * c0[3], a[2] * c0[3] + a[3] * c0[2]};
            const f32x4 ob = {b[0] * c1[0] - b[1] * c1[1], b[0] * c1[1] + b[1] * c1[0], b[2] * c1[2] - b[3] * c1[3], b[2] * c1[3] + b[3] * c1[2]};
            a = oa; b = ob;
        }
        store_bf8(Q + (size_t)row * MQW + col, a, b);
    }
};
struct EpiMlaKV {
    static constexpr bool MID = false, PRO = true;
    bf16_t* KV; int row_off;
    __device__ __forceinline__ void quad(int row, int col, f32x4 v) const { store_bf4(KV + (size_t)(row_off + row) * MKVW + col, v); }
    __device__ __forceinline__ void oct(int row, int col, f32x4 a, f32x4 b) const { store_bf8(KV + (size_t)(row_off + row) * MKVW + col, a, b); }
};
template <int STEP> struct EpiMerge {
    static constexpr bool MID = false, PRO = false;
    bf16_t* Y; const bf16_t* P;
    __device__ __forceinline__ void quad(int row, int col, f32x4 v) const {
        const u32x2 g = *(const u32x2*)(P + (size_t)row * NP + (STEP == 0 ? PC_GA : PC_GB) + col);
        const f32x4 gv = {__uint_as_float(g.x << 16), __uint_as_float(g.x & 0xffff0000u), __uint_as_float(g.y << 16), __uint_as_float(g.y & 0xffff0000u)};
        v = v * gv;
        if (STEP == 1) {
            const u32x2 y = *(const u32x2*)(Y + (size_t)row * DM + col);
            v[0] += __uint_as_float(y.x << 16); v[1] += __uint_as_float(y.x & 0xffff0000u); v[2] += __uint_as_float(y.y << 16); v[3] += __uint_as_float(y.y & 0xffff0000u);
        }
        store_bf4(Y + (size_t)row * DM + col, v);
    }
};
struct EpiMergeF {
    static constexpr bool MID = true, PRO = false;
    bf16_t* Y; const bf16_t* P;
    __device__ __forceinline__ static f32x4 ld4(const bf16_t* q) { const u32x2 g = *(const u32x2*)q;
        return (f32x4){__uint_as_float(g.x << 16), __uint_as_float(g.x & 0xffff0000u), __uint_as_float(g.y << 16), __uint_as_float(g.y & 0xffff0000u)}; }
    __device__ __forceinline__ void midquad(int row, int col, f32x4& v) const {
        const f32x4 ga = ld4(P + (size_t)row * NP + PC_GA + col), gb = ld4(P + (size_t)row * NP + PC_GB + col);
#pragma unroll
        for (int e = 0; e < 4; ++e) v[e] *= ga[e] * __builtin_amdgcn_rcpf(fmaxf(gb[e], 1e-30f));
    }
    __device__ __forceinline__ void quad(int row, int col, f32x4 v) const { store_bf4(Y + (size_t)row * DM + col, v * ld4(P + (size_t)row * NP + PC_GB + col)); }
    __device__ __forceinline__ void midload(int row, int col, u32x4& ga, u32x4& gb) const { ga = *(const u32x4*)(P + (size_t)row * NP + PC_GA + col); gb = *(const u32x4*)(P + (size_t)row * NP + PC_GB + col); }
    __device__ __forceinline__ static void midapply(const u32x4 ga, const u32x4 gb, f32x4& a, f32x4& b) {
        const unsigned a0 = ga[0], a1 = ga[1], a2 = ga[2], a3 = ga[3], b0 = gb[0], b1 = gb[1], b2 = gb[2], b3 = gb[3];
        const f32x4 sa0 = {__uint_as_float(a0 << 16), __uint_as_float(a0 & 0xffff0000u), __uint_as_float(a1 << 16), __uint_as_float(a1 & 0xffff0000u)};
        const f32x4 sa1 = {__uint_as_float(a2 << 16), __uint_as_float(a2 & 0xffff0000u), __uint_as_float(a3 << 16), __uint_as_float(a3 & 0xffff0000u)};
        const f32x4 sb0 = {__uint_as_float(b0 << 16), __uint_as_float(b0 & 0xffff0000u), __uint_as_float(b1 << 16), __uint_as_float(b1 & 0xffff0000u)};
        const f32x4 sb1 = {__uint_as_float(b2 << 16), __uint_as_float(b2 & 0xffff0000u), __uint_as_float(b3 << 16), __uint_as_float(b3 & 0xffff0000u)};
#pragma unroll
        for (int e = 0; e < 4; ++e) { a[e] *= sa0[e] * __builtin_amdgcn_rcpf(fmaxf(sb0[e], 1e-30f)); b[e] *= sa1[e] * __builtin_amdgcn_rcpf(fmaxf(sb1[e], 1e-30f)); }
    }
    __device__ __forceinline__ void oct(int row, int col, f32x4 a, f32x4 b) const { f32x4 g0, g1; load_bf8(P + (size_t)row * NP + PC_GB + col, g0, g1); store_bf8(Y + (size_t)row * DM + col, a * g0, b * g1); }
};
struct EpiStore {
    static constexpr bool MID = false, PRO = false;
    bf16_t* O; int ldo;
    __device__ __forceinline__ void quad(int row, int col, f32x4 v) const { store_bf4(O + (size_t)row * ldo + col, v); }
    __device__ __forceinline__ void oct(int row, int col, f32x4 a, f32x4 b) const { store_bf8(O + (size_t)row * ldo + col, a, b); }
};

namespace pg8 {
#define PG8_LAS __attribute__((address_space(3)))
constexpr int BM = 256, BK = 64, HALF = 128, HTB = HALF * BK * 2  , STAGE_BYTES = 8 * HTB, NXCD = 8, WGM = 8;

__host__ __device__ __forceinline__ int lds_byte(int r, int c) { const int st = (r >> 4) * 2 + (c >> 5), rr = r & 15, cc = c & 31, ob = rr * 64 + cc * 2; return st * 1024 + (ob ^ (((ob >> 9) & 1) << 5)); }
__host__ __device__ __forceinline__ void stage_rc(int b, int& R, int& C) { const int st = b / 1024, sb = b % 1024, swz = sb ^ (((sb >> 9) & 1) << 5); R = (st >> 1) * 16 + swz / 64; C = (st & 1) * 32 + (swz % 64) / 2; }
__host__ __device__ __forceinline__ int perm32(int rho) { const int n = rho >> 4, i = rho & 15; return 8 * (i >> 2) + 4 * n + (i & 3); }

struct Unit { int pm, pn, ui; };
struct Gemm { const bf16_t* A; const bf16_t* Bt; int M, N, K, lda, ldb; };

struct StaticOrder {
    int nM, nN, nwg, G, c;
    __host__ __device__ void init(int M, int N, int G_, int c_) { nM = M / BM; nN = N / BM; nwg = nM * nN; G = G_; c = c_; }
    __host__ __device__ bool next(int i, Unit& u) const {
        const long L = (long)i * G + c; if (L >= nwg) return false;
        int wgid = (int)L; { const int q = nwg / NXCD, r = nwg % NXCD, xcd = wgid % NXCD, off = wgid / NXCD; wgid = (xcd < r ? xcd * (q + 1) : r * (q + 1) + (xcd - r) * q) + off; }
        const int nig = WGM * nN, gid = wgid / nig, fm = gid * WGM, gsz = (nM - fm) < WGM ? (nM - fm) : WGM;
        u.pm = fm + ((wgid % nig) % gsz); u.pn = (wgid % nig) / gsz; u.ui = i; return true;
    }
    __device__ __forceinline__ void a_ready(const Unit&) const {}
    __device__ __forceinline__ void done(const Unit&) const {}
};
template <class Epi, class Sched, bool ALIGN_EPI = false, bool SP2 = false>
__device__ __forceinline__ void gemm_phase(PG8_LAS unsigned char* lds, const Gemm g, const Sched& S, const Epi& E) {
    int tid_ = threadIdx.x; asm volatile("" : "+v"(tid_)); const int tid = tid_, wid = __builtin_amdgcn_readfirstlane(tid >> 6), lane = tid & 63, wr = wid >> 2, wc = wid & 3, fr = lane & 15, fq = lane >> 4;
    const int K = g.K, nt = K / BK;
    unsigned voffA[2], voffB[2];
#pragma unroll
    for (int i = 0; i < 2; ++i) { int R, C; stage_rc(tid * 16 + i * 8192, R, C); const int Rb = Epi::PERM ? ((R & ~31) + perm32(R & 31)) : R;
        voffA[i] = (unsigned)(R * g.lda + C) * 2u; voffB[i] = (unsigned)(Rb * g.ldb + C) * 2u; }
    const size_t kstep = (size_t)(BK * 2);
    const size_t hstepA = (size_t)HALF * g.lda * 2, hstepB = (size_t)HALF * g.ldb * 2;
    const size_t tstepA = 2 * hstepA, tstepB = 2 * hstepB;
    const unsigned ldsw = (unsigned)wid * 1024u;
    const int aoff = lds_byte(wr * 64 + fr, fq * 8), boff = lds_byte(wc * 32 + fr, fq * 8);
#define PG8_SA(b, h) (((b) * 2 + (h)) * HTB)
#define PG8_SB(b, h) ((4 + (b) * 2 + (h)) * HTB)
#define PG8_STAGE(bufoff, gbase, voff) do { _Pragma("unroll") for (int _i = 0; _i < 2; ++_i) \
        __builtin_amdgcn_global_load_lds((const unsigned*)((const char*)(gbase) + (voff)[_i]), (PG8_LAS unsigned*)(lds + (bufoff) + ldsw + _i * 8192), 16, 0, 0); } while (0)
#define PG8_LDA(dst, b, h) do { _Pragma("unroll") for (int m = 0; m < 4; ++m) _Pragma("unroll") for (int k = 0; k < 2; ++k) dst[m][k] = *(const PG8_LAS bf16x8*)(lds + PG8_SA(b, h) + aoff + m * 2048 + k * 1024); } while (0)
#define PG8_LDB(dst, b, h) do { _Pragma("unroll") for (int n = 0; n < 2; ++n) _Pragma("unroll") for (int k = 0; k < 2; ++k) dst[n][k] = *(const PG8_LAS bf16x8*)(lds + PG8_SB(b, h) + boff + n * 2048 + k * 1024); } while (0)
#define PG8_MMA(ai, bj, At, Bt) do { __builtin_amdgcn_s_setprio(1); _Pragma("unroll") for (int m = 0; m < 4; ++m) _Pragma("unroll") for (int n = 0; n < 2; ++n) _Pragma("unroll") for (int k = 0; k < 2; ++k) \
        acc[ai][bj][m][n] = __builtin_amdgcn_mfma_f32_16x16x32_bf16(Bt[n][k], At[m][k], acc[ai][bj][m][n], 0, 0, 0); __builtin_amdgcn_s_setprio(0); } while (0)
#define PG8_WAIT_V(n) asm volatile("s_waitcnt vmcnt(" #n ")" ::: "memory")
#define PG8_WAIT_L(n) asm volatile("s_waitcnt lgkmcnt(" #n ")" ::: "memory")
#define PG8_BAR __builtin_amdgcn_s_barrier()
#define PG8_SCHED __builtin_amdgcn_sched_barrier(0)
    Unit cur, nxt; int ui = 0;
    if (!S.next(0, cur)) return;
    f32x4 acc[2][2][4][2];
#pragma unroll
    for (int a = 0; a < 2; ++a)
#pragma unroll
        for (int b = 0; b < 2; ++b)
#pragma unroll
            for (int m = 0; m < 4; ++m)
#pragma unroll
                for (int n = 0; n < 2; ++n) acc[a][b][m][n] = (f32x4){0.f, 0.f, 0.f, 0.f};
    bf16x8 At[4][2], B0[2][2], B1[2][2];
    const char* cA = (const char*)g.A + (size_t)cur.pm * tstepA; const char* cB = (const char*)g.Bt + (size_t)cur.pn * tstepB;
    S.a_ready(cur);
    if constexpr (SP2) {
        PG8_STAGE(PG8_SB(0, 0), cB, voffB); PG8_STAGE(PG8_SB(0, 1), cB + hstepB, voffB); PG8_STAGE(PG8_SA(0, 0), cA, voffA); PG8_STAGE(PG8_SA(0, 1), cA + hstepA, voffA);
        if (wr == 1) PG8_BAR;
        PG8_WAIT_V(2); PG8_BAR;
        PG8_STAGE(PG8_SB(1, 0), cB + kstep, voffB); PG8_STAGE(PG8_SA(1, 0), cA + kstep, voffA); PG8_STAGE(PG8_SB(1, 1), cB + hstepB + kstep, voffB);
        PG8_WAIT_V(6); PG8_BAR;
    } else {
        PG8_STAGE(PG8_SB(0, 0), cB, voffB); PG8_STAGE(PG8_SA(0, 0), cA, voffA); PG8_STAGE(PG8_SB(0, 1), cB + hstepB, voffB); PG8_STAGE(PG8_SA(0, 1), cA + hstepA, voffA);
        if (wr == 1) PG8_BAR;
        PG8_WAIT_V(4); PG8_BAR;
        PG8_STAGE(PG8_SB(1, 0), cB + kstep, voffB); PG8_STAGE(PG8_SA(1, 0), cA + kstep, voffA); PG8_STAGE(PG8_SB(1, 1), cB + hstepB + kstep, voffB);
        PG8_WAIT_V(6); PG8_BAR;
    }
    for (;;) {
        const bool has_next = S.next(ui + 1, nxt);
        const char* nA = has_next ? (const char*)g.A + (size_t)nxt.pm * tstepA : cA; const char* nB = has_next ? (const char*)g.Bt + (size_t)nxt.pn * tstepB : cB;
        for (int t = 0; t < nt; t += 2) {
            if constexpr (Epi::MID) { if (t == (nt >> 1)) { E.mid(acc, cur, wr, wc, fr, fq); } }
            const bool last = (t == nt - 2);
            const char* a1 = cA + (size_t)(t + 1) * kstep;
            const char* a2 = last ? nA : cA + (size_t)(t + 2) * kstep; const char* b2 = last ? nB : cB + (size_t)(t + 2) * kstep;
            const char* a3 = a2 + kstep; const char* b3 = b2 + kstep;
            if (last && has_next) S.a_ready(nxt);
            if constexpr (SP2) {
            PG8_LDB(B0, 0, 0); PG8_LDB(B1, 0, 1); PG8_SCHED; PG8_LDA(At, 0, 0); PG8_STAGE(PG8_SA(1, 1), a1 + hstepA, voffA);
            PG8_WAIT_V(8); PG8_WAIT_L(0); PG8_BAR; PG8_MMA(0, 0, At, B0); PG8_MMA(0, 1, At, B1); PG8_BAR; PG8_SCHED;
            PG8_LDA(At, 0, 1); PG8_STAGE(PG8_SB(0, 0), b2, voffB); PG8_STAGE(PG8_SB(0, 1), b2 + hstepB, voffB); PG8_STAGE(PG8_SA(0, 0), a2, voffA);
            PG8_WAIT_V(8); PG8_WAIT_L(0); PG8_BAR; PG8_MMA(1, 0, At, B0); PG8_MMA(1, 1, At, B1); PG8_BAR; PG8_SCHED;
            PG8_LDB(B0, 1, 0); PG8_LDB(B1, 1, 1); PG8_SCHED; PG8_LDA(At, 1, 0); PG8_STAGE(PG8_SA(0, 1), a2 + hstepA, voffA);
            PG8_WAIT_V(8); PG8_WAIT_L(0); PG8_BAR; PG8_MMA(0, 0, At, B0); PG8_MMA(0, 1, At, B1); PG8_BAR; PG8_SCHED;
            PG8_LDA(At, 1, 1); PG8_STAGE(PG8_SB(1, 0), b3, voffB); PG8_STAGE(PG8_SB(1, 1), b3 + hstepB, voffB); PG8_STAGE(PG8_SA(1, 0), a3, voffA);
            PG8_WAIT_V(8); PG8_WAIT_L(0); PG8_BAR; PG8_MMA(1, 0, At, B0); PG8_MMA(1, 1, At, B1); PG8_BAR; PG8_SCHED;
            } else {
            PG8_LDB(B0, 0, 0); PG8_SCHED; PG8_LDA(At, 0, 0); PG8_STAGE(PG8_SA(1, 1), a1 + hstepA, voffA);
            PG8_WAIT_L(8); PG8_BAR; PG8_WAIT_L(0); PG8_MMA(0, 0, At, B0); PG8_BAR; PG8_SCHED;
            PG8_LDB(B1, 0, 1); PG8_STAGE(PG8_SB(0, 0), b2, voffB);
            PG8_BAR; PG8_WAIT_L(0); PG8_MMA(0, 1, At, B1); PG8_BAR;
            PG8_LDA(At, 0, 1); PG8_STAGE(PG8_SA(0, 0), a2, voffA);
            PG8_BAR; PG8_WAIT_L(0); PG8_MMA(1, 0, At, B0); PG8_BAR; PG8_SCHED;
            PG8_STAGE(PG8_SB(0, 1), b2 + hstepB, voffB);
            PG8_WAIT_V(6); PG8_BAR; PG8_MMA(1, 1, At, B1); PG8_BAR;
            PG8_LDB(B0, 1, 0); PG8_SCHED; PG8_LDA(At, 1, 0); PG8_STAGE(PG8_SA(0, 1), a2 + hstepA, voffA);
            PG8_WAIT_L(8); PG8_BAR; PG8_WAIT_L(0); PG8_MMA(0, 0, At, B0); PG8_BAR; PG8_SCHED;
            PG8_LDB(B1, 1, 1); PG8_STAGE(PG8_SB(1, 0), b3, voffB);
            PG8_BAR; PG8_WAIT_L(0); PG8_MMA(0, 1, At, B1); PG8_BAR;
            PG8_LDA(At, 1, 1); PG8_STAGE(PG8_SA(1, 0), a3, voffA);
            PG8_BAR; PG8_WAIT_L(0); PG8_MMA(1, 0, At, B0); PG8_BAR; PG8_SCHED;
            PG8_STAGE(PG8_SB(1, 1), b3 + hstepB, voffB);
            PG8_WAIT_V(6); PG8_BAR; PG8_MMA(1, 1, At, B1); PG8_BAR;
            }
        }
        if constexpr (ALIGN_EPI) { if (wr == 0) PG8_BAR; }
        if constexpr (!Epi::AFTER_DRAIN) { E(acc, cur, wr, wc, fr, fq); S.done(cur); }
        if (!has_next) break;
#pragma unroll
        for (int a = 0; a < 2; ++a)
#pragma unroll
            for (int b = 0; b < 2; ++b)
#pragma unroll
                for (int m = 0; m < 4; ++m)
#pragma unroll
                    for (int n = 0; n < 2; ++n) acc[a][b][m][n] = (f32x4){0.f, 0.f, 0.f, 0.f};
        cur = nxt; cA = nA; cB = nB; ++ui;
        if constexpr (ALIGN_EPI) { if (wr == 1) PG8_BAR; }
    }
    PG8_WAIT_V(0);
    if constexpr (!ALIGN_EPI) { if (wr == 0) PG8_BAR; }
    PG8_BAR;
    if constexpr (Epi::AFTER_DRAIN) { E.fused(acc, cur, wr, wc, fr, fq, lds, wid, lane); S.done(cur); }
#undef PG8_SA
#undef PG8_SB
#undef PG8_STAGE
#undef PG8_LDA
#undef PG8_LDB
#undef PG8_MMA
#undef PG8_WAIT_V
#undef PG8_WAIT_L
#undef PG8_BAR
#undef PG8_SCHED
}
}

template <class Q, bool RS> struct EpiQuad {
    static constexpr bool PERM = true, AFTER_DRAIN = false, MID = Q::MID;
    Q q; const float* rs;
    __device__ __forceinline__ void mid(f32x4 (&acc)[2][2][4][2], const pg8::Unit& u, int wr, int wc, int fr, int fq, bool inv = false) const {
        if constexpr (Q::MID) {
            asm volatile("" : "+v"(fr), "+v"(fq));
#pragma unroll
            for (int ai = 0; ai < 2; ++ai) {
                u32x4 ga[4][2], gb[4][2];
#pragma unroll
                for (int m = 0; m < 4; ++m)
#pragma unroll
                    for (int bj = 0; bj < 2; ++bj) q.midload(u.pm * 256 + ai * 128 + wr * 64 + m * 16 + fr, u.pn * 256 + bj * 128 + wc * 32 + 8 * fq, ga[m][bj], gb[m][bj]);
#pragma unroll
                for (int m = 0; m < 4; ++m)
#pragma unroll
                    for (int bj = 0; bj < 2; ++bj) { if (!inv) q.midapply(ga[m][bj], gb[m][bj], acc[ai][bj][m][0], acc[ai][bj][m][1]); else q.midapply(gb[m][bj], ga[m][bj], acc[ai][bj][m][0], acc[ai][bj][m][1]); }
                __builtin_amdgcn_sched_barrier(0);
            }
        }
    }
    __device__ __forceinline__ void operator()(const f32x4 (&acc)[2][2][4][2], const pg8::Unit& u, int wr, int wc, int fr, int fq) const {
        if constexpr (Q::MID) asm volatile("" : "+v"(fr), "+v"(fq));
#pragma unroll
        for (int ai = 0; ai < 2; ++ai)
#pragma unroll
            for (int m = 0; m < 4; ++m) {
                const int rl = ai * 128 + wr * 64 + m * 16 + fr, row = u.pm * 256 + rl;
                const float r = RS ? rs[u.ui * 256 + rl] : 1.f;
#pragma unroll
                for (int bj = 0; bj < 2; ++bj) q.oct(row, u.pn * 256 + bj * 128 + wc * 32 + 8 * fq, acc[ai][bj][m][0] * r, acc[ai][bj][m][1] * r);
            }
    }
};
__device__ __forceinline__ void unit_row_rstd(const bf16_t* __restrict__ A, int lda, int K, const pg8::StaticOrder& S, float* rs) {
    pg8::Unit u;
    int tid_ = threadIdx.x; asm volatile("" : "+v"(tid_)); const int tid = tid_, r = tid >> 1, part = tid & 1, len = K >> 1;
    for (int i = 0; S.next(i, u); ++i) {
        const bf16_t* ar = A + (size_t)(u.pm * 256 + r) * lda + part * len;
        float ss = 0.f;
        for (int k = 0; k < len; k += 8) { const bf16x8 v = *(const bf16x8*)(ar + k);
#pragma unroll
            for (int e = 0; e < 8; ++e) { const float f = bf2f((bf16_t)v[e]); ss += f * f; } }
        ss += __shfl_xor(ss, 1);
        if (part == 0) rs[i * 256 + r] = rsqrtf(ss / (float)K + EPS);
    }
    __syncthreads();
}
template <class Q, bool RS>
__device__ __forceinline__ void run_gemm(unsigned char* lds, const bf16_t* A, int lda, const bf16_t* Bt, int ldb, int M, int N, int K, const Q& q, int rot = 0) {
    pg8::Gemm g{A, Bt, M, N, K, lda, ldb};
    pg8::StaticOrder S; S.init(M, N, (int)gridDim.x, (int)((blockIdx.x + gridDim.x - (unsigned)rot % gridDim.x) % gridDim.x));
    float* rs = (float*)(lds + 131072);
    if (RS) unit_row_rstd(A, lda, K, S, rs);
    EpiQuad<Q, RS> E{q, rs};
    pg8::gemm_phase<EpiQuad<Q, RS>, pg8::StaticOrder, true, true>((PG8_LAS unsigned char*)lds, g, S, E);
}

__device__ __forceinline__ int win_dest_row(int n) {
    if (n < 1024) return PC_QA + n;
    if (n < 2048) return PC_KA + (n - 1024);
    if (n < 3072) return PC_VA + (n - 2048);
    if (n < 3840) return PC_CQ + (n - 3072);
    if (n < 4352) return PC_CKV + (n - 3840);
    if (n < 4416) { const int r = n - 4352; return PC_KPE + (r < 32 ? 2 * r : 2 * (r - 32) + 1); }
    if (n < 6464) return PC_GA + (n - 4416);
    return PC_GB + (n - 6464);
}
__device__ __forceinline__ int wq_dest_row(int n) {
    const int h = n / 192, d = n % 192;
    if (d < 128) return n;
    const int r = d - 128;
    return h * 192 + 128 + (r < 32 ? 2 * r : 2 * (r - 32) + 1);
}
template <int MODE>
__device__ __forceinline__ void transpose_item(const float* __restrict__ W, int K, int N, bf16_t* __restrict__ WT, const float* __restrict__ kscale, float* scr, int item, int lane, int ldt = 0, int koff = 0) {
    if (ldt == 0) ldt = K;
    const int nblk = N / 32, kb = item / nblk, nb = item % nblk, k0 = 64 * kb, n0 = 32 * nb;
#pragma unroll
    for (int i = 0; i < 8; ++i) { const int kk = 8 * i + (lane >> 3), n4 = (lane & 7) * 4;
        f32x4 w = *(const f32x4*)(W + (size_t)(k0 + kk) * N + n0 + n4); if (kscale) w = w * kscale[k0 + kk];
        scr[kk * 33 + n4] = w[0]; scr[kk * 33 + n4 + 1] = w[1]; scr[kk * 33 + n4 + 2] = w[2]; scr[kk * 33 + n4 + 3] = w[3]; }
    __builtin_amdgcn_s_waitcnt(0xc07f); asm volatile("" ::: "memory");
    const int c = lane & 7;
#pragma unroll
    for (int j = 0; j < 4; ++j) {
        const int n = (lane >> 3) + 8 * j; const float* s = scr + (8 * c) * 33 + n;
        u32x4 o; o.x = pk2(s[0 * 33], s[1 * 33]); o.y = pk2(s[2 * 33], s[3 * 33]); o.z = pk2(s[4 * 33], s[5 * 33]); o.w = pk2(s[6 * 33], s[7 * 33]);
        const int ns = n0 + n;
        const int dr = MODE == 1 ? win_dest_row(ns) : (MODE == 2 ? wq_dest_row(ns) : ns);
        *(u32x4*)(WT + (size_t)dr * ldt + koff + k0 + 8 * c) = o;
    }
    __builtin_amdgcn_s_waitcnt(0xc07f); asm volatile("" ::: "memory");
}

__device__ __forceinline__ void phase0(const Params& p, unsigned char* lds) {
    int tid_ = threadIdx.x; asm volatile("" : "+v"(tid_)); const int tid = tid_, lane = tid & 63, wid = tid >> 6;
    unsigned char* ws = p.ws;
    {
        float* sl = (float*)lds;
        float* red = sl + 9 * 2048;
        const float* c = p.in[1]; const float* cctx = p.in[3]; const float* wada = p.in[4]; const float* bada = p.in[5];
        float* mod = (float*)(ws + WS_MOD);
        if (blockIdx.x < 192) {
            for (int i = tid; i < 9 * 2048; i += NTHREADS) { const int r = i >> 11, k = i & 2047; const float v = r < 8 ? c[r * DM + k] : cctx[k]; sl[i] = silu_(v); }
            __syncthreads();
            for (int it = blockIdx.x; it < 192; it += gridDim.x) {
                const int kq = tid >> 4, c4 = tid & 15, col = it * 64 + c4 * 4;
                f32x4 acc[9];
#pragma unroll
                for (int r = 0; r < 9; ++r) acc[r] = (f32x4){0.f, 0.f, 0.f, 0.f};
#pragma unroll 8
                for (int i = 0; i < 64; ++i) {
                    const int k = kq + 32 * i;
                    const f32x4 w = *(const f32x4*)(wada + (size_t)k * 12288 + col);
#pragma unroll
                    for (int r = 0; r < 9; ++r) acc[r] += w * sl[r * 2048 + k];
                }
#pragma unroll
                for (int r = 0; r < 9; ++r) {
#pragma unroll
                    for (int e = 0; e < 4; ++e) { float v = acc[r][e]; v += __shfl_xor(v, 16); v += __shfl_xor(v, 32); acc[r][e] = v; }
                    if (lane < 16) *(f32x4*)(red + (wid * 9 + r) * 64 + c4 * 4) = acc[r];
                }
                __syncthreads();
                for (int o = tid; o < 9 * 64; o += NTHREADS) {
                    const int r = o >> 6, cc = o & 63;
                    float sum = bada[it * 64 + cc];
                    for (int q = 0; q < 8; ++q) sum += red[(q * 9 + r) * 64 + cc];
                    mod[(size_t)r * 12288 + it * 64 + cc] = sum;
                }
                __syncthreads();
            }
        }
        __syncthreads();
    }
    {
        float* scr = (float*)lds + wid * (64 * 33);
        const int gw = blockIdx.x * NWAVES + wid, NGW = gridDim.x * NWAVES;
        constexpr int I_IN = 32 * (IN_COLS / 32), I_QB = 12 * 48, I_KVB = 8 * 64, I_AB = 16 * 64, I_OO = 32 * 64;
        constexpr int NITEMS = I_IN + I_QB + I_KVB + 2 * I_AB + 2 * I_OO;
        for (int it = gw; it < NITEMS; it += NGW) {
            int r = it;
            if (r < I_IN) { transpose_item<1>(p.in[10], DM, IN_COLS, (bf16_t*)(ws + WS_WIN), nullptr, scr, r, lane); continue; } r -= I_IN;
            if (r < I_QB) { transpose_item<2>(p.in[13], QR, MQW, (bf16_t*)(ws + WS_WQB), p.in[12], scr, r, lane); continue; } r -= I_QB;
            if (r < I_KVB) { transpose_item<0>(p.in[15], KVR, MKVW, (bf16_t*)(ws + WS_WKVB), p.in[14], scr, r, lane); continue; } r -= I_KVB;
            if (r < I_AB) { transpose_item<0>(p.in[16], 1024, DM, (bf16_t*)(ws + WS_WA), nullptr, scr, r, lane, 2048, 0); continue; } r -= I_AB;
            if (r < I_AB) { transpose_item<0>(p.in[17], 1024, DM, (bf16_t*)(ws + WS_WA), nullptr, scr, r, lane, 2048, 1024); continue; } r -= I_AB;
            if (r < I_OO) { transpose_item<0>(p.in[18], DM, DM, (bf16_t*)(ws + WS_WO), nullptr, scr, r, lane); continue; } r -= I_OO;
            transpose_item<0>(p.in[19], DM, DM, (bf16_t*)(ws + WS_WPQ), nullptr, scr, r, lane);
        }
    }
    {
        const size_t gt = (size_t)blockIdx.x * NTHREADS + tid, NGT = (size_t)gridDim.x * NTHREADS;
        u32x4* padp = (u32x4*)(ws + WS_WIN + (size_t)(PC_KPE + 64) * DM * 2);
        for (size_t i = gt; i < (size_t)192 * DM * 2 / 16; i += NGT) padp[i] = (u32x4){0u, 0u, 0u, 0u};
        float* rope = (float*)(ws + WS_ROPE);
        for (size_t i = gt; i < (size_t)SEQ * 32; i += NGT) { float c, sn; rope_cs((int)(i >> 5), (int)(i & 31), c, sn); rope[i * 2] = c; rope[i * 2 + 1] = sn; }
        const float* sk = p.in[20]; bf16_t* skb = (bf16_t*)(ws + WS_SUBK);
        for (size_t i = gt; i < 262144 / 4; i += NGT) { const f32x4 v = *(const f32x4*)(sk + i * 4); store_bf4(skb + i * 4, v); }
    }
}

__device__ __forceinline__ void phase1(const Params& p) {
    int tid_ = threadIdx.x; asm volatile("" : "+v"(tid_)); const int tid = tid_, lane = tid & 63, wid = tid >> 6;
    const int gw = blockIdx.x * NWAVES + wid, NGW = gridDim.x * NWAVES;
    const float* mod = (const float*)(p.ws + WS_MOD); const float* g = p.in[6];
    bf16_t* H = (bf16_t*)(p.ws + WS_H);
    const int per = (TA + NGW - 1) / NGW;
    int curb = -1; f32x4 G[8], S[8];
    for (int i = 0; i < per; ++i) {
        const int m = gw * per + i; if (m >= TA) break;
        const float* xr = m < TL ? p.in[0] + (size_t)m * DM : p.in[2] + (size_t)(m - TL) * DM;
        const int mr = m < TL ? m / SEQ : 8;
        if (mr != curb) { curb = mr; const float* sh = mod + (size_t)mr * 12288, * sc = sh + 2048;
#pragma unroll
            for (int j = 0; j < 8; ++j) { const int c = j * 256 + lane * 4; G[j] = *(const f32x4*)(g + c) * (*(const f32x4*)(sc + c) + 1.f); S[j] = *(const f32x4*)(sh + c); } }
        f32x4 v[8]; float ss = 0.f;
#pragma unroll
        for (int j = 0; j < 8; ++j) { v[j] = *(const f32x4*)(xr + j * 256 + lane * 4); ss += v[j][0] * v[j][0] + v[j][1] * v[j][1] + v[j][2] * v[j][2] + v[j][3] * v[j][3]; }
        const float rstd = rsqrtf(wave_sum_dpp(ss) * (1.f / DM) + EPS);
#pragma unroll
        for (int j = 0; j < 8; ++j) store_bf4(H + (size_t)m * DM + j * 256 + lane * 4, (v[j] * rstd) * G[j] + S[j]);
    }
}

__device__ __forceinline__ void kpe_pass(const Params& p) {
    const size_t gt = (size_t)blockIdx.x * NTHREADS + threadIdx.x, NGT = (size_t)gridDim.x * NTHREADS;
    const bf16_t* PL = (const bf16_t*)(p.ws + WS_PL); const bf16_t* PCx = (const bf16_t*)(p.ws + WS_PC);
    bf16_t* KPE = (bf16_t*)(p.ws + WS_KPE); const float* rope = (const float*)(p.ws + WS_ROPE);
    for (size_t i = gt; i < (size_t)TA * 32; i += NGT) {
        const int m = (int)(i >> 5), j = (int)(i & 31);
        unsigned w;
        if (m < TL) {
            w = *(const unsigned*)(PL + (size_t)m * NP + PC_KPE + 2 * j);
            const float x1 = __uint_as_float(w << 16), x2 = __uint_as_float(w & 0xffff0000u);
            const float c = rope[((size_t)(m & (SEQ - 1)) * 32 + j) * 2], s = rope[((size_t)(m & (SEQ - 1)) * 32 + j) * 2 + 1];
            w = pk2(x1 * c - x2 * s, x1 * s + x2 * c);
        } else w = *(const unsigned*)(PCx + (size_t)(m - TL) * NPC + PC_KPE + 2 * j);
        *(unsigned*)(KPE + (size_t)m * 64 + 2 * j) = w;
    }
}

__device__ __forceinline__ float dot_bf16x8(const bf16x8 k, const float* q) {
    float s = 0.f;
#pragma unroll
    for (int e = 0; e < 8; ++e) s += q[e] * bf2f((bf16_t)k[e]);
    return s;
}

__device__ __forceinline__ void na_naive(const Params& p, unsigned char* lds) {
    int tid_ = threadIdx.x; asm volatile("" : "+v"(tid_)); const int tid = tid_, lane = tid & 63, wid = tid >> 6;
    const int gw = blockIdx.x * NWAVES + wid, NGW = gridDim.x * NWAVES;
    const bf16_t* PL = (const bf16_t*)(p.ws + WS_PL); const bf16_t* PCx = (const bf16_t*)(p.ws + WS_PC);
    bf16_t* OA = (bf16_t*)(p.ws + WS_OA);
    const float* rpb = p.in[11];
    float* qs = (float*)lds + wid * 512;
    float* ps = qs + 64;
    for (int it = gw; it < TL * 16; it += NGW) {
        const int h = it & 15, m = it >> 4, b = m / SEQ, s = m % SEQ, r = s >> 6, qc = s & 63;
        int r0 = r - 4; r0 = r0 < 0 ? 0 : (r0 > GROWS - 8 ? GROWS - 8 : r0);
        int w0 = qc - 8; w0 = w0 < 0 ? 0 : (w0 > GW - 16 ? GW - 16 : w0);
        qs[lane] = bf2f(PL[(size_t)m * NP + PC_QA + h * 64 + lane]);
        __builtin_amdgcn_s_waitcnt(0xc07f); asm volatile("" ::: "memory");
        float sc[6];
#pragma unroll
        for (int i = 0; i < 6; ++i) {
            const int kk = lane + 64 * i;
            const bf16_t* kp; float bias = 0.f;
            if (i < 2) { const int dy = kk >> 4, dx = kk & 15, kr = r0 + dy, kc = w0 + dx;
                kp = PL + (size_t)(b * SEQ + kr * 64 + kc) * NP + PC_KA + h * 64;
                bias = rpb[(h * 15 + (kr - r + 7)) * 31 + (kc - qc + 15)]; }
            else kp = PCx + (size_t)(b * CTX + (kk - 128)) * NPC + PC_KA + h * 64;
            float d = 0.f;
#pragma unroll
            for (int e = 0; e < 8; ++e) d += dot_bf16x8(*(const bf16x8*)(kp + e * 8), qs + e * 8);
            sc[i] = d * NA_SCALE + bias;
        }
        float mx = sc[0];
#pragma unroll
        for (int i = 1; i < 6; ++i) mx = fmaxf(mx, sc[i]);
        mx = wave_max(mx);
        float sum = 0.f;
#pragma unroll
        for (int i = 0; i < 6; ++i) { sc[i] = __expf(sc[i] - mx); sum += sc[i]; ps[lane + 64 * i] = sc[i]; }
        sum = wave_sum(sum);
        __builtin_amdgcn_s_waitcnt(0xc07f); asm volatile("" ::: "memory");
        float o = 0.f;
        for (int kk = 0; kk < 128; ++kk) { const int kr = r0 + (kk >> 4), kc = w0 + (kk & 15);
            o += ps[kk] * bf2f(PL[(size_t)(b * SEQ + kr * 64 + kc) * NP + PC_VA + h * 64 + lane]); }
        for (int kk = 0; kk < 256; ++kk) o += ps[128 + kk] * bf2f(PCx[(size_t)(b * CTX + kk) * NPC + PC_VA + h * 64 + lane]);
        OA[(size_t)m * 2048 + h * 64 + lane] = (bf16_t)f2bf(o / sum);
        __builtin_amdgcn_s_waitcnt(0xc07f); asm volatile("" ::: "memory");
    }
}

__device__ __forceinline__ void mla_naive(const Params& p, unsigned char* lds) {
    int tid_ = threadIdx.x; asm volatile("" : "+v"(tid_)); const int tid = tid_, lane = tid & 63, wid = tid >> 6;
    const bf16_t* QM = (const bf16_t*)(p.ws + WS_QM); const bf16_t* KVM = (const bf16_t*)(p.ws + WS_KVM); const bf16_t* KPE = (const bf16_t*)(p.ws + WS_KPE);
    bf16_t* OB = (bf16_t*)(p.ws + WS_OB);
    float* qs = (float*)lds + wid * (192 + 2304);
    float* ps = qs + 192;
    for (int it = blockIdx.x; it < NB * 8 * (SEQ / 8); it += gridDim.x) {
        const int qg = it % (SEQ / 8), bh = it / (SEQ / 8), h = bh & 7, b = bh >> 3;
        const int m = b * SEQ + qg * 8 + wid;
#pragma unroll
        for (int i = 0; i < 3; ++i) qs[lane + 64 * i] = bf2f(QM[(size_t)m * MQW + h * 192 + lane + 64 * i]);
        __builtin_amdgcn_s_waitcnt(0xc07f); asm volatile("" ::: "memory");
        float mx = -INFINITY;
        for (int i = 0; i < 36; ++i) {
            const int kk = lane + 64 * i;
            const int krow = kk < SEQ ? b * SEQ + kk : TL + b * CTX + (kk - SEQ);
            const bf16_t* kn = KVM + (size_t)krow * MKVW + h * 256; const bf16_t* kp = KPE + (size_t)krow * 64;
            float d = 0.f;
#pragma unroll
            for (int e = 0; e < 16; ++e) d += dot_bf16x8(*(const bf16x8*)(kn + e * 8), qs + e * 8);
#pragma unroll
            for (int e = 0; e < 8; ++e) d += dot_bf16x8(*(const bf16x8*)(kp + e * 8), qs + 128 + e * 8);
            ps[kk] = d; mx = fmaxf(mx, d);
        }
        mx = wave_max(mx);
        float sum = 0.f;
        for (int i = 0; i < 36; ++i) { const float e = exp2f(ps[lane + 64 * i] - mx); sum += e; ps[lane + 64 * i] = e; }
        sum = wave_sum(sum);
        __builtin_amdgcn_s_waitcnt(0xc07f); asm volatile("" ::: "memory");
        float o0 = 0.f, o1 = 0.f;
        const bf16_t* vb = KVM + h * 256 + 128 + lane;
        for (int kk = 0; kk < SEQ; ++kk) { const bf16_t* vp = vb + (size_t)(b * SEQ + kk) * MKVW; const float pp = ps[kk]; o0 += pp * bf2f(vp[0]); o1 += pp * bf2f(vp[64]); }
        for (int kk = 0; kk < CTX; ++kk) { const bf16_t* vp = vb + (size_t)(TL + b * CTX + kk) * MKVW; const float pp = ps[SEQ + kk]; o0 += pp * bf2f(vp[0]); o1 += pp * bf2f(vp[64]); }
        const float inv = 1.f / sum;
        OB[(size_t)m * 2048 + h * 128 + lane] = (bf16_t)f2bf(o0 * inv);
        OB[(size_t)m * 2048 + h * 128 + 64 + lane] = (bf16_t)f2bf(o1 * inv);
        __builtin_amdgcn_s_waitcnt(0xc07f); asm volatile("" ::: "memory");
    }
}


typedef float f32x16 __attribute__((ext_vector_type(16)));
typedef short s16x4 __attribute__((ext_vector_type(4)));
typedef float f32x2_t __attribute__((ext_vector_type(2)));
typedef __bf16 bf16x2_t __attribute__((ext_vector_type(2)));
#define LAS3 __attribute__((address_space(3)))
__device__ __forceinline__ unsigned cvtpk(float lo, float hi) { f32x2_t v = {lo, hi}; bf16x2_t b = __builtin_convertvector(v, bf16x2_t); return __builtin_bit_cast(unsigned, b); }
__device__ __forceinline__ s16x4 vtr(const LAS3 unsigned char* p) { return __builtin_bit_cast(s16x4, __builtin_amdgcn_ds_read_tr16_b64_v4i16((LAS3 s16x4*)p)); }
__device__ __forceinline__ float max16(const f32x16& a) {
    float m0 = fmaxf(fmaxf(a[0], a[1]), fmaxf(a[2], a[3])), m1 = fmaxf(fmaxf(a[4], a[5]), fmaxf(a[6], a[7]));
    float m2 = fmaxf(fmaxf(a[8], a[9]), fmaxf(a[10], a[11])), m3 = fmaxf(fmaxf(a[12], a[13]), fmaxf(a[14], a[15]));
    return fmaxf(fmaxf(m0, m1), fmaxf(m2, m3));
}
__device__ __forceinline__ bf16x8 pfrag(const f32x16& a, int s) {
    u32x4 w; w.x = cvtpk(a[8 * s + 0], a[8 * s + 1]); w.y = cvtpk(a[8 * s + 2], a[8 * s + 3]); w.z = cvtpk(a[8 * s + 4], a[8 * s + 5]); w.w = cvtpk(a[8 * s + 6], a[8 * s + 7]);
    return __builtin_bit_cast(bf16x8, w);
}

__device__ __forceinline__ void mla_flash(const Params& p, unsigned char* lds_) {
    int tid_ = threadIdx.x; asm volatile("" : "+v"(tid_)); const int tid = tid_, lane = tid & 63, wid = tid >> 6, r32 = lane & 31, hi = lane >> 5;
    LAS3 unsigned char* lds = (LAS3 unsigned char*)lds_;
    constexpr int KP = 400, VP = 320, KBYTES = 64 * KP, VBYTES = 64 * VP, STG = KBYTES + VBYTES, NT = (SEQ + CTX) / 64;
    const bf16_t* QM = (const bf16_t*)(p.ws + WS_QM); const bf16_t* KVM = (const bf16_t*)(p.ws + WS_KVM); const bf16_t* KPE = (const bf16_t*)(p.ws + WS_KPE);
    bf16_t* OB = (bf16_t*)(p.ws + WS_OB);
    const int G = gridDim.x, vcu = (G % 8 == 0) ? (blockIdx.x % 8) * (G / 8) + blockIdx.x / 8 : blockIdx.x;
    const int skey = tid >> 4, spc = tid & 15, pkey = tid >> 3, ppc = tid & 7;
    const int vb = (4 * hi + ((lane & 15) >> 2)) * VP + (16 * ((lane >> 4) & 1) + 4 * (lane & 3)) * 2;
    for (int unit = vcu; unit < NB * 8 * 8; unit += G) {
        const int bh = unit >> 3, qt = unit & 7, b = bh >> 3, h = bh & 7;
        const int qrow = b * SEQ + qt * 256 + wid * 32 + r32;
        bf16x8 qf[12];
#pragma unroll
        for (int s = 0; s < 12; ++s) qf[s] = *(const bf16x8*)(QM + (size_t)qrow * MQW + h * 192 + 16 * s + 8 * hi);
        f32x16 o[4];
#pragma unroll
        for (int d = 0; d < 4; ++d)
#pragma unroll
            for (int r = 0; r < 16; ++r) o[d][r] = 0.f;
        float m = -1e30f, l = 0.f;
        u32x4 g0, g1, g2, g3, g4;
#define MLA_LOAD(t) do { const int kr_ = (t) < 32 ? b * SEQ + 64 * (t) : TL + b * CTX + 64 * ((t) - 32); \
            const bf16_t* kp_ = KVM + (size_t)(kr_ + skey) * MKVW + h * 256 + spc * 8; \
            g0 = *(const u32x4*)kp_; g1 = *(const u32x4*)(kp_ + (size_t)32 * MKVW); g2 = *(const u32x4*)(kp_ + 128); g3 = *(const u32x4*)(kp_ + (size_t)32 * MKVW + 128); \
            g4 = *(const u32x4*)(KPE + (size_t)(kr_ + pkey) * 64 + ppc * 8); } while (0)
#define MLA_STORE(buf) do { LAS3 unsigned char* kb_ = lds + (buf) * STG; LAS3 unsigned char* vb_ = kb_ + KBYTES; \
            *(LAS3 u32x4*)(kb_ + skey * KP + spc * 16) = g0; *(LAS3 u32x4*)(kb_ + (skey + 32) * KP + spc * 16) = g1; \
            *(LAS3 u32x4*)(vb_ + skey * VP + spc * 16) = g2; *(LAS3 u32x4*)(vb_ + (skey + 32) * VP + spc * 16) = g3; \
            *(LAS3 u32x4*)(kb_ + pkey * KP + 256 + ppc * 16) = g4; } while (0)
        MLA_LOAD(0); MLA_STORE(0);
#pragma unroll
        for (int s = 0; s < 12; ++s) asm volatile("" : "+v"(qf[s]));
        __syncthreads();
        for (int t = 0; t < NT; ++t) {
            const int cur = t & 1;
            if (t + 1 < NT) MLA_LOAD(t + 1);
            const LAS3 unsigned char* Kb = lds + cur * STG; const LAS3 unsigned char* Vb = Kb + KBYTES;
            f32x16 s0, s1;
#pragma unroll
            for (int r = 0; r < 16; ++r) { s0[r] = 0.f; s1[r] = 0.f; }
            const LAS3 unsigned char* ka = Kb + r32 * KP + 16 * hi;
#pragma unroll
            for (int s = 0; s < 12; ++s) {
                const bf16x8 a0 = *(const LAS3 bf16x8*)(ka + 32 * s), a1 = *(const LAS3 bf16x8*)(ka + 32 * KP + 32 * s);
                s0 = __builtin_amdgcn_mfma_f32_32x32x16_bf16(a0, qf[s], s0, 0, 0, 0);
                s1 = __builtin_amdgcn_mfma_f32_32x32x16_bf16(a1, qf[s], s1, 0, 0, 0);
            }
            float mx = fmaxf(max16(s0), max16(s1));
            mx = fmaxf(mx, __shfl_xor(mx, 32));
            const float mn = fmaxf(m, mx);
            if (__builtin_amdgcn_ballot_w64(mx > m) != 0ull) {
                const float alpha = __builtin_amdgcn_exp2f(m - mn);
                l *= alpha;
#pragma unroll
                for (int d = 0; d < 4; ++d) o[d] = o[d] * alpha;
            }
            m = mn;
            float rs = 0.f;
#pragma unroll
            for (int r = 0; r < 16; ++r) { s0[r] = __builtin_amdgcn_exp2f(s0[r] - mn); s1[r] = __builtin_amdgcn_exp2f(s1[r] - mn); rs += s0[r] + s1[r]; }
            l += rs;
            bf16x8 pf[4];
            pf[0] = pfrag(s0, 0); pf[1] = pfrag(s0, 1); pf[2] = pfrag(s1, 0); pf[3] = pfrag(s1, 1);
            const LAS3 unsigned char* va = Vb + vb;
#pragma unroll
            for (int ks = 0; ks < 4; ++ks)
#pragma unroll
                for (int d = 0; d < 4; ++d) {
                    const s16x4 lo = vtr(va + (16 * ks) * VP + 64 * d), hh = vtr(va + (16 * ks + 8) * VP + 64 * d);
                    const bf16x8 vf = {lo[0], lo[1], lo[2], lo[3], hh[0], hh[1], hh[2], hh[3]};
                    o[d] = __builtin_amdgcn_mfma_f32_32x32x16_bf16(vf, pf[ks], o[d], 0, 0, 0);
                }
            if (t + 1 < NT) MLA_STORE(cur ^ 1);
            __syncthreads();
        }
#undef MLA_LOAD
#undef MLA_STORE
        l += __shfl_xor(l, 32);
        const float inv = 1.f / l;
        bf16_t* op = OB + (size_t)qrow * 2048 + h * 128 + 4 * hi;
#pragma unroll
        for (int d = 0; d < 4; ++d)
#pragma unroll
            for (int g = 0; g < 4; ++g) {
                const f32x4 v = {o[d][4 * g] * inv, o[d][4 * g + 1] * inv, o[d][4 * g + 2] * inv, o[d][4 * g + 3] * inv};
                store_bf4(op + 32 * d + 8 * g, v);
            }
    }
}


__device__ __forceinline__ void na_flash(const Params& p, unsigned char* lds_) {
    int tid_ = threadIdx.x; asm volatile("" : "+v"(tid_)); const int tid = tid_, lane = tid & 63, wid = tid >> 6, r32 = lane & 31, hi = lane >> 5;
    constexpr int VP = 192, WB = 12800;
    LAS3 unsigned char* vl = (LAS3 unsigned char*)lds_ + wid * WB;
    LAS3 float* tbl = (LAS3 float*)(vl + 64 * VP);
    tbl[lane] = 0.f; tbl[lane + 64] = 0.f;
    const bf16_t* PL = (const bf16_t*)(p.ws + WS_PL); const bf16_t* PCx = (const bf16_t*)(p.ws + WS_PC);
    bf16_t* OA = (bf16_t*)(p.ws + WS_OA);
    const float* rpb = p.in[11];
    const int G = gridDim.x, vcu = (G % 8 == 0) ? (blockIdx.x % 8) * (G / 8) + blockIdx.x / 8 : blockIdx.x;
    const int vb = (4 * hi + ((lane & 15) >> 2)) * VP + (16 * ((lane >> 4) & 1) + 4 * (lane & 3)) * 2;
    constexpr float SC = NA_SCALE * LOG2E;
    for (int wu = vcu * NWAVES + wid; wu < NB * GROWS * 16 * 2; wu += G * NWAVES) {
        const int half = wu & 1, h = (wu >> 1) & 15, br = wu >> 5, r = br & 31, b = br >> 5;
        const int qc = 32 * half + r32;
        int w0 = qc - 8; w0 = w0 < 0 ? 0 : (w0 > GW - 16 ? GW - 16 : w0);
        int r0 = r - 4; r0 = r0 < 0 ? 0 : (r0 > GROWS - 8 ? GROWS - 8 : r0);
        const int qtok = b * SEQ + r * 64 + qc;
        bf16x8 qf[4];
#pragma unroll
        for (int s = 0; s < 4; ++s) qf[s] = *(const bf16x8*)(PL + (size_t)qtok * NP + PC_QA + h * 64 + 16 * s + 8 * hi);
        f32x16 o[2];
#pragma unroll
        for (int d = 0; d < 2; ++d)
#pragma unroll
            for (int e = 0; e < 16; ++e) o[d][e] = 0.f;
        float m = -1e30f, l = 0.f;
        bf16x8 kf[2][4]; u32x4 vg[8];
#define NA_LOAD(t, WHAT) do { const bf16_t* kb_; size_t pitch_; \
            if ((t) < 8) { kb_ = PL + (size_t)(b * SEQ + (r0 + (t)) * 64) * NP + PC_KA + h * 64; pitch_ = NP; } \
            else { kb_ = PCx + (size_t)(b * CTX + 64 * ((t) - 8)) * NPC + PC_KA + h * 64; pitch_ = NPC; } \
            if (WHAT & 1) { _Pragma("unroll") for (int kb = 0; kb < 2; ++kb) _Pragma("unroll") for (int s = 0; s < 4; ++s) kf[kb][s] = *(const bf16x8*)(kb_ + (size_t)(32 * kb + r32) * pitch_ + 16 * s + 8 * hi); } \
            if (WHAT & 2) { _Pragma("unroll") for (int i = 0; i < 8; ++i) vg[i] = *(const u32x4*)(kb_ + (size_t)((lane >> 3) + 8 * i) * pitch_ + 1024 + (lane & 7) * 8); } } while (0)
#define NA_STORE(t) do { _Pragma("unroll") for (int i = 0; i < 8; ++i) *(LAS3 u32x4*)(vl + ((lane >> 3) + 8 * i) * VP + (lane & 7) * 16) = vg[i]; \
            if ((t) < 8 && lane < 31) tbl[48 + lane] = rpb[(h * 15 + (r0 + (t) - r + 7)) * 31 + lane] * LOG2E; } while (0)
        NA_LOAD(0, 3); NA_STORE(0);
#pragma nounroll
        for (int t = 0; t < 12; ++t) {
            f32x16 s0, s1;
#pragma unroll
            for (int e = 0; e < 16; ++e) { s0[e] = 0.f; s1[e] = 0.f; }
#pragma unroll
            for (int s = 0; s < 4; ++s) {
                s0 = __builtin_amdgcn_mfma_f32_32x32x16_bf16(kf[0][s], qf[s], s0, 0, 0, 0);
                s1 = __builtin_amdgcn_mfma_f32_32x32x16_bf16(kf[1][s], qf[s], s1, 0, 0, 0);
            }
            __builtin_amdgcn_sched_barrier(0);
            if (t + 1 < 12) NA_LOAD(t + 1, 1);
            __builtin_amdgcn_sched_barrier(0);
            if (t < 8) {
                int w0v = w0 - 4 * hi, tb = 4 * hi - qc + 63; asm volatile("" : "+v"(w0v), "+v"(tb));
                const LAS3 float* tp = tbl + tb;
#pragma unroll
                for (int e = 0; e < 16; ++e) {
                    const int c0 = (e & 3) + 8 * (e >> 2), c1 = c0 + 32;
                    const bool ok0 = (unsigned)(c0 - w0v) < 16u, ok1 = (unsigned)(c1 - w0v) < 16u;
                    const float v0 = s0[e] * SC + tp[c0], v1 = s1[e] * SC + tp[c1];
                    s0[e] = ok0 ? v0 : -1e30f;
                    s1[e] = ok1 ? v1 : -1e30f;
                }
            } else {
#pragma unroll
                for (int e = 0; e < 16; ++e) { s0[e] *= SC; s1[e] *= SC; }
            }
            float mx = fmaxf(max16(s0), max16(s1));
            mx = fmaxf(mx, __shfl_xor(mx, 32));
            const float mn = fmaxf(m, mx), alpha = __builtin_amdgcn_exp2f(m - mn);
            m = mn; l *= alpha;
            o[0] = o[0] * alpha; o[1] = o[1] * alpha;
            float rs = 0.f;
#pragma unroll
            for (int e = 0; e < 16; ++e) { s0[e] = __builtin_amdgcn_exp2f(s0[e] - mn); s1[e] = __builtin_amdgcn_exp2f(s1[e] - mn); rs += s0[e] + s1[e]; }
            l += rs;
            __builtin_amdgcn_sched_barrier(0);
            if (t + 1 < 12) NA_LOAD(t + 1, 2);
            bf16x8 pf[4];
            pf[0] = pfrag(s0, 0); pf[1] = pfrag(s0, 1); pf[2] = pfrag(s1, 0); pf[3] = pfrag(s1, 1);
            const LAS3 unsigned char* va = vl + vb;
#pragma unroll
            for (int ks = 0; ks < 4; ++ks)
#pragma unroll
                for (int d = 0; d < 2; ++d) {
                    const s16x4 lo = vtr(va + (16 * ks) * VP + 64 * d), hh = vtr(va + (16 * ks + 8) * VP + 64 * d);
                    const bf16x8 vf = {lo[0], lo[1], lo[2], lo[3], hh[0], hh[1], hh[2], hh[3]};
                    o[d] = __builtin_amdgcn_mfma_f32_32x32x16_bf16(vf, pf[ks], o[d], 0, 0, 0);
                }
            __builtin_amdgcn_sched_barrier(0);
            if (t + 1 < 12) NA_STORE(t + 1);
        }
#undef NA_LOAD
#undef NA_STORE
        l += __shfl_xor(l, 32);
        const float inv = 1.f / l;
        bf16_t* op = OA + (size_t)qtok * 2048 + h * 64 + 4 * hi;
#pragma unroll
        for (int d = 0; d < 2; ++d)
#pragma unroll
            for (int g = 0; g < 4; ++g) {
                const f32x4 v = {o[d][4 * g] * inv, o[d][4 * g + 1] * inv, o[d][4 * g + 2] * inv, o[d][4 * g + 3] * inv};
                store_bf4(op + 32 * d + 8 * g, v);
            }
    }
}


template <bool LAT, int HALF>
__device__ __forceinline__ void na_tile(const LAS3 unsigned char* Kb, const LAS3 unsigned char* Vb, const LAS3 float* tbl, const bf16x8 (&qf)[4], f32x16 (&o)[2], float& m, float& l,
                                        int r32, int hi, int qc, int w0, int vb) {
    constexpr int KP = 144, VP = 192;
    constexpr float SC = NA_SCALE * LOG2E;
    constexpr int L0 = (LAT && HALF == 1) ? 12 : 0;
    constexpr int H1 = (LAT && HALF == 0) ? 4 : 16;
    f32x16 s0, s1;
#pragma unroll
    for (int e = 0; e < 16; ++e) { s0[e] = 0.f; s1[e] = 0.f; }
    const LAS3 unsigned char* ka = Kb + r32 * KP + 16 * hi;
#pragma unroll
    for (int s = 0; s < 4; ++s) {
        const bf16x8 a0 = *(const LAS3 bf16x8*)(ka + 32 * s), a1 = *(const LAS3 bf16x8*)(ka + 32 * KP + 32 * s);
        s0 = __builtin_amdgcn_mfma_f32_32x32x16_bf16(a0, qf[s], s0, 0, 0, 0);
        s1 = __builtin_amdgcn_mfma_f32_32x32x16_bf16(a1, qf[s], s1, 0, 0, 0);
    }
    if constexpr (LAT) {
        int w0v = w0 - 4 * hi, tb = 4 * hi - qc + 63; asm volatile("" : "+v"(w0v), "+v"(tb));
        const LAS3 float* tp = tbl + tb;
#pragma unroll
        for (int e = 0; e < 16; ++e) {
            const int c0 = (e & 3) + 8 * (e >> 2), c1 = c0 + 32;
            if (e >= L0) { const float p0 = (float)((unsigned)(c0 - w0v) & 0xFFFFFFF0u); s0[e] = fmaf(p0, -1e28f, fmaf(s0[e], SC, tp[c0])); }
            if (e < H1) { const float p1 = (float)((unsigned)(c1 - w0v) & 0xFFFFFFF0u); s1[e] = fmaf(p1, -1e28f, fmaf(s1[e], SC, tp[c1])); }
        }
    } else {
#pragma unroll
        for (int e = 0; e < 16; ++e) { s0[e] *= SC; s1[e] *= SC; }
    }
    float mx = -1e30f;
#pragma unroll
    for (int e = 0; e < 16; ++e) { if (e >= L0) mx = fmaxf(mx, s0[e]); if (e < H1) mx = fmaxf(mx, s1[e]); }
    mx = fmaxf(mx, __shfl_xor(mx, 32));
    const float mn = fmaxf(m, mx);
    if (__builtin_amdgcn_ballot_w64(mx > m) != 0ull) {
        const float alpha = __builtin_amdgcn_exp2f(m - mn);
        l *= alpha; o[0] = o[0] * alpha; o[1] = o[1] * alpha;
    }
    m = mn;
    float rs = 0.f;
#pragma unroll
    for (int e = 0; e < 16; ++e) {
        if (e >= L0) { s0[e] = __builtin_amdgcn_exp2f(s0[e] - mn); rs += s0[e]; } else s0[e] = 0.f;
        if (e < H1) { s1[e] = __builtin_amdgcn_exp2f(s1[e] - mn); rs += s1[e]; } else s1[e] = 0.f;
    }
    l += rs;
    bf16x8 pf[4];
    pf[0] = pfrag(s0, 0); pf[1] = pfrag(s0, 1); pf[2] = pfrag(s1, 0); pf[3] = pfrag(s1, 1);
    const LAS3 unsigned char* va = Vb + vb;
#pragma unroll
    for (int ks = 0; ks < 4; ++ks) {
        if (LAT && ((HALF == 0 && ks == 3) || (HALF == 1 && ks == 0))) continue;
#pragma unroll
        for (int d = 0; d < 2; ++d) {
            const s16x4 lo = vtr(va + (16 * ks) * VP + 64 * d), hh = vtr(va + (16 * ks + 8) * VP + 64 * d);
            const bf16x8 vf = {lo[0], lo[1], lo[2], lo[3], hh[0], hh[1], hh[2], hh[3]};
            o[d] = __builtin_amdgcn_mfma_f32_32x32x16_bf16(vf, pf[ks], o[d], 0, 0, 0);
        }
    }
}
__device__ __forceinline__ void na_coop(const Params& p, unsigned char* lds_) {
    int tid_ = threadIdx.x; asm volatile("" : "+v"(tid_)); const int tid = tid_, lane = tid & 63, wid = tid >> 6, r32 = lane & 31, hi = lane >> 5;
    constexpr int KP = 144, VP = 192, KT = 64 * KP, VT = 64 * VP, STG = KT + VT;
    LAS3 unsigned char* lds = (LAS3 unsigned char*)lds_;
    LAS3 float* tbl = (LAS3 float*)(lds + 2 * STG) + wid * 128;
    tbl[lane] = 0.f; tbl[lane + 64] = 0.f;
    const bf16_t* PL = (const bf16_t*)(p.ws + WS_PL); const bf16_t* PCx = (const bf16_t*)(p.ws + WS_PC);
    bf16_t* OA = (bf16_t*)(p.ws + WS_OA);
    const float* rpb = p.in[11];
    const int G = gridDim.x, vcu = (G % 8 == 0) ? (blockIdx.x % 8) * (G / 8) + blockIdx.x / 8 : blockIdx.x;
    const int vb = (4 * hi + ((lane & 15) >> 2)) * VP + (16 * ((lane >> 4) & 1) + 4 * (lane & 3)) * 2;
    const int half = wid & 1, rw = wid >> 1, skey = tid >> 3, spc = tid & 7;
    constexpr float SC = NA_SCALE * LOG2E;
    for (int unit = vcu; unit < NB * 16 * (GROWS / 4); unit += G) {
        const int rg = unit & 7, h = (unit >> 3) & 15, b = unit >> 7;
        const int R = rg * 4, r = R + rw;
        int r0w = r - 4; r0w = r0w < 0 ? 0 : (r0w > GROWS - 8 ? GROWS - 8 : r0w);
        int kr_lo = R - 4; kr_lo = kr_lo < 0 ? 0 : (kr_lo > GROWS - 8 ? GROWS - 8 : kr_lo);
        int kr_hi = R - 1; kr_hi = (kr_hi < 0 ? 0 : (kr_hi > GROWS - 8 ? GROWS - 8 : kr_hi)) + 7;
        const int nlat = kr_hi - kr_lo + 1, NT = nlat + 4;
        const int qc = 32 * half + r32;
        int w0 = qc - 8; w0 = w0 < 0 ? 0 : (w0 > GW - 16 ? GW - 16 : w0);
        const int qtok = b * SEQ + r * 64 + qc;
        bf16x8 qf[4];
#pragma unroll
        for (int s = 0; s < 4; ++s) qf[s] = *(const bf16x8*)(PL + (size_t)qtok * NP + PC_QA + h * 64 + 16 * s + 8 * hi);
        f32x16 o[2];
#pragma unroll
        for (int d = 0; d < 2; ++d)
#pragma unroll
            for (int e = 0; e < 16; ++e) o[d][e] = 0.f;
        float m = -1e30f, l = 0.f;
        float brow[8];
#pragma unroll
        for (int i = 0; i < 8; ++i) brow[i] = lane < 31 ? rpb[(h * 15 + (r0w - r + 7 + i)) * 31 + lane] * LOG2E : 0.f;
        u32x4 gk, gv;
#define NC_LOAD(t) do { const bf16_t* kp_ = (t) < nlat ? PL + (size_t)(b * SEQ + (kr_lo + (t)) * 64 + skey) * NP + PC_KA + h * 64 + spc * 8 \
                                                      : PCx + (size_t)(b * CTX + 64 * ((t) - nlat) + skey) * NPC + PC_KA + h * 64 + spc * 8; \
            gk = *(const u32x4*)kp_; gv = *(const u32x4*)(kp_ + 1024); } while (0)
#define NC_STORE(buf) do { *(LAS3 u32x4*)(lds + (buf) * STG + skey * KP + spc * 16) = gk; *(LAS3 u32x4*)(lds + (buf) * STG + KT + skey * VP + spc * 16) = gv; } while (0)
        __syncthreads();
        NC_LOAD(0); NC_STORE(0);
#pragma unroll
        for (int s = 0; s < 4; ++s) asm volatile("" : "+v"(qf[s]));
#pragma unroll
        for (int i = 0; i < 8; ++i) asm volatile("" : "+v"(brow[i]));
        __syncthreads();
#pragma nounroll
        for (int t = 0; t < NT; ++t) {
            const int cur = t & 1;
            if (t + 1 < NT) NC_LOAD(t + 1);
            const bool lat = t < nlat; const int kr = kr_lo + t;
            if (!lat || (kr >= r0w && kr < r0w + 8)) {
                const LAS3 unsigned char* Kb = lds + cur * STG; const LAS3 unsigned char* Vb = Kb + KT;
                if (lat) { const int bi_ = kr - r0w; float bv = brow[0];
#pragma unroll
                    for (int i = 1; i < 8; ++i) bv = bi_ == i ? brow[i] : bv;
                    if (lane < 31) tbl[48 + lane] = bv; }
                if (!lat) na_tile<false, 0>(Kb, Vb, tbl, qf, o, m, l, r32, hi, qc, w0, vb);
                else if (half == 0) na_tile<true, 0>(Kb, Vb, tbl, qf, o, m, l, r32, hi, qc, w0, vb);
                else na_tile<true, 1>(Kb, Vb, tbl, qf, o, m, l, r32, hi, qc, w0, vb);
            }
            if (t + 1 < NT) NC_STORE(cur ^ 1);
            __syncthreads();
        }
#undef NC_LOAD
#undef NC_STORE
        l += __shfl_xor(l, 32);
        const float inv = 1.f / l;
        bf16_t* op = OA + (size_t)qtok * 2048 + h * 64 + 4 * hi;
#pragma unroll
        for (int d = 0; d < 2; ++d)
#pragma unroll
            for (int g = 0; g < 4; ++g) {
                const f32x4 v = {o[d][4 * g] * inv, o[d][4 * g + 1] * inv, o[d][4 * g + 2] * inv, o[d][4 * g + 3] * inv};
                store_bf4(op + 32 * d + 8 * g, v);
            }
    }
}

__device__ __forceinline__ void phase7(const Params& p) {
    int tid_ = threadIdx.x; asm volatile("" : "+v"(tid_)); const int tid = tid_, lane = tid & 63, wid = tid >> 6;
    const int gw = blockIdx.x * NWAVES + wid, NGW = gridDim.x * NWAVES;
    const float* mod = (const float*)(p.ws + WS_MOD);
    const bf16_t* Z = (const bf16_t*)(p.ws + WS_Z); bf16_t* H = (bf16_t*)(p.ws + WS_H);
    const float* gpm = p.in[7]; const float* gpf = p.in[8];
    const int per = (TL + NGW - 1) / NGW;
    int curb = -1; f32x4 A[8], B[8], C[8];
    for (int i = 0; i < per; ++i) {
        const int m = gw * per + i; if (m >= TL) break;
        const int b = m / SEQ;
        if (b != curb) { curb = b; const float* mb = mod + (size_t)b * 12288;
#pragma unroll
            for (int j = 0; j < 8; ++j) { const int c = j * 256 + lane * 4;
                A[j] = *(const f32x4*)(mb + 4096 + c) * *(const f32x4*)(gpm + c); B[j] = *(const f32x4*)(gpf + c) * (*(const f32x4*)(mb + 8192 + c) + 1.f); C[j] = *(const f32x4*)(mb + 6144 + c); } }
        f32x4 z[8]; float ss = 0.f;
#pragma unroll
        for (int j = 0; j < 8; ++j) {
            const u32x2 w = *(const u32x2*)(Z + (size_t)m * DM + j * 256 + lane * 4);
            z[j] = (f32x4){__uint_as_float(w.x << 16), __uint_as_float(w.x & 0xffff0000u), __uint_as_float(w.y << 16), __uint_as_float(w.y & 0xffff0000u)};
            ss += z[j][0] * z[j][0] + z[j][1] * z[j][1] + z[j][2] * z[j][2] + z[j][3] * z[j][3];
        }
        f32x4 xv[8];
#pragma unroll
        for (int j = 0; j < 8; ++j) xv[j] = *(const f32x4*)(p.in[0] + (size_t)m * DM + j * 256 + lane * 4);
        const float rz = rsqrtf(wave_sum_dpp(ss) * (1.f / DM) + EPS);
        float s2 = 0.f;
#pragma unroll
        for (int j = 0; j < 8; ++j) {
            const f32x4 x1 = xv[j] + (z[j] * rz) * A[j];
            *(f32x4*)(p.out + (size_t)m * DM + j * 256 + lane * 4) = x1;
            z[j] = x1; s2 += x1[0] * x1[0] + x1[1] * x1[1] + x1[2] * x1[2] + x1[3] * x1[3];
        }
        const float rx = rsqrtf(wave_sum_dpp(s2) * (1.f / DM) + EPS);
#pragma unroll
        for (int j = 0; j < 8; ++j) store_bf4(H + (size_t)m * DM + j * 256 + lane * 4, (z[j] * rx) * B[j] + C[j]);
    }
}

template <int NPER>
__device__ __forceinline__ void wave_top16(float (&v)[NPER], const int (&idx)[NPER], float& outv, int& outi, int lane) {
    outv = -INFINITY; outi = 0;
#pragma nounroll
    for (int r = 0; r < 16; ++r) {
        float bv = v[0]; int bi = idx[0];
#pragma unroll
        for (int e = 1; e < NPER; ++e) if (v[e] > bv || (v[e] == bv && idx[e] < bi)) { bv = v[e]; bi = idx[e]; }
#pragma unroll
        for (int o = 32; o >= 1; o >>= 1) {
            const float ov = __shfl_xor(bv, o); const int oi = __shfl_xor(bi, o);
            if (ov > bv || (ov == bv && oi < bi)) { bv = ov; bi = oi; }
        }
#pragma unroll
        for (int e = 0; e < NPER; ++e) if (idx[e] == bi) v[e] = -INFINITY;
        if (lane == r) { outv = bv; outi = bi; }
    }
}

__device__ __forceinline__ void peer_topk_naive(const Params& p, unsigned char* lds) {
    int tid_ = threadIdx.x; asm volatile("" : "+v"(tid_)); const int tid = tid_, lane = tid & 63, wid = tid >> 6;
    const int gw = blockIdx.x * NWAVES + wid, NGW = gridDim.x * NWAVES;
    const bf16_t* QP = (const bf16_t*)(p.ws + WS_QP); const bf16_t* SK = (const bf16_t*)(p.ws + WS_SUBK);
    float* TKV = (float*)(p.ws + WS_TKV); int* TKI = (int*)(p.ws + WS_TKI);
    float* qs = (float*)lds + wid * 128;
    for (int it = gw; it < TL * 16; it += NGW) {
        const int hp = it & 15, m = it >> 4;
        qs[lane] = bf2f(QP[(size_t)m * DM + hp * 128 + lane]); qs[lane + 64] = bf2f(QP[(size_t)m * DM + hp * 128 + 64 + lane]);
        __builtin_amdgcn_s_waitcnt(0xc07f); asm volatile("" ::: "memory");
        float v[2]; int idx[2];
#pragma unroll
        for (int i = 0; i < 2; ++i) {
            const int n = lane + 64 * i; const bf16_t* kp = SK + (size_t)(hp * 128 + n) * 128;
            float d = 0.f;
#pragma unroll
            for (int e = 0; e < 16; ++e) d += dot_bf16x8(*(const bf16x8*)(kp + e * 8), qs + e * 8);
            v[i] = d; idx[i] = n;
        }
        float ov; int oi; wave_top16<2>(v, idx, ov, oi, lane);
        if (lane < 16) { TKV[(size_t)it * 16 + lane] = ov; TKI[(size_t)it * 16 + lane] = oi; }
        __builtin_amdgcn_s_waitcnt(0xc07f); asm volatile("" ::: "memory");
    }
}

__device__ __forceinline__ void peer_final_naive(const Params& p, unsigned char* lds) {
    int tid_ = threadIdx.x; asm volatile("" : "+v"(tid_)); const int tid = tid_, lane = tid & 63, wid = tid >> 6;
    const float* TKV = (const float*)(p.ws + WS_TKV); const int* TKI = (const int*)(p.ws + WS_TKI);
    const bf16_t* H = (const bf16_t*)(p.ws + WS_H);
    const float* U = p.in[21]; const float* V = p.in[22];
    const float* mod = (const float*)(p.ws + WS_MOD); const float* gpo = p.in[9];
    float* part = (float*)lds;
    float* red = part + 8 * 2048;
    for (int m = blockIdx.x; m < TL; m += gridDim.x) {
        const int b = m / SEQ, h = wid;
        const float* v1 = TKV + ((size_t)m * 16 + h * 2) * 16; const float* v2 = v1 + 16;
        const int* i1 = TKI + ((size_t)m * 16 + h * 2) * 16; const int* i2 = i1 + 16;
        float cv[4]; int ci[4];
        const float v2j = v2[lane & 15];
#pragma unroll
        for (int e = 0; e < 4; ++e) { const int i = (lane >> 4) + 4 * e; cv[e] = v1[i] + v2j; ci[e] = i * 16 + (lane & 15); }
        float tv; int tc; wave_top16<4>(cv, ci, tv, tc, lane);
        int eid = 0; float gate = 0.f;
        if (lane < 16) eid = i1[tc >> 4] * 128 + i2[tc & 15];
        const float mx = __shfl(tv, 0);
        const float ex = lane < 16 ? __expf(tv - mx) : 0.f;
        gate = ex / wave_sum(ex);
        f32x4 hv[8];
#pragma unroll
        for (int j = 0; j < 8; ++j) { const u32x2 w = *(const u32x2*)(H + (size_t)m * DM + j * 256 + lane * 4);
            hv[j] = (f32x4){__uint_as_float(w.x << 16), __uint_as_float(w.x & 0xffff0000u), __uint_as_float(w.y << 16), __uint_as_float(w.y & 0xffff0000u)}; }
        f32x4 acc[8];
#pragma unroll
        for (int j = 0; j < 8; ++j) acc[j] = (f32x4){0.f, 0.f, 0.f, 0.f};
        for (int k = 0; k < 16; ++k) {
            const int e = __shfl(eid, k); const float g = __shfl(gate, k);
#ifdef PEER_NAIVE_BF16
            const bf16_t* ur = (const bf16_t*)(p.ws + WS_UB) + (size_t)e * DM + lane * 4; const bf16_t* vr = (const bf16_t*)(p.ws + WS_VB) + (size_t)e * DM + lane * 4;
            float d = 0.f;
#pragma unroll
            for (int j = 0; j < 8; ++j) { const u32x2 w = *(const u32x2*)(ur + j * 256); const f32x4 u = {__uint_as_float(w.x << 16), __uint_as_float(w.x & 0xffff0000u), __uint_as_float(w.y << 16), __uint_as_float(w.y & 0xffff0000u)};
                d += u[0] * hv[j][0] + u[1] * hv[j][1] + u[2] * hv[j][2] + u[3] * hv[j][3]; }
            d = wave_sum(d);
            const float coef = g * gelu_as(d);
#pragma unroll
            for (int j = 0; j < 8; ++j) { const u32x2 w = *(const u32x2*)(vr + j * 256); const f32x4 vv = {__uint_as_float(w.x << 16), __uint_as_float(w.x & 0xffff0000u), __uint_as_float(w.y << 16), __uint_as_float(w.y & 0xffff0000u)};
                acc[j] += vv * coef; }
#else
            const float* ur = U + (size_t)e * DM + lane * 4; const float* vr = V + (size_t)e * DM + lane * 4;
            float d = 0.f;
#pragma unroll
            for (int j = 0; j < 8; ++j) { const f32x4 u = *(const f32x4*)(ur + j * 256); d += u[0] * hv[j][0] + u[1] * hv[j][1] + u[2] * hv[j][2] + u[3] * hv[j][3]; }
            d = wave_sum(d);
            const float coef = g * gelu_erf(d);
#pragma unroll
            for (int j = 0; j < 8; ++j) acc[j] += *(const f32x4*)(vr + j * 256) * coef;
#endif
        }
        __syncthreads();
#pragma unroll
        for (int j = 0; j < 8; ++j) *(f32x4*)(part + wid * 2048 + j * 256 + lane * 4) = acc[j];
        __syncthreads();
        f32x4 y = (f32x4){0.f, 0.f, 0.f, 0.f};
#pragma unroll
        for (int w = 0; w < 8; ++w) y += *(const f32x4*)(part + w * 2048 + tid * 4);
        float ss = wave_sum(y[0] * y[0] + y[1] * y[1] + y[2] * y[2] + y[3] * y[3]);
        if (lane == 0) red[wid] = ss;
        __syncthreads();
        float tot = 0.f;
#pragma unroll
        for (int w = 0; w < 8; ++w) tot += red[w];
        const float rstd = rsqrtf(tot * (1.f / DM) + EPS);
        const int c = tid * 4;
        const f32x4 gt2 = *(const f32x4*)(mod + (size_t)b * 12288 + 10240 + c);
        float* op = p.out + (size_t)m * DM + c;
        const f32x4 x1 = *(const f32x4*)op;
        *(f32x4*)op = x1 + gt2 * (y * rstd * *(const f32x4*)(gpo + c));
    }
}


__device__ __forceinline__ void peer_topk_mfma(const Params& p, unsigned char* lds_) {
    int tid_ = threadIdx.x; asm volatile("" : "+v"(tid_)); const int tid = tid_, lane = tid & 63, wid = tid >> 6, r32 = lane & 31, hi = lane >> 5;
    LAS3 unsigned char* lds = (LAS3 unsigned char*)lds_;
    constexpr int SP = 272;
    const bf16_t* QP = (const bf16_t*)(p.ws + WS_QP); const bf16_t* SK = (const bf16_t*)(p.ws + WS_SUBK);
    float* TKV = (float*)(p.ws + WS_TKV); int* TKI = (int*)(p.ws + WS_TKI);
    for (int bi = blockIdx.x; bi < 256; bi += gridDim.x) {
        const int hp = bi & 15, sub = bi >> 4;
        __syncthreads();
        for (int c = tid; c < 2048; c += NTHREADS) { const int row = c >> 4, pc = c & 15;
            *(LAS3 u32x4*)(lds + row * SP + pc * 16) = *(const u32x4*)(SK + ((size_t)hp * 128 + row) * 128 + pc * 8); }
        __syncthreads();
        for (int g = wid; g < 32; g += NWAVES) {
            const int tok = (sub * 32 + g) * 32 + r32;
            bf16x8 qf[8];
#pragma unroll
            for (int s = 0; s < 8; ++s) qf[s] = *(const bf16x8*)(QP + (size_t)tok * DM + hp * 128 + 16 * s + 8 * hi);
            f32x16 sc[4];
#pragma unroll
            for (int kb = 0; kb < 4; ++kb) {
#pragma unroll
                for (int e = 0; e < 16; ++e) sc[kb][e] = 0.f;
#pragma unroll
                for (int s = 0; s < 8; ++s) {
                    const bf16x8 a = *(const LAS3 bf16x8*)(lds + (32 * kb + r32) * SP + 32 * s + 16 * hi);
                    sc[kb] = __builtin_amdgcn_mfma_f32_32x32x16_bf16(a, qf[s], sc[kb], 0, 0, 0);
                }
            }
#pragma unroll
            for (int kb = 0; kb < 4; ++kb)
#pragma unroll
                for (int e = 0; e < 16; ++e) {
                    const unsigned key = 32 * kb + (e & 3) + 8 * (e >> 2) + 4 * hi;
                    sc[kb][e] = __uint_as_float((__float_as_uint(sc[kb][e]) & 0xFFFFFF80u) | key);
                }
            float ov[16];
#pragma unroll
            for (int r = 0; r < 16; ++r) {
                float mx = -INFINITY;
#pragma unroll
                for (int kb = 0; kb < 4; ++kb) mx = fmaxf(mx, max16(sc[kb]));
                const float w = fmaxf(mx, __shfl_xor(mx, 32));
                ov[r] = w;
#pragma unroll
                for (int kb = 0; kb < 4; ++kb)
#pragma unroll
                    for (int e = 0; e < 16; ++e) sc[kb][e] = sc[kb][e] == w ? -INFINITY : sc[kb][e];
            }
            if (hi == 0) {
                float* vp = TKV + ((size_t)tok * 16 + hp) * 16; int* ip = TKI + ((size_t)tok * 16 + hp) * 16;
#pragma unroll
                for (int q = 0; q < 4; ++q) {
                    f32x4 vv; u32x4 ii;
#pragma unroll
                    for (int e = 0; e < 4; ++e) { const unsigned u = __float_as_uint(ov[4 * q + e]); vv[e] = __uint_as_float(u & 0xFFFFFF80u); ii[e] = u & 127u; }
                    *(f32x4*)(vp + 4 * q) = vv; *(u32x4*)(ip + 4 * q) = ii;
                }
            }
        }
    }
}


constexpr int cand_jmax(int i) { return 16 / (i + 1); }
constexpr int cand_off(int i) { int t = 0; for (int k = 0; k < i; ++k) t += 16 / (k + 1); return t; }
static_assert(cand_off(16) == 50, "candidate count");
template <int N> __device__ __forceinline__ void bitonic_sort_desc(float (&a)[N]) {
#pragma unroll
    for (int k = 2; k <= N; k <<= 1)
#pragma unroll
        for (int j = k >> 1; j > 0; j >>= 1)
#pragma unroll
            for (int i = 0; i < N; ++i) { const int l = i ^ j; if (l > i) { const bool up = (i & k) == 0; const float x = a[i], y = a[l];
                a[i] = up ? fmaxf(x, y) : fminf(x, y); a[l] = up ? fminf(x, y) : fmaxf(x, y); } }
}
template <int N> __device__ __forceinline__ void bitonic_merge_desc(float (&a)[N]) {
#pragma unroll
    for (int j = N >> 1; j > 0; j >>= 1)
#pragma unroll
        for (int i = 0; i < N; ++i) { const int l = i ^ j; if (l > i) { const float x = a[i], y = a[l]; a[i] = fmaxf(x, y); a[l] = fminf(x, y); } }
}
__device__ __forceinline__ void top16_merge(float (&a)[16], const float (&b)[16]) {
#pragma unroll
    for (int i = 0; i < 16; ++i) a[i] = fmaxf(a[i], b[15 - i]);
    bitonic_merge_desc<16>(a);
}
__device__ __forceinline__ void top16_of_64(float (&g0)[16], float (&g1)[16], float (&g2)[16], float (&g3)[16]) {
    bitonic_sort_desc<16>(g0); bitonic_sort_desc<16>(g1); bitonic_sort_desc<16>(g2); bitonic_sort_desc<16>(g3);
    top16_merge(g0, g1); top16_merge(g2, g3); top16_merge(g0, g2);
}
__device__ __forceinline__ void topk_stage1(const LAS3 unsigned char* skl, const bf16_t* __restrict__ qrow, int r32, int hi, float (&ov)[16]) {
    constexpr int SP = 272;
    bf16x8 qf[8];
#pragma unroll
    for (int s = 0; s < 8; ++s) qf[s] = *(const bf16x8*)(qrow + 16 * s + 8 * hi);
    f32x16 sc[4];
#pragma unroll
    for (int kb = 0; kb < 4; ++kb) {
#pragma unroll
        for (int e = 0; e < 16; ++e) sc[kb][e] = 0.f;
#pragma unroll
        for (int s = 0; s < 8; ++s) {
            const bf16x8 a = *(const LAS3 bf16x8*)(skl + (32 * kb + r32) * SP + 32 * s + 16 * hi);
            sc[kb] = __builtin_amdgcn_mfma_f32_32x32x16_bf16(a, qf[s], sc[kb], 0, 0, 0);
        }
    }
    float g1[16], g2[16], g3[16];
#pragma unroll
    for (int e = 0; e < 16; ++e) {
        const unsigned key = (e & 3) + 8 * (e >> 2) + 4 * hi;
        ov[e] = __uint_as_float((__float_as_uint(sc[0][e]) & 0xFFFFFF80u) | key);
        g1[e] = __uint_as_float((__float_as_uint(sc[1][e]) & 0xFFFFFF80u) | (key + 32u));
        g2[e] = __uint_as_float((__float_as_uint(sc[2][e]) & 0xFFFFFF80u) | (key + 64u));
        g3[e] = __uint_as_float((__float_as_uint(sc[3][e]) & 0xFFFFFF80u) | (key + 96u));
    }
    top16_of_64(ov, g1, g2, g3);
    float pb[16];
#pragma unroll
    for (int e = 0; e < 16; ++e) pb[e] = __shfl_xor(ov[e], 32);
    top16_merge(ov, pb);
}
__device__ __forceinline__ void peer_tables_q8(const Params& p, int gw, int NGW, int lane);
__device__ __forceinline__ void peer_select_mfma(const Params& p, unsigned char* lds_, int mode = 0) {
    int tid_ = threadIdx.x; asm volatile("" : "+v"(tid_)); const int tid = tid_, lane = tid & 63, wid = tid >> 6, r32 = lane & 31, hi = lane >> 5;
    LAS3 unsigned char* lds = (LAS3 unsigned char*)lds_;
    constexpr int SP = 272;
    LAS3 unsigned* ktab = (LAS3 unsigned*)(lds + 256 * SP) + wid * 2048 + lane;
    const bf16_t* QP = (const bf16_t*)(p.ws + WS_QP); const bf16_t* SK = (const bf16_t*)(p.ws + WS_SUBK);
    int* SE = (int*)(p.ws + WS_TKI); float* SG = (float*)(p.ws + WS_TKV);
    for (int bi = blockIdx.x; bi < 256; bi += gridDim.x) {
        const int h = bi & 7, sub = bi >> 3;
        __syncthreads();
        for (int c = tid; c < 4096; c += NTHREADS) { const int row = c >> 4, pc = c & 15;
            *(LAS3 u32x4*)(lds + row * SP + pc * 16) = *(const u32x4*)(SK + ((size_t)h * 256 + row) * 128 + pc * 8); }
        __syncthreads();
#ifdef SEL_SPLIT
        if (wid >= 4) { if (bi == (int)blockIdx.x && mode != 1) peer_tables_q8(p, blockIdx.x * 4 + (wid - 4), gridDim.x * 4, lane); continue; }
        if (mode == 2) continue;
        for (int g = wid; g < 16; g += 4) {
#else
        if (mode == 2) continue;
        for (int g = wid; g < 16; g += NWAVES) {
#endif
            const int tok = (sub * 16 + g) * 32 + r32;
            float ov0[16], ov1[16];
            int lo0 = 0, lo1 = 128 * SP; asm volatile("" : "+v"(lo0), "+v"(lo1));
            topk_stage1(lds + lo0, QP + (size_t)tok * DM + h * 256, r32, hi, ov0);
            topk_stage1(lds + lo1, QP + (size_t)tok * DM + h * 256 + 128, r32, hi, ov1);
#pragma unroll
            for (int q = 0; q < 16; ++q) { ktab[q * 64] = __float_as_uint(ov0[q]) & 127u; ktab[(16 + q) * 64] = __float_as_uint(ov1[q]) & 127u; }
            float c0[16], c1[16], c2[16], c3[16];
#pragma unroll
            for (int e = 0; e < 16; ++e) { c0[e] = -INFINITY; c1[e] = -INFINITY; c2[e] = -INFINITY; c3[e] = -INFINITY; }
#pragma unroll
            for (int i = 0; i < 16; ++i) {
                const float a = __uint_as_float(__float_as_uint(ov0[i]) & 0xFFFFFF80u);
#pragma unroll
                for (int j = 0; j < 16; ++j) if (j < cand_jmax(i)) {
                    const float bb = __uint_as_float(__float_as_uint(ov1[j]) & 0xFFFFFF80u);
                    const float cv = __uint_as_float((__float_as_uint(a + bb) & 0xFFFFFF00u) | (unsigned)(i * 16 + j));
                    const int n = cand_off(i) + j;
                    if (n < 16) c0[n & 15] = cv; else if (n < 32) c1[n & 15] = cv; else if (n < 48) c2[n & 15] = cv; else c3[n & 15] = cv;
                }
            }
            top16_of_64(c0, c1, c2, c3);
            float tv[16]; unsigned te[16];
#pragma unroll
            for (int r = 0; r < 16; ++r) {
                const unsigned ij = __float_as_uint(c0[r]) & 255u;
                te[r] = ktab[(ij >> 4) * 64] * 128u + ktab[(16 + (ij & 15u)) * 64];
                tv[r] = __uint_as_float(__float_as_uint(c0[r]) & 0xFFFFFF00u);
            }
            const float tmax = tv[0]; float sum = 0.f;
#pragma unroll
            for (int r = 0; r < 16; ++r) { tv[r] = __expf(tv[r] - tmax); sum += tv[r]; }
            const float rinv = 1.f / sum;
#pragma unroll
            for (int r = 0; r < 16; ++r) tv[r] *= rinv;
            if (hi == 0) {
                int* ep = SE + (size_t)tok * 128 + h * 16; float* gp = SG + (size_t)tok * 128 + h * 16;
#pragma unroll
                for (int q = 0; q < 4; ++q) { *(u32x4*)(ep + 4 * q) = (u32x4){te[4 * q], te[4 * q + 1], te[4 * q + 2], te[4 * q + 3]}; *(f32x4*)(gp + 4 * q) = (f32x4){tv[4 * q], tv[4 * q + 1], tv[4 * q + 2], tv[4 * q + 3]}; }
            }
        }
#ifndef SEL_SPLIT
        if (bi == (int)blockIdx.x && mode != 1) peer_tables_q8(p, blockIdx.x * NWAVES + wid, gridDim.x * NWAVES, lane);
#endif
    }
}

__device__ __forceinline__ void peer_tables_bf16(const Params& p) {
    const size_t gt = (size_t)blockIdx.x * NTHREADS + threadIdx.x, NGT = (size_t)gridDim.x * NTHREADS;
    const float* U = p.in[21]; const float* V = p.in[22];
    bf16_t* UB = (bf16_t*)(p.ws + WS_UB); bf16_t* VB = (bf16_t*)(p.ws + WS_VB);
    for (size_t i = gt; i < (size_t)16384 * DM / 8; i += NGT) {
        const f32x4 a0 = *(const f32x4*)(U + i * 8), a1 = *(const f32x4*)(U + i * 8 + 4), b0 = *(const f32x4*)(V + i * 8), b1 = *(const f32x4*)(V + i * 8 + 4);
        u32x4 w; w.x = pk2(a0[0], a0[1]); w.y = pk2(a0[2], a0[3]); w.z = pk2(a1[0], a1[1]); w.w = pk2(a1[2], a1[3]);
        *(u32x4*)(UB + i * 8) = w;
        w.x = pk2(b0[0], b0[1]); w.y = pk2(b0[2], b0[3]); w.z = pk2(b1[0], b1[1]); w.w = pk2(b1[2], b1[3]);
        *(u32x4*)(VB + i * 8) = w;
    }
}

typedef short s16x2 __attribute__((ext_vector_type(2)));
__device__ __forceinline__ float dot2_bf16(unsigned a, unsigned b, float acc) { return __builtin_amdgcn_fdot2_f32_bf16(__builtin_bit_cast(s16x2, a), __builtin_bit_cast(s16x2, b), acc, false); }
__device__ __forceinline__ float dot8_bf16(const u32x4 a, const u32x4 b, float acc) {
    const unsigned a0 = a[0], a1 = a[1], a2 = a[2], a3 = a[3], b0 = b[0], b1 = b[1], b2 = b[2], b3 = b[3];
    acc = dot2_bf16(a0, b0, acc); acc = dot2_bf16(a1, b1, acc); acc = dot2_bf16(a2, b2, acc); acc = dot2_bf16(a3, b3, acc);
    return acc;
}
__device__ __forceinline__ void peer_select(const float* __restrict__ TKV, const int* __restrict__ TKI, int m, int lane, int& eA, int& eB, float& gA, float& gB) {
    eA = 0; eB = 0; gA = 0.f; gB = 0.f;
#pragma nounroll
    for (int h = 0; h < 8; ++h) {
        const float* v1 = TKV + ((size_t)m * 16 + h * 2) * 16; const float* v2 = v1 + 16;
        const int* i1 = TKI + ((size_t)m * 16 + h * 2) * 16; const int* i2 = i1 + 16;
        float cv[4]; int ci[4];
        const float v2j = v2[lane & 15];
#pragma unroll
        for (int e = 0; e < 4; ++e) { const int i = (lane >> 4) + 4 * e; cv[e] = v1[i] + v2j; ci[e] = i * 16 + (lane & 15); }
        float tv; int tc; wave_top16<4>(cv, ci, tv, tc, lane);
        int eid = 0;
        if (lane < 16) eid = i1[tc >> 4] * 128 + i2[tc & 15];
        const float mx = __shfl(tv, 0);
        const float ex = lane < 16 ? __expf(tv - mx) : 0.f;
        const float gate = ex / wave_sum(ex);
        const int es = __shfl(eid, lane & 15); const float gs = __shfl(gate, lane & 15);
        if ((lane >> 4) == (h & 3)) { if (h < 4) { eA = es; gA = gs; } else { eB = es; gB = gs; } }
    }
}
__device__ __forceinline__ void peer_gather(const Params& p, bool dry = false) {
    int tid_ = threadIdx.x; asm volatile("" : "+v"(tid_)); const int tid = tid_, lane = tid & 63, wid = tid >> 6;
    const int gw = blockIdx.x * NWAVES + wid, NGW = gridDim.x * NWAVES;
    const float* TKV = (const float*)(p.ws + WS_TKV); const int* TKI = (const int*)(p.ws + WS_TKI);
    const bf16_t* H = (const bf16_t*)(p.ws + WS_H);
    const bf16_t* UB = (const bf16_t*)(p.ws + WS_UB); const bf16_t* VB = (const bf16_t*)(p.ws + WS_VB);
    const float* mod = (const float*)(p.ws + WS_MOD); const float* gpo = p.in[9];
    for (int m = gw; m < TL; m += NGW) {
        int eA, eB; float gA, gB;
        peer_select(TKV, TKI, m, lane, eA, eB, gA, gB);
        asm volatile("" : "+v"(eA), "+v"(eB), "+v"(gA), "+v"(gB));
        u32x4 us[2][4], vs[2][4];
#define PG_LOAD(S, k) do { const int e_ = __builtin_amdgcn_readlane((k) < 64 ? eA : eB, (k) & 63); \
            const bf16_t* up_ = UB + (size_t)e_ * DM + lane * 8; const bf16_t* vp_ = VB + (size_t)e_ * DM + lane * 8; \
            _Pragma("unroll") for (int i = 0; i < 4; ++i) { us[S][i] = *(const u32x4*)(up_ + i * 512); vs[S][i] = *(const u32x4*)(vp_ + i * 512); } } while (0)
        PG_LOAD(0, 0); PG_LOAD(1, 1);
        u32x4 hq[4];
#pragma unroll
        for (int i = 0; i < 4; ++i) hq[i] = *(const u32x4*)(H + (size_t)m * DM + i * 512 + lane * 8);
        float acc[4][8];
#pragma unroll
        for (int i = 0; i < 4; ++i)
#pragma unroll
            for (int e = 0; e < 8; ++e) acc[i][e] = 0.f;
#define PG_USE(S, k) do { float d_ = 0.f; \
            _Pragma("unroll") for (int i = 0; i < 4; ++i) d_ = dot8_bf16(us[S][i], hq[i], d_); \
            d_ = wave_sum(d_); \
            const float g_ = __uint_as_float((unsigned)__builtin_amdgcn_readlane((int)__float_as_uint((k) < 64 ? gA : gB), (k) & 63)); \
            const float cf_ = g_ * gelu_as(d_); \
            _Pragma("unroll") for (int i = 0; i < 4; ++i) { const u32x4 w_ = vs[S][i]; \
                acc[i][0] += cf_ * __uint_as_float(w_.x << 16); acc[i][1] += cf_ * __uint_as_float(w_.x & 0xffff0000u); \
                acc[i][2] += cf_ * __uint_as_float(w_.y << 16); acc[i][3] += cf_ * __uint_as_float(w_.y & 0xffff0000u); \
                acc[i][4] += cf_ * __uint_as_float(w_.z << 16); acc[i][5] += cf_ * __uint_as_float(w_.z & 0xffff0000u); \
                acc[i][6] += cf_ * __uint_as_float(w_.w << 16); acc[i][7] += cf_ * __uint_as_float(w_.w & 0xffff0000u); } } while (0)
#pragma nounroll
        for (int k = 0; k < 128; k += 2) {
            PG_USE(0, k);     if (k + 2 < 128) PG_LOAD(0, k + 2);
            PG_USE(1, k + 1); if (k + 3 < 128) PG_LOAD(1, k + 3);
        }
#undef PG_LOAD
#undef PG_USE
        float ss = 0.f;
#pragma unroll
        for (int i = 0; i < 4; ++i)
#pragma unroll
            for (int e = 0; e < 8; ++e) ss += acc[i][e] * acc[i][e];
        const float rstd = rsqrtf(wave_sum(ss) * (1.f / DM) + EPS);
        const int b = m / SEQ;
#pragma unroll
        for (int i = 0; i < 4; ++i)
#pragma unroll
            for (int q = 0; q < 2; ++q) {
                const int c = i * 512 + lane * 8 + q * 4;
                const f32x4 gt2 = *(const f32x4*)(mod + (size_t)b * 12288 + 10240 + c), gg = *(const f32x4*)(gpo + c);
                float* op = p.out + (size_t)m * DM + c;
                const f32x4 x1 = *(const f32x4*)op;
                const f32x4 y = {acc[i][4 * q], acc[i][4 * q + 1], acc[i][4 * q + 2], acc[i][4 * q + 3]};
                const f32x4 res = x1 + gt2 * (y * rstd * gg);
                if (!dry) *(f32x4*)op = res; else asm volatile("" :: "v"(res));
            }
    }
}


__device__ __forceinline__ void peer_q8_row(const Params& p, int r, const f32x4 (&v)[8], int lane) {
    unsigned char* UQ = p.ws + WS_UQ; unsigned char* VQ = p.ws + WS_VQ; float* USC = (float*)(p.ws + WS_USC); float* VSC = (float*)(p.ws + WS_VSC);
    const bool isv = r >= 16384; const int e = isv ? r - 16384 : r;
    float mx = 0.f;
#pragma unroll
    for (int j = 0; j < 8; ++j) mx = fmaxf(mx, fmaxf(fmaxf(fabsf(v[j][0]), fabsf(v[j][1])), fmaxf(fabsf(v[j][2]), fabsf(v[j][3]))));
    mx = fmaxf(wave_max(mx), 1e-30f);
    const float sc = mx * (1.f / 127.f), inv = 127.f / mx;
    unsigned char* dst = (isv ? VQ : UQ) + (size_t)e * DM;
    const int zp = isv ? 128 : 0;
#pragma unroll
    for (int j = 0; j < 8; ++j) {
        unsigned w = 0;
#pragma unroll
        for (int c = 0; c < 4; ++c) { const int q = (int)rintf(v[j][c] * inv) + zp; w |= ((unsigned)q & 0xffu) << (8 * c); }
        *(unsigned*)(dst + j * 256 + lane * 4) = w;
    }
    if (lane == 0) (isv ? VSC : USC)[e] = sc;
}
__device__ __forceinline__ void peer_tables_q8(const Params& p, int gw, int NGW, int lane) {
    f32x4 va[8], vb[8];
#define Q8_LOAD(dst, r) do { const float* s_ = ((r) >= 16384 ? p.in[22] + (size_t)((r) - 16384) * DM : p.in[21] + (size_t)(r) * DM); \
        _Pragma("unroll") for (int j = 0; j < 8; ++j) dst[j] = *(const f32x4*)(s_ + j * 256 + lane * 4); } while (0)
    int r = gw;
    if (r < 2 * 16384) Q8_LOAD(va, r);
    for (; r < 2 * 16384; r += 2 * NGW) {
        const int r1 = r + NGW, r2 = r + 2 * NGW;
        if (r1 < 2 * 16384) Q8_LOAD(vb, r1);
        peer_q8_row(p, r, va, lane);
        if (r2 < 2 * 16384) Q8_LOAD(va, r2);
        if (r1 < 2 * 16384) peer_q8_row(p, r1, vb, lane);
    }
#undef Q8_LOAD
}

__device__ __forceinline__ void peer_gather_q8(const Params& p, unsigned char* lds_, bool dry = false, int emask = 0x3fff) {
    int tid_ = threadIdx.x; asm volatile("" : "+v"(tid_)); const int tid = tid_, lane = tid & 63, wid = tid >> 6;
    LAS3 int* srt = (LAS3 int*)lds_ + wid * 256;
    const int gw = blockIdx.x * NWAVES + wid, NGW = gridDim.x * NWAVES;
    const float* TKV = (const float*)(p.ws + WS_TKV); const int* TKI = (const int*)(p.ws + WS_TKI);
    const bf16_t* H = (const bf16_t*)(p.ws + WS_H);
    const unsigned char* UQ = p.ws + WS_UQ; const unsigned char* VQ = p.ws + WS_VQ; const float* USC = (const float*)(p.ws + WS_USC); const float* VSC = (const float*)(p.ws + WS_VSC);
    const float* mod = (const float*)(p.ws + WS_MOD); const float* gpo = p.in[9];
    const int rounds = (TL + NGW - 1) / NGW;
    for (int it = 0; it < rounds; ++it) {
        const int m = gw + it * NGW;
#ifndef GATHER_UNSORTED
        __syncthreads();
#endif
        if (m >= TL) continue;
        int eA, eB; float gA, gB;
#if defined(TOPK_NAIVE) || defined(TOPK_STAGE1)
        peer_select(TKV, TKI, m, lane, eA, eB, gA, gB);
#else
        eA = TKI[(size_t)m * 128 + lane]; eB = TKI[(size_t)m * 128 + 64 + lane]; gA = TKV[(size_t)m * 128 + lane]; gB = TKV[(size_t)m * 128 + 64 + lane];
#endif
#ifndef GATHER_UNSORTED
        {
            int rA = 0, rB = 0;
#pragma nounroll
            for (int j = 0; j < 64; ++j) {
                const int ea = __builtin_amdgcn_readlane(eA, j), eb = __builtin_amdgcn_readlane(eB, j);
                rA += (ea < eA || (ea == eA && j < lane)) ? 1 : 0; rA += (eb < eA) ? 1 : 0;
                rB += (ea < eB || ea == eB) ? 1 : 0; rB += (eb < eB || (eb == eB && j < lane)) ? 1 : 0;
            }
            srt[rA] = eA; srt[128 + rA] = __float_as_int(gA); srt[rB] = eB; srt[128 + rB] = __float_as_int(gB);
            eA = srt[lane]; eB = srt[64 + lane]; gA = __int_as_float(srt[128 + lane]); gB = __int_as_float(srt[192 + lane]);
        }
#endif
        asm volatile("" : "+v"(eA), "+v"(eB), "+v"(gA), "+v"(gB));
        unsigned hq[2][4]; float hscale;
        {
            u32x4 hw[2][2]; float mx = 0.f;
#pragma unroll
            for (int i = 0; i < 2; ++i)
#pragma unroll
                for (int q = 0; q < 2; ++q) { hw[i][q] = *(const u32x4*)(H + (size_t)m * DM + i * 1024 + lane * 16 + q * 8);
#pragma unroll
                    for (int c = 0; c < 4; ++c) { const unsigned w = hw[i][q][c]; mx = fmaxf(mx, fmaxf(fabsf(__uint_as_float(w << 16)), fabsf(__uint_as_float(w & 0xffff0000u)))); } }
            mx = fmaxf(wave_max(mx), 1e-30f);
            hscale = mx * (1.f / 127.f); const float inv = 127.f / mx;
#pragma unroll
            for (int i = 0; i < 2; ++i)
#pragma unroll
                for (int q = 0; q < 2; ++q)
#pragma unroll
                    for (int c2 = 0; c2 < 2; ++c2) {
                        const unsigned w0 = hw[i][q][2 * c2], w1 = hw[i][q][2 * c2 + 1];
                        const int q0 = (int)rintf(__uint_as_float(w0 << 16) * inv), q1 = (int)rintf(__uint_as_float(w0 & 0xffff0000u) * inv);
                        const int q2 = (int)rintf(__uint_as_float(w1 << 16) * inv), q3 = (int)rintf(__uint_as_float(w1 & 0xffff0000u) * inv);
                        hq[i][2 * q + c2] = ((unsigned)q0 & 0xffu) | (((unsigned)q1 & 0xffu) << 8) | (((unsigned)q2 & 0xffu) << 16) | (((unsigned)q3 & 0xffu) << 24);
                    }
        }
        float cA = 0.f, cB = 0.f; float csum = 0.f;
        {
            u32x4 us[8][2]; float usc[8], vsc[8];
#define PU_LOAD(S, k) do { const int e_ = __builtin_amdgcn_readlane((k) < 64 ? eA : eB, (k) & 63) & emask; int ev_ = e_; asm volatile("" : "+v"(ev_)); \
                const unsigned char* up_ = UQ + (size_t)e_ * DM + lane * 16; us[S][0] = *(const u32x4*)up_; us[S][1] = *(const u32x4*)(up_ + 1024); usc[S] = USC[ev_]; vsc[S] = VSC[ev_]; } while (0)
#define PU_COEF(S, k) do { int id_ = 0; \
                _Pragma("unroll") for (int i = 0; i < 2; ++i) _Pragma("unroll") for (int c = 0; c < 4; ++c) { const unsigned uw_ = us[S][i][c]; id_ = __builtin_amdgcn_sdot4((int)uw_, (int)hq[i][c], id_, false); } \
                const float d_ = wave_sum_dpp((float)id_) * (hscale * usc[S]); \
                const float g_ = __uint_as_float((unsigned)__builtin_amdgcn_readlane((int)__float_as_uint((k) < 64 ? gA : gB), (k) & 63)); \
                const float cf_ = g_ * gelu_as(d_) * vsc[S]; csum += cf_; \
                if ((k) < 64) cA = lane == ((k) & 63) ? cf_ : cA; else cB = lane == ((k) & 63) ? cf_ : cB; } while (0)
            PU_LOAD(0, 0); PU_LOAD(1, 1); PU_LOAD(2, 2); PU_LOAD(3, 3);
#pragma nounroll
            for (int k = 0; k < 128; k += 4) {
                const int kn = k + 4 < 128 ? k + 4 : 124;
                PU_COEF(0, k + 0); PU_COEF(1, k + 1); PU_COEF(2, k + 2); PU_COEF(3, k + 3);
                PU_LOAD(0, kn + 0); PU_LOAD(1, kn + 1); PU_LOAD(2, kn + 2); PU_LOAD(3, kn + 3);
            }
#undef PU_LOAD
#undef PU_COEF
        }
        float acc[2][16];
#pragma unroll
        for (int i = 0; i < 2; ++i)
#pragma unroll
            for (int e = 0; e < 16; ++e) acc[i][e] = 0.f;
        {
            u32x4 vs[8][2];
#define PV_LOAD(S, k) do { const int e_ = __builtin_amdgcn_readlane((k) < 64 ? eA : eB, (k) & 63) & emask; \
                const unsigned char* vp_ = VQ + (size_t)e_ * DM + lane * 16; vs[S][0] = *(const u32x4*)vp_; vs[S][1] = *(const u32x4*)(vp_ + 1024); } while (0)
#define PV_ACC(S, k) do { const float cf_ = __uint_as_float((unsigned)__builtin_amdgcn_readlane((int)__float_as_uint((k) < 64 ? cA : cB), (k) & 63)); \
                _Pragma("unroll") for (int i = 0; i < 2; ++i) _Pragma("unroll") for (int c = 0; c < 4; ++c) { const unsigned w_ = vs[S][i][c]; \
                    acc[i][4 * c + 0] += cf_ * (float)(w_ & 0xffu); acc[i][4 * c + 1] += cf_ * (float)((w_ >> 8) & 0xffu); \
                    acc[i][4 * c + 2] += cf_ * (float)((w_ >> 16) & 0xffu); acc[i][4 * c + 3] += cf_ * (float)(w_ >> 24); } } while (0)
            PV_LOAD(0, 0); PV_LOAD(1, 1); PV_LOAD(2, 2); PV_LOAD(3, 3);
#pragma nounroll
            for (int k = 0; k < 128; k += 4) {
                const int kn = k + 4 < 128 ? k + 4 : 124;
                PV_ACC(0, k + 0); PV_ACC(1, k + 1); PV_ACC(2, k + 2); PV_ACC(3, k + 3);
                PV_LOAD(0, kn + 0); PV_LOAD(1, kn + 1); PV_LOAD(2, kn + 2); PV_LOAD(3, kn + 3);
            }
#undef PV_LOAD
#undef PV_ACC
        }
        const float zoff = 128.f * csum;
        float ss = 0.f;
#pragma unroll
        for (int i = 0; i < 2; ++i)
#pragma unroll
            for (int e = 0; e < 16; ++e) { acc[i][e] -= zoff; ss += acc[i][e] * acc[i][e]; }
        const float rstd = rsqrtf(wave_sum(ss) * (1.f / DM) + EPS);
        const int b = m / SEQ;
#pragma unroll
        for (int i = 0; i < 2; ++i)
#pragma unroll
            for (int q = 0; q < 4; ++q) {
                const int c = i * 1024 + lane * 16 + q * 4;
                const f32x4 gt2 = *(const f32x4*)(mod + (size_t)b * 12288 + 10240 + c), gg = *(const f32x4*)(gpo + c);
                float* op = p.out + (size_t)m * DM + c;
                const f32x4 x1 = *(const f32x4*)op;
                const f32x4 y = {acc[i][4 * q], acc[i][4 * q + 1], acc[i][4 * q + 2], acc[i][4 * q + 3]};
                const f32x4 res = x1 + gt2 * (y * rstd * gg);
                if (!dry) *(f32x4*)op = res; else asm volatile("" :: "v"(res));
            }
    }
}


#define LAS __attribute__((address_space(3)))
#define XB_TMO      128
#define XB_XCNT(j)  (256  + 64 * (j))
#define XB_XSUB(j)  (1280 + 64 * (j))
#define XB_XGEN(j)  (2304 + 64 * (j))
#define XB_TOP      3328
#define XB_TOPGEN   3392
#define XCD_BAR_WORDS 3456
#define XB_SPIN_CAP (1u << 18)

__device__ __forceinline__ unsigned xb_ld(unsigned* p)              { return __hip_atomic_load(p, __ATOMIC_RELAXED, __HIP_MEMORY_SCOPE_AGENT); }
__device__ __forceinline__ unsigned xb_add(unsigned* p, unsigned v) { return __hip_atomic_fetch_add(p, v, __ATOMIC_RELAXED, __HIP_MEMORY_SCOPE_AGENT); }
__device__ __forceinline__ unsigned xb_xcc_id() { return (unsigned)__builtin_amdgcn_s_getreg((3 << 11) | 20) & 0xFu; }
#define XB_SPIN(cond, bar) do { unsigned _sp = 0; while (cond) { __builtin_amdgcn_s_sleep(1); \
    if ((++_sp & 255u) == 0u) { if (xb_ld(&(bar)[XB_TMO])) break; if (_sp > XB_SPIN_CAP) { atomicAdd(&(bar)[XB_TMO], 1u); break; } } } } while (0)

struct XcdBarrier {
    unsigned* bar; unsigned x;
    volatile LAS unsigned* st;
};

__device__ __forceinline__ XcdBarrier xcd_barrier_post(unsigned* bar, volatile LAS unsigned* st) {
    XcdBarrier b; b.bar = bar; b.x = xb_xcc_id(); b.st = st;
    if (threadIdx.x == 0) (void)xb_add(&bar[XB_XCNT(b.x)], 1u);
    return b;
}
__device__ __forceinline__ void xcd_barrier_complete(unsigned* bar, unsigned x, unsigned& nloc, unsigned& nx) {
    const unsigned G = gridDim.x * gridDim.y * gridDim.z;
    unsigned sum, cnt, mine, sp = 0u;
    for (;;) {
        sum = 0u; cnt = 0u; mine = 0u;
#pragma unroll
        for (unsigned j = 0; j < 16; ++j) { const unsigned c = xb_ld(&bar[XB_XCNT(j)]); sum += c; cnt += (c > 0u) ? 1u : 0u; mine = (j == x) ? c : mine; }
        if (sum == G) break;
        __builtin_amdgcn_s_sleep(1);
        if ((++sp & 255u) == 0u) { if (xb_ld(&bar[XB_TMO])) break; if (sp > XB_SPIN_CAP) { atomicAdd(&bar[XB_TMO], 1u); break; } }
    }
    nloc = mine > 0u ? mine : 1u; nx = cnt > 0u ? cnt : 1u;
}

__device__ __forceinline__ void xcd_barrier(const XcdBarrier& b) {
    asm volatile("s_waitcnt vmcnt(0)" ::: "memory");
    __syncthreads();
    if (threadIdx.x == 0) {
        unsigned* bar = b.bar;
        __builtin_amdgcn_s_waitcnt(0);
        unsigned nloc = b.st[0], nx = b.st[1];
        if (nloc == 0u) { xcd_barrier_complete(bar, b.x, nloc, nx); b.st[0] = nloc; b.st[1] = nx; }
        const unsigned old = xb_add(&bar[XB_XSUB(b.x)], 1u);
        const unsigned gen = old / nloc;
        if (old + 1u == (gen + 1u) * nloc) {
            __builtin_amdgcn_fence(__ATOMIC_RELEASE, "agent");
            asm volatile("s_waitcnt vmcnt(0)" ::: "memory");
            const unsigned og = xb_add(&bar[XB_TOP], 1u);
            const unsigned tg = og / nx;
            if (og + 1u == (tg + 1u) * nx) xb_add(&bar[XB_TOPGEN], 1u);
            else XB_SPIN(xb_ld(&bar[XB_TOPGEN]) == tg, bar);
            __builtin_amdgcn_fence(__ATOMIC_ACQUIRE, "agent");
            xb_add(&bar[XB_XGEN(b.x)], 1u);
            asm volatile("s_waitcnt vmcnt(0)" ::: "memory");
        } else {
            XB_SPIN(xb_ld(&bar[XB_XGEN(b.x)]) == gen, bar);
            __builtin_amdgcn_fence(__ATOMIC_ACQUIRE, "agent");
            asm volatile("s_waitcnt vmcnt(0)" ::: "memory");
        }
    }
    __syncthreads();
}


__global__ void __launch_bounds__(NTHREADS, 2) mega(Params p) {
    extern __shared__ __attribute__((aligned(16))) unsigned char lds[];
    cg::grid_group grid = cg::this_grid();
    unsigned char* ws = p.ws;
    bf16_t* H = (bf16_t*)(ws + WS_H); bf16_t* PL = (bf16_t*)(ws + WS_PL); bf16_t* PCx = (bf16_t*)(ws + WS_PC);
    const int lo = p.ph_lo, hi = p.ph_hi;
    volatile LAS unsigned* bst = (volatile LAS unsigned*)((LAS unsigned char*)lds + (LDS_BYTES - 64));
    unsigned* barw = (unsigned*)(ws + WS_BAR);
    if (threadIdx.x < 2) bst[threadIdx.x] = 0u;
    if (blockIdx.x == 0) for (int i = threadIdx.x; i < XCD_BAR_WORDS; i += NTHREADS) barw[i] = 0u;
    __syncthreads();
    XcdBarrier xbar; xbar.bar = barw; xbar.x = 0; xbar.st = bst;
#ifdef PHONLY
#define IN(k) ((k) == PHONLY && lo <= (k) && (k) < hi)
#else
#define IN(k) (lo <= (k) && (k) < hi)
#endif
#ifndef DUP
#define DUP -1
#endif
#define REP(k) for (int rep_ = 0; rep_ < ((k) == DUP ? 2 : 1); ++rep_)
#define SEAM(k) do { if (IN(k) && IN((k) + 1)) { \
        if ((k) == 0) { asm volatile("s_waitcnt vmcnt(0) lgkmcnt(0)" ::: "memory"); grid.sync(); \
            if (threadIdx.x < 64) { __builtin_amdgcn_fence(__ATOMIC_ACQUIRE, "agent"); asm volatile("s_waitcnt vmcnt(0)" ::: "memory"); } __syncthreads(); \
            xbar = xcd_barrier_post(barw, bst); } \
        else xcd_barrier(xbar); } } while (0)
    if (IN(0)) { phase0(p, lds); __syncthreads(); if (DUP == 0) { phase0(p, lds); __syncthreads(); } }
    SEAM(0);
    if (IN(1)) REP(1) phase1(p);
    SEAM(1);
    if (IN(2)) REP(2) {
        { EpiInproj e{PL, NP, PC_GA}; run_gemm<EpiInproj, false>(lds, H, DM, (const bf16_t*)(ws + WS_WIN), DM, TL, NP, DM, e); }
        { EpiInproj e{PCx, NPC, 1 << 30}; run_gemm<EpiInproj, false>(lds, H + (size_t)TL * DM, DM, (const bf16_t*)(ws + WS_WIN), DM, TC, NPC, DM, e, 128); }
    }
    SEAM(2);
    if (IN(3)) {
#ifndef NO_P3_GEMM
        { EpiMlaQ e{(bf16_t*)(ws + WS_QM), (const float*)(ws + WS_ROPE)}; run_gemm<EpiMlaQ, true>(lds, PL + PC_CQ, NP, (const bf16_t*)(ws + WS_WQB), QR, TL, MQW, QR, e); }
        { EpiMlaKV e{(bf16_t*)(ws + WS_KVM), 0}; run_gemm<EpiMlaKV, true>(lds, PL + PC_CKV, NP, (const bf16_t*)(ws + WS_WKVB), KVR, TL, MKVW, KVR, e); }
        { EpiMlaKV e{(bf16_t*)(ws + WS_KVM), TL}; run_gemm<EpiMlaKV, true>(lds, PCx + PC_CKV, NPC, (const bf16_t*)(ws + WS_WKVB), KVR, TC, MKVW, KVR, e, 128); __syncthreads(); }
        if (DUP == 31) {
        { EpiMlaQ e{(bf16_t*)(ws + WS_QM), (const float*)(ws + WS_ROPE)}; run_gemm<EpiMlaQ, true>(lds, PL + PC_CQ, NP, (const bf16_t*)(ws + WS_WQB), QR, TL, MQW, QR, e); }
        { EpiMlaKV e{(bf16_t*)(ws + WS_KVM), 0}; run_gemm<EpiMlaKV, true>(lds, PL + PC_CKV, NP, (const bf16_t*)(ws + WS_WKVB), KVR, TL, MKVW, KVR, e); }
        { EpiMlaKV e{(bf16_t*)(ws + WS_KVM), TL}; run_gemm<EpiMlaKV, true>(lds, PCx + PC_CKV, NPC, (const bf16_t*)(ws + WS_WKVB), KVR, TC, MKVW, KVR, e, 128); __syncthreads(); }
        }
#endif
        kpe_pass(p);
#ifdef NA_NAIVE
        na_naive(p, lds);
#else
#ifdef NA_PERWAVE
        na_flash(p, lds);
        if (DUP == 30) na_flash(p, lds);
#else
        na_coop(p, lds);
        if (DUP == 30) na_coop(p, lds);
#endif
#endif
    }
    SEAM(3);
#ifdef MLA_NAIVE
    if (IN(4)) mla_naive(p, lds);
#else
    if (IN(4)) REP(4) mla_flash(p, lds);
#endif
    SEAM(4);
    if (IN(5)) REP(5) {
        { EpiMergeF e{H, PL}; run_gemm<EpiMergeF, false>(lds, (const bf16_t*)(ws + WS_OA), DM, (const bf16_t*)(ws + WS_WA), DM, TL, DM, DM, e); }
    }
    SEAM(5);
    if (IN(6)) REP(6) { EpiStore e{(bf16_t*)(ws + WS_Z), DM}; run_gemm<EpiStore, false>(lds, H, DM, (const bf16_t*)(ws + WS_WO), DM, TL, DM, DM, e); }
    SEAM(6);
    if (IN(7)) REP(7) phase7(p);
    SEAM(7);
    if (IN(8)) REP(8) { EpiStore e{(bf16_t*)(ws + WS_QP), DM}; run_gemm<EpiStore, false>(lds, H, DM, (const bf16_t*)(ws + WS_WPQ), DM, TL, DM, DM, e); }
    SEAM(8);
    if (IN(9)) REP(9) {
#if defined(TOPK_NAIVE)
        peer_topk_naive(p, lds);
#elif defined(TOPK_STAGE1)
        peer_topk_mfma(p, lds);
#else
        peer_select_mfma(p, lds);
        if (DUP == 90) peer_select_mfma(p, lds, 1);
        if (DUP == 91) peer_select_mfma(p, lds, 2);
#endif
#ifdef PEER_BF16
        peer_tables_bf16(p);
#endif
    }
    SEAM(9);
#ifdef PEER_NAIVE
    if (IN(10)) peer_final_naive(p, lds);
#else
#ifdef PEER_BF16
    if (IN(10)) { if (DUP == 10) peer_gather(p, true); peer_gather(p); }
#else
    if (IN(10)) { if (DUP == 10) peer_gather_q8(p, lds, true); if (DUP == 100) peer_gather_q8(p, lds, true, 1023); if (DUP == 101) peer_gather_q8(p, lds, true, 127); peer_gather_q8(p, lds); }
#endif
#endif
#undef IN
#undef SEAM
}

extern "C" void kernel_launch(void* const* d_in, const int* in_sizes, int n_in, void* d_out, int out_size, void* d_ws, size_t ws_size, hipStream_t stream) {
    static int grid = 0;
    if (grid == 0) {
        int dev = 0, cus = 0, per_cu = 0;
        (void)hipGetDevice(&dev);
        (void)hipDeviceGetAttribute(&cus, hipDeviceAttributeMultiprocessorCount, dev);
        (void)hipFuncSetAttribute((const void*)mega, hipFuncAttributeMaxDynamicSharedMemorySize, LDS_BYTES);
        (void)hipOccupancyMaxActiveBlocksPerMultiprocessor(&per_cu, (const void*)mega, NTHREADS, LDS_BYTES);
        if (per_cu < 1) { fprintf(stderr, "occupancy query says %d blocks per CU\n", per_cu); per_cu = 1; }
        grid = cus * 1;
        (void)hipGetLastError();
        if (n_in != 23 || ws_size < WS_END) fprintf(stderr, "kernel_launch: unexpected n_in %d or ws %zu\n", n_in, ws_size);
    }
    Params p{};
    for (int i = 0; i < 23; ++i) p.in[i] = (const float*)d_in[i];
    p.out = (float*)d_out; p.ws = (unsigned char*)d_ws; p.ph_lo = 0; p.ph_hi = 11;
    void* args[] = {&p};
    hipError_t e = hipLaunchCooperativeKernel((const void*)mega, dim3(grid), dim3(NTHREADS), args, LDS_BYTES, stream);
    if (e != hipSuccess) fprintf(stderr, "cooperative launch failed: %s (grid %d)\n", hipGetErrorString(e), grid);
}
```

```cpp
#include <hip/hip_runtime.h>
#include <hip/hip_cooperative_groups.h>
#include <cstdio>
#include <cstdint>
namespace cg = cooperative_groups;

typedef unsigned short bf16_t;
typedef short bf16x8 __attribute__((ext_vector_type(8)));
typedef float f32x4 __attribute__((ext_vector_type(4)));
typedef unsigned u32x4 __attribute__((ext_vector_type(4)));
typedef unsigned u32x2 __attribute__((ext_vector_type(2)));

constexpr int DM = 2048, NB = 8, SEQ = 2048, CTX = 256, GW = 64, GROWS = 32;
constexpr int TL = NB * SEQ;
constexpr int TC = NB * CTX;
constexpr int TA = TL + TC;
constexpr int IN_COLS = 8512;
constexpr int NP = 8704;
constexpr int NPC = 2816;
constexpr int PC_KA = 0, PC_VA = 1024, PC_CKV = 2048, PC_KPE = 2560, PC_QA = 2816, PC_CQ = 3840, PC_GA = 4608, PC_GB = 6656;
constexpr int QR = 768, KVR = 512;
constexpr int MQW = 1536, MKVW = 2048;
constexpr float EPS = 1e-6f;
constexpr float LOG2E = 1.4426950408889634f;
constexpr float MLA_QSCALE = 0.07216878364870322f * LOG2E;
constexpr float NA_SCALE = 0.125f;

constexpr size_t al256(size_t x) { return (x + 255) & ~(size_t)255; }
constexpr size_t WS_MOD = 0;
constexpr size_t WS_ROPE = al256(WS_MOD + 9 * 12288 * 4);
constexpr size_t WS_BAR = al256(WS_ROPE + (size_t)SEQ * 32 * 2 * 4);
constexpr size_t WS_WIN = al256(WS_BAR + 3456 * 4);
constexpr size_t WS_WQB = WS_WIN + (size_t)NP * DM * 2;
constexpr size_t WS_WKVB = WS_WQB + (size_t)MQW * QR * 2;
constexpr size_t WS_WA = WS_WKVB + (size_t)MKVW * KVR * 2;
constexpr size_t WS_WB = WS_WA + (size_t)DM * 1024 * 2;
constexpr size_t WS_WO = WS_WB + (size_t)DM * 1024 * 2;
constexpr size_t WS_WPQ = WS_WO + (size_t)DM * DM * 2;
constexpr size_t WS_SUBK = WS_WPQ + (size_t)DM * DM * 2;
constexpr size_t WS_H = WS_SUBK + (size_t)262144 * 2;
constexpr size_t WS_PL = WS_H + (size_t)TA * DM * 2;
constexpr size_t WS_PC = WS_PL + (size_t)TL * NP * 2;
constexpr size_t WS_QM = WS_PC + (size_t)TC * NPC * 2;
constexpr size_t WS_KVM = WS_QM + (size_t)TL * MQW * 2;
constexpr size_t WS_KPE = WS_KVM + (size_t)TA * MKVW * 2;
constexpr size_t WS_OA = WS_KPE + (size_t)TA * 64 * 2;
constexpr size_t WS_OB = WS_OA + 1024 * 2;
constexpr size_t WS_END = WS_OA + (size_t)TL * 2048 * 2;
constexpr size_t WS_Z = WS_PL;
constexpr size_t WS_QP = WS_PL + (size_t)TL * DM * 2;
constexpr size_t WS_TKV = WS_QP + (size_t)TL * DM * 2;
constexpr size_t WS_TKI = WS_TKV + (size_t)TL * 256 * 4;
constexpr size_t WS_UB = WS_QM;
constexpr size_t WS_VB = WS_UB + (size_t)16384 * DM * 2;
constexpr size_t WS_UQ = WS_QM;
constexpr size_t WS_VQ = WS_UQ + (size_t)16384 * DM;
constexpr size_t WS_USC = WS_VQ + (size_t)16384 * DM;
constexpr size_t WS_VSC = WS_USC + 16384 * 4;
static_assert(WS_TKI + (size_t)TL * 256 * 4 <= WS_PC, "overlay");
static_assert(WS_END <= 650307648ull, "workspace");
static_assert(WS_VB + (size_t)16384 * DM * 2 <= WS_END, "expert table overlay");

constexpr int NTHREADS = 512, NWAVES = 8;
constexpr int LDS_BYTES = 139264;

struct Params {
    const float* in[23];
    float* out;
    unsigned char* ws;
    int ph_lo, ph_hi;
};

__device__ __forceinline__ float bf2f(bf16_t v) { return __uint_as_float((unsigned)v << 16); }
__device__ __forceinline__ unsigned f2bf(float f) { unsigned u = __float_as_uint(f); return (u + 0x7fffu + ((u >> 16) & 1u)) >> 16; }
typedef float pk_f32x2 __attribute__((ext_vector_type(2)));
typedef __bf16 pk_bf16x2 __attribute__((ext_vector_type(2)));
__device__ __forceinline__ unsigned pk2(float lo, float hi) { pk_f32x2 v = {lo, hi}; pk_bf16x2 b = __builtin_convertvector(v, pk_bf16x2); return __builtin_bit_cast(unsigned, b); }
__device__ __forceinline__ float wave_sum(float v) {
#pragma unroll
    for (int o = 1; o < 64; o <<= 1) v += __shfl_xor(v, o);
    return v;
}
__device__ __forceinline__ float wave_sum_dpp(float v) {
    v += __builtin_bit_cast(float, __builtin_amdgcn_update_dpp(0, __builtin_bit_cast(int, v), 0xB1, 0xF, 0xF, false));
    v += __builtin_bit_cast(float, __builtin_amdgcn_update_dpp(0, __builtin_bit_cast(int, v), 0x4E, 0xF, 0xF, false));
    v += __builtin_bit_cast(float, __builtin_amdgcn_update_dpp(0, __builtin_bit_cast(int, v), 0x141, 0xF, 0xF, false));
    v += __builtin_bit_cast(float, __builtin_amdgcn_update_dpp(0, __builtin_bit_cast(int, v), 0x140, 0xF, 0xF, false));
    v += __builtin_bit_cast(float, __builtin_amdgcn_update_dpp(0, __builtin_bit_cast(int, v), 0x142, 0xA, 0xF, false));
    v += __builtin_bit_cast(float, __builtin_amdgcn_update_dpp(0, __builtin_bit_cast(int, v), 0x143, 0xC, 0xF, false));
    return __builtin_bit_cast(float, __builtin_amdgcn_readlane(__builtin_bit_cast(int, v), 63));
}
__device__ __forceinline__ float wave_max(float v) {
#pragma unroll
    for (int o = 1; o < 64; o <<= 1) v = fmaxf(v, __shfl_xor(v, o));
    return v;
}
__device__ __forceinline__ float sigmoidf_(float x) { return __builtin_amdgcn_rcpf(1.f + __expf(-x)); }
__device__ __forceinline__ float silu_(float x) { return x / (1.f + __expf(-x)); }
__device__ __forceinline__ float gelu_erf(float x) { return 0.5f * x * (1.f + erff(x * 0.70710678118654752f)); }

__device__ __forceinline__ float gelu_as(float v) {
    const float t = __builtin_amdgcn_rcpf(fabsf(v) * 0.2316418882f + 1.0f);
    float q = t * 0.5307027145f + (-0.7265760135f); q = q * t + 0.7107068705f; q = q * t + (-0.142248368f); q = q * t + 0.127414796f; q = q * t;
    const float e = __builtin_amdgcn_exp2f((v * v) * (-0.72134752044f));
    const float mm = v * (q * e);
    return v < 0.f ? mm : v - mm;
}
__device__ __forceinline__ void rope_cs(int s, int j, float& c, float& sn) {
    const int gr = s >> 6, gc = s & 63;
    const int i = j & 15;
    const float invf = exp2f(-(float)i * (13.287712379549449f / 16.f));
    const float ang = (float)(j < 16 ? gr : gc) * invf;
    sincosf(ang, &sn, &c);
}

template <class Epi>
__device__ __forceinline__ void ngemm(const bf16_t* __restrict__ A, int lda, const bf16_t* __restrict__ Bt, int ldb, int M, int N, int K, const Epi& epi, float* rs = nullptr) {
    int tid_ = threadIdx.x; asm volatile("" : "+v"(tid_)); const int tid = tid_, wid = tid >> 6, lane = tid & 63, fr = lane & 15, fq = lane >> 4;
    const int tilesM = M / 128, tilesN = N / 256, nt = tilesM * tilesN;
    for (int t = blockIdx.x; t < nt; t += gridDim.x) {
        const int tm = t % tilesM, tn = t / tilesM;
        const int row0 = tm * 128 + (wid >> 2) * 64, col0 = tn * 256 + (wid & 3) * 64;
        if (Epi::PRO) {
            __syncthreads();
            const int r = tid >> 2, part = tid & 3, len = K >> 2;
            const bf16_t* ar = A + (size_t)(tm * 128 + r) * lda + part * len;
            float ss = 0.f;
            for (int k = 0; k < len; k += 8) { const bf16x8 v = *(const bf16x8*)(ar + k);
#pragma unroll
                for (int e = 0; e < 8; ++e) { const float f = bf2f((bf16_t)v[e]); ss += f * f; } }
            ss += __shfl_xor(ss, 1); ss += __shfl_xor(ss, 2);
            if (part == 0) rs[r] = rsqrtf(ss / (float)K + EPS);
            __syncthreads();
        }
        f32x4 acc[4][4];
#pragma unroll
        for (int i = 0; i < 4; ++i)
#pragma unroll
            for (int j = 0; j < 4; ++j) acc[i][j] = (f32x4){0.f, 0.f, 0.f, 0.f};
        const bf16_t* ap = A + (size_t)(row0 + fr) * lda + fq * 8;
        const bf16_t* bp = Bt + (size_t)(col0 + fr) * ldb + fq * 8;
        for (int k0 = 0; k0 < K; k0 += 32) {
            bf16x8 a[4], b[4];
#pragma unroll
            for (int i = 0; i < 4; ++i) a[i] = *(const bf16x8*)(ap + (size_t)i * 16 * lda + k0);
#pragma unroll
            for (int j = 0; j < 4; ++j) b[j] = *(const bf16x8*)(bp + (size_t)j * 16 * ldb + k0);
#pragma unroll
            for (int i = 0; i < 4; ++i)
#pragma unroll
                for (int j = 0; j < 4; ++j) acc[i][j] = __builtin_amdgcn_mfma_f32_16x16x32_bf16(b[j], a[i], acc[i][j], 0, 0, 0);
        }
#pragma unroll
        for (int i = 0; i < 4; ++i) {
            const int row = row0 + i * 16 + fr;
            const float rstd = Epi::PRO ? rs[row - tm * 128] : 1.f;
#pragma unroll
            for (int j = 0; j < 4; ++j) epi.quad(row, col0 + j * 16 + 4 * fq, acc[i][j] * rstd);
        }
    }
}

__device__ __forceinline__ void store_bf4(bf16_t* p, f32x4 v) { u32x2 w; w.x = pk2(v[0], v[1]); w.y = pk2(v[2], v[3]); *(u32x2*)p = w; }
__device__ __forceinline__ void store_bf8(bf16_t* p, f32x4 a, f32x4 b) { u32x4 w; w.x = pk2(a[0], a[1]); w.y = pk2(a[2], a[3]); w.z = pk2(b[0], b[1]); w.w = pk2(b[2], b[3]); *(u32x4*)p = w; }
__device__ __forceinline__ void load_bf8(const bf16_t* p, f32x4& a, f32x4& b) { const u32x4 g = *(const u32x4*)p;
    a = (f32x4){__uint_as_float(g.x << 16), __uint_as_float(g.x & 0xffff0000u), __uint_as_float(g.y << 16), __uint_as_float(g.y & 0xffff0000u)};
    b = (f32x4){__uint_as_float(g.z << 16), __uint_as_float(g.z & 0xffff0000u), __uint_as_float(g.w << 16), __uint_as_float(g.w & 0xffff0000u)}; }

struct EpiInproj {
    static constexpr bool MID = false, PRO = false;
    bf16_t* P; int ldp; int gate0;
    __device__ __forceinline__ void quad(int row, int col, f32x4 v) const {
        if (col >= gate0) { v[0] = sigmoidf_(v[0]); v[1] = sigmoidf_(v[1]); v[2] = sigmoidf_(v[2]); v[3] = sigmoidf_(v[3]); }
        store_bf4(P + (size_t)row * ldp + col, v);
    }
    __device__ __forceinline__ void oct(int row, int col, f32x4 a, f32x4 b) const {
        if (col >= gate0) {
#pragma unroll
            for (int e = 0; e < 4; ++e) { a[e] = sigmoidf_(a[e]); b[e] = sigmoidf_(b[e]); } }
        store_bf8(P + (size_t)row * ldp + col, a, b);
    }
};
struct EpiMlaQ {
    static constexpr bool MID = false, PRO = true;
    bf16_t* Q; const float* rope;
    __device__ __forceinline__ void quad(int row, int col, f32x4 v) const {
        v = v * MLA_QSCALE;
        const int d = col % 192;
        if (d >= 128) {
            const int j = (d - 128) >> 1, s = row & (SEQ - 1);
            const f32x4 cs = *(const f32x4*)(rope + ((size_t)s * 32 + j) * 2);
            const f32x4 o = {v[0] * cs[0] - v[1] * cs[1], v[0] * cs[1] + v[1] * cs[0], v[2] * cs[2] - v[3] * cs[3], v[2] * cs[3] + v[3] * cs[2]};
            v = o;
        }
        store_bf4(Q + (size_t)row * MQW + col, v);
    }
    __device__ __forceinline__ void oct(int row, int col, f32x4 a, f32x4 b) const {
        a = a * MLA_QSCALE; b = b * MLA_QSCALE;
        const int d = col % 192;
        if (d >= 128) {
            const int j = (d - 128) >> 1, s = row & (SEQ - 1);
            const f32x4 c0 = *(const f32x4*)(rope + ((size_t)s * 32 + j) * 2), c1 = *(const f32x4*)(rope + ((size_t)s * 32 + j + 2) * 2);
            const f32x4 oa = {a[0] * c0[0] - a[1] * c0[1], a[0] * c0[1] + a[1] * c0[0], a[2] * c0[2] - a[3] * c0[3], a[2] * c0[3] + a[3] * c0[2]};
            const f32x4 ob = {b[0] * c1[0] - b[1] * c1[1], b[0] * c1[1] + b[1] * c1[0], b[2] * c1[2] - b[3] * c1[3], b[2] * c1[3] + b[3] * c1[2]};
            a = oa; b = ob;
        }
        store_bf8(Q + (size_t)row * MQW + col, a, b);
    }
};
struct EpiMlaKV {
    static constexpr bool MID = false, PRO = true;
    bf16_t* KV; int row_off;
    __device__ __forceinline__ void quad(int row, int col, f32x4 v) const { store_bf4(KV + (size_t)(row_off + row) * MKVW + col, v); }
    __device__ __forceinline__ void oct(int row, int col, f32x4 a, f32x4 b) const { store_bf8(KV + (size_t)(row_off + row) * MKVW + col, a, b); }
};
template <int STEP> struct EpiMerge {
    static constexpr bool MID = false, PRO = false;
    bf16_t* Y; const bf16_t* P;
    __device__ __forceinline__ void quad(int row, int col, f32x4 v) const {
        const u32x2 g = *(const u32x2*)(P + (size_t)row * NP + (STEP == 0 ? PC_GA : PC_GB) + col);
        const f32x4 gv = {__uint_as_float(g.x << 16), __uint_as_float(g.x & 0xffff0000u), __uint_as_float(g.y << 16), __uint_as_float(g.y & 0xffff0000u)};
        v = v * gv;
        if (STEP == 1) {
            const u32x2 y = *(const u32x2*)(Y + (size_t)row * DM + col);
            v[0] += __uint_as_float(y.x << 16); v[1] += __uint_as_float(y.x & 0xffff0000u); v[2] += __uint_as_float(y.y << 16); v[3] += __uint_as_float(y.y & 0xffff0000u);
        }
        store_bf4(Y + (size_t)row * DM + col, v);
    }
};
struct EpiMergeF {
    static constexpr bool MID = true, PRO = false;
    bf16_t* Y; const bf16_t* P;
    __device__ __forceinline__ static f32x4 ld4(const bf16_t* q) { const u32x2 g = *(const u32x2*)q;
        return (f32x4){__uint_as_float(g.x << 16), __uint_as_float(g.x & 0xffff0000u), __uint_as_float(g.y << 16), __uint_as_float(g.y & 0xffff0000u)}; }
    __device__ __forceinline__ void midquad(int row, int col, f32x4& v) const {
        const f32x4 ga = ld4(P + (size_t)row * NP + PC_GA + col), gb = ld4(P + (size_t)row * NP + PC_GB + col);
#pragma unroll
        for (int e = 0; e < 4; ++e) v[e] *= ga[e] * __builtin_amdgcn_rcpf(fmaxf(gb[e], 1e-30f));
    }
    __device__ __forceinline__ void quad(int row, int col, f32x4 v) const { store_bf4(Y + (size_t)row * DM + col, v * ld4(P + (size_t)row * NP + PC_GB + col)); }
    __device__ __forceinline__ void midload(int row, int col, u32x4& ga, u32x4& gb) const { ga = *(const u32x4*)(P + (size_t)row * NP + PC_GA + col); gb = *(const u32x4*)(P + (size_t)row * NP + PC_GB + col); }
    __device__ __forceinline__ static void midapply(const u32x4 ga, const u32x4 gb, f32x4& a, f32x4& b) {
        const unsigned a0 = ga[0], a1 = ga[1], a2 = ga[2], a3 = ga[3], b0 = gb[0], b1 = gb[1], b2 = gb[2], b3 = gb[3];
        const f32x4 sa0 = {__uint_as_float(a0 << 16), __uint_as_float(a0 & 0xffff0000u), __uint_as_float(a1 << 16), __uint_as_float(a1 & 0xffff0000u)};
        const f32x4 sa1 = {__uint_as_float(a2 << 16), __uint_as_float(a2 & 0xffff0000u), __uint_as_float(a3 << 16), __uint_as_float(a3 & 0xffff0000u)};
        const f32x4 sb0 = {__uint_as_float(b0 << 16), __uint_as_float(b0 & 0xffff0000u), __uint_as_float(b1 << 16), __uint_as_float(b1 & 0xffff0000u)};
        const f32x4 sb1 = {__uint_as_float(b2 << 16), __uint_as_float(b2 & 0xffff0000u), __uint_as_float(b3 << 16), __uint_as_float(b3 & 0xffff0000u)};
#pragma unroll
        for (int e = 0; e < 4; ++e) { a[e] *= sa0[e] * __builtin_amdgcn_rcpf(fmaxf(sb0[e], 1e-30f)); b[e] *= sa1[e] * __builtin_amdgcn_rcpf(fmaxf(sb1[e], 1e-30f)); }
    }
    __device__ __forceinline__ void oct(int row, int col, f32x4 a, f32x4 b) const { f32x4 g0, g1; load_bf8(P + (size_t)row * NP + PC_GB + col, g0, g1); store_bf8(Y + (size_t)row * DM + col, a * g0, b * g1); }
};
struct EpiStore {
    static constexpr bool MID = false, PRO = false;
    bf16_t* O; int ldo;
    __device__ __forceinline__ void quad(int row, int col, f32x4 v) const { store_bf4(O + (size_t)row * ldo + col, v); }
    __device__ __forceinline__ void oct(int row, int col, f32x4 a, f32x4 b) const { store_bf8(O + (size_t)row * ldo + col, a, b); }
};

namespace pg8 {
#define PG8_LAS __attribute__((address_space(3)))
constexpr int BM = 256, BK = 64, HALF = 128, HTB = HALF * BK * 2  , STAGE_BYTES = 8 * HTB, NXCD = 8, WGM = 8;

__host__ __device__ __forceinline__ int lds_byte(int r, int c) { const int st = (r >> 4) * 2 + (c >> 5), rr = r & 15, cc = c & 31, ob = rr * 64 + cc * 2; return st * 1024 + (ob ^ (((ob >> 9) & 1) << 5)); }
__host__ __device__ __forceinline__ void stage_rc(int b, int& R, int& C) { const int st = b / 1024, sb = b % 1024, swz = sb ^ (((sb >> 9) & 1) << 5); R = (st >> 1) * 16 + swz / 64; C = (st & 1) * 32 + (swz % 64) / 2; }
__host__ __device__ __forceinline__ int perm32(int rho) { const int n = rho >> 4, i = rho & 15; return 8 * (i >> 2) + 4 * n + (i & 3); }

struct Unit { int pm, pn, ui; };
struct Gemm { const bf16_t* A; const bf16_t* Bt; int M, N, K, lda, ldb; };

struct StaticOrder {
    int nM, nN, nwg, G, c;
    __host__ __device__ void init(int M, int N, int G_, int c_) { nM = M / BM; nN = N / BM; nwg = nM * nN; G = G_; c = c_; }
    __host__ __device__ bool next(int i, Unit& u) const {
        const long L = (long)i * G + c; if (L >= nwg) return false;
        int wgid = (int)L; { const int q = nwg / NXCD, r = nwg % NXCD, xcd = wgid % NXCD, off = wgid / NXCD; wgid = (xcd < r ? xcd * (q + 1) : r * (q + 1) + (xcd - r) * q) + off; }
        const int nig = WGM * nN, gid = wgid / nig, fm = gid * WGM, gsz = (nM - fm) < WGM ? (nM - fm) : WGM;
        u.pm = fm + ((wgid % nig) % gsz); u.pn = (wgid % nig) / gsz; u.ui = i; return true;
    }
    __device__ __forceinline__ void a_ready(const Unit&) const {}
    __device__ __forceinline__ void done(const Unit&) const {}
};
template <class Epi, class Sched, bool ALIGN_EPI = false, bool SP2 = false>
__device__ __forceinline__ void gemm_phase(PG8_LAS unsigned char* lds, const Gemm g, const Sched& S, const Epi& E) {
    int tid_ = threadIdx.x; asm volatile("" : "+v"(tid_)); const int tid = tid_, wid = __builtin_amdgcn_readfirstlane(tid >> 6), lane = tid & 63, wr = wid >> 2, wc = wid & 3, fr = lane & 15, fq = lane >> 4;
    const int K = g.K, nt = K / BK;
    unsigned voffA[2], voffB[2];
#pragma unroll
    for (int i = 0; i < 2; ++i) { int R, C; stage_rc(tid * 16 + i * 8192, R, C); const int Rb = Epi::PERM ? ((R & ~31) + perm32(R & 31)) : R;
        voffA[i] = (unsigned)(R * g.lda + C) * 2u; voffB[i] = (unsigned)(Rb * g.ldb + C) * 2u; }
    const size_t kstep = (size_t)(BK * 2);
    const size_t hstepA = (size_t)HALF * g.lda * 2, hstepB = (size_t)HALF * g.ldb * 2;
    const size_t tstepA = 2 * hstepA, tstepB = 2 * hstepB;
    const unsigned ldsw = (unsigned)wid * 1024u;
    const int aoff = lds_byte(wr * 64 + fr, fq * 8), boff = lds_byte(wc * 32 + fr, fq * 8);
#define PG8_SA(b, h) (((b) * 2 + (h)) * HTB)
#define PG8_SB(b, h) ((4 + (b) * 2 + (h)) * HTB)
#define PG8_STAGE(bufoff, gbase, voff) do { _Pragma("unroll") for (int _i = 0; _i < 2; ++_i) \
        __builtin_amdgcn_global_load_lds((const unsigned*)((const char*)(gbase) + (voff)[_i]), (PG8_LAS unsigned*)(lds + (bufoff) + ldsw + _i * 8192), 16, 0, 0); } while (0)
#define PG8_LDA(dst, b, h) do { _Pragma("unroll") for (int m = 0; m < 4; ++m) _Pragma("unroll") for (int k = 0; k < 2; ++k) dst[m][k] = *(const PG8_LAS bf16x8*)(lds + PG8_SA(b, h) + aoff + m * 2048 + k * 1024); } while (0)
#define PG8_LDB(dst, b, h) do { _Pragma("unroll") for (int n = 0; n < 2; ++n) _Pragma("unroll") for (int k = 0; k < 2; ++k) dst[n][k] = *(const PG8_LAS bf16x8*)(lds + PG8_SB(b, h) + boff + n * 2048 + k * 1024); } while (0)
#define PG8_MMA(ai, bj, At, Bt) do { __builtin_amdgcn_s_setprio(1); _Pragma("unroll") for (int m = 0; m < 4; ++m) _Pragma("unroll") for (int n = 0; n < 2; ++n) _Pragma("unroll") for (int k = 0; k < 2; ++k) \
        acc[ai][bj][m][n] = __builtin_amdgcn_mfma_f32_16x16x32_bf16(Bt[n][k], At[m][k], acc[ai][bj][m][n], 0, 0, 0); __builtin_amdgcn_s_setprio(0); } while (0)
#define PG8_WAIT_V(n) asm volatile("s_waitcnt vmcnt(" #n ")" ::: "memory")
#define PG8_WAIT_L(n) asm volatile("s_waitcnt lgkmcnt(" #n ")" ::: "memory")
#define PG8_BAR __builtin_amdgcn_s_barrier()
#define PG8_SCHED __builtin_amdgcn_sched_barrier(0)
    Unit cur, nxt; int ui = 0;
    if (!S.next(0, cur)) return;
    f32x4 acc[2][2][4][2];
#pragma unroll
    for (int a = 0; a < 2; ++a)
#pragma unroll
        for (int b = 0; b < 2; ++b)
#pragma unroll
            for (int m = 0; m < 4; ++m)
#pragma unroll
                for (int n = 0; n < 2; ++n) acc[a][b][m][n] = (f32x4){0.f, 0.f, 0.f, 0.f};
    bf16x8 At[4][2], B0[2][2], B1[2][2];
    const char* cA = (const char*)g.A + (size_t)cur.pm * tstepA; const char* cB = (const char*)g.Bt + (size_t)cur.pn * tstepB;
    S.a_ready(cur);
    if constexpr (SP2) {
        PG8_STAGE(PG8_SB(0, 0), cB, voffB); PG8_STAGE(PG8_SB(0, 1), cB + hstepB, voffB); PG8_STAGE(PG8_SA(0, 0), cA, voffA); PG8_STAGE(PG8_SA(0, 1), cA + hstepA, voffA);
        if (wr == 1) PG8_BAR;
        PG8_WAIT_V(2); PG8_BAR;
        PG8_STAGE(PG8_SB(1, 0), cB + kstep, voffB); PG8_STAGE(PG8_SA(1, 0), cA + kstep, voffA); PG8_STAGE(PG8_SB(1, 1), cB + hstepB + kstep, voffB);
        PG8_WAIT_V(6); PG8_BAR;
    } else {
        PG8_STAGE(PG8_SB(0, 0), cB, voffB); PG8_STAGE(PG8_SA(0, 0), cA, voffA); PG8_STAGE(PG8_SB(0, 1), cB + hstepB, voffB); PG8_STAGE(PG8_SA(0, 1), cA + hstepA, voffA);
        if (wr == 1) PG8_BAR;
        PG8_WAIT_V(4); PG8_BAR;
        PG8_STAGE(PG8_SB(1, 0), cB + kstep, voffB); PG8_STAGE(PG8_SA(1, 0), cA + kstep, voffA); PG8_STAGE(PG8_SB(1, 1), cB + hstepB + kstep, voffB);
        PG8_WAIT_V(6); PG8_BAR;
    }
    for (;;) {
        const bool has_next = S.next(ui + 1, nxt);
        const char* nA = has_next ? (const char*)g.A + (size_t)nxt.pm * tstepA : cA; const char* nB = has_next ? (const char*)g.Bt + (size_t)nxt.pn * tstepB : cB;
        for (int t = 0; t < nt; t += 2) {
            if constexpr (Epi::MID) { if (t == (nt >> 1)) { E.mid(acc, cur, wr, wc, fr, fq); } }
            const bool last = (t == nt - 2);
            const char* a1 = cA + (size_t)(t + 1) * kstep;
            const char* a2 = last ? nA : cA + (size_t)(t + 2) * kstep; const char* b2 = last ? nB : cB + (size_t)(t + 2) * kstep;
            const char* a3 = a2 + kstep; const char* b3 = b2 + kstep;
            if (last && has_next) S.a_ready(nxt);
            if constexpr (SP2) {
            PG8_LDB(B0, 0, 0); PG8_LDB(B1, 0, 1); PG8_SCHED; PG8_LDA(At, 0, 0); PG8_STAGE(PG8_SA(1, 1), a1 + hstepA, voffA);
            PG8_WAIT_V(8); PG8_WAIT_L(0); PG8_BAR; PG8_MMA(0, 0, At, B0); PG8_MMA(0, 1, At, B1); PG8_BAR; PG8_SCHED;
            PG8_LDA(At, 0, 1); PG8_STAGE(PG8_SB(0, 0), b2, voffB); PG8_STAGE(PG8_SB(0, 1), b2 + hstepB, voffB); PG8_STAGE(PG8_SA(0, 0), a2, voffA);
            PG8_WAIT_V(8); PG8_WAIT_L(0); PG8_BAR; PG8_MMA(1, 0, At, B0); PG8_MMA(1, 1, At, B1); PG8_BAR; PG8_SCHED;
            PG8_LDB(B0, 1, 0); PG8_LDB(B1, 1, 1); PG8_SCHED; PG8_LDA(At, 1, 0); PG8_STAGE(PG8_SA(0, 1), a2 + hstepA, voffA);
            PG8_WAIT_V(8); PG8_WAIT_L(0); PG8_BAR; PG8_MMA(0, 0, At, B0); PG8_MMA(0, 1, At, B1); PG8_BAR; PG8_SCHED;
            PG8_LDA(At, 1, 1); PG8_STAGE(PG8_SB(1, 0), b3, voffB); PG8_STAGE(PG8_SB(1, 1), b3 + hstepB, voffB); PG8_STAGE(PG8_SA(1, 0), a3, voffA);
            PG8_WAIT_V(8); PG8_WAIT_L(0); PG8_BAR; PG8_MMA(1, 0, At, B0); PG8_MMA(1, 1, At, B1); PG8_BAR; PG8_SCHED;
            } else {
            PG8_LDB(B0, 0, 0); PG8_SCHED; PG8_LDA(At, 0, 0); PG8_STAGE(PG8_SA(1, 1), a1 + hstepA, voffA);
            PG8_WAIT_L(8); PG8_BAR; PG8_WAIT_L(0); PG8_MMA(0, 0, At, B0); PG8_BAR; PG8_SCHED;
            PG8_LDB(B1, 0, 1); PG8_STAGE(PG8_SB(0, 0), b2, voffB);
            PG8_BAR; PG8_WAIT_L(0); PG8_MMA(0, 1, At, B1); PG8_BAR;
            PG8_LDA(At, 0, 1); PG8_STAGE(PG8_SA(0, 0), a2, voffA);
            PG8_BAR; PG8_WAIT_L(0); PG8_MMA(1, 0, At, B0); PG8_BAR; PG8_SCHED;
            PG8_STAGE(PG8_SB(0, 1), b2 + hstepB, voffB);
            PG8_WAIT_V(6); PG8_BAR; PG8_MMA(1, 1, At, B1); PG8_BAR;
            PG8_LDB(B0, 1, 0); PG8_SCHED; PG8_LDA(At, 1, 0); PG8_STAGE(PG8_SA(0, 1), a2 + hstepA, voffA);
            PG8_WAIT_L(8); PG8_BAR; PG8_WAIT_L(0); PG8_MMA(0, 0, At, B0); PG8_BAR; PG8_SCHED;
            PG8_LDB(B1, 1, 1); PG8_STAGE(PG8_SB(1, 0), b3, voffB);
            PG8_BAR; PG8_WAIT_L(0); PG8_MMA(0, 1, At, B1); PG8_BAR;
            PG8_LDA(At, 1, 1); PG8_STAGE(PG8_SA(1, 0), a3, voffA);
            PG8_BAR; PG8_WAIT_L(0); PG8_MMA(1, 0, At, B0); PG8_BAR; PG8_SCHED;
            PG8_STAGE(PG8_SB(1, 1), b3 + hstepB, voffB);
            PG8_WAIT_V(6); PG8_BAR; PG8_MMA(1, 1, At, B1); PG8_BAR;
            }
        }
        if constexpr (ALIGN_EPI) { if (wr == 0) PG8_BAR; }
        if constexpr (!Epi::AFTER_DRAIN) { E(acc, cur, wr, wc, fr, fq); S.done(cur); }
        if (!has_next) break;
#pragma unroll
        for (int a = 0; a < 2; ++a)
#pragma unroll
            for (int b = 0; b < 2; ++b)
#pragma unroll
                for (int m = 0; m < 4; ++m)
#pragma unroll
                    for (int n = 0; n < 2; ++n) acc[a][b][m][n] = (f32x4){0.f, 0.f, 0.f, 0.f};
        cur = nxt; cA = nA; cB = nB; ++ui;
        if constexpr (ALIGN_EPI) { if (wr == 1) PG8_BAR; }
    }
    PG8_WAIT_V(0);
    if constexpr (!ALIGN_EPI) { if (wr == 0) PG8_BAR; }
    PG8_BAR;
    if constexpr (Epi::AFTER_DRAIN) { E.fused(acc, cur, wr, wc, fr, fq, lds, wid, lane); S.done(cur); }
#undef PG8_SA
#undef PG8_SB
#undef PG8_STAGE
#undef PG8_LDA
#undef PG8_LDB
#undef PG8_MMA
#undef PG8_WAIT_V
#undef PG8_WAIT_L
#undef PG8_BAR
#undef PG8_SCHED
}
}

template <class Q, bool RS> struct EpiQuad {
    static constexpr bool PERM = true, AFTER_DRAIN = false, MID = Q::MID;
    Q q; const float* rs;
    __device__ __forceinline__ void mid(f32x4 (&acc)[2][2][4][2], const pg8::Unit& u, int wr, int wc, int fr, int fq, bool inv = false) const {
        if constexpr (Q::MID) {
            asm volatile("" : "+v"(fr), "+v"(fq));
#pragma unroll
            for (int ai = 0; ai < 2; ++ai) {
                u32x4 ga[4][2], gb[4][2];
#pragma unroll
                for (int m = 0; m < 4; ++m)
#pragma unroll
                    for (int bj = 0; bj < 2; ++bj) q.midload(u.pm * 256 + ai * 128 + wr * 64 + m * 16 + fr, u.pn * 256 + bj * 128 + wc * 32 + 8 * fq, ga[m][bj], gb[m][bj]);
#pragma unroll
                for (int m = 0; m < 4; ++m)
#pragma unroll
                    for (int bj = 0; bj < 2; ++bj) { if (!inv) q.midapply(ga[m][bj], gb[m][bj], acc[ai][bj][m][0], acc[ai][bj][m][1]); else q.midapply(gb[m][bj], ga[m][bj], acc[ai][bj][m][0], acc[ai][bj][m][1]); }
                __builtin_amdgcn_sched_barrier(0);
            }
        }
    }
    __device__ __forceinline__ void operator()(const f32x4 (&acc)[2][2][4][2], const pg8::Unit& u, int wr, int wc, int fr, int fq) const {
        if constexpr (Q::MID) asm volatile("" : "+v"(fr), "+v"(fq));
#pragma unroll
        for (int ai = 0; ai < 2; ++ai)
#pragma unroll
            for (int m = 0; m < 4; ++m) {
                const int rl = ai * 128 + wr * 64 + m * 16 + fr, row = u.pm * 256 + rl;
                const float r = RS ? rs[u.ui * 256 + rl] : 1.f;
#pragma unroll
                for (int bj = 0; bj < 2; ++bj) q.oct(row, u.pn * 256 + bj * 128 + wc * 32 + 8 * fq, acc[ai][bj][m][0] * r, acc[ai][bj][m][1] * r);
            }
    }
};
__device__ __forceinline__ void unit_row_rstd(const bf16_t* __restrict__ A, int lda, int K, const pg8::StaticOrder& S, float* rs) {
    pg8::Unit u;
    int tid_ = threadIdx.x; asm volatile("" : "+v"(tid_)); const int tid = tid_, r = tid >> 1, part = tid & 1, len = K >> 1;
    for (int i = 0; S.next(i, u); ++i) {
        const bf16_t* ar = A + (size_t)(u.pm * 256 + r) * lda + part * len;
        float ss = 0.f;
        for (int k = 0; k < len; k += 8) { const bf16x8 v = *(const bf16x8*)(ar + k);
#pragma unroll
            for (int e = 0; e < 8; ++e) { const float f = bf2f((bf16_t)v[e]); ss += f * f; } }
        ss += __shfl_xor(ss, 1);
        if (part == 0) rs[i * 256 + r] = rsqrtf(ss / (float)K + EPS);
    }
    __syncthreads();
}
template <class Q, bool RS>
__device__ __forceinline__ void run_gemm(unsigned char* lds, const bf16_t* A, int lda, const bf16_t* Bt, int ldb, int M, int N, int K, const Q& q, int rot = 0) {
    pg8::Gemm g{A, Bt, M, N, K, lda, ldb};
    pg8::StaticOrder S; S.init(M, N, (int)gridDim.x, (int)((blockIdx.x + gridDim.x - (unsigned)rot % gridDim.x) % gridDim.x));
    float* rs = (float*)(lds + 131072);
    if (RS) unit_row_rstd(A, lda, K, S, rs);
    EpiQuad<Q, RS> E{q, rs};
    pg8::gemm_phase<EpiQuad<Q, RS>, pg8::StaticOrder, true, true>((PG8_LAS unsigned char*)lds, g, S, E);
}

__device__ __forceinline__ int win_dest_row(int n) {
    if (n < 1024) return PC_QA + n;
    if (n < 2048) return PC_KA + (n - 1024);
    if (n < 3072) return PC_VA + (n - 2048);
    if (n < 3840) return PC_CQ + (n - 3072);
    if (n < 4352) return PC_CKV + (n - 3840);
    if (n < 4416) { const int r = n - 4352; return PC_KPE + (r < 32 ? 2 * r : 2 * (r - 32) + 1); }
    if (n < 6464) return PC_GA + (n - 4416);
    return PC_GB + (n - 6464);
}
__device__ __forceinline__ int wq_dest_row(int n) {
    const int h = n / 192, d = n % 192;
    if (d < 128) return n;
    const int r = d - 128;
    return h * 192 + 128 + (r < 32 ? 2 * r : 2 * (r - 32) + 1);
}
template <int MODE>
__device__ __forceinline__ void transpose_item(const float* __restrict__ W, int K, int N, bf16_t* __restrict__ WT, const float* __restrict__ kscale, float* scr, int item, int lane, int ldt = 0, int koff = 0) {
    if (ldt == 0) ldt = K;
    const int nblk = N / 32, kb = item / nblk, nb = item % nblk, k0 = 64 * kb, n0 = 32 * nb;
#pragma unroll
    for (int i = 0; i < 8; ++i) { const int kk = 8 * i + (lane >> 3), n4 = (lane & 7) * 4;
        f32x4 w = *(const f32x4*)(W + (size_t)(k0 + kk) * N + n0 + n4); if (kscale) w = w * kscale[k0 + kk];
        scr[kk * 33 + n4] = w[0]; scr[kk * 33 + n4 + 1] = w[1]; scr[kk * 33 + n4 + 2] = w[2]; scr[kk * 33 + n4 + 3] = w[3]; }
    __builtin_amdgcn_s_waitcnt(0xc07f); asm volatile("" ::: "memory");
    const int c = lane & 7;
#pragma unroll
    for (int j = 0; j < 4; ++j) {
        const int n = (lane >> 3) + 8 * j; const float* s = scr + (8 * c) * 33 + n;
        u32x4 o; o.x = pk2(s[0 * 33], s[1 * 33]); o.y = pk2(s[2 * 33], s[3 * 33]); o.z = pk2(s[4 * 33], s[5 * 33]); o.w = pk2(s[6 * 33], s[7 * 33]);
        const int ns = n0 + n;
        const int dr = MODE == 1 ? win_dest_row(ns) : (MODE == 2 ? wq_dest_row(ns) : ns);
        *(u32x4*)(WT + (size_t)dr * ldt + koff + k0 + 8 * c) = o;
    }
    __builtin_amdgcn_s_waitcnt(0xc07f); asm volatile("" ::: "memory");
}

__device__ __forceinline__ void phase0(const Params& p, unsigned char* lds) {
    int tid_ = threadIdx.x; asm volatile("" : "+v"(tid_)); const int tid = tid_, lane = tid & 63, wid = tid >> 6;
    unsigned char* ws = p.ws;
    {
        float* sl = (float*)lds;
        float* red = sl + 9 * 2048;
        const float* c = p.in[1]; const float* cctx = p.in[3]; const float* wada = p.in[4]; const float* bada = p.in[5];
        float* mod = (float*)(ws + WS_MOD);
        if (blockIdx.x < 192) {
            for (int i = tid; i < 9 * 2048; i += NTHREADS) { const int r = i >> 11, k = i & 2047; const float v = r < 8 ? c[r * DM + k] : cctx[k]; sl[i] = silu_(v); }
            __syncthreads();
            for (int it = blockIdx.x; it < 192; it += gridDim.x) {
                const int kq = tid >> 4, c4 = tid & 15, col = it * 64 + c4 * 4;
                f32x4 acc[9];
#pragma unroll
                for (int r = 0; r < 9; ++r) acc[r] = (f32x4){0.f, 0.f, 0.f, 0.f};
#pragma unroll 8
                for (int i = 0; i < 64; ++i) {
                    const int k = kq + 32 * i;
                    const f32x4 w = *(const f32x4*)(wada + (size_t)k * 12288 + col);
#pragma unroll
                    for (int r = 0; r < 9; ++r) acc[r] += w * sl[r * 2048 + k];
                }
#pragma unroll
                for (int r = 0; r < 9; ++r) {
#pragma unroll
                    for (int e = 0; e < 4; ++e) { float v = acc[r][e]; v += __shfl_xor(v, 16); v += __shfl_xor(v, 32); acc[r][e] = v; }
                    if (lane < 16) *(f32x4*)(red + (wid * 9 + r) * 64 + c4 * 4) = acc[r];
                }
                __syncthreads();
                for (int o = tid; o < 9 * 64; o += NTHREADS) {
                    const int r = o >> 6, cc = o & 63;
                    float sum = bada[it * 64 + cc];
                    for (int q = 0; q < 8; ++q) sum += red[(q * 9 + r) * 64 + cc];
                    mod[(size_t)r * 12288 + it * 64 + cc] = sum;
                }
                __syncthreads();
            }
        }
        __syncthreads();
    }
    {
        float* scr = (float*)lds + wid * (64 * 33);
        const int gw = blockIdx.x * NWAVES + wid, NGW = gridDim.x * NWAVES;
        constexpr int I_IN = 32 * (IN_COLS / 32), I_QB = 12 * 48, I_KVB = 8 * 64, I_AB = 16 * 64, I_OO = 32 * 64;
        constexpr int NITEMS = I_IN + I_QB + I_KVB + 2 * I_AB + 2 * I_OO;
        for (int it = gw; it < NITEMS; it += NGW) {
            int r = it;
            if (r < I_IN) { transpose_item<1>(p.in[10], DM, IN_COLS, (bf16_t*)(ws + WS_WIN), nullptr, scr, r, lane); continue; } r -= I_IN;
            if (r < I_QB) { transpose_item<2>(p.in[13], QR, MQW, (bf16_t*)(ws + WS_WQB), p.in[12], scr, r, lane); continue; } r -= I_QB;
            if (r < I_KVB) { transpose_item<0>(p.in[15], KVR, MKVW, (bf16_t*)(ws + WS_WKVB), p.in[14], scr, r, lane); continue; } r -= I_KVB;
            if (r < I_AB) { transpose_item<0>(p.in[16], 1024, DM, (bf16_t*)(ws + WS_WA), nullptr, scr, r, lane, 2048, 0); continue; } r -= I_AB;
            if (r < I_AB) { transpose_item<0>(p.in[17], 1024, DM, (bf16_t*)(ws + WS_WA), nullptr, scr, r, lane, 2048, 1024); continue; } r -= I_AB;
            if (r < I_OO) { transpose_item<0>(p.in[18], DM, DM, (bf16_t*)(ws + WS_WO), nullptr, scr, r, lane); continue; } r -= I_OO;
            transpose_item<0>(p.in[19], DM, DM, (bf16_t*)(ws + WS_WPQ), nullptr, scr, r, lane);
        }
    }
    {
        const size_t gt = (size_t)blockIdx.x * NTHREADS + tid, NGT = (size_t)gridDim.x * NTHREADS;
        u32x4* padp = (u32x4*)(ws + WS_WIN + (size_t)(PC_KPE + 64) * DM * 2);
        for (size_t i = gt; i < (size_t)192 * DM * 2 / 16; i += NGT) padp[i] = (u32x4){0u, 0u, 0u, 0u};
        float* rope = (float*)(ws + WS_ROPE);
        for (size_t i = gt; i < (size_t)SEQ * 32; i += NGT) { float c, sn; rope_cs((int)(i >> 5), (int)(i & 31), c, sn); rope[i * 2] = c; rope[i * 2 + 1] = sn; }
        const float* sk = p.in[20]; bf16_t* skb = (bf16_t*)(ws + WS_SUBK);
        for (size_t i = gt; i < 262144 / 4; i += NGT) { const f32x4 v = *(const f32x4*)(sk + i * 4); store_bf4(skb + i * 4, v); }
    }
}

__device__ __forceinline__ void phase1(const Params& p) {
    int tid_ = threadIdx.x; asm volatile("" : "+v"(tid_)); const int tid = tid_, lane = tid & 63, wid = tid >> 6;
    const int gw = blockIdx.x * NWAVES + wid, NGW = gridDim.x * NWAVES;
    const float* mod = (const float*)(p.ws + WS_MOD); const float* g = p.in[6];
    bf16_t* H = (bf16_t*)(p.ws + WS_H);
    const int per = (TA + NGW - 1) / NGW;
    int curb = -1; f32x4 G[8], S[8];
    for (int i = 0; i < per; ++i) {
        const int m = gw * per + i; if (m >= TA) break;
        const float* xr = m < TL ? p.in[0] + (size_t)m * DM : p.in[2] + (size_t)(m - TL) * DM;
        const int mr = m < TL ? m / SEQ : 8;
        if (mr != curb) { curb = mr; const float* sh = mod + (size_t)mr * 12288, * sc = sh + 2048;
#pragma unroll
            for (int j = 0; j < 8; ++j) { const int c = j * 256 + lane * 4; G[j] = *(const f32x4*)(g + c) * (*(const f32x4*)(sc + c) + 1.f); S[j] = *(const f32x4*)(sh + c); } }
        f32x4 v[8]; float ss = 0.f;
#pragma unroll
        for (int j = 0; j < 8; ++j) { v[j] = *(const f32x4*)(xr + j * 256 + lane * 4); ss += v[j][0] * v[j][0] + v[j][1] * v[j][1] + v[j][2] * v[j][2] + v[j][3] * v[j][3]; }
        const float rstd = rsqrtf(wave_sum_dpp(ss) * (1.f / DM) + EPS);
#pragma unroll
        for (int j = 0; j < 8; ++j) store_bf4(H + (size_t)m * DM + j * 256 + lane * 4, (v[j] * rstd) * G[j] + S[j]);
    }
}

__device__ __forceinline__ void kpe_pass(const Params& p) {
    const size_t gt = (size_t)blockIdx.x * NTHREADS + threadIdx.x, NGT = (size_t)gridDim.x * NTHREADS;
    const bf16_t* PL = (const bf16_t*)(p.ws + WS_PL); const bf16_t* PCx = (const bf16_t*)(p.ws + WS_PC);
    bf16_t* KPE = (bf16_t*)(p.ws + WS_KPE); const float* rope = (const float*)(p.ws + WS_ROPE);
    for (size_t i = gt; i < (size_t)TA * 32; i += NGT) {
        const int m = (int)(i >> 5), j = (int)(i & 31);
        unsigned w;
        if (m < TL) {
            w = *(const unsigned*)(PL + (size_t)m * NP + PC_KPE + 2 * j);
            const float x1 = __uint_as_float(w << 16), x2 = __uint_as_float(w & 0xffff0000u);
            const float c = rope[((size_t)(m & (SEQ - 1)) * 32 + j) * 2], s = rope[((size_t)(m & (SEQ - 1)) * 32 + j) * 2 + 1];
            w = pk2(x1 * c - x2 * s, x1 * s + x2 * c);
        } else w = *(const unsigned*)(PCx + (size_t)(m - TL) * NPC + PC_KPE + 2 * j);
        *(unsigned*)(KPE + (size_t)m * 64 + 2 * j) = w;
    }
}

__device__ __forceinline__ float dot_bf16x8(const bf16x8 k, const float* q) {
    float s = 0.f;
#pragma unroll
    for (int e = 0; e < 8; ++e) s += q[e] * bf2f((bf16_t)k[e]);
    return s;
}

__device__ __forceinline__ void na_naive(const Params& p, unsigned char* lds) {
    int tid_ = threadIdx.x; asm volatile("" : "+v"(tid_)); const int tid = tid_, lane = tid & 63, wid = tid >> 6;
    const int gw = blockIdx.x * NWAVES + wid, NGW = gridDim.x * NWAVES;
    const bf16_t* PL = (const bf16_t*)(p.ws + WS_PL); const bf16_t* PCx = (const bf16_t*)(p.ws + WS_PC);
    bf16_t* OA = (bf16_t*)(p.ws + WS_OA);
    const float* rpb = p.in[11];
    float* qs = (float*)lds + wid * 512;
    float* ps = qs + 64;
    for (int it = gw; it < TL * 16; it += NGW) {
        const int h = it & 15, m = it >> 4, b = m / SEQ, s = m % SEQ, r = s >> 6, qc = s & 63;
        int r0 = r - 4; r0 = r0 < 0 ? 0 : (r0 > GROWS - 8 ? GROWS - 8 : r0);
        int w0 = qc - 8; w0 = w0 < 0 ? 0 : (w0 > GW - 16 ? GW - 16 : w0);
        qs[lane] = bf2f(PL[(size_t)m * NP + PC_QA + h * 64 + lane]);
        __builtin_amdgcn_s_waitcnt(0xc07f); asm volatile("" ::: "memory");
        float sc[6];
#pragma unroll
        for (int i = 0; i < 6; ++i) {
            const int kk = lane + 64 * i;
            const bf16_t* kp; float bias = 0.f;
            if (i < 2) { const int dy = kk >> 4, dx = kk & 15, kr = r0 + dy, kc = w0 + dx;
                kp = PL + (size_t)(b * SEQ + kr * 64 + kc) * NP + PC_KA + h * 64;
                bias = rpb[(h * 15 + (kr - r + 7)) * 31 + (kc - qc + 15)]; }
            else kp = PCx + (size_t)(b * CTX + (kk - 128)) * NPC + PC_KA + h * 64;
            float d = 0.f;
#pragma unroll
            for (int e = 0; e < 8; ++e) d += dot_bf16x8(*(const bf16x8*)(kp + e * 8), qs + e * 8);
            sc[i] = d * NA_SCALE + bias;
        }
        float mx = sc[0];
#pragma unroll
        for (int i = 1; i < 6; ++i) mx = fmaxf(mx, sc[i]);
        mx = wave_max(mx);
        float sum = 0.f;
#pragma unroll
        for (int i = 0; i < 6; ++i) { sc[i] = __expf(sc[i] - mx); sum += sc[i]; ps[lane + 64 * i] = sc[i]; }
        sum = wave_sum(sum);
        __builtin_amdgcn_s_waitcnt(0xc07f); asm volatile("" ::: "memory");
        float o = 0.f;
        for (int kk = 0; kk < 128; ++kk) { const int kr = r0 + (kk >> 4), kc = w0 + (kk & 15);
            o += ps[kk] * bf2f(PL[(size_t)(b * SEQ + kr * 64 + kc) * NP + PC_VA + h * 64 + lane]); }
        for (int kk = 0; kk < 256; ++kk) o += ps[128 + kk] * bf2f(PCx[(size_t)(b * CTX + kk) * NPC + PC_VA + h * 64 + lane]);
        OA[(size_t)m * 2048 + h * 64 + lane] = (bf16_t)f2bf(o / sum);
        __builtin_amdgcn_s_waitcnt(0xc07f); asm volatile("" ::: "memory");
    }
}

__device__ __forceinline__ void mla_naive(const Params& p, unsigned char* lds) {
    int tid_ = threadIdx.x; asm volatile("" : "+v"(tid_)); const int tid = tid_, lane = tid & 63, wid = tid >> 6;
    const bf16_t* QM = (const bf16_t*)(p.ws + WS_QM); const bf16_t* KVM = (const bf16_t*)(p.ws + WS_KVM); const bf16_t* KPE = (const bf16_t*)(p.ws + WS_KPE);
    bf16_t* OB = (bf16_t*)(p.ws + WS_OB);
    float* qs = (float*)lds + wid * (192 + 2304);
    float* ps = qs + 192;
    for (int it = blockIdx.x; it < NB * 8 * (SEQ / 8); it += gridDim.x) {
        const int qg = it % (SEQ / 8), bh = it / (SEQ / 8), h = bh & 7, b = bh >> 3;
        const int m = b * SEQ + qg * 8 + wid;
#pragma unroll
        for (int i = 0; i < 3; ++i) qs[lane + 64 * i] = bf2f(QM[(size_t)m * MQW + h * 192 + lane + 64 * i]);
        __builtin_amdgcn_s_waitcnt(0xc07f); asm volatile("" ::: "memory");
        float mx = -INFINITY;
        for (int i = 0; i < 36; ++i) {
            const int kk = lane + 64 * i;
            const int krow = kk < SEQ ? b * SEQ + kk : TL + b * CTX + (kk - SEQ);
            const bf16_t* kn = KVM + (size_t)krow * MKVW + h * 256; const bf16_t* kp = KPE + (size_t)krow * 64;
            float d = 0.f;
#pragma unroll
            for (int e = 0; e < 16; ++e) d += dot_bf16x8(*(const bf16x8*)(kn + e * 8), qs + e * 8);
#pragma unroll
            for (int e = 0; e < 8; ++e) d += dot_bf16x8(*(const bf16x8*)(kp + e * 8), qs + 128 + e * 8);
            ps[kk] = d; mx = fmaxf(mx, d);
        }
        mx = wave_max(mx);
        float sum = 0.f;
        for (int i = 0; i < 36; ++i) { const float e = exp2f(ps[lane + 64 * i] - mx); sum += e; ps[lane + 64 * i] = e; }
        sum = wave_sum(sum);
        __builtin_amdgcn_s_waitcnt(0xc07f); asm volatile("" ::: "memory");
        float o0 = 0.f, o1 = 0.f;
        const bf16_t* vb = KVM + h * 256 + 128 + lane;
        for (int kk = 0; kk < SEQ; ++kk) { const bf16_t* vp = vb + (size_t)(b * SEQ + kk) * MKVW; const float pp = ps[kk]; o0 += pp * bf2f(vp[0]); o1 += pp * bf2f(vp[64]); }
        for (int kk = 0; kk < CTX; ++kk) { const bf16_t* vp = vb + (size_t)(TL + b * CTX + kk) * MKVW; const float pp = ps[SEQ + kk]; o0 += pp * bf2f(vp[0]); o1 += pp * bf2f(vp[64]); }
        const float inv = 1.f / sum;
        OB[(size_t)m * 2048 + h * 128 + lane] = (bf16_t)f2bf(o0 * inv);
        OB[(size_t)m * 2048 + h * 128 + 64 + lane] = (bf16_t)f2bf(o1 * inv);
        __builtin_amdgcn_s_waitcnt(0xc07f); asm volatile("" ::: "memory");
    }
}


typedef float f32x16 __attribute__((ext_vector_type(16)));
typedef short s16x4 __attribute__((ext_vector_type(4)));
typedef float f32x2_t __attribute__((ext_vector_type(2)));
typedef __bf16 bf16x2_t __attribute__((ext_vector_type(2)));
#define LAS3 __attribute__((address_space(3)))
__device__ __forceinline__ unsigned cvtpk(float lo, float hi) { f32x2_t v = {lo, hi}; bf16x2_t b = __builtin_convertvector(v, bf16x2_t); return __builtin_bit_cast(unsigned, b); }
__device__ __forceinline__ s16x4 vtr(const LAS3 unsigned char* p) { return __builtin_bit_cast(s16x4, __builtin_amdgcn_ds_read_tr16_b64_v4i16((LAS3 s16x4*)p)); }
__device__ __forceinline__ float max16(const f32x16& a) {
    float m0 = fmaxf(fmaxf(a[0], a[1]), fmaxf(a[2], a[3])), m1 = fmaxf(fmaxf(a[4], a[5]), fmaxf(a[6], a[7]));
    float m2 = fmaxf(fmaxf(a[8], a[9]), fmaxf(a[10], a[11])), m3 = fmaxf(fmaxf(a[12], a[13]), fmaxf(a[14], a[15]));
    return fmaxf(fmaxf(m0, m1), fmaxf(m2, m3));
}
__device__ __forceinline__ bf16x8 pfrag(const f32x16& a, int s) {
    u32x4 w; w.x = cvtpk(a[8 * s + 0], a[8 * s + 1]); w.y = cvtpk(a[8 * s + 2], a[8 * s + 3]); w.z = cvtpk(a[8 * s + 4], a[8 * s + 5]); w.w = cvtpk(a[8 * s + 6], a[8 * s + 7]);
    return __builtin_bit_cast(bf16x8, w);
}

__device__ __forceinline__ void mla_flash(const Params& p, unsigned char* lds_) {
    int tid_ = threadIdx.x; asm volatile("" : "+v"(tid_)); const int tid = tid_, lane = tid & 63, wid = tid >> 6, r32 = lane & 31, hi = lane >> 5;
    LAS3 unsigned char* lds = (LAS3 unsigned char*)lds_;
    constexpr int KP = 400, VP = 320, KBYTES = 64 * KP, VBYTES = 64 * VP, STG = KBYTES + VBYTES, NT = (SEQ + CTX) / 64;
    const bf16_t* QM = (const bf16_t*)(p.ws + WS_QM); const bf16_t* KVM = (const bf16_t*)(p.ws + WS_KVM); const bf16_t* KPE = (const bf16_t*)(p.ws + WS_KPE);
    bf16_t* OB = (bf16_t*)(p.ws + WS_OB);
    const int G = gridDim.x, vcu = (G % 8 == 0) ? (blockIdx.x % 8) * (G / 8) + blockIdx.x / 8 : blockIdx.x;
    const int skey = tid >> 4, spc = tid & 15, pkey = tid >> 3, ppc = tid & 7;
    const int vb = (4 * hi + ((lane & 15) >> 2)) * VP + (16 * ((lane >> 4) & 1) + 4 * (lane & 3)) * 2;
    for (int unit = vcu; unit < NB * 8 * 8; unit += G) {
        const int bh = unit >> 3, qt = unit & 7, b = bh >> 3, h = bh & 7;
        const int qrow = b * SEQ + qt * 256 + wid * 32 + r32;
        bf16x8 qf[12];
#pragma unroll
        for (int s = 0; s < 12; ++s) qf[s] = *(const bf16x8*)(QM + (size_t)qrow * MQW + h * 192 + 16 * s + 8 * hi);
        f32x16 o[4];
#pragma unroll
        for (int d = 0; d < 4; ++d)
#pragma unroll
            for (int r = 0; r < 16; ++r) o[d][r] = 0.f;
        float m = -1e30f, l = 0.f;
        u32x4 g0, g1, g2, g3, g4;
#define MLA_LOAD(t) do { const int kr_ = (t) < 32 ? b * SEQ + 64 * (t) : TL + b * CTX + 64 * ((t) - 32); \
            const bf16_t* kp_ = KVM + (size_t)(kr_ + skey) * MKVW + h * 256 + spc * 8; \
            g0 = *(const u32x4*)kp_; g1 = *(const u32x4*)(kp_ + (size_t)32 * MKVW); g2 = *(const u32x4*)(kp_ + 128); g3 = *(const u32x4*)(kp_ + (size_t)32 * MKVW + 128); \
            g4 = *(const u32x4*)(KPE + (size_t)(kr_ + pkey) * 64 + ppc * 8); } while (0)
#define MLA_STORE(buf) do { LAS3 unsigned char* kb_ = lds + (buf) * STG; LAS3 unsigned char* vb_ = kb_ + KBYTES; \
            *(LAS3 u32x4*)(kb_ + skey * KP + spc * 16) = g0; *(LAS3 u32x4*)(kb_ + (skey + 32) * KP + spc * 16) = g1; \
            *(LAS3 u32x4*)(vb_ + skey * VP + spc * 16) = g2; *(LAS3 u32x4*)(vb_ + (skey + 32) * VP + spc * 16) = g3; \
            *(LAS3 u32x4*)(kb_ + pkey * KP + 256 + ppc * 16) = g4; } while (0)
        MLA_LOAD(0); MLA_STORE(0);
#pragma unroll
        for (int s = 0; s < 12; ++s) asm volatile("" : "+v"(qf[s]));
        __syncthreads();
        for (int t = 0; t < NT; ++t) {
            const int cur = t & 1;
            if (t + 1 < NT) MLA_LOAD(t + 1);
            const LAS3 unsigned char* Kb = lds + cur * STG; const LAS3 unsigned char* Vb = Kb + KBYTES;
            f32x16 s0, s1;
#pragma unroll
            for (int r = 0; r < 16; ++r) { s0[r] = 0.f; s1[r] = 0.f; }
            const LAS3 unsigned char* ka = Kb + r32 * KP + 16 * hi;
#pragma unroll
            for (int s = 0; s < 12; ++s) {
                const bf16x8 a0 = *(const LAS3 bf16x8*)(ka + 32 * s), a1 = *(const LAS3 bf16x8*)(ka + 32 * KP + 32 * s);
                s0 = __builtin_amdgcn_mfma_f32_32x32x16_bf16(a0, qf[s], s0, 0, 0, 0);
                s1 = __builtin_amdgcn_mfma_f32_32x32x16_bf16(a1, qf[s], s1, 0, 0, 0);
            }
            float mx = fmaxf(max16(s0), max16(s1));
            mx = fmaxf(mx, __shfl_xor(mx, 32));
            const float mn = fmaxf(m, mx);
            if (__builtin_amdgcn_ballot_w64(mx > m) != 0ull) {
                const float alpha = __builtin_amdgcn_exp2f(m - mn);
                l *= alpha;
#pragma unroll
                for (int d = 0; d < 4; ++d) o[d] = o[d] * alpha;
            }
            m = mn;
            float rs = 0.f;
#pragma unroll
            for (int r = 0; r < 16; ++r) { s0[r] = __builtin_amdgcn_exp2f(s0[r] - mn); s1[r] = __builtin_amdgcn_exp2f(s1[r] - mn); rs += s0[r] + s1[r]; }
            l += rs;
            bf16x8 pf[4];
            pf[0] = pfrag(s0, 0); pf[1] = pfrag(s0, 1); pf[2] = pfrag(s1, 0); pf[3] = pfrag(s1, 1);
            const LAS3 unsigned char* va = Vb + vb;
#pragma unroll
            for (int ks = 0; ks < 4; ++ks)
#pragma unroll
                for (int d = 0; d < 4; ++d) {
                    const s16x4 lo = vtr(va + (16 * ks) * VP + 64 * d), hh = vtr(va + (16 * ks + 8) * VP + 64 * d);
                    const bf16x8 vf = {lo[0], lo[1], lo[2], lo[3], hh[0], hh[1], hh[2], hh[3]};
                    o[d] = __builtin_amdgcn_mfma_f32_32x32x16_bf16(vf, pf[ks], o[d], 0, 0, 0);
                }
            if (t + 1 < NT) MLA_STORE(cur ^ 1);
            __syncthreads();
        }
#undef MLA_LOAD
#undef MLA_STORE
        l += __shfl_xor(l, 32);
        const float inv = 1.f / l;
        bf16_t* op = OB + (size_t)qrow * 2048 + h * 128 + 4 * hi;
#pragma unroll
        for (int d = 0; d < 4; ++d)
#pragma unroll
            for (int g = 0; g < 4; ++g) {
                const f32x4 v = {o[d][4 * g] * inv, o[d][4 * g + 1] * inv, o[d][4 * g + 2] * inv, o[d][4 * g + 3] * inv};
                store_bf4(op + 32 * d + 8 * g, v);
            }
    }
}


__device__ __forceinline__ void na_flash(const Params& p, unsigned char* lds_) {
    int tid_ = threadIdx.x; asm volatile("" : "+v"(tid_)); const int tid = tid_, lane = tid & 63, wid = tid >> 6, r32 = lane & 31, hi = lane >> 5;
    constexpr int VP = 192, WB = 12800;
    LAS3 unsigned char* vl = (LAS3 unsigned char*)lds_ + wid * WB;
    LAS3 float* tbl = (LAS3 float*)(vl + 64 * VP);
    tbl[lane] = 0.f; tbl[lane + 64] = 0.f;
    const bf16_t* PL = (const bf16_t*)(p.ws + WS_PL); const bf16_t* PCx = (const bf16_t*)(p.ws + WS_PC);
    bf16_t* OA = (bf16_t*)(p.ws + WS_OA);
    const float* rpb = p.in[11];
    const int G = gridDim.x, vcu = (G % 8 == 0) ? (blockIdx.x % 8) * (G / 8) + blockIdx.x / 8 : blockIdx.x;
    const int vb = (4 * hi + ((lane & 15) >> 2)) * VP + (16 * ((lane >> 4) & 1) + 4 * (lane & 3)) * 2;
    constexpr float SC = NA_SCALE * LOG2E;
    for (int wu = vcu * NWAVES + wid; wu < NB * GROWS * 16 * 2; wu += G * NWAVES) {
        const int half = wu & 1, h = (wu >> 1) & 15, br = wu >> 5, r = br & 31, b = br >> 5;
        const int qc = 32 * half + r32;
        int w0 = qc - 8; w0 = w0 < 0 ? 0 : (w0 > GW - 16 ? GW - 16 : w0);
        int r0 = r - 4; r0 = r0 < 0 ? 0 : (r0 > GROWS - 8 ? GROWS - 8 : r0);
        const int qtok = b * SEQ + r * 64 + qc;
        bf16x8 qf[4];
#pragma unroll
        for (int s = 0; s < 4; ++s) qf[s] = *(const bf16x8*)(PL + (size_t)qtok * NP + PC_QA + h * 64 + 16 * s + 8 * hi);
        f32x16 o[2];
#pragma unroll
        for (int d = 0; d < 2; ++d)
#pragma unroll
            for (int e = 0; e < 16; ++e) o[d][e] = 0.f;
        float m = -1e30f, l = 0.f;
        bf16x8 kf[2][4]; u32x4 vg[8];
#define NA_LOAD(t, WHAT) do { const bf16_t* kb_; size_t pitch_; \
            if ((t) < 8) { kb_ = PL + (size_t)(b * SEQ + (r0 + (t)) * 64) * NP + PC_KA + h * 64; pitch_ = NP; } \
            else { kb_ = PCx + (size_t)(b * CTX + 64 * ((t) - 8)) * NPC + PC_KA + h * 64; pitch_ = NPC; } \
            if (WHAT & 1) { _Pragma("unroll") for (int kb = 0; kb < 2; ++kb) _Pragma("unroll") for (int s = 0; s < 4; ++s) kf[kb][s] = *(const bf16x8*)(kb_ + (size_t)(32 * kb + r32) * pitch_ + 16 * s + 8 * hi); } \
            if (WHAT & 2) { _Pragma("unroll") for (int i = 0; i < 8; ++i) vg[i] = *(const u32x4*)(kb_ + (size_t)((lane >> 3) + 8 * i) * pitch_ + 1024 + (lane & 7) * 8); } } while (0)
#define NA_STORE(t) do { _Pragma("unroll") for (int i = 0; i < 8; ++i) *(LAS3 u32x4*)(vl + ((lane >> 3) + 8 * i) * VP + (lane & 7) * 16) = vg[i]; \
            if ((t) < 8 && lane < 31) tbl[48 + lane] = rpb[(h * 15 + (r0 + (t) - r + 7)) * 31 + lane] * LOG2E; } while (0)
        NA_LOAD(0, 3); NA_STORE(0);
#pragma nounroll
        for (int t = 0; t < 12; ++t) {
            f32x16 s0, s1;
#pragma unroll
            for (int e = 0; e < 16; ++e) { s0[e] = 0.f; s1[e] = 0.f; }
#pragma unroll
            for (int s = 0; s < 4; ++s) {
                s0 = __builtin_amdgcn_mfma_f32_32x32x16_bf16(kf[0][s], qf[s], s0, 0, 0, 0);
                s1 = __builtin_amdgcn_mfma_f32_32x32x16_bf16(kf[1][s], qf[s], s1, 0, 0, 0);
            }
            __builtin_amdgcn_sched_barrier(0);
            if (t + 1 < 12) NA_LOAD(t + 1, 1);
            __builtin_amdgcn_sched_barrier(0);
            if (t < 8) {
                int w0v = w0 - 4 * hi, tb = 4 * hi - qc + 63; asm volatile("" : "+v"(w0v), "+v"(tb));
                const LAS3 float* tp = tbl + tb;
#pragma unroll
                for (int e = 0; e < 16; ++e) {
                    const int c0 = (e & 3) + 8 * (e >> 2), c1 = c0 + 32;
                    const bool ok0 = (unsigned)(c0 - w0v) < 16u, ok1 = (unsigned)(c1 - w0v) < 16u;
                    const float v0 = s0[e] * SC + tp[c0], v1 = s1[e] * SC + tp[c1];
                    s0[e] = ok0 ? v0 : -1e30f;
                    s1[e] = ok1 ? v1 : -1e30f;
                }
            } else {
#pragma unroll
                for (int e = 0; e < 16; ++e) { s0[e] *= SC; s1[e] *= SC; }
            }
            float mx = fmaxf(max16(s0), max16(s1));
            mx = fmaxf(mx, __shfl_xor(mx, 32));
            const float mn = fmaxf(m, mx), alpha = __builtin_amdgcn_exp2f(m - mn);
            m = mn; l *= alpha;
            o[0] = o[0] * alpha; o[1] = o[1] * alpha;
            float rs = 0.f;
#pragma unroll
            for (int e = 0; e < 16; ++e) { s0[e] = __builtin_amdgcn_exp2f(s0[e] - mn); s1[e] = __builtin_amdgcn_exp2f(s1[e] - mn); rs += s0[e] + s1[e]; }
            l += rs;
            __builtin_amdgcn_sched_barrier(0);
            if (t + 1 < 12) NA_LOAD(t + 1, 2);
            bf16x8 pf[4];
            pf[0] = pfrag(s0, 0); pf[1] = pfrag(s0, 1); pf[2] = pfrag(s1, 0); pf[3] = pfrag(s1, 1);
            const LAS3 unsigned char* va = vl + vb;
#pragma unroll
            for (int ks = 0; ks < 4; ++ks)
#pragma unroll
                for (int d = 0; d < 2; ++d) {
                    const s16x4 lo = vtr(va + (16 * ks) * VP + 64 * d), hh = vtr(va + (16 * ks + 8) * VP + 64 * d);
                    const bf16x8 vf = {lo[0], lo[1], lo[2], lo[3], hh[0], hh[1], hh[2], hh[3]};
                    o[d] = __builtin_amdgcn_mfma_f32_32x32x16_bf16(vf, pf[ks], o[d], 0, 0, 0);
                }
            __builtin_amdgcn_sched_barrier(0);
            if (t + 1 < 12) NA_STORE(t + 1);
        }
#undef NA_LOAD
#undef NA_STORE
        l += __shfl_xor(l, 32);
        const float inv = 1.f / l;
        bf16_t* op = OA + (size_t)qtok * 2048 + h * 64 + 4 * hi;
#pragma unroll
        for (int d = 0; d < 2; ++d)
#pragma unroll
            for (int g = 0; g < 4; ++g) {
                const f32x4 v = {o[d][4 * g] * inv, o[d][4 * g + 1] * inv, o[d][4 * g + 2] * inv, o[d][4 * g + 3] * inv};
                store_bf4(op + 32 * d + 8 * g, v);
            }
    }
}


template <bool LAT, int HALF>
__device__ __forceinline__ void na_tile(const LAS3 unsigned char* Kb, const LAS3 unsigned char* Vb, const LAS3 float* tbl, const bf16x8 (&qf)[4], f32x16 (&o)[2], float& m, float& l,
                                        int r32, int hi, int qc, int w0, int vb) {
    constexpr int KP = 144, VP = 192;
    constexpr float SC = NA_SCALE * LOG2E;
    constexpr int L0 = (LAT && HALF == 1) ? 12 : 0;
    constexpr int H1 = (LAT && HALF == 0) ? 4 : 16;
    f32x16 s0, s1;
#pragma unroll
    for (int e = 0; e < 16; ++e) { s0[e] = 0.f; s1[e] = 0.f; }
    const LAS3 unsigned char* ka = Kb + r32 * KP + 16 * hi;
#pragma unroll
    for (int s = 0; s < 4; ++s) {
        const bf16x8 a0 = *(const LAS3 bf16x8*)(ka + 32 * s), a1 = *(const LAS3 bf16x8*)(ka + 32 * KP + 32 * s);
        s0 = __builtin_amdgcn_mfma_f32_32x32x16_bf16(a0, qf[s], s0, 0, 0, 0);
        s1 = __builtin_amdgcn_mfma_f32_32x32x16_bf16(a1, qf[s], s1, 0, 0, 0);
    }
    if constexpr (LAT) {
        int w0v = w0 - 4 * hi, tb = 4 * hi - qc + 63; asm volatile("" : "+v"(w0v), "+v"(tb));
        const LAS3 float* tp = tbl + tb;
#pragma unroll
        for (int e = 0; e < 16; ++e) {
            const int c0 = (e & 3) + 8 * (e >> 2), c1 = c0 + 32;
            if (e >= L0) { const float p0 = (float)((unsigned)(c0 - w0v) & 0xFFFFFFF0u); s0[e] = fmaf(p0, -1e28f, fmaf(s0[e], SC, tp[c0])); }
            if (e < H1) { const float p1 = (float)((unsigned)(c1 - w0v) & 0xFFFFFFF0u); s1[e] = fmaf(p1, -1e28f, fmaf(s1[e], SC, tp[c1])); }
        }
    } else {
#pragma unroll
        for (int e = 0; e < 16; ++e) { s0[e] *= SC; s1[e] *= SC; }
    }
    float mx = -1e30f;
#pragma unroll
    for (int e = 0; e < 16; ++e) { if (e >= L0) mx = fmaxf(mx, s0[e]); if (e < H1) mx = fmaxf(mx, s1[e]); }
    mx = fmaxf(mx, __shfl_xor(mx, 32));
    const float mn = fmaxf(m, mx);
    if (__builtin_amdgcn_ballot_w64(mx > m) != 0ull) {
        const float alpha = __builtin_amdgcn_exp2f(m - mn);
        l *= alpha; o[0] = o[0] * alpha; o[1] = o[1] * alpha;
    }
    m = mn;
    float rs = 0.f;
#pragma unroll
    for (int e = 0; e < 16; ++e) {
        if (e >= L0) { s0[e] = __builtin_amdgcn_exp2f(s0[e] - mn); rs += s0[e]; } else s0[e] = 0.f;
        if (e < H1) { s1[e] = __builtin_amdgcn_exp2f(s1[e] - mn); rs += s1[e]; } else s1[e] = 0.f;
    }
    l += rs;
    bf16x8 pf[4];
    pf[0] = pfrag(s0, 0); pf[1] = pfrag(s0, 1); pf[2] = pfrag(s1, 0); pf[3] = pfrag(s1, 1);
    const LAS3 unsigned char* va = Vb + vb;
#pragma unroll
    for (int ks = 0; ks < 4; ++ks) {
        if (LAT && ((HALF == 0 && ks == 3) || (HALF == 1 && ks == 0))) continue;
#pragma unroll
        for (int d = 0; d < 2; ++d) {
            const s16x4 lo = vtr(va + (16 * ks) * VP + 64 * d), hh = vtr(va + (16 * ks + 8) * VP + 64 * d);
            const bf16x8 vf = {lo[0], lo[1], lo[2], lo[3], hh[0], hh[1], hh[2], hh[3]};
            o[d] = __builtin_amdgcn_mfma_f32_32x32x16_bf16(vf, pf[ks], o[d], 0, 0, 0);
        }
    }
}
__device__ __forceinline__ void na_coop(const Params& p, unsigned char* lds_) {
    int tid_ = threadIdx.x; asm volatile("" : "+v"(tid_)); const int tid = tid_, lane = tid & 63, wid = tid >> 6, r32 = lane & 31, hi = lane >> 5;
    constexpr int KP = 144, VP = 192, KT = 64 * KP, VT = 64 * VP, STG = KT + VT;
    LAS3 unsigned char* lds = (LAS3 unsigned char*)lds_;
    LAS3 float* tbl = (LAS3 float*)(lds + 2 * STG) + wid * 128;
    tbl[lane] = 0.f; tbl[lane + 64] = 0.f;
    const bf16_t* PL = (const bf16_t*)(p.ws + WS_PL); const bf16_t* PCx = (const bf16_t*)(p.ws + WS_PC);
    bf16_t* OA = (bf16_t*)(p.ws + WS_OA);
    const float* rpb = p.in[11];
    const int G = gridDim.x, vcu = (G % 8 == 0) ? (blockIdx.x % 8) * (G / 8) + blockIdx.x / 8 : blockIdx.x;
    const int vb = (4 * hi + ((lane & 15) >> 2)) * VP + (16 * ((lane >> 4) & 1) + 4 * (lane & 3)) * 2;
    const int half = wid & 1, rw = wid >> 1, skey = tid >> 3, spc = tid & 7;
    constexpr float SC = NA_SCALE * LOG2E;
    for (int unit = vcu; unit < NB * 16 * (GROWS / 4); unit += G) {
        const int rg = unit & 7, h = (unit >> 3) & 15, b = unit >> 7;
        const int R = rg * 4, r = R + rw;
        int r0w = r - 4; r0w = r0w < 0 ? 0 : (r0w > GROWS - 8 ? GROWS - 8 : r0w);
        int kr_lo = R - 4; kr_lo = kr_lo < 0 ? 0 : (kr_lo > GROWS - 8 ? GROWS - 8 : kr_lo);
        int kr_hi = R - 1; kr_hi = (kr_hi < 0 ? 0 : (kr_hi > GROWS - 8 ? GROWS - 8 : kr_hi)) + 7;
        const int nlat = kr_hi - kr_lo + 1, NT = nlat + 4;
        const int qc = 32 * half + r32;
        int w0 = qc - 8; w0 = w0 < 0 ? 0 : (w0 > GW - 16 ? GW - 16 : w0);
        const int qtok = b * SEQ + r * 64 + qc;
        bf16x8 qf[4];
#pragma unroll
        for (int s = 0; s < 4; ++s) qf[s] = *(const bf16x8*)(PL + (size_t)qtok * NP + PC_QA + h * 64 + 16 * s + 8 * hi);
        f32x16 o[2];
#pragma unroll
        for (int d = 0; d < 2; ++d)
#pragma unroll
            for (int e = 0; e < 16; ++e) o[d][e] = 0.f;
        float m = -1e30f, l = 0.f;
        float brow[8];
#pragma unroll
        for (int i = 0; i < 8; ++i) brow[i] = lane < 31 ? rpb[(h * 15 + (r0w - r + 7 + i)) * 31 + lane] * LOG2E : 0.f;
        u32x4 gk, gv;
#define NC_LOAD(t) do { const bf16_t* kp_ = (t) < nlat ? PL + (size_t)(b * SEQ + (kr_lo + (t)) * 64 + skey) * NP + PC_KA + h * 64 + spc * 8 \
                                                      : PCx + (size_t)(b * CTX + 64 * ((t) - nlat) + skey) * NPC + PC_KA + h * 64 + spc * 8; \
            gk = *(const u32x4*)kp_; gv = *(const u32x4*)(kp_ + 1024); } while (0)
#define NC_STORE(buf) do { *(LAS3 u32x4*)(lds + (buf) * STG + skey * KP + spc * 16) = gk; *(LAS3 u32x4*)(lds + (buf) * STG + KT + skey * VP + spc * 16) = gv; } while (0)
        __syncthreads();
        NC_LOAD(0); NC_STORE(0);
#pragma unroll
        for (int s = 0; s < 4; ++s) asm volatile("" : "+v"(qf[s]));
#pragma unroll
        for (int i = 0; i < 8; ++i) asm volatile("" : "+v"(brow[i]));
        __syncthreads();
#pragma nounroll
        for (int t = 0; t < NT; ++t) {
            const int cur = t & 1;
            if (t + 1 < NT) NC_LOAD(t + 1);
            const bool lat = t < nlat; const int kr = kr_lo + t;
            if (!lat || (kr >= r0w && kr < r0w + 8)) {
                const LAS3 unsigned char* Kb = lds + cur * STG; const LAS3 unsigned char* Vb = Kb + KT;
                if (lat) { const int bi_ = kr - r0w; float bv = brow[0];
#pragma unroll
                    for (int i = 1; i < 8; ++i) bv = bi_ == i ? brow[i] : bv;
                    if (lane < 31) tbl[48 + lane] = bv; }
                if (!lat) na_tile<false, 0>(Kb, Vb, tbl, qf, o, m, l, r32, hi, qc, w0, vb);
                else if (half == 0) na_tile<true, 0>(Kb, Vb, tbl, qf, o, m, l, r32, hi, qc, w0, vb);
                else na_tile<true, 1>(Kb, Vb, tbl, qf, o, m, l, r32, hi, qc, w0, vb);
            }
            if (t + 1 < NT) NC_STORE(cur ^ 1);
            __syncthreads();
        }
#undef NC_LOAD
#undef NC_STORE
        l += __shfl_xor(l, 32);
        const float inv = 1.f / l;
        bf16_t* op = OA + (size_t)qtok * 2048 + h * 64 + 4 * hi;
#pragma unroll
        for (int d = 0; d < 2; ++d)
#pragma unroll
            for (int g = 0; g < 4; ++g) {
                const f32x4 v = {o[d][4 * g] * inv, o[d][4 * g + 1] * inv, o[d][4 * g + 2] * inv, o[d][4 * g + 3] * inv};
                store_bf4(op + 32 * d + 8 * g, v);
            }
    }
}

__device__ __forceinline__ void phase7(const Params& p) {
    int tid_ = threadIdx.x; asm volatile("" : "+v"(tid_)); const int tid = tid_, lane = tid & 63, wid = tid >> 6;
    const int gw = blockIdx.x * NWAVES + wid, NGW = gridDim.x * NWAVES;
    const float* mod = (const float*)(p.ws + WS_MOD);
    const bf16_t* Z = (const bf16_t*)(p.ws + WS_Z); bf16_t* H = (bf16_t*)(p.ws + WS_H);
    const float* gpm = p.in[7]; const float* gpf = p.in[8];
    const int per = (TL + NGW - 1) / NGW;
    int curb = -1; f32x4 A[8], B[8], C[8];
    for (int i = 0; i < per; ++i) {
        const int m = gw * per + i; if (m >= TL) break;
        const int b = m / SEQ;
        if (b != curb) { curb = b; const float* mb = mod + (size_t)b * 12288;
#pragma unroll
            for (int j = 0; j < 8; ++j) { const int c = j * 256 + lane * 4;
                A[j] = *(const f32x4*)(mb + 4096 + c) * *(const f32x4*)(gpm + c); B[j] = *(const f32x4*)(gpf + c) * (*(const f32x4*)(mb + 8192 + c) + 1.f); C[j] = *(const f32x4*)(mb + 6144 + c); } }
        f32x4 z[8]; float ss = 0.f;
#pragma unroll
        for (int j = 0; j < 8; ++j) {
            const u32x2 w = *(const u32x2*)(Z + (size_t)m * DM + j * 256 + lane * 4);
            z[j] = (f32x4){__uint_as_float(w.x << 16), __uint_as_float(w.x & 0xffff0000u), __uint_as_float(w.y << 16), __uint_as_float(w.y & 0xffff0000u)};
            ss += z[j][0] * z[j][0] + z[j][1] * z[j][1] + z[j][2] * z[j][2] + z[j][3] * z[j][3];
        }
        f32x4 xv[8];
#pragma unroll
        for (int j = 0; j < 8; ++j) xv[j] = *(const f32x4*)(p.in[0] + (size_t)m * DM + j * 256 + lane * 4);
        const float rz = rsqrtf(wave_sum_dpp(ss) * (1.f / DM) + EPS);
        float s2 = 0.f;
#pragma unroll
        for (int j = 0; j < 8; ++j) {
            const f32x4 x1 = xv[j] + (z[j] * rz) * A[j];
            *(f32x4*)(p.out + (size_t)m * DM + j * 256 + lane * 4) = x1;
            z[j] = x1; s2 += x1[0] * x1[0] + x1[1] * x1[1] + x1[2] * x1[2] + x1[3] * x1[3];
        }
        const float rx = rsqrtf(wave_sum_dpp(s2) * (1.f / DM) + EPS);
#pragma unroll
        for (int j = 0; j < 8; ++j) store_bf4(H + (size_t)m * DM + j * 256 + lane * 4, (z[j] * rx) * B[j] + C[j]);
    }
}

template <int NPER>
__device__ __forceinline__ void wave_top16(float (&v)[NPER], const int (&idx)[NPER], float& outv, int& outi, int lane) {
    outv = -INFINITY; outi = 0;
#pragma nounroll
    for (int r = 0; r < 16; ++r) {
        float bv = v[0]; int bi = idx[0];
#pragma unroll
        for (int e = 1; e < NPER; ++e) if (v[e] > bv || (v[e] == bv && idx[e] < bi)) { bv = v[e]; bi = idx[e]; }
#pragma unroll
        for (int o = 32; o >= 1; o >>= 1) {
            const float ov = __shfl_xor(bv, o); const int oi = __shfl_xor(bi, o);
            if (ov > bv || (ov == bv && oi < bi)) { bv = ov; bi = oi; }
        }
#pragma unroll
        for (int e = 0; e < NPER; ++e) if (idx[e] == bi) v[e] = -INFINITY;
        if (lane == r) { outv = bv; outi = bi; }
    }
}

__device__ __forceinline__ void peer_topk_naive(const Params& p, unsigned char* lds) {
    int tid_ = threadIdx.x; asm volatile("" : "+v"(tid_)); const int tid = tid_, lane = tid & 63, wid = tid >> 6;
    const int gw = blockIdx.x * NWAVES + wid, NGW = gridDim.x * NWAVES;
    const bf16_t* QP = (const bf16_t*)(p.ws + WS_QP); const bf16_t* SK = (const bf16_t*)(p.ws + WS_SUBK);
    float* TKV = (float*)(p.ws + WS_TKV); int* TKI = (int*)(p.ws + WS_TKI);
    float* qs = (float*)lds + wid * 128;
    for (int it = gw; it < TL * 16; it += NGW) {
        const int hp = it & 15, m = it >> 4;
        qs[lane] = bf2f(QP[(size_t)m * DM + hp * 128 + lane]); qs[lane + 64] = bf2f(QP[(size_t)m * DM + hp * 128 + 64 + lane]);
        __builtin_amdgcn_s_waitcnt(0xc07f); asm volatile("" ::: "memory");
        float v[2]; int idx[2];
#pragma unroll
        for (int i = 0; i < 2; ++i) {
            const int n = lane + 64 * i; const bf16_t* kp = SK + (size_t)(hp * 128 + n) * 128;
            float d = 0.f;
#pragma unroll
            for (int e = 0; e < 16; ++e) d += dot_bf16x8(*(const bf16x8*)(kp + e * 8), qs + e * 8);
            v[i] = d; idx[i] = n;
        }
        float ov; int oi; wave_top16<2>(v, idx, ov, oi, lane);
        if (lane < 16) { TKV[(size_t)it * 16 + lane] = ov; TKI[(size_t)it * 16 + lane] = oi; }
        __builtin_amdgcn_s_waitcnt(0xc07f); asm volatile("" ::: "memory");
    }
}

__device__ __forceinline__ void peer_final_naive(const Params& p, unsigned char* lds) {
    int tid_ = threadIdx.x; asm volatile("" : "+v"(tid_)); const int tid = tid_, lane = tid & 63, wid = tid >> 6;
    const float* TKV = (const float*)(p.ws + WS_TKV); const int* TKI = (const int*)(p.ws + WS_TKI);
    const bf16_t* H = (const bf16_t*)(p.ws + WS_H);
    const float* U = p.in[21]; const float* V = p.in[22];
    const float* mod = (const float*)(p.ws + WS_MOD); const float* gpo = p.in[9];
    float* part = (float*)lds;
    float* red = part + 8 * 2048;
    for (int m = blockIdx.x; m < TL; m += gridDim.x) {
        const int b = m / SEQ, h = wid;
        const float* v1 = TKV + ((size_t)m * 16 + h * 2) * 16; const float* v2 = v1 + 16;
        const int* i1 = TKI + ((size_t)m * 16 + h * 2) * 16; const int* i2 = i1 + 16;
        float cv[4]; int ci[4];
        const float v2j = v2[lane & 15];
#pragma unroll
        for (int e = 0; e < 4; ++e) { const int i = (lane >> 4) + 4 * e; cv[e] = v1[i] + v2j; ci[e] = i * 16 + (lane & 15); }
        float tv; int tc; wave_top16<4>(cv, ci, tv, tc, lane);
        int eid = 0; float gate = 0.f;
        if (lane < 16) eid = i1[tc >> 4] * 128 + i2[tc & 15];
        const float mx = __shfl(tv, 0);
        const float ex = lane < 16 ? __expf(tv - mx) : 0.f;
        gate = ex / wave_sum(ex);
        f32x4 hv[8];
#pragma unroll
        for (int j = 0; j < 8; ++j) { const u32x2 w = *(const u32x2*)(H + (size_t)m * DM + j * 256 + lane * 4);
            hv[j] = (f32x4){__uint_as_float(w.x << 16), __uint_as_float(w.x & 0xffff0000u), __uint_as_float(w.y << 16), __uint_as_float(w.y & 0xffff0000u)}; }
        f32x4 acc[8];
#pragma unroll
        for (int j = 0; j < 8; ++j) acc[j] = (f32x4){0.f, 0.f, 0.f, 0.f};
        for (int k = 0; k < 16; ++k) {
            const int e = __shfl(eid, k); const float g = __shfl(gate, k);
#ifdef PEER_NAIVE_BF16
            const bf16_t* ur = (const bf16_t*)(p.ws + WS_UB) + (size_t)e * DM + lane * 4; const bf16_t* vr = (const bf16_t*)(p.ws + WS_VB) + (size_t)e * DM + lane * 4;
            float d = 0.f;
#pragma unroll
            for (int j = 0; j < 8; ++j) { const u32x2 w = *(const u32x2*)(ur + j * 256); const f32x4 u = {__uint_as_float(w.x << 16), __uint_as_float(w.x & 0xffff0000u), __uint_as_float(w.y << 16), __uint_as_float(w.y & 0xffff0000u)};
                d += u[0] * hv[j][0] + u[1] * hv[j][1] + u[2] * hv[j][2] + u[3] * hv[j][3]; }
            d = wave_sum(d);
            const float coef = g * gelu_as(d);
#pragma unroll
            for (int j = 0; j < 8; ++j) { const u32x2 w = *(const u32x2*)(vr + j * 256); const f32x4 vv = {__uint_as_float(w.x << 16), __uint_as_float(w.x & 0xffff0000u), __uint_as_float(w.y << 16), __uint_as_float(w.y & 0xffff0000u)};
                acc[j] += vv * coef; }
#else
            const float* ur = U + (size_t)e * DM + lane * 4; const float* vr = V + (size_t)e * DM + lane * 4;
            float d = 0.f;
#pragma unroll
            for (int j = 0; j < 8; ++j) { const f32x4 u = *(const f32x4*)(ur + j * 256); d += u[0] * hv[j][0] + u[1] * hv[j][1] + u[2] * hv[j][2] + u[3] * hv[j][3]; }
            d = wave_sum(d);
            const float coef = g * gelu_erf(d);
#pragma unroll
            for (int j = 0; j < 8; ++j) acc[j] += *(const f32x4*)(vr + j * 256) * coef;
#endif
        }
        __syncthreads();
#pragma unroll
        for (int j = 0; j < 8; ++j) *(f32x4*)(part + wid * 2048 + j * 256 + lane * 4) = acc[j];
        __syncthreads();
        f32x4 y = (f32x4){0.f, 0.f, 0.f, 0.f};
#pragma unroll
        for (int w = 0; w < 8; ++w) y += *(const f32x4*)(part + w * 2048 + tid * 4);
        float ss = wave_sum(y[0] * y[0] + y[1] * y[1] + y[2] * y[2] + y[3] * y[3]);
        if (lane == 0) red[wid] = ss;
        __syncthreads();
        float tot = 0.f;
#pragma unroll
        for (int w = 0; w < 8; ++w) tot += red[w];
        const float rstd = rsqrtf(tot * (1.f / DM) + EPS);
        const int c = tid * 4;
        const f32x4 gt2 = *(const f32x4*)(mod + (size_t)b * 12288 + 10240 + c);
        float* op = p.out + (size_t)m * DM + c;
        const f32x4 x1 = *(const f32x4*)op;
        *(f32x4*)op = x1 + gt2 * (y * rstd * *(const f32x4*)(gpo + c));
    }
}


__device__ __forceinline__ void peer_topk_mfma(const Params& p, unsigned char* lds_) {
    int tid_ = threadIdx.x; asm volatile("" : "+v"(tid_)); const int tid = tid_, lane = tid & 63, wid = tid >> 6, r32 = lane & 31, hi = lane >> 5;
    LAS3 unsigned char* lds = (LAS3 unsigned char*)lds_;
    constexpr int SP = 272;
    const bf16_t* QP = (const bf16_t*)(p.ws + WS_QP); const bf16_t* SK = (const bf16_t*)(p.ws + WS_SUBK);
    float* TKV = (float*)(p.ws + WS_TKV); int* TKI = (int*)(p.ws + WS_TKI);
    for (int bi = blockIdx.x; bi < 256; bi += gridDim.x) {
        const int hp = bi & 15, sub = bi >> 4;
        __syncthreads();
        for (int c = tid; c < 2048; c += NTHREADS) { const int row = c >> 4, pc = c & 15;
            *(LAS3 u32x4*)(lds + row * SP + pc * 16) = *(const u32x4*)(SK + ((size_t)hp * 128 + row) * 128 + pc * 8); }
        __syncthreads();
        for (int g = wid; g < 32; g += NWAVES) {
            const int tok = (sub * 32 + g) * 32 + r32;
            bf16x8 qf[8];
#pragma unroll
            for (int s = 0; s < 8; ++s) qf[s] = *(const bf16x8*)(QP + (size_t)tok * DM + hp * 128 + 16 * s + 8 * hi);
            f32x16 sc[4];
#pragma unroll
            for (int kb = 0; kb < 4; ++kb) {
#pragma unroll
                for (int e = 0; e < 16; ++e) sc[kb][e] = 0.f;
#pragma unroll
                for (int s = 0; s < 8; ++s) {
                    const bf16x8 a = *(const LAS3 bf16x8*)(lds + (32 * kb + r32) * SP + 32 * s + 16 * hi);
                    sc[kb] = __builtin_amdgcn_mfma_f32_32x32x16_bf16(a, qf[s], sc[kb], 0, 0, 0);
                }
            }
#pragma unroll
            for (int kb = 0; kb < 4; ++kb)
#pragma unroll
                for (int e = 0; e < 16; ++e) {
                    const unsigned key = 32 * kb + (e & 3) + 8 * (e >> 2) + 4 * hi;
                    sc[kb][e] = __uint_as_float((__float_as_uint(sc[kb][e]) & 0xFFFFFF80u) | key);
                }
            float ov[16];
#pragma unroll
            for (int r = 0; r < 16; ++r) {
                float mx = -INFINITY;
#pragma unroll
                for (int kb = 0; kb < 4; ++kb) mx = fmaxf(mx, max16(sc[kb]));
                const float w = fmaxf(mx, __shfl_xor(mx, 32));
                ov[r] = w;
#pragma unroll
                for (int kb = 0; kb < 4; ++kb)
#pragma unroll
                    for (int e = 0; e < 16; ++e) sc[kb][e] = sc[kb][e] == w ? -INFINITY : sc[kb][e];
            }
            if (hi == 0) {
                float* vp = TKV + ((size_t)tok * 16 + hp) * 16; int* ip = TKI + ((size_t)tok * 16 + hp) * 16;
#pragma unroll
                for (int q = 0; q < 4; ++q) {
                    f32x4 vv; u32x4 ii;
#pragma unroll
                    for (int e = 0; e < 4; ++e) { const unsigned u = __float_as_uint(ov[4 * q + e]); vv[e] = __uint_as_float(u & 0xFFFFFF80u); ii[e] = u & 127u; }
                    *(f32x4*)(vp + 4 * q) = vv; *(u32x4*)(ip + 4 * q) = ii;
                }
            }
        }
    }
}


constexpr int cand_jmax(int i) { return 16 / (i + 1); }
constexpr int cand_off(int i) { int t = 0; for (int k = 0; k < i; ++k) t += 16 / (k + 1); return t; }
static_assert(cand_off(16) == 50, "candidate count");
template <int N> __device__ __forceinline__ void bitonic_sort_desc(float (&a)[N]) {
#pragma unroll
    for (int k = 2; k <= N; k <<= 1)
#pragma unroll
        for (int j = k >> 1; j > 0; j >>= 1)
#pragma unroll
            for (int i = 0; i < N; ++i) { const int l = i ^ j; if (l > i) { const bool up = (i & k) == 0; const float x = a[i], y = a[l];
                a[i] = up ? fmaxf(x, y) : fminf(x, y); a[l] = up ? fminf(x, y) : fmaxf(x, y); } }
}
template <int N> __device__ __forceinline__ void bitonic_merge_desc(float (&a)[N]) {
#pragma unroll
    for (int j = N >> 1; j > 0; j >>= 1)
#pragma unroll
        for (int i = 0; i < N; ++i) { const int l = i ^ j; if (l > i) { const float x = a[i], y = a[l]; a[i] = fmaxf(x, y); a[l] = fminf(x, y); } }
}
__device__ __forceinline__ void top16_merge(float (&a)[16], const float (&b)[16]) {
#pragma unroll
    for (int i = 0; i < 16; ++i) a[i] = fmaxf(a[i], b[15 - i]);
    bitonic_merge_desc<16>(a);
}
__device__ __forceinline__ void top16_of_64(float (&g0)[16], float (&g1)[16], float (&g2)[16], float (&g3)[16]) {
    bitonic_sort_desc<16>(g0); bitonic_sort_desc<16>(g1); bitonic_sort_desc<16>(g2); bitonic_sort_desc<16>(g3);
    top16_merge(g0, g1); top16_merge(g2, g3); top16_merge(g0, g2);
}
__device__ __forceinline__ void topk_stage1(const LAS3 unsigned char* skl, const bf16_t* __restrict__ qrow, int r32, int hi, float (&ov)[16]) {
    constexpr int SP = 272;
    bf16x8 qf[8];
#pragma unroll
    for (int s = 0; s < 8; ++s) qf[s] = *(const bf16x8*)(qrow + 16 * s + 8 * hi);
    f32x16 sc[4];
#pragma unroll
    for (int kb = 0; kb < 4; ++kb) {
#pragma unroll
        for (int e = 0; e < 16; ++e) sc[kb][e] = 0.f;
#pragma unroll
        for (int s = 0; s < 8; ++s) {
            const bf16x8 a = *(const LAS3 bf16x8*)(skl + (32 * kb + r32) * SP + 32 * s + 16 * hi);
            sc[kb] = __builtin_amdgcn_mfma_f32_32x32x16_bf16(a, qf[s], sc[kb], 0, 0, 0);
        }
    }
    float g1[16], g2[16], g3[16];
#pragma unroll
    for (int e = 0; e < 16; ++e) {
        const unsigned key = (e & 3) + 8 * (e >> 2) + 4 * hi;
        ov[e] = __uint_as_float((__float_as_uint(sc[0][e]) & 0xFFFFFF80u) | key);
        g1[e] = __uint_as_float((__float_as_uint(sc[1][e]) & 0xFFFFFF80u) | (key + 32u));
        g2[e] = __uint_as_float((__float_as_uint(sc[2][e]) & 0xFFFFFF80u) | (key + 64u));
        g3[e] = __uint_as_float((__float_as_uint(sc[3][e]) & 0xFFFFFF80u) | (key + 96u));
    }
    top16_of_64(ov, g1, g2, g3);
    float pb[16];
#pragma unroll
    for (int e = 0; e < 16; ++e) pb[e] = __shfl_xor(ov[e], 32);
    top16_merge(ov, pb);
}
__device__ __forceinline__ void peer_tables_q8(const Params& p, int gw, int NGW, int lane);
__device__ __forceinline__ void peer_select_mfma(const Params& p, unsigned char* lds_, int mode = 0) {
    int tid_ = threadIdx.x; asm volatile("" : "+v"(tid_)); const int tid = tid_, lane = tid & 63, wid = tid >> 6, r32 = lane & 31, hi = lane >> 5;
    LAS3 unsigned char* lds = (LAS3 unsigned char*)lds_;
    constexpr int SP = 272;
    LAS3 unsigned* ktab = (LAS3 unsigned*)(lds + 256 * SP) + wid * 2048 + lane;
    const bf16_t* QP = (const bf16_t*)(p.ws + WS_QP); const bf16_t* SK = (const bf16_t*)(p.ws + WS_SUBK);
    int* SE = (int*)(p.ws + WS_TKI); float* SG = (float*)(p.ws + WS_TKV);
    for (int bi = blockIdx.x; bi < 256; bi += gridDim.x) {
        const int h = bi & 7, sub = bi >> 3;
        __syncthreads();
        for (int c = tid; c < 4096; c += NTHREADS) { const int row = c >> 4, pc = c & 15;
            *(LAS3 u32x4*)(lds + row * SP + pc * 16) = *(const u32x4*)(SK + ((size_t)h * 256 + row) * 128 + pc * 8); }
        __syncthreads();
#ifdef SEL_SPLIT
        if (wid >= 4) { if (bi == (int)blockIdx.x && mode != 1) peer_tables_q8(p, blockIdx.x * 4 + (wid - 4), gridDim.x * 4, lane); continue; }
        if (mode == 2) continue;
        for (int g = wid; g < 16; g += 4) {
#else
        if (mode == 2) continue;
        for (int g = wid; g < 16; g += NWAVES) {
#endif
            const int tok = (sub * 16 + g) * 32 + r32;
            float ov0[16], ov1[16];
            int lo0 = 0, lo1 = 128 * SP; asm volatile("" : "+v"(lo0), "+v"(lo1));
            topk_stage1(lds + lo0, QP + (size_t)tok * DM + h * 256, r32, hi, ov0);
            topk_stage1(lds + lo1, QP + (size_t)tok * DM + h * 256 + 128, r32, hi, ov1);
#pragma unroll
            for (int q = 0; q < 16; ++q) { ktab[q * 64] = __float_as_uint(ov0[q]) & 127u; ktab[(16 + q) * 64] = __float_as_uint(ov1[q]) & 127u; }
            float c0[16], c1[16], c2[16], c3[16];
#pragma unroll
            for (int e = 0; e < 16; ++e) { c0[e] = -INFINITY; c1[e] = -INFINITY; c2[e] = -INFINITY; c3[e] = -INFINITY; }
#pragma unroll
            for (int i = 0; i < 16; ++i) {
                const float a = __uint_as_float(__float_as_uint(ov0[i]) & 0xFFFFFF80u);
#pragma unroll
                for (int j = 0; j < 16; ++j) if (j < cand_jmax(i)) {
                    const float bb = __uint_as_float(__float_as_uint(ov1[j]) & 0xFFFFFF80u);
                    const float cv = __uint_as_float((__float_as_uint(a + bb) & 0xFFFFFF00u) | (unsigned)(i * 16 + j));
                    const int n = cand_off(i) + j;
                    if (n < 16) c0[n & 15] = cv; else if (n < 32) c1[n & 15] = cv; else if (n < 48) c2[n & 15] = cv; else c3[n & 15] = cv;
                }
            }
            top16_of_64(c0, c1, c2, c3);
            float tv[16]; unsigned te[16];
#pragma unroll
            for (int r = 0; r < 16; ++r) {
                const unsigned ij = __float_as_uint(c0[r]) & 255u;
                te[r] = ktab[(ij >> 4) * 64] * 128u + ktab[(16 + (ij & 15u)) * 64];
                tv[r] = __uint_as_float(__float_as_uint(c0[r]) & 0xFFFFFF00u);
            }
            const float tmax = tv[0]; float sum = 0.f;
#pragma unroll
            for (int r = 0; r < 16; ++r) { tv[r] = __expf(tv[r] - tmax); sum += tv[r]; }
            const float rinv = 1.f / sum;
#pragma unroll
            for (int r = 0; r < 16; ++r) tv[r] *= rinv;
            if (hi == 0) {
                int* ep = SE + (size_t)tok * 128 + h * 16; float* gp = SG + (size_t)tok * 128 + h * 16;
#pragma unroll
                for (int q = 0; q < 4; ++q) { *(u32x4*)(ep + 4 * q) = (u32x4){te[4 * q], te[4 * q + 1], te[4 * q + 2], te[4 * q + 3]}; *(f32x4*)(gp + 4 * q) = (f32x4){tv[4 * q], tv[4 * q + 1], tv[4 * q + 2], tv[4 * q + 3]}; }
            }
        }
#ifndef SEL_SPLIT
        if (bi == (int)blockIdx.x && mode != 1) peer_tables_q8(p, blockIdx.x * NWAVES + wid, gridDim.x * NWAVES, lane);
#endif
    }
}

__device__ __forceinline__ void peer_tables_bf16(const Params& p) {
    const size_t gt = (size_t)blockIdx.x * NTHREADS + threadIdx.x, NGT = (size_t)gridDim.x * NTHREADS;
    const float* U = p.in[21]; const float* V = p.in[22];
    bf16_t* UB = (bf16_t*)(p.ws + WS_UB); bf16_t* VB = (bf16_t*)(p.ws + WS_VB);
    for (size_t i = gt; i < (size_t)16384 * DM / 8; i += NGT) {
        const f32x4 a0 = *(const f32x4*)(U + i * 8), a1 = *(const f32x4*)(U + i * 8 + 4), b0 = *(const f32x4*)(V + i * 8), b1 = *(const f32x4*)(V + i * 8 + 4);
        u32x4 w; w.x = pk2(a0[0], a0[1]); w.y = pk2(a0[2], a0[3]); w.z = pk2(a1[0], a1[1]); w.w = pk2(a1[2], a1[3]);
        *(u32x4*)(UB + i * 8) = w;
        w.x = pk2(b0[0], b0[1]); w.y = pk2(b0[2], b0[3]); w.z = pk2(b1[0], b1[1]); w.w = pk2(b1[2], b1[3]);
        *(u32x4*)(VB + i * 8) = w;
    }
}

typedef short s16x2 __attribute__((ext_vector_type(2)));
__device__ __forceinline__ float dot2_bf16(unsigned a, unsigned b, float acc) { return __builtin_amdgcn_fdot2_f32_bf16(__builtin_bit_cast(s16x2, a), __builtin_bit_cast(s16x2, b), acc, false); }
__device__ __forceinline__ float dot8_bf16(const u32x4 a, const u32x4 b, float acc) {
    const unsigned a0 = a[0], a1 = a[1], a2 = a[2], a3 = a[3], b0 = b[0], b1 = b[1], b2 = b[2], b3 = b[3];
    acc = dot2_bf16(a0, b0, acc); acc = dot2_bf16(a1, b1, acc); acc = dot2_bf16(a2, b2, acc); acc = dot2_bf16(a3, b3, acc);
    return acc;
}
__device__ __forceinline__ void peer_select(const float* __restrict__ TKV, const int* __restrict__ TKI, int m, int lane, int& eA, int& eB, float& gA, float& gB) {
    eA = 0; eB = 0; gA = 0.f; gB = 0.f;
#pragma nounroll
    for (int h = 0; h < 8; ++h) {
        const float* v1 = TKV + ((size_t)m * 16 + h * 2) * 16; const float* v2 = v1 + 16;
        const int* i1 = TKI + ((size_t)m * 16 + h * 2) * 16; const int* i2 = i1 + 16;
        float cv[4]; int ci[4];
        const float v2j = v2[lane & 15];
#pragma unroll
        for (int e = 0; e < 4; ++e) { const int i = (lane >> 4) + 4 * e; cv[e] = v1[i] + v2j; ci[e] = i * 16 + (lane & 15); }
        float tv; int tc; wave_top16<4>(cv, ci, tv, tc, lane);
        int eid = 0;
        if (lane < 16) eid = i1[tc >> 4] * 128 + i2[tc & 15];
        const float mx = __shfl(tv, 0);
        const float ex = lane < 16 ? __expf(tv - mx) : 0.f;
        const float gate = ex / wave_sum(ex);
        const int es = __shfl(eid, lane & 15); const float gs = __shfl(gate, lane & 15);
        if ((lane >> 4) == (h & 3)) { if (h < 4) { eA = es; gA = gs; } else { eB = es; gB = gs; } }
    }
}
__device__ __forceinline__ void peer_gather(const Params& p, bool dry = false) {
    int tid_ = threadIdx.x; asm volatile("" : "+v"(tid_)); const int tid = tid_, lane = tid & 63, wid = tid >> 6;
    const int gw = blockIdx.x * NWAVES + wid, NGW = gridDim.x * NWAVES;
    const float* TKV = (const float*)(p.ws + WS_TKV); const int* TKI = (const int*)(p.ws + WS_TKI);
    const bf16_t* H = (const bf16_t*)(p.ws + WS_H);
    const bf16_t* UB = (const bf16_t*)(p.ws + WS_UB); const bf16_t* VB = (const bf16_t*)(p.ws + WS_VB);
    const float* mod = (const float*)(p.ws + WS_MOD); const float* gpo = p.in[9];
    for (int m = gw; m < TL; m += NGW) {
        int eA, eB; float gA, gB;
        peer_select(TKV, TKI, m, lane, eA, eB, gA, gB);
        asm volatile("" : "+v"(eA), "+v"(eB), "+v"(gA), "+v"(gB));
        u32x4 us[2][4], vs[2][4];
#define PG_LOAD(S, k) do { const int e_ = __builtin_amdgcn_readlane((k) < 64 ? eA : eB, (k) & 63); \
            const bf16_t* up_ = UB + (size_t)e_ * DM + lane * 8; const bf16_t* vp_ = VB + (size_t)e_ * DM + lane * 8; \
            _Pragma("unroll") for (int i = 0; i < 4; ++i) { us[S][i] = *(const u32x4*)(up_ + i * 512); vs[S][i] = *(const u32x4*)(vp_ + i * 512); } } while (0)
        PG_LOAD(0, 0); PG_LOAD(1, 1);
        u32x4 hq[4];
#pragma unroll
        for (int i = 0; i < 4; ++i) hq[i] = *(const u32x4*)(H + (size_t)m * DM + i * 512 + lane * 8);
        float acc[4][8];
#pragma unroll
        for (int i = 0; i < 4; ++i)
#pragma unroll
            for (int e = 0; e < 8; ++e) acc[i][e] = 0.f;
#define PG_USE(S, k) do { float d_ = 0.f; \
            _Pragma("unroll") for (int i = 0; i < 4; ++i) d_ = dot8_bf16(us[S][i], hq[i], d_); \
            d_ = wave_sum(d_); \
            const float g_ = __uint_as_float((unsigned)__builtin_amdgcn_readlane((int)__float_as_uint((k) < 64 ? gA : gB), (k) & 63)); \
            const float cf_ = g_ * gelu_as(d_); \
            _Pragma("unroll") for (int i = 0; i < 4; ++i) { const u32x4 w_ = vs[S][i]; \
                acc[i][0] += cf_ * __uint_as_float(w_.x << 16); acc[i][1] += cf_ * __uint_as_float(w_.x & 0xffff0000u); \
                acc[i][2] += cf_ * __uint_as_float(w_.y << 16); acc[i][3] += cf_ * __uint_as_float(w_.y & 0xffff0000u); \
                acc[i][4] += cf_ * __uint_as_float(w_.z << 16); acc[i][5] += cf_ * __uint_as_float(w_.z & 0xffff0000u); \
                acc[i][6] += cf_ * __uint_as_float(w_.w << 16); acc[i][7] += cf_ * __uint_as_float(w_.w & 0xffff0000u); } } while (0)
#pragma nounroll
        for (int k = 0; k < 128; k += 2) {
            PG_USE(0, k);     if (k + 2 < 128) PG_LOAD(0, k + 2);
            PG_USE(1, k + 1); if (k + 3 < 128) PG_LOAD(1, k + 3);
        }
#undef PG_LOAD
#undef PG_USE
        float ss = 0.f;
#pragma unroll
        for (int i = 0; i < 4; ++i)
#pragma unroll
            for (int e = 0; e < 8; ++e) ss += acc[i][e] * acc[i][e];
        const float rstd = rsqrtf(wave_sum(ss) * (1.f / DM) + EPS);
        const int b = m / SEQ;
#pragma unroll
        for (int i = 0; i < 4; ++i)
#pragma unroll
            for (int q = 0; q < 2; ++q) {
                const int c = i * 512 + lane * 8 + q * 4;
                const f32x4 gt2 = *(const f32x4*)(mod + (size_t)b * 12288 + 10240 + c), gg = *(const f32x4*)(gpo + c);
                float* op = p.out + (size_t)m * DM + c;
                const f32x4 x1 = *(const f32x4*)op;
                const f32x4 y = {acc[i][4 * q], acc[i][4 * q + 1], acc[i][4 * q + 2], acc[i][4 * q + 3]};
                const f32x4 res = x1 + gt2 * (y * rstd * gg);
                if (!dry) *(f32x4*)op = res; else asm volatile("" :: "v"(res));
            }
    }
}


__device__ __forceinline__ void peer_q8_row(const Params& p, int r, const f32x4 (&v)[8], int lane) {
    unsigned char* UQ = p.ws + WS_UQ; unsigned char* VQ = p.ws + WS_VQ; float* USC = (float*)(p.ws + WS_USC); float* VSC = (float*)(p.ws + WS_VSC);
    const bool isv = r >= 16384; const int e = isv ? r - 16384 : r;
    float mx = 0.f;
#pragma unroll
    for (int j = 0; j < 8; ++j) mx = fmaxf(mx, fmaxf(fmaxf(fabsf(v[j][0]), fabsf(v[j][1])), fmaxf(fabsf(v[j][2]), fabsf(v[j][3]))));
    mx = fmaxf(wave_max(mx), 1e-30f);
    const float sc = mx * (1.f / 127.f), inv = 127.f / mx;
    unsigned char* dst = (isv ? VQ : UQ) + (size_t)e * DM;
    const int zp = isv ? 128 : 0;
#pragma unroll
    for (int j = 0; j < 8; ++j) {
        unsigned w = 0;
#pragma unroll
        for (int c = 0; c < 4; ++c) { const int q = (int)rintf(v[j][c] * inv) + zp; w |= ((unsigned)q & 0xffu) << (8 * c); }
        *(unsigned*)(dst + j * 256 + lane * 4) = w;
    }
    if (lane == 0) (isv ? VSC : USC)[e] = sc;
}
__device__ __forceinline__ void peer_tables_q8(const Params& p, int gw, int NGW, int lane) {
    f32x4 va[8], vb[8];
#define Q8_LOAD(dst, r) do { const float* s_ = ((r) >= 16384 ? p.in[22] + (size_t)((r) - 16384) * DM : p.in[21] + (size_t)(r) * DM); \
        _Pragma("unroll") for (int j = 0; j < 8; ++j) dst[j] = *(const f32x4*)(s_ + j * 256 + lane * 4); } while (0)
    int r = gw;
    if (r < 2 * 16384) Q8_LOAD(va, r);
    for (; r < 2 * 16384; r += 2 * NGW) {
        const int r1 = r + NGW, r2 = r + 2 * NGW;
        if (r1 < 2 * 16384) Q8_LOAD(vb, r1);
        peer_q8_row(p, r, va, lane);
        if (r2 < 2 * 16384) Q8_LOAD(va, r2);
        if (r1 < 2 * 16384) peer_q8_row(p, r1, vb, lane);
    }
#undef Q8_LOAD
}

__device__ __forceinline__ void peer_gather_q8(const Params& p, unsigned char* lds_, bool dry = false, int emask = 0x3fff) {
    int tid_ = threadIdx.x; asm volatile("" : "+v"(tid_)); const int tid = tid_, lane = tid & 63, wid = tid >> 6;
    LAS3 int* srt = (LAS3 int*)lds_ + wid * 256;
    const int gw = blockIdx.x * NWAVES + wid, NGW = gridDim.x * NWAVES;
    const float* TKV = (const float*)(p.ws + WS_TKV); const int* TKI = (const int*)(p.ws + WS_TKI);
    const bf16_t* H = (const bf16_t*)(p.ws + WS_H);
    const unsigned char* UQ = p.ws + WS_UQ; const unsigned char* VQ = p.ws + WS_VQ; const float* USC = (const float*)(p.ws + WS_USC); const float* VSC = (const float*)(p.ws + WS_VSC);
    const float* mod = (const float*)(p.ws + WS_MOD); const float* gpo = p.in[9];
    const int rounds = (TL + NGW - 1) / NGW;
    for (int it = 0; it < rounds; ++it) {
        const int m = gw + it * NGW;
#ifndef GATHER_UNSORTED
        __syncthreads();
#endif
        if (m >= TL) continue;
        int eA, eB; float gA, gB;
#if defined(TOPK_NAIVE) || defined(TOPK_STAGE1)
        peer_select(TKV, TKI, m, lane, eA, eB, gA, gB);
#else
        eA = TKI[(size_t)m * 128 + lane]; eB = TKI[(size_t)m * 128 + 64 + lane]; gA = TKV[(size_t)m * 128 + lane]; gB = TKV[(size_t)m * 128 + 64 + lane];
#endif
#ifndef GATHER_UNSORTED
        {
            int rA = 0, rB = 0;
#pragma nounroll
            for (int j = 0; j < 64; ++j) {
                const int ea = __builtin_amdgcn_readlane(eA, j), eb = __builtin_amdgcn_readlane(eB, j);
                rA += (ea < eA || (ea == eA && j < lane)) ? 1 : 0; rA += (eb < eA) ? 1 : 0;
                rB += (ea < eB || ea == eB) ? 1 : 0; rB += (eb < eB || (eb == eB && j < lane)) ? 1 : 0;
            }
            srt[rA] = eA; srt[128 + rA] = __float_as_int(gA); srt[rB] = eB; srt[128 + rB] = __float_as_int(gB);
            eA = srt[lane]; eB = srt[64 + lane]; gA = __int_as_float(srt[128 + lane]); gB = __int_as_float(srt[192 + lane]);
        }
#endif
        asm volatile("" : "+v"(eA), "+v"(eB), "+v"(gA), "+v"(gB));
        unsigned hq[2][4]; float hscale;
        {
            u32x4 hw[2][2]; float mx = 0.f;
#pragma unroll
            for (int i = 0; i < 2; ++i)
#pragma unroll
                for (int q = 0; q < 2; ++q) { hw[i][q] = *(const u32x4*)(H + (size_t)m * DM + i * 1024 + lane * 16 + q * 8);
#pragma unroll
                    for (int c = 0; c < 4; ++c) { const unsigned w = hw[i][q][c]; mx = fmaxf(mx, fmaxf(fabsf(__uint_as_float(w << 16)), fabsf(__uint_as_float(w & 0xffff0000u)))); } }
            mx = fmaxf(wave_max(mx), 1e-30f);
            hscale = mx * (1.f / 127.f); const float inv = 127.f / mx;
#pragma unroll
            for (int i = 0; i < 2; ++i)
#pragma unroll
                for (int q = 0; q < 2; ++q)
#pragma unroll
                    for (int c2 = 0; c2 < 2; ++c2) {
                        const unsigned w0 = hw[i][q][2 * c2], w1 = hw[i][q][2 * c2 + 1];
                        const int q0 = (int)rintf(__uint_as_float(w0 << 16) * inv), q1 = (int)rintf(__uint_as_float(w0 & 0xffff0000u) * inv);
                        const int q2 = (int)rintf(__uint_as_float(w1 << 16) * inv), q3 = (int)rintf(__uint_as_float(w1 & 0xffff0000u) * inv);
                        hq[i][2 * q + c2] = ((unsigned)q0 & 0xffu) | (((unsigned)q1 & 0xffu) << 8) | (((unsigned)q2 & 0xffu) << 16) | (((unsigned)q3 & 0xffu) << 24);
                    }
        }
        float cA = 0.f, cB = 0.f; float csum = 0.f;
        {
            u32x4 us[8][2]; float usc[8], vsc[8];
#define PU_LOAD(S, k) do { const int e_ = __builtin_amdgcn_readlane((k) < 64 ? eA : eB, (k) & 63) & emask; int ev_ = e_; asm volatile("" : "+v"(ev_)); \
                const unsigned char* up_ = UQ + (size_t)e_ * DM + lane * 16; us[S][0] = *(const u32x4*)up_; us[S][1] = *(const u32x4*)(up_ + 1024); usc[S] = USC[ev_]; vsc[S] = VSC[ev_]; } while (0)
#define PU_COEF(S, k) do { int id_ = 0; \
                _Pragma("unroll") for (int i = 0; i < 2; ++i) _Pragma("unroll") for (int c = 0; c < 4; ++c) { const unsigned uw_ = us[S][i][c]; id_ = __builtin_amdgcn_sdot4((int)uw_, (int)hq[i][c], id_, false); } \
                const float d_ = wave_sum_dpp((float)id_) * (hscale * usc[S]); \
                const float g_ = __uint_as_float((unsigned)__builtin_amdgcn_readlane((int)__float_as_uint((k) < 64 ? gA : gB), (k) & 63)); \
                const float cf_ = g_ * gelu_as(d_) * vsc[S]; csum += cf_; \
                if ((k) < 64) cA = lane == ((k) & 63) ? cf_ : cA; else cB = lane == ((k) & 63) ? cf_ : cB; } while (0)
            PU_LOAD(0, 0); PU_LOAD(1, 1); PU_LOAD(2, 2); PU_LOAD(3, 3);
#pragma nounroll
            for (int k = 0; k < 128; k += 4) {
                const int kn = k + 4 < 128 ? k + 4 : 124;
                PU_COEF(0, k + 0); PU_COEF(1, k + 1); PU_COEF(2, k + 2); PU_COEF(3, k + 3);
                PU_LOAD(0, kn + 0); PU_LOAD(1, kn + 1); PU_LOAD(2, kn + 2); PU_LOAD(3, kn + 3);
            }
#undef PU_LOAD
#undef PU_COEF
        }
        float acc[2][16];
#pragma unroll
        for (int i = 0; i < 2; ++i)
#pragma unroll
            for (int e = 0; e < 16; ++e) acc[i][e] = 0.f;
        {
            u32x4 vs[8][2];
#define PV_LOAD(S, k) do { const int e_ = __builtin_amdgcn_readlane((k) < 64 ? eA : eB, (k) & 63) & emask; \
                const unsigned char* vp_ = VQ + (size_t)e_ * DM + lane * 16; vs[S][0] = *(const u32x4*)vp_; vs[S][1] = *(const u32x4*)(vp_ + 1024); } while (0)
#define PV_ACC(S, k) do { const float cf_ = __uint_as_float((unsigned)__builtin_amdgcn_readlane((int)__float_as_uint((k) < 64 ? cA : cB), (k) & 63)); \
                _Pragma("unroll") for (int i = 0; i < 2; ++i) _Pragma("unroll") for (int c = 0; c < 4; ++c) { const unsigned w_ = vs[S][i][c]; \
                    acc[i][4 * c + 0] += cf_ * (float)(w_ & 0xffu); acc[i][4 * c + 1] += cf_ * (float)((w_ >> 8) & 0xffu); \
                    acc[i][4 * c + 2] += cf_ * (float)((w_ >> 16) & 0xffu); acc[i][4 * c + 3] += cf_ * (float)(w_ >> 24); } } while (0)
            PV_LOAD(0, 0); PV_LOAD(1, 1);
#pragma nounroll
            for (int k = 0; k < 128; k += 2) {
                const int kn = k + 2 < 128 ? k + 2 : 126;
                PV_ACC(0, k); PV_ACC(1, k + 1);
                PV_LOAD(0, kn); PV_LOAD(1, kn + 1);
            }
#undef PV_LOAD
#undef PV_ACC
        }
        const float zoff = 128.f * csum;
        float ss = 0.f;
#pragma unroll
        for (int i = 0; i < 2; ++i)
#pragma unroll
            for (int e = 0; e < 16; ++e) { acc[i][e] -= zoff; ss += acc[i][e] * acc[i][e]; }
        const float rstd = rsqrtf(wave_sum(ss) * (1.f / DM) + EPS);
        const int b = m / SEQ;
#pragma unroll
        for (int i = 0; i < 2; ++i)
#pragma unroll
            for (int q = 0; q < 4; ++q) {
                const int c = i * 1024 + lane * 16 + q * 4;
                const f32x4 gt2 = *(const f32x4*)(mod + (size_t)b * 12288 + 10240 + c), gg = *(const f32x4*)(gpo + c);
                float* op = p.out + (size_t)m * DM + c;
                const f32x4 x1 = *(const f32x4*)op;
                const f32x4 y = {acc[i][4 * q], acc[i][4 * q + 1], acc[i][4 * q + 2], acc[i][4 * q + 3]};
                const f32x4 res = x1 + gt2 * (y * rstd * gg);
                if (!dry) *(f32x4*)op = res; else asm volatile("" :: "v"(res));
            }
    }
}


#define LAS __attribute__((address_space(3)))
#define XB_TMO      128
#define XB_XCNT(j)  (256  + 64 * (j))
#define XB_XSUB(j)  (1280 + 64 * (j))
#define XB_XGEN(j)  (2304 + 64 * (j))
#define XB_TOP      3328
#define XB_TOPGEN   3392
#define XCD_BAR_WORDS 3456
#define XB_SPIN_CAP (1u << 18)

__device__ __forceinline__ unsigned xb_ld(unsigned* p)              { return __hip_atomic_load(p, __ATOMIC_RELAXED, __HIP_MEMORY_SCOPE_AGENT); }
__device__ __forceinline__ unsigned xb_add(unsigned* p, unsigned v) { return __hip_atomic_fetch_add(p, v, __ATOMIC_RELAXED, __HIP_MEMORY_SCOPE_AGENT); }
__device__ __forceinline__ unsigned xb_xcc_id() { return (unsigned)__builtin_amdgcn_s_getreg((3 << 11) | 20) & 0xFu; }
#define XB_SPIN(cond, bar) do { unsigned _sp = 0; while (cond) { __builtin_amdgcn_s_sleep(1); \
    if ((++_sp & 255u) == 0u) { if (xb_ld(&(bar)[XB_TMO])) break; if (_sp > XB_SPIN_CAP) { atomicAdd(&(bar)[XB_TMO], 1u); break; } } } } while (0)

struct XcdBarrier {
    unsigned* bar; unsigned x;
    volatile LAS unsigned* st;
};

__device__ __forceinline__ XcdBarrier xcd_barrier_post(unsigned* bar, volatile LAS unsigned* st) {
    XcdBarrier b; b.bar = bar; b.x = xb_xcc_id(); b.st = st;
    if (threadIdx.x == 0) (void)xb_add(&bar[XB_XCNT(b.x)], 1u);
    return b;
}
__device__ __forceinline__ void xcd_barrier_complete(unsigned* bar, unsigned x, unsigned& nloc, unsigned& nx) {
    const unsigned G = gridDim.x * gridDim.y * gridDim.z;
    unsigned sum, cnt, mine, sp = 0u;
    for (;;) {
        sum = 0u; cnt = 0u; mine = 0u;
#pragma unroll
        for (unsigned j = 0; j < 16; ++j) { const unsigned c = xb_ld(&bar[XB_XCNT(j)]); sum += c; cnt += (c > 0u) ? 1u : 0u; mine = (j == x) ? c : mine; }
        if (sum == G) break;
        __builtin_amdgcn_s_sleep(1);
        if ((++sp & 255u) == 0u) { if (xb_ld(&bar[XB_TMO])) break; if (sp > XB_SPIN_CAP) { atomicAdd(&bar[XB_TMO], 1u); break; } }
    }
    nloc = mine > 0u ? mine : 1u; nx = cnt > 0u ? cnt : 1u;
}

__device__ __forceinline__ void xcd_barrier(const XcdBarrier& b) {
    asm volatile("s_waitcnt vmcnt(0)" ::: "memory");
    __syncthreads();
    if (threadIdx.x == 0) {
        unsigned* bar = b.bar;
        __builtin_amdgcn_s_waitcnt(0);
        unsigned nloc = b.st[0], nx = b.st[1];
        if (nloc == 0u) { xcd_barrier_complete(bar, b.x, nloc, nx); b.st[0] = nloc; b.st[1] = nx; }
        const unsigned old = xb_add(&bar[XB_XSUB(b.x)], 1u);
        const unsigned gen = old / nloc;
        if (old + 1u == (gen + 1u) * nloc) {
            __builtin_amdgcn_fence(__ATOMIC_RELEASE, "agent");
            asm volatile("s_waitcnt vmcnt(0)" ::: "memory");
            const unsigned og = xb_add(&bar[XB_TOP], 1u);
            const unsigned tg = og / nx;
            if (og + 1u == (tg + 1u) * nx) xb_add(&bar[XB_TOPGEN], 1u);
            else XB_SPIN(xb_ld(&bar[XB_TOPGEN]) == tg, bar);
            __builtin_amdgcn_fence(__ATOMIC_ACQUIRE, "agent");
            xb_add(&bar[XB_XGEN(b.x)], 1u);
            asm volatile("s_waitcnt vmcnt(0)" ::: "memory");
        } else {
            XB_SPIN(xb_ld(&bar[XB_XGEN(b.x)]) == gen, bar);
            __builtin_amdgcn_fence(__ATOMIC_ACQUIRE, "agent");
            asm volatile("s_waitcnt vmcnt(0)" ::: "memory");
        }
    }
    __syncthreads();
}


__global__ void __launch_bounds__(NTHREADS, 2) mega(Params p) {
    extern __shared__ __attribute__((aligned(16))) unsigned char lds[];
    cg::grid_group grid = cg::this_grid();
    unsigned char* ws = p.ws;
    bf16_t* H = (bf16_t*)(ws + WS_H); bf16_t* PL = (bf16_t*)(ws + WS_PL); bf16_t* PCx = (bf16_t*)(ws + WS_PC);
    const int lo = p.ph_lo, hi = p.ph_hi;
    volatile LAS unsigned* bst = (volatile LAS unsigned*)((LAS unsigned char*)lds + (LDS_BYTES - 64));
    unsigned* barw = (unsigned*)(ws + WS_BAR);
    if (threadIdx.x < 2) bst[threadIdx.x] = 0u;
    if (blockIdx.x == 0) for (int i = threadIdx.x; i < XCD_BAR_WORDS; i += NTHREADS) barw[i] = 0u;
    __syncthreads();
    XcdBarrier xbar; xbar.bar = barw; xbar.x = 0; xbar.st = bst;
#ifdef PHONLY
#define IN(k) ((k) == PHONLY && lo <= (k) && (k) < hi)
#else
#define IN(k) (lo <= (k) && (k) < hi)
#endif
#ifndef DUP
#define DUP -1
#endif
#define REP(k) for (int rep_ = 0; rep_ < ((k) == DUP ? 2 : 1); ++rep_)
#define SEAM(k) do { if (IN(k) && IN((k) + 1)) { \
        if ((k) == 0) { asm volatile("s_waitcnt vmcnt(0) lgkmcnt(0)" ::: "memory"); grid.sync(); \
            if (threadIdx.x < 64) { __builtin_amdgcn_fence(__ATOMIC_ACQUIRE, "agent"); asm volatile("s_waitcnt vmcnt(0)" ::: "memory"); } __syncthreads(); \
            xbar = xcd_barrier_post(barw, bst); } \
        else xcd_barrier(xbar); } } while (0)
    if (IN(0)) { phase0(p, lds); __syncthreads(); if (DUP == 0) { phase0(p, lds); __syncthreads(); } }
    SEAM(0);
    if (IN(1)) REP(1) phase1(p);
    SEAM(1);
    if (IN(2)) REP(2) {
        { EpiInproj e{PL, NP, PC_GA}; run_gemm<EpiInproj, false>(lds, H, DM, (const bf16_t*)(ws + WS_WIN), DM, TL, NP, DM, e); }
        { EpiInproj e{PCx, NPC, 1 << 30}; run_gemm<EpiInproj, false>(lds, H + (size_t)TL * DM, DM, (const bf16_t*)(ws + WS_WIN), DM, TC, NPC, DM, e, 128); }
    }
    SEAM(2);
    if (IN(3)) {
#ifndef NO_P3_GEMM
        { EpiMlaQ e{(bf16_t*)(ws + WS_QM), (const float*)(ws + WS_ROPE)}; run_gemm<EpiMlaQ, true>(lds, PL + PC_CQ, NP, (const bf16_t*)(ws + WS_WQB), QR, TL, MQW, QR, e); }
        { EpiMlaKV e{(bf16_t*)(ws + WS_KVM), 0}; run_gemm<EpiMlaKV, true>(lds, PL + PC_CKV, NP, (const bf16_t*)(ws + WS_WKVB), KVR, TL, MKVW, KVR, e); }
        { EpiMlaKV e{(bf16_t*)(ws + WS_KVM), TL}; run_gemm<EpiMlaKV, true>(lds, PCx + PC_CKV, NPC, (const bf16_t*)(ws + WS_WKVB), KVR, TC, MKVW, KVR, e, 128); __syncthreads(); }
        if (DUP == 31) {
        { EpiMlaQ e{(bf16_t*)(ws + WS_QM), (const float*)(ws + WS_ROPE)}; run_gemm<EpiMlaQ, true>(lds, PL + PC_CQ, NP, (const bf16_t*)(ws + WS_WQB), QR, TL, MQW, QR, e); }
        { EpiMlaKV e{(bf16_t*)(ws + WS_KVM), 0}; run_gemm<EpiMlaKV, true>(lds, PL + PC_CKV, NP, (const bf16_t*)(ws + WS_WKVB), KVR, TL, MKVW, KVR, e); }
        { EpiMlaKV e{(bf16_t*)(ws + WS_KVM), TL}; run_gemm<EpiMlaKV, true>(lds, PCx + PC_CKV, NPC, (const bf16_t*)(ws + WS_WKVB), KVR, TC, MKVW, KVR, e, 128); __syncthreads(); }
        }
#endif
        kpe_pass(p);
#ifdef NA_NAIVE
        na_naive(p, lds);
#else
#ifdef NA_PERWAVE
        na_flash(p, lds);
        if (DUP == 30) na_flash(p, lds);
#else
        na_coop(p, lds);
        if (DUP == 30) na_coop(p, lds);
#endif
#endif
    }
    SEAM(3);
#ifdef MLA_NAIVE
    if (IN(4)) mla_naive(p, lds);
#else
    if (IN(4)) REP(4) mla_flash(p, lds);
#endif
    SEAM(4);
    if (IN(5)) REP(5) {
        { EpiMergeF e{H, PL}; run_gemm<EpiMergeF, false>(lds, (const bf16_t*)(ws + WS_OA), DM, (const bf16_t*)(ws + WS_WA), DM, TL, DM, DM, e); }
    }
    SEAM(5);
    if (IN(6)) REP(6) { EpiStore e{(bf16_t*)(ws + WS_Z), DM}; run_gemm<EpiStore, false>(lds, H, DM, (const bf16_t*)(ws + WS_WO), DM, TL, DM, DM, e); }
    SEAM(6);
    if (IN(7)) REP(7) phase7(p);
    SEAM(7);
    if (IN(8)) REP(8) { EpiStore e{(bf16_t*)(ws + WS_QP), DM}; run_gemm<EpiStore, false>(lds, H, DM, (const bf16_t*)(ws + WS_WPQ), DM, TL, DM, DM, e); }
    SEAM(8);
    if (IN(9)) REP(9) {
#if defined(TOPK_NAIVE)
        peer_topk_naive(p, lds);
#elif defined(TOPK_STAGE1)
        peer_topk_mfma(p, lds);
#else
        peer_select_mfma(p, lds);
        if (DUP == 90) peer_select_mfma(p, lds, 1);
        if (DUP == 91) peer_select_mfma(p, lds, 2);
#endif
#ifdef PEER_BF16
        peer_tables_bf16(p);
#endif
    }
    SEAM(9);
#ifdef PEER_NAIVE
    if (IN(10)) peer_final_naive(p, lds);
#else
#ifdef PEER_BF16
    if (IN(10)) { if (DUP == 10) peer_gather(p, true); peer_gather(p); }
#else
    if (IN(10)) { if (DUP == 10) peer_gather_q8(p, lds, true); if (DUP == 100) peer_gather_q8(p, lds, true, 1023); if (DUP == 101) peer_gather_q8(p, lds, true, 127); peer_gather_q8(p, lds); }
#endif
#endif
#undef IN
#undef SEAM
}

extern "C" void kernel_launch(void* const* d_in, const int* in_sizes, int n_in, void* d_out, int out_size, void* d_ws, size_t ws_size, hipStream_t stream) {
    static int grid = 0;
    if (grid == 0) {
        int dev = 0, cus = 0, per_cu = 0;
        (void)hipGetDevice(&dev);
        (void)hipDeviceGetAttribute(&cus, hipDeviceAttributeMultiprocessorCount, dev);
        (void)hipFuncSetAttribute((const void*)mega, hipFuncAttributeMaxDynamicSharedMemorySize, LDS_BYTES);
        (void)hipOccupancyMaxActiveBlocksPerMultiprocessor(&per_cu, (const void*)mega, NTHREADS, LDS_BYTES);
        if (per_cu < 1) { fprintf(stderr, "occupancy query says %d blocks per CU\n", per_cu); per_cu = 1; }
        grid = cus * 1;
        (void)hipGetLastError();
        if (n_in != 23 || ws_size < WS_END) fprintf(stderr, "kernel_launch: unexpected n_in %d or ws %zu\n", n_in, ws_size);
    }
    Params p{};
    for (int i = 0; i < 23; ++i) p.in[i] = (const float*)d_in[i];
    p.out = (float*)d_out; p.ws = (unsigned char*)d_ws; p.ph_lo = 0; p.ph_hi = 11;
    void* args[] = {&p};
    hipError_t e = hipLaunchCooperativeKernel((const void*)mega, dim3(grid), dim3(NTHREADS), args, LDS_BYTES, stream);
    if (e != hipSuccess) fprintf(stderr, "cooperative launch failed: %s (grid %d)\n", hipGetErrorString(e), grid);
}
```

```cpp
#include <hip/hip_runtime.h>
#include <hip/hip_cooperative_groups.h>
#include <cstdio>
#include <cstdint>
namespace cg = cooperative_groups;

typedef unsigned short bf16_t;
typedef short bf16x8 __attribute__((ext_vector_type(8)));
typedef float f32x4 __attribute__((ext_vector_type(4)));
typedef unsigned u32x4 __attribute__((ext_vector_type(4)));
typedef unsigned u32x2 __attribute__((ext_vector_type(2)));

constexpr int DM = 2048, NB = 8, SEQ = 2048, CTX = 256, GW = 64, GROWS = 32;
constexpr int TL = NB * SEQ;
constexpr int TC = NB * CTX;
constexpr int TA = TL + TC;
constexpr int IN_COLS = 8512;
constexpr int NP = 8704;
constexpr int NPC = 2816;
constexpr int PC_KA = 0, PC_VA = 1024, PC_CKV = 2048, PC_KPE = 2560, PC_QA = 2816, PC_CQ = 3840, PC_GA = 4608, PC_GB = 6656;
constexpr int QR = 768, KVR = 512;
constexpr int MQW = 1536, MKVW = 2048;
constexpr float EPS = 1e-6f;
constexpr float LOG2E = 1.4426950408889634f;
constexpr float MLA_QSCALE = 0.07216878364870322f * LOG2E;
constexpr float NA_SCALE = 0.125f;

constexpr size_t al256(size_t x) { return (x + 255) & ~(size_t)255; }
constexpr size_t WS_MOD = 0;
constexpr size_t WS_ROPE = al256(WS_MOD + 9 * 12288 * 4);
constexpr size_t WS_BAR = al256(WS_ROPE + (size_t)SEQ * 32 * 2 * 4);
constexpr size_t WS_WIN = al256(WS_BAR + 3456 * 4);
constexpr size_t WS_WQB = WS_WIN + (size_t)NP * DM * 2;
constexpr size_t WS_WKVB = WS_WQB + (size_t)MQW * QR * 2;
constexpr size_t WS_WA = WS_WKVB + (size_t)MKVW * KVR * 2;
constexpr size_t WS_WB = WS_WA + (size_t)DM * 1024 * 2;
constexpr size_t WS_WO = WS_WB + (size_t)DM * 1024 * 2;
constexpr size_t WS_WPQ = WS_WO + (size_t)DM * DM * 2;
constexpr size_t WS_SUBK = WS_WPQ + (size_t)DM * DM * 2;
constexpr size_t WS_H = WS_SUBK + (size_t)262144 * 2;
constexpr size_t WS_PL = WS_H + (size_t)TA * DM * 2;
constexpr size_t WS_PC = WS_PL + (size_t)TL * NP * 2;
constexpr size_t WS_QM = WS_PC + (size_t)TC * NPC * 2;
constexpr size_t WS_KVM = WS_QM + (size_t)TL * MQW * 2;
constexpr size_t WS_KPE = WS_KVM + (size_t)TA * MKVW * 2;
constexpr size_t WS_OA = WS_KPE + (size_t)TA * 64 * 2;
constexpr size_t WS_OB = WS_OA + 1024 * 2;
constexpr size_t WS_END = WS_OA + (size_t)TL * 2048 * 2;
constexpr size_t WS_Z = WS_PL;
constexpr size_t WS_QP = WS_PL + (size_t)TL * DM * 2;
constexpr size_t WS_TKV = WS_QP + (size_t)TL * DM * 2;
constexpr size_t WS_TKI = WS_TKV + (size_t)TL * 256 * 4;
constexpr size_t WS_UB = WS_QM;
constexpr size_t WS_VB = WS_UB + (size_t)16384 * DM * 2;
constexpr size_t WS_UQ = WS_QM;
constexpr size_t WS_VQ = WS_UQ + (size_t)16384 * DM;
constexpr size_t WS_USC = WS_VQ + (size_t)16384 * DM;
constexpr size_t WS_VSC = WS_USC + 16384 * 4;
static_assert(WS_TKI + (size_t)TL * 256 * 4 <= WS_PC, "overlay");
static_assert(WS_END <= 650307648ull, "workspace");
static_assert(WS_VB + (size_t)16384 * DM * 2 <= WS_END, "expert table overlay");

constexpr int NTHREADS = 512, NWAVES = 8;
constexpr int LDS_BYTES = 157824;

struct Params {
    const float* in[23];
    float* out;
    unsigned char* ws;
    int ph_lo, ph_hi;
};

__device__ __forceinline__ float bf2f(bf16_t v) { return __uint_as_float((unsigned)v << 16); }
__device__ __forceinline__ unsigned f2bf(float f) { unsigned u = __float_as_uint(f); return (u + 0x7fffu + ((u >> 16) & 1u)) >> 16; }
typedef float pk_f32x2 __attribute__((ext_vector_type(2)));
typedef __bf16 pk_bf16x2 __attribute__((ext_vector_type(2)));
__device__ __forceinline__ unsigned pk2(float lo, float hi) { pk_f32x2 v = {lo, hi}; pk_bf16x2 b = __builtin_convertvector(v, pk_bf16x2); return __builtin_bit_cast(unsigned, b); }
__device__ __forceinline__ float wave_sum(float v) {
#pragma unroll
    for (int o = 1; o < 64; o <<= 1) v += __shfl_xor(v, o);
    return v;
}
__device__ __forceinline__ float wave_sum_dpp(float v) {
    v += __builtin_bit_cast(float, __builtin_amdgcn_update_dpp(0, __builtin_bit_cast(int, v), 0xB1, 0xF, 0xF, false));
    v += __builtin_bit_cast(float, __builtin_amdgcn_update_dpp(0, __builtin_bit_cast(int, v), 0x4E, 0xF, 0xF, false));
    v += __builtin_bit_cast(float, __builtin_amdgcn_update_dpp(0, __builtin_bit_cast(int, v), 0x141, 0xF, 0xF, false));
    v += __builtin_bit_cast(float, __builtin_amdgcn_update_dpp(0, __builtin_bit_cast(int, v), 0x140, 0xF, 0xF, false));
    v += __builtin_bit_cast(float, __builtin_amdgcn_update_dpp(0, __builtin_bit_cast(int, v), 0x142, 0xA, 0xF, false));
    v += __builtin_bit_cast(float, __builtin_amdgcn_update_dpp(0, __builtin_bit_cast(int, v), 0x143, 0xC, 0xF, false));
    return __builtin_bit_cast(float, __builtin_amdgcn_readlane(__builtin_bit_cast(int, v), 63));
}
__device__ __forceinline__ float wave_max(float v) {
#pragma unroll
    for (int o = 1; o < 64; o <<= 1) v = fmaxf(v, __shfl_xor(v, o));
    return v;
}
__device__ __forceinline__ float sigmoidf_(float x) { return __builtin_amdgcn_rcpf(1.f + __expf(-x)); }
__device__ __forceinline__ float silu_(float x) { return x / (1.f + __expf(-x)); }
__device__ __forceinline__ float gelu_erf(float x) { return 0.5f * x * (1.f + erff(x * 0.70710678118654752f)); }

__device__ __forceinline__ float gelu_as(float v) {
    const float t = __builtin_amdgcn_rcpf(fabsf(v) * 0.2316418882f + 1.0f);
    float q = t * 0.5307027145f + (-0.7265760135f); q = q * t + 0.7107068705f; q = q * t + (-0.142248368f); q = q * t + 0.127414796f; q = q * t;
    const float e = __builtin_amdgcn_exp2f((v * v) * (-0.72134752044f));
    const float mm = v * (q * e);
    return v < 0.f ? mm : v - mm;
}
__device__ __forceinline__ void rope_cs(int s, int j, float& c, float& sn) {
    const int gr = s >> 6, gc = s & 63;
    const int i = j & 15;
    const float invf = exp2f(-(float)i * (13.287712379549449f / 16.f));
    const float ang = (float)(j < 16 ? gr : gc) * invf;
    sincosf(ang, &sn, &c);
}

template <class Epi>
__device__ __forceinline__ void ngemm(const bf16_t* __restrict__ A, int lda, const bf16_t* __restrict__ Bt, int ldb, int M, int N, int K, const Epi& epi, float* rs = nullptr) {
    int tid_ = threadIdx.x; asm volatile("" : "+v"(tid_)); const int tid = tid_, wid = tid >> 6, lane = tid & 63, fr = lane & 15, fq = lane >> 4;
    const int tilesM = M / 128, tilesN = N / 256, nt = tilesM * tilesN;
    for (int t = blockIdx.x; t < nt; t += gridDim.x) {
        const int tm = t % tilesM, tn = t / tilesM;
        const int row0 = tm * 128 + (wid >> 2) * 64, col0 = tn * 256 + (wid & 3) * 64;
        if (Epi::PRO) {
            __syncthreads();
            const int r = tid >> 2, part = tid & 3, len = K >> 2;
            const bf16_t* ar = A + (size_t)(tm * 128 + r) * lda + part * len;
            float ss = 0.f;
            for (int k = 0; k < len; k += 8) { const bf16x8 v = *(const bf16x8*)(ar + k);
#pragma unroll
                for (int e = 0; e < 8; ++e) { const float f = bf2f((bf16_t)v[e]); ss += f * f; } }
            ss += __shfl_xor(ss, 1); ss += __shfl_xor(ss, 2);
            if (part == 0) rs[r] = rsqrtf(ss / (float)K + EPS);
            __syncthreads();
        }
        f32x4 acc[4][4];
#pragma unroll
        for (int i = 0; i < 4; ++i)
#pragma unroll
            for (int j = 0; j < 4; ++j) acc[i][j] = (f32x4){0.f, 0.f, 0.f, 0.f};
        const bf16_t* ap = A + (size_t)(row0 + fr) * lda + fq * 8;
        const bf16_t* bp = Bt + (size_t)(col0 + fr) * ldb + fq * 8;
        for (int k0 = 0; k0 < K; k0 += 32) {
            bf16x8 a[4], b[4];
#pragma unroll
            for (int i = 0; i < 4; ++i) a[i] = *(const bf16x8*)(ap + (size_t)i * 16 * lda + k0);
#pragma unroll
            for (int j = 0; j < 4; ++j) b[j] = *(const bf16x8*)(bp + (size_t)j * 16 * ldb + k0);
#pragma unroll
            for (int i = 0; i < 4; ++i)
#pragma unroll
                for (int j = 0; j < 4; ++j) acc[i][j] = __builtin_amdgcn_mfma_f32_16x16x32_bf16(b[j], a[i], acc[i][j], 0, 0, 0);
        }
#pragma unroll
        for (int i = 0; i < 4; ++i) {
            const int row = row0 + i * 16 + fr;
            const float rstd = Epi::PRO ? rs[row - tm * 128] : 1.f;
#pragma unroll
            for (int j = 0; j < 4; ++j) epi.quad(row, col0 + j * 16 + 4 * fq, acc[i][j] * rstd);
        }
    }
}

__device__ __forceinline__ void store_bf4(bf16_t* p, f32x4 v) { u32x2 w; w.x = pk2(v[0], v[1]); w.y = pk2(v[2], v[3]); *(u32x2*)p = w; }
__device__ __forceinline__ void store_bf8(bf16_t* p, f32x4 a, f32x4 b) { u32x4 w; w.x = pk2(a[0], a[1]); w.y = pk2(a[2], a[3]); w.z = pk2(b[0], b[1]); w.w = pk2(b[2], b[3]); *(u32x4*)p = w; }
__device__ __forceinline__ void load_bf8(const bf16_t* p, f32x4& a, f32x4& b) { const u32x4 g = *(const u32x4*)p;
    a = (f32x4){__uint_as_float(g.x << 16), __uint_as_float(g.x & 0xffff0000u), __uint_as_float(g.y << 16), __uint_as_float(g.y & 0xffff0000u)};
    b = (f32x4){__uint_as_float(g.z << 16), __uint_as_float(g.z & 0xffff0000u), __uint_as_float(g.w << 16), __uint_as_float(g.w & 0xffff0000u)}; }

struct EpiInproj {
    static constexpr bool MID = false, PRO = false;
    bf16_t* P; int ldp; int gate0;
    __device__ __forceinline__ void quad(int row, int col, f32x4 v) const {
        if (col >= gate0) { v[0] = sigmoidf_(v[0]); v[1] = sigmoidf_(v[1]); v[2] = sigmoidf_(v[2]); v[3] = sigmoidf_(v[3]); }
        store_bf4(P + (size_t)row * ldp + col, v);
    }
    __device__ __forceinline__ void oct(int row, int col, f32x4 a, f32x4 b) const {
        if (col >= gate0) {
#pragma unroll
            for (int e = 0; e < 4; ++e) { a[e] = sigmoidf_(a[e]); b[e] = sigmoidf_(b[e]); } }
        store_bf8(P + (size_t)row * ldp + col, a, b);
    }
};
struct EpiMlaQ {
    static constexpr bool MID = false, PRO = true;
    bf16_t* Q; const float* rope;
    __device__ __forceinline__ void quad(int row, int col, f32x4 v) const {
        v = v * MLA_QSCALE;
        const int d = col % 192;
        if (d >= 128) {
            const int j = (d - 128) >> 1, s = row & (SEQ - 1);
            const f32x4 cs = *(const f32x4*)(rope + ((size_t)s * 32 + j) * 2);
            const f32x4 o = {v[0] * cs[0] - v[1] * cs[1], v[0] * cs[1] + v[1] * cs[0], v[2] * cs[2] - v[3] * cs[3], v[2] * cs[3] + v[3] * cs[2]};
            v = o;
        }
        store_bf4(Q + (size_t)row * MQW + col, v);
    }
    __device__ __forceinline__ void oct(int row, int col, f32x4 a, f32x4 b) const {
        a = a * MLA_QSCALE; b = b * MLA_QSCALE;
        const int d = col % 192;
        if (d >= 128) {
            const int j = (d - 128) >> 1, s = row & (SEQ - 1);
            const f32x4 c0 = *(const f32x4*)(rope + ((size_t)s * 32 + j) * 2), c1 = *(const f32x4*)(rope + ((size_t)s * 32 + j + 2) * 2);
            const f32x4 oa = {a[0] * c0[0] - a[1] * c0[1], a[0] * c0[1] + a[1] * c0[0], a[2] * c0[2] - a[3] * c0[3], a[2] * c0[3] + a[3] * c0[2]};
            const f32x4 ob = {b[0] * c1[0] - b[1] * c1[1], b[0] * c1[1] + b[1] * c1[0], b[2] * c1[2] - b[3] * c1[3], b[2] * c1[3] + b[3] * c1[2]};
            a = oa; b = ob;
        }
        store_bf8(Q + (size_t)row * MQW + col, a, b);
    }
};
struct EpiMlaKV {
    static constexpr bool MID = false, PRO = true;
    bf16_t* KV; int row_off;
    __device__ __forceinline__ void quad(int row, int col, f32x4 v) const { store_bf4(KV + (size_t)(row_off + row) * MKVW + col, v); }
    __device__ __forceinline__ void oct(int row, int col, f32x4 a, f32x4 b) const { store_bf8(KV + (size_t)(row_off + row) * MKVW + col, a, b); }
};
template <int STEP> struct EpiMerge {
    static constexpr bool MID = false, PRO = false;
    bf16_t* Y; const bf16_t* P;
    __device__ __forceinline__ void quad(int row, int col, f32x4 v) const {
        const u32x2 g = *(const u32x2*)(P + (size_t)row * NP + (STEP == 0 ? PC_GA : PC_GB) + col);
        const f32x4 gv = {__uint_as_float(g.x << 16), __uint_as_float(g.x & 0xffff0000u), __uint_as_float(g.y << 16), __uint_as_float(g.y & 0xffff0000u)};
        v = v * gv;
        if (STEP == 1) {
            const u32x2 y = *(const u32x2*)(Y + (size_t)row * DM + col);
            v[0] += __uint_as_float(y.x << 16); v[1] += __uint_as_float(y.x & 0xffff0000u); v[2] += __uint_as_float(y.y << 16); v[3] += __uint_as_float(y.y & 0xffff0000u);
        }
        store_bf4(Y + (size_t)row * DM + col, v);
    }
};
struct EpiMergeF {
    static constexpr bool MID = true, PRO = false;
    bf16_t* Y; const bf16_t* P;
    __device__ __forceinline__ static f32x4 ld4(const bf16_t* q) { const u32x2 g = *(const u32x2*)q;
        return (f32x4){__uint_as_float(g.x << 16), __uint_as_float(g.x & 0xffff0000u), __uint_as_float(g.y << 16), __uint_as_float(g.y & 0xffff0000u)}; }
    __device__ __forceinline__ void midquad(int row, int col, f32x4& v) const {
        const f32x4 ga = ld4(P + (size_t)row * NP + PC_GA + col), gb = ld4(P + (size_t)row * NP + PC_GB + col);
#pragma unroll
        for (int e = 0; e < 4; ++e) v[e] *= ga[e] * __builtin_amdgcn_rcpf(fmaxf(gb[e], 1e-30f));
    }
    __device__ __forceinline__ void quad(int row, int col, f32x4 v) const { store_bf4(Y + (size_t)row * DM + col, v * ld4(P + (size_t)row * NP + PC_GB + col)); }
    __device__ __forceinline__ void midload(int row, int col, u32x4& ga, u32x4& gb) const { ga = *(const u32x4*)(P + (size_t)row * NP + PC_GA + col); gb = *(const u32x4*)(P + (size_t)row * NP + PC_GB + col); }
    __device__ __forceinline__ static void midapply(const u32x4 ga, const u32x4 gb, f32x4& a, f32x4& b) {
        const unsigned a0 = ga[0], a1 = ga[1], a2 = ga[2], a3 = ga[3], b0 = gb[0], b1 = gb[1], b2 = gb[2], b3 = gb[3];
        const f32x4 sa0 = {__uint_as_float(a0 << 16), __uint_as_float(a0 & 0xffff0000u), __uint_as_float(a1 << 16), __uint_as_float(a1 & 0xffff0000u)};
        const f32x4 sa1 = {__uint_as_float(a2 << 16), __uint_as_float(a2 & 0xffff0000u), __uint_as_float(a3 << 16), __uint_as_float(a3 & 0xffff0000u)};
        const f32x4 sb0 = {__uint_as_float(b0 << 16), __uint_as_float(b0 & 0xffff0000u), __uint_as_float(b1 << 16), __uint_as_float(b1 & 0xffff0000u)};
        const f32x4 sb1 = {__uint_as_float(b2 << 16), __uint_as_float(b2 & 0xffff0000u), __uint_as_float(b3 << 16), __uint_as_float(b3 & 0xffff0000u)};
#pragma unroll
        for (int e = 0; e < 4; ++e) { a[e] *= sa0[e] * __builtin_amdgcn_rcpf(fmaxf(sb0[e], 1e-30f)); b[e] *= sa1[e] * __builtin_amdgcn_rcpf(fmaxf(sb1[e], 1e-30f)); }
    }
    __device__ __forceinline__ void oct(int row, int col, f32x4 a, f32x4 b) const { f32x4 g0, g1; load_bf8(P + (size_t)row * NP + PC_GB + col, g0, g1); store_bf8(Y + (size_t)row * DM + col, a * g0, b * g1); }
};
struct EpiStore {
    static constexpr bool MID = false, PRO = false;
    bf16_t* O; int ldo;
    __device__ __forceinline__ void quad(int row, int col, f32x4 v) const { store_bf4(O + (size_t)row * ldo + col, v); }
    __device__ __forceinline__ void oct(int row, int col, f32x4 a, f32x4 b) const { store_bf8(O + (size_t)row * ldo + col, a, b); }
};

namespace pg8 {
#define PG8_LAS __attribute__((address_space(3)))
constexpr int BM = 256, BK = 64, HALF = 128, HTB = HALF * BK * 2  , STAGE_BYTES = 8 * HTB, NXCD = 8, WGM = 8;

__host__ __device__ __forceinline__ int lds_byte(int r, int c) { const int st = (r >> 4) * 2 + (c >> 5), rr = r & 15, cc = c & 31, ob = rr * 64 + cc * 2; return st * 1024 + (ob ^ (((ob >> 9) & 1) << 5)); }
__host__ __device__ __forceinline__ void stage_rc(int b, int& R, int& C) { const int st = b / 1024, sb = b % 1024, swz = sb ^ (((sb >> 9) & 1) << 5); R = (st >> 1) * 16 + swz / 64; C = (st & 1) * 32 + (swz % 64) / 2; }
__host__ __device__ __forceinline__ int perm32(int rho) { const int n = rho >> 4, i = rho & 15; return 8 * (i >> 2) + 4 * n + (i & 3); }

struct Unit { int pm, pn, ui; };
struct Gemm { const bf16_t* A; const bf16_t* Bt; int M, N, K, lda, ldb; };

struct StaticOrder {
    int nM, nN, nwg, G, c;
    __host__ __device__ void init(int M, int N, int G_, int c_) { nM = M / BM; nN = N / BM; nwg = nM * nN; G = G_; c = c_; }
    __host__ __device__ bool next(int i, Unit& u) const {
        const long L = (long)i * G + c; if (L >= nwg) return false;
        int wgid = (int)L; { const int q = nwg / NXCD, r = nwg % NXCD, xcd = wgid % NXCD, off = wgid / NXCD; wgid = (xcd < r ? xcd * (q + 1) : r * (q + 1) + (xcd - r) * q) + off; }
        const int nig = WGM * nN, gid = wgid / nig, fm = gid * WGM, gsz = (nM - fm) < WGM ? (nM - fm) : WGM;
        u.pm = fm + ((wgid % nig) % gsz); u.pn = (wgid % nig) / gsz; u.ui = i; return true;
    }
    __device__ __forceinline__ void a_ready(const Unit&) const {}
    __device__ __forceinline__ void done(const Unit&) const {}
};
template <class Epi, class Sched, bool ALIGN_EPI = false, bool SP2 = false>
__device__ __forceinline__ void gemm_phase(PG8_LAS unsigned char* lds, const Gemm g, const Sched& S, const Epi& E) {
    int tid_ = threadIdx.x; asm volatile("" : "+v"(tid_)); const int tid = tid_, wid = __builtin_amdgcn_readfirstlane(tid >> 6), lane = tid & 63, wr = wid >> 2, wc = wid & 3, fr = lane & 15, fq = lane >> 4;
    const int K = g.K, nt = K / BK;
    unsigned voffA[2], voffB[2];
#pragma unroll
    for (int i = 0; i < 2; ++i) { int R, C; stage_rc(tid * 16 + i * 8192, R, C); const int Rb = Epi::PERM ? ((R & ~31) + perm32(R & 31)) : R;
        voffA[i] = (unsigned)(R * g.lda + C) * 2u; voffB[i] = (unsigned)(Rb * g.ldb + C) * 2u; }
    const size_t kstep = (size_t)(BK * 2);
    const size_t hstepA = (size_t)HALF * g.lda * 2, hstepB = (size_t)HALF * g.ldb * 2;
    const size_t tstepA = 2 * hstepA, tstepB = 2 * hstepB;
    const unsigned ldsw = (unsigned)wid * 1024u;
    const int aoff = lds_byte(wr * 64 + fr, fq * 8), boff = lds_byte(wc * 32 + fr, fq * 8);
#define PG8_SA(b, h) (((b) * 2 + (h)) * HTB)
#define PG8_SB(b, h) ((4 + (b) * 2 + (h)) * HTB)
#define PG8_STAGE(bufoff, gbase, voff) do { _Pragma("unroll") for (int _i = 0; _i < 2; ++_i) \
        __builtin_amdgcn_global_load_lds((const unsigned*)((const char*)(gbase) + (voff)[_i]), (PG8_LAS unsigned*)(lds + (bufoff) + ldsw + _i * 8192), 16, 0, 0); } while (0)
#define PG8_LDA(dst, b, h) do { _Pragma("unroll") for (int m = 0; m < 4; ++m) _Pragma("unroll") for (int k = 0; k < 2; ++k) dst[m][k] = *(const PG8_LAS bf16x8*)(lds + PG8_SA(b, h) + aoff + m * 2048 + k * 1024); } while (0)
#define PG8_LDB(dst, b, h) do { _Pragma("unroll") for (int n = 0; n < 2; ++n) _Pragma("unroll") for (int k = 0; k < 2; ++k) dst[n][k] = *(const PG8_LAS bf16x8*)(lds + PG8_SB(b, h) + boff + n * 2048 + k * 1024); } while (0)
#define PG8_MMA(ai, bj, At, Bt) do { __builtin_amdgcn_s_setprio(1); _Pragma("unroll") for (int m = 0; m < 4; ++m) _Pragma("unroll") for (int n = 0; n < 2; ++n) _Pragma("unroll") for (int k = 0; k < 2; ++k) \
        acc[ai][bj][m][n] = __builtin_amdgcn_mfma_f32_16x16x32_bf16(Bt[n][k], At[m][k], acc[ai][bj][m][n], 0, 0, 0); __builtin_amdgcn_s_setprio(0); } while (0)
#define PG8_WAIT_V(n) asm volatile("s_waitcnt vmcnt(" #n ")" ::: "memory")
#define PG8_WAIT_L(n) asm volatile("s_waitcnt lgkmcnt(" #n ")" ::: "memory")
#define PG8_BAR __builtin_amdgcn_s_barrier()
#define PG8_SCHED __builtin_amdgcn_sched_barrier(0)
    Unit cur, nxt; int ui = 0;
    if (!S.next(0, cur)) return;
    f32x4 acc[2][2][4][2];
#pragma unroll
    for (int a = 0; a < 2; ++a)
#pragma unroll
        for (int b = 0; b < 2; ++b)
#pragma unroll
            for (int m = 0; m < 4; ++m)
#pragma unroll
                for (int n = 0; n < 2; ++n) acc[a][b][m][n] = (f32x4){0.f, 0.f, 0.f, 0.f};
    bf16x8 At[4][2], B0[2][2], B1[2][2];
    const char* cA = (const char*)g.A + (size_t)cur.pm * tstepA; const char* cB = (const char*)g.Bt + (size_t)cur.pn * tstepB;
    S.a_ready(cur);
    if constexpr (SP2) {
        PG8_STAGE(PG8_SB(0, 0), cB, voffB); PG8_STAGE(PG8_SB(0, 1), cB + hstepB, voffB); PG8_STAGE(PG8_SA(0, 0), cA, voffA); PG8_STAGE(PG8_SA(0, 1), cA + hstepA, voffA);
        if (wr == 1) PG8_BAR;
        PG8_WAIT_V(2); PG8_BAR;
        PG8_STAGE(PG8_SB(1, 0), cB + kstep, voffB); PG8_STAGE(PG8_SA(1, 0), cA + kstep, voffA); PG8_STAGE(PG8_SB(1, 1), cB + hstepB + kstep, voffB);
        PG8_WAIT_V(6); PG8_BAR;
    } else {
        PG8_STAGE(PG8_SB(0, 0), cB, voffB); PG8_STAGE(PG8_SA(0, 0), cA, voffA); PG8_STAGE(PG8_SB(0, 1), cB + hstepB, voffB); PG8_STAGE(PG8_SA(0, 1), cA + hstepA, voffA);
        if (wr == 1) PG8_BAR;
        PG8_WAIT_V(4); PG8_BAR;
        PG8_STAGE(PG8_SB(1, 0), cB + kstep, voffB); PG8_STAGE(PG8_SA(1, 0), cA + kstep, voffA); PG8_STAGE(PG8_SB(1, 1), cB + hstepB + kstep, voffB);
        PG8_WAIT_V(6); PG8_BAR;
    }
    for (;;) {
        const bool has_next = S.next(ui + 1, nxt);
        const char* nA = has_next ? (const char*)g.A + (size_t)nxt.pm * tstepA : cA; const char* nB = has_next ? (const char*)g.Bt + (size_t)nxt.pn * tstepB : cB;
        for (int t = 0; t < nt; t += 2) {
            if constexpr (Epi::MID) { if (t == (nt >> 1)) { E.mid(acc, cur, wr, wc, fr, fq); } }
            const bool last = (t == nt - 2);
            const char* a1 = cA + (size_t)(t + 1) * kstep;
            const char* a2 = last ? nA : cA + (size_t)(t + 2) * kstep; const char* b2 = last ? nB : cB + (size_t)(t + 2) * kstep;
            const char* a3 = a2 + kstep; const char* b3 = b2 + kstep;
            if (last && has_next) S.a_ready(nxt);
            if constexpr (SP2) {
            PG8_LDB(B0, 0, 0); PG8_LDB(B1, 0, 1); PG8_SCHED; PG8_LDA(At, 0, 0); PG8_STAGE(PG8_SA(1, 1), a1 + hstepA, voffA);
            PG8_WAIT_V(8); PG8_WAIT_L(0); PG8_BAR; PG8_MMA(0, 0, At, B0); PG8_MMA(0, 1, At, B1); PG8_BAR; PG8_SCHED;
            PG8_LDA(At, 0, 1); PG8_STAGE(PG8_SB(0, 0), b2, voffB); PG8_STAGE(PG8_SB(0, 1), b2 + hstepB, voffB); PG8_STAGE(PG8_SA(0, 0), a2, voffA);
            PG8_WAIT_V(8); PG8_WAIT_L(0); PG8_BAR; PG8_MMA(1, 0, At, B0); PG8_MMA(1, 1, At, B1); PG8_BAR; PG8_SCHED;
            PG8_LDB(B0, 1, 0); PG8_LDB(B1, 1, 1); PG8_SCHED; PG8_LDA(At, 1, 0); PG8_STAGE(PG8_SA(0, 1), a2 + hstepA, voffA);
            PG8_WAIT_V(8); PG8_WAIT_L(0); PG8_BAR; PG8_MMA(0, 0, At, B0); PG8_MMA(0, 1, At, B1); PG8_BAR; PG8_SCHED;
            PG8_LDA(At, 1, 1); PG8_STAGE(PG8_SB(1, 0), b3, voffB); PG8_STAGE(PG8_SB(1, 1), b3 + hstepB, voffB); PG8_STAGE(PG8_SA(1, 0), a3, voffA);
            PG8_WAIT_V(8); PG8_WAIT_L(0); PG8_BAR; PG8_MMA(1, 0, At, B0); PG8_MMA(1, 1, At, B1); PG8_BAR; PG8_SCHED;
            } else {
            PG8_LDB(B0, 0, 0); PG8_SCHED; PG8_LDA(At, 0, 0); PG8_STAGE(PG8_SA(1, 1), a1 + hstepA, voffA);
            PG8_WAIT_L(8); PG8_BAR; PG8_WAIT_L(0); PG8_MMA(0, 0, At, B0); PG8_BAR; PG8_SCHED;
            PG8_LDB(B1, 0, 1); PG8_STAGE(PG8_SB(0, 0), b2, voffB);
            PG8_BAR; PG8_WAIT_L(0); PG8_MMA(0, 1, At, B1); PG8_BAR;
            PG8_LDA(At, 0, 1); PG8_STAGE(PG8_SA(0, 0), a2, voffA);
            PG8_BAR; PG8_WAIT_L(0); PG8_MMA(1, 0, At, B0); PG8_BAR; PG8_SCHED;
            PG8_STAGE(PG8_SB(0, 1), b2 + hstepB, voffB);
            PG8_WAIT_V(6); PG8_BAR; PG8_MMA(1, 1, At, B1); PG8_BAR;
            PG8_LDB(B0, 1, 0); PG8_SCHED; PG8_LDA(At, 1, 0); PG8_STAGE(PG8_SA(0, 1), a2 + hstepA, voffA);
            PG8_WAIT_L(8); PG8_BAR; PG8_WAIT_L(0); PG8_MMA(0, 0, At, B0); PG8_BAR; PG8_SCHED;
            PG8_LDB(B1, 1, 1); PG8_STAGE(PG8_SB(1, 0), b3, voffB);
            PG8_BAR; PG8_WAIT_L(0); PG8_MMA(0, 1, At, B1); PG8_BAR;
            PG8_LDA(At, 1, 1); PG8_STAGE(PG8_SA(1, 0), a3, voffA);
            PG8_BAR; PG8_WAIT_L(0); PG8_MMA(1, 0, At, B0); PG8_BAR; PG8_SCHED;
            PG8_STAGE(PG8_SB(1, 1), b3 + hstepB, voffB);
            PG8_WAIT_V(6); PG8_BAR; PG8_MMA(1, 1, At, B1); PG8_BAR;
            }
        }
        if constexpr (ALIGN_EPI) { if (wr == 0) PG8_BAR; }
        if constexpr (!Epi::AFTER_DRAIN) { E(acc, cur, wr, wc, fr, fq); S.done(cur); }
        if (!has_next) break;
#pragma unroll
        for (int a = 0; a < 2; ++a)
#pragma unroll
            for (int b = 0; b < 2; ++b)
#pragma unroll
                for (int m = 0; m < 4; ++m)
#pragma unroll
                    for (int n = 0; n < 2; ++n) acc[a][b][m][n] = (f32x4){0.f, 0.f, 0.f, 0.f};
        cur = nxt; cA = nA; cB = nB; ++ui;
        if constexpr (ALIGN_EPI) { if (wr == 1) PG8_BAR; }
    }
    PG8_WAIT_V(0);
    if constexpr (!ALIGN_EPI) { if (wr == 0) PG8_BAR; }
    PG8_BAR;
    if constexpr (Epi::AFTER_DRAIN) { E.fused(acc, cur, wr, wc, fr, fq, lds, wid, lane); S.done(cur); }
#undef PG8_SA
#undef PG8_SB
#undef PG8_STAGE
#undef PG8_LDA
#undef PG8_LDB
#undef PG8_MMA
#undef PG8_WAIT_V
#undef PG8_WAIT_L
#undef PG8_BAR
#undef PG8_SCHED
}
}

template <class Q, bool RS> struct EpiQuad {
    static constexpr bool PERM = true, AFTER_DRAIN = false, MID = Q::MID;
    Q q; const float* rs;
    __device__ __forceinline__ void mid(f32x4 (&acc)[2][2][4][2], const pg8::Unit& u, int wr, int wc, int fr, int fq, bool inv = false) const {
        if constexpr (Q::MID) {
            asm volatile("" : "+v"(fr), "+v"(fq));
#pragma unroll
            for (int ai = 0; ai < 2; ++ai) {
                u32x4 ga[4][2], gb[4][2];
#pragma unroll
                for (int m = 0; m < 4; ++m)
#pragma unroll
                    for (int bj = 0; bj < 2; ++bj) q.midload(u.pm * 256 + ai * 128 + wr * 64 + m * 16 + fr, u.pn * 256 + bj * 128 + wc * 32 + 8 * fq, ga[m][bj], gb[m][bj]);
#pragma unroll
                for (int m = 0; m < 4; ++m)
#pragma unroll
                    for (int bj = 0; bj < 2; ++bj) { if (!inv) q.midapply(ga[m][bj], gb[m][bj], acc[ai][bj][m][0], acc[ai][bj][m][1]); else q.midapply(gb[m][bj], ga[m][bj], acc[ai][bj][m][0], acc[ai][bj][m][1]); }
                __builtin_amdgcn_sched_barrier(0);
            }
        }
    }
    __device__ __forceinline__ void operator()(const f32x4 (&acc)[2][2][4][2], const pg8::Unit& u, int wr, int wc, int fr, int fq) const {
        if constexpr (Q::MID) asm volatile("" : "+v"(fr), "+v"(fq));
#pragma unroll
        for (int ai = 0; ai < 2; ++ai)
#pragma unroll
            for (int m = 0; m < 4; ++m) {
                const int rl = ai * 128 + wr * 64 + m * 16 + fr, row = u.pm * 256 + rl;
                const float r = RS ? rs[u.ui * 256 + rl] : 1.f;
#pragma unroll
                for (int bj = 0; bj < 2; ++bj) q.oct(row, u.pn * 256 + bj * 128 + wc * 32 + 8 * fq, acc[ai][bj][m][0] * r, acc[ai][bj][m][1] * r);
            }
    }
};
__device__ __forceinline__ void unit_row_rstd(const bf16_t* __restrict__ A, int lda, int K, const pg8::StaticOrder& S, float* rs) {
    pg8::Unit u;
    int tid_ = threadIdx.x; asm volatile("" : "+v"(tid_)); const int tid = tid_, r = tid >> 1, part = tid & 1, len = K >> 1;
    for (int i = 0; S.next(i, u); ++i) {
        const bf16_t* ar = A + (size_t)(u.pm * 256 + r) * lda + part * len;
        float ss = 0.f;
        for (int k = 0; k < len; k += 8) { const bf16x8 v = *(const bf16x8*)(ar + k);
#pragma unroll
            for (int e = 0; e < 8; ++e) { const float f = bf2f((bf16_t)v[e]); ss += f * f; } }
        ss += __shfl_xor(ss, 1);
        if (part == 0) rs[i * 256 + r] = rsqrtf(ss / (float)K + EPS);
    }
    __syncthreads();
}
template <class Q, bool RS>
__device__ __forceinline__ void run_gemm(unsigned char* lds, const bf16_t* A, int lda, const bf16_t* Bt, int ldb, int M, int N, int K, const Q& q, int rot = 0) {
    pg8::Gemm g{A, Bt, M, N, K, lda, ldb};
    int cb_ = (int)blockIdx.x - rot; if (cb_ < 0) cb_ += (int)gridDim.x; if (cb_ < 0) cb_ = (int)blockIdx.x;
    pg8::StaticOrder S; S.init(M, N, (int)gridDim.x, cb_);
    float* rs = (float*)(lds + 131072);
    if (RS) unit_row_rstd(A, lda, K, S, rs);
    EpiQuad<Q, RS> E{q, rs};
    pg8::gemm_phase<EpiQuad<Q, RS>, pg8::StaticOrder, true, true>((PG8_LAS unsigned char*)lds, g, S, E);
}

__device__ __forceinline__ int win_dest_row(int n) {
    if (n < 1024) return PC_QA + n;
    if (n < 2048) return PC_KA + (n - 1024);
    if (n < 3072) return PC_VA + (n - 2048);
    if (n < 3840) return PC_CQ + (n - 3072);
    if (n < 4352) return PC_CKV + (n - 3840);
    if (n < 4416) { const int r = n - 4352; return PC_KPE + (r < 32 ? 2 * r : 2 * (r - 32) + 1); }
    if (n < 6464) return PC_GA + (n - 4416);
    return PC_GB + (n - 6464);
}
__device__ __forceinline__ int wq_dest_row(int n) {
    const int h = n / 192, d = n % 192;
    if (d < 128) return n;
    const int r = d - 128;
    return h * 192 + 128 + (r < 32 ? 2 * r : 2 * (r - 32) + 1);
}
template <int MODE>
__device__ __forceinline__ void transpose_item(const float* __restrict__ W, int K, int N, bf16_t* __restrict__ WT, const float* __restrict__ kscale, float* scr, int item, int lane, int ldt = 0, int koff = 0) {
    if (ldt == 0) ldt = K;
    const int nblk = N / 32, kb = item / nblk, nb = item % nblk, k0 = 64 * kb, n0 = 32 * nb;
#pragma unroll
    for (int i = 0; i < 8; ++i) { const int kk = 8 * i + (lane >> 3), n4 = (lane & 7) * 4;
        f32x4 w = *(const f32x4*)(W + (size_t)(k0 + kk) * N + n0 + n4); if (kscale) w = w * kscale[k0 + kk];
        scr[kk * 33 + n4] = w[0]; scr[kk * 33 + n4 + 1] = w[1]; scr[kk * 33 + n4 + 2] = w[2]; scr[kk * 33 + n4 + 3] = w[3]; }
    __builtin_amdgcn_s_waitcnt(0xc07f); asm volatile("" ::: "memory");
    const int c = lane & 7;
#pragma unroll
    for (int j = 0; j < 4; ++j) {
        const int n = (lane >> 3) + 8 * j; const float* s = scr + (8 * c) * 33 + n;
        u32x4 o; o.x = pk2(s[0 * 33], s[1 * 33]); o.y = pk2(s[2 * 33], s[3 * 33]); o.z = pk2(s[4 * 33], s[5 * 33]); o.w = pk2(s[6 * 33], s[7 * 33]);
        const int ns = n0 + n;
        const int dr = MODE == 1 ? win_dest_row(ns) : (MODE == 2 ? wq_dest_row(ns) : ns);
        *(u32x4*)(WT + (size_t)dr * ldt + koff + k0 + 8 * c) = o;
    }
    __builtin_amdgcn_s_waitcnt(0xc07f); asm volatile("" ::: "memory");
}

__device__ __forceinline__ void phase0(const Params& p, unsigned char* lds) {
    int tid_ = threadIdx.x; asm volatile("" : "+v"(tid_)); const int tid = tid_, lane = tid & 63, wid = tid >> 6;
    unsigned char* ws = p.ws;
    {
        float* sl = (float*)lds;
        float* red = sl + 9 * 2048;
        const float* c = p.in[1]; const float* cctx = p.in[3]; const float* wada = p.in[4]; const float* bada = p.in[5];
        float* mod = (float*)(ws + WS_MOD);
        if (blockIdx.x < 192) {
            for (int i = tid; i < 9 * 2048; i += NTHREADS) { const int r = i >> 11, k = i & 2047; const float v = r < 8 ? c[r * DM + k] : cctx[k]; sl[i] = silu_(v); }
            __syncthreads();
            for (int it = blockIdx.x; it < 192; it += gridDim.x) {
                const int kq = tid >> 4, c4 = tid & 15, col = it * 64 + c4 * 4;
                f32x4 acc[9];
#pragma unroll
                for (int r = 0; r < 9; ++r) acc[r] = (f32x4){0.f, 0.f, 0.f, 0.f};
#pragma unroll 8
                for (int i = 0; i < 64; ++i) {
                    const int k = kq + 32 * i;
                    const f32x4 w = *(const f32x4*)(wada + (size_t)k * 12288 + col);
#pragma unroll
                    for (int r = 0; r < 9; ++r) acc[r] += w * sl[r * 2048 + k];
                }
#pragma unroll
                for (int r = 0; r < 9; ++r) {
#pragma unroll
                    for (int e = 0; e < 4; ++e) { float v = acc[r][e]; v += __shfl_xor(v, 16); v += __shfl_xor(v, 32); acc[r][e] = v; }
                    if (lane < 16) *(f32x4*)(red + (wid * 9 + r) * 64 + c4 * 4) = acc[r];
                }
                __syncthreads();
                for (int o = tid; o < 9 * 64; o += NTHREADS) {
                    const int r = o >> 6, cc = o & 63;
                    float sum = bada[it * 64 + cc];
                    for (int q = 0; q < 8; ++q) sum += red[(q * 9 + r) * 64 + cc];
                    mod[(size_t)r * 12288 + it * 64 + cc] = sum;
                }
                __syncthreads();
            }
        }
        __syncthreads();
    }
    {
        float* scr = (float*)lds + wid * (64 * 33);
        const int gw = blockIdx.x * NWAVES + wid, NGW = gridDim.x * NWAVES;
        constexpr int I_IN = 32 * (IN_COLS / 32), I_QB = 12 * 48, I_KVB = 8 * 64, I_AB = 16 * 64, I_OO = 32 * 64;
        constexpr int NITEMS = I_IN + I_QB + I_KVB + 2 * I_AB + 2 * I_OO;
        for (int it = gw; it < NITEMS; it += NGW) {
            int r = it;
            if (r < I_IN) { transpose_item<1>(p.in[10], DM, IN_COLS, (bf16_t*)(ws + WS_WIN), nullptr, scr, r, lane); continue; } r -= I_IN;
            if (r < I_QB) { transpose_item<2>(p.in[13], QR, MQW, (bf16_t*)(ws + WS_WQB), p.in[12], scr, r, lane); continue; } r -= I_QB;
            if (r < I_KVB) { transpose_item<0>(p.in[15], KVR, MKVW, (bf16_t*)(ws + WS_WKVB), p.in[14], scr, r, lane); continue; } r -= I_KVB;
            if (r < I_AB) { transpose_item<0>(p.in[16], 1024, DM, (bf16_t*)(ws + WS_WA), nullptr, scr, r, lane, 2048, 0); continue; } r -= I_AB;
            if (r < I_AB) { transpose_item<0>(p.in[17], 1024, DM, (bf16_t*)(ws + WS_WA), nullptr, scr, r, lane, 2048, 1024); continue; } r -= I_AB;
            if (r < I_OO) { transpose_item<0>(p.in[18], DM, DM, (bf16_t*)(ws + WS_WO), nullptr, scr, r, lane); continue; } r -= I_OO;
            transpose_item<0>(p.in[19], DM, DM, (bf16_t*)(ws + WS_WPQ), nullptr, scr, r, lane);
        }
    }
    {
        const size_t gt = (size_t)blockIdx.x * NTHREADS + tid, NGT = (size_t)gridDim.x * NTHREADS;
        u32x4* padp = (u32x4*)(ws + WS_WIN + (size_t)(PC_KPE + 64) * DM * 2);
        for (size_t i = gt; i < (size_t)192 * DM * 2 / 16; i += NGT) padp[i] = (u32x4){0u, 0u, 0u, 0u};
        float* rope = (float*)(ws + WS_ROPE);
        for (size_t i = gt; i < (size_t)SEQ * 32; i += NGT) { float c, sn; rope_cs((int)(i >> 5), (int)(i & 31), c, sn); rope[i * 2] = c; rope[i * 2 + 1] = sn; }
        const float* sk = p.in[20]; bf16_t* skb = (bf16_t*)(ws + WS_SUBK);
        for (size_t i = gt; i < 262144 / 4; i += NGT) { const f32x4 v = *(const f32x4*)(sk + i * 4); store_bf4(skb + i * 4, v); }
    }
}

__device__ __forceinline__ void phase1(const Params& p) {
    int tid_ = threadIdx.x; asm volatile("" : "+v"(tid_)); const int tid = tid_, lane = tid & 63, wid = tid >> 6;
    const int gw = blockIdx.x * NWAVES + wid, NGW = gridDim.x * NWAVES;
    const float* mod = (const float*)(p.ws + WS_MOD); const float* g = p.in[6];
    bf16_t* H = (bf16_t*)(p.ws + WS_H);
    const int per = (TA + NGW - 1) / NGW;
    int curb = -1; f32x4 G[8], S[8];
    for (int i = 0; i < per; ++i) {
        const int m = gw * per + i; if (m >= TA) break;
        const float* xr = m < TL ? p.in[0] + (size_t)m * DM : p.in[2] + (size_t)(m - TL) * DM;
        const int mr = m < TL ? m / SEQ : 8;
        if (mr != curb) { curb = mr; const float* sh = mod + (size_t)mr * 12288, * sc = sh + 2048;
#pragma unroll
            for (int j = 0; j < 8; ++j) { const int c = j * 256 + lane * 4; G[j] = *(const f32x4*)(g + c) * (*(const f32x4*)(sc + c) + 1.f); S[j] = *(const f32x4*)(sh + c); } }
        f32x4 v[8]; float ss = 0.f;
#pragma unroll
        for (int j = 0; j < 8; ++j) { v[j] = *(const f32x4*)(xr + j * 256 + lane * 4); ss += v[j][0] * v[j][0] + v[j][1] * v[j][1] + v[j][2] * v[j][2] + v[j][3] * v[j][3]; }
        const float rstd = rsqrtf(wave_sum_dpp(ss) * (1.f / DM) + EPS);
#pragma unroll
        for (int j = 0; j < 8; ++j) store_bf4(H + (size_t)m * DM + j * 256 + lane * 4, (v[j] * rstd) * G[j] + S[j]);
    }
}

__device__ __forceinline__ void kpe_pass(const Params& p) {
    const size_t gt = (size_t)blockIdx.x * NTHREADS + threadIdx.x, NGT = (size_t)gridDim.x * NTHREADS;
    const bf16_t* PL = (const bf16_t*)(p.ws + WS_PL); const bf16_t* PCx = (const bf16_t*)(p.ws + WS_PC);
    bf16_t* KPE = (bf16_t*)(p.ws + WS_KPE); const float* rope = (const float*)(p.ws + WS_ROPE);
    for (size_t i = gt; i < (size_t)TA * 32; i += NGT) {
        const int m = (int)(i >> 5), j = (int)(i & 31);
        unsigned w;
        if (m < TL) {
            w = *(const unsigned*)(PL + (size_t)m * NP + PC_KPE + 2 * j);
            const float x1 = __uint_as_float(w << 16), x2 = __uint_as_float(w & 0xffff0000u);
            const float c = rope[((size_t)(m & (SEQ - 1)) * 32 + j) * 2], s = rope[((size_t)(m & (SEQ - 1)) * 32 + j) * 2 + 1];
            w = pk2(x1 * c - x2 * s, x1 * s + x2 * c);
        } else w = *(const unsigned*)(PCx + (size_t)(m - TL) * NPC + PC_KPE + 2 * j);
        *(unsigned*)(KPE + (size_t)m * 64 + 2 * j) = w;
    }
}

__device__ __forceinline__ float dot_bf16x8(const bf16x8 k, const float* q) {
    float s = 0.f;
#pragma unroll
    for (int e = 0; e < 8; ++e) s += q[e] * bf2f((bf16_t)k[e]);
    return s;
}

__device__ __forceinline__ void na_naive(const Params& p, unsigned char* lds) {
    int tid_ = threadIdx.x; asm volatile("" : "+v"(tid_)); const int tid = tid_, lane = tid & 63, wid = tid >> 6;
    const int gw = blockIdx.x * NWAVES + wid, NGW = gridDim.x * NWAVES;
    const bf16_t* PL = (const bf16_t*)(p.ws + WS_PL); const bf16_t* PCx = (const bf16_t*)(p.ws + WS_PC);
    bf16_t* OA = (bf16_t*)(p.ws + WS_OA);
    const float* rpb = p.in[11];
    float* qs = (float*)lds + wid * 512;
    float* ps = qs + 64;
    for (int it = gw; it < TL * 16; it += NGW) {
        const int h = it & 15, m = it >> 4, b = m / SEQ, s = m % SEQ, r = s >> 6, qc = s & 63;
        int r0 = r - 4; r0 = r0 < 0 ? 0 : (r0 > GROWS - 8 ? GROWS - 8 : r0);
        int w0 = qc - 8; w0 = w0 < 0 ? 0 : (w0 > GW - 16 ? GW - 16 : w0);
        qs[lane] = bf2f(PL[(size_t)m * NP + PC_QA + h * 64 + lane]);
        __builtin_amdgcn_s_waitcnt(0xc07f); asm volatile("" ::: "memory");
        float sc[6];
#pragma unroll
        for (int i = 0; i < 6; ++i) {
            const int kk = lane + 64 * i;
            const bf16_t* kp; float bias = 0.f;
            if (i < 2) { const int dy = kk >> 4, dx = kk & 15, kr = r0 + dy, kc = w0 + dx;
                kp = PL + (size_t)(b * SEQ + kr * 64 + kc) * NP + PC_KA + h * 64;
                bias = rpb[(h * 15 + (kr - r + 7)) * 31 + (kc - qc + 15)]; }
            else kp = PCx + (size_t)(b * CTX + (kk - 128)) * NPC + PC_KA + h * 64;
            float d = 0.f;
#pragma unroll
            for (int e = 0; e < 8; ++e) d += dot_bf16x8(*(const bf16x8*)(kp + e * 8), qs + e * 8);
            sc[i] = d * NA_SCALE + bias;
        }
        float mx = sc[0];
#pragma unroll
        for (int i = 1; i < 6; ++i) mx = fmaxf(mx, sc[i]);
        mx = wave_max(mx);
        float sum = 0.f;
#pragma unroll
        for (int i = 0; i < 6; ++i) { sc[i] = __expf(sc[i] - mx); sum += sc[i]; ps[lane + 64 * i] = sc[i]; }
        sum = wave_sum(sum);
        __builtin_amdgcn_s_waitcnt(0xc07f); asm volatile("" ::: "memory");
        float o = 0.f;
        for (int kk = 0; kk < 128; ++kk) { const int kr = r0 + (kk >> 4), kc = w0 + (kk & 15);
            o += ps[kk] * bf2f(PL[(size_t)(b * SEQ + kr * 64 + kc) * NP + PC_VA + h * 64 + lane]); }
        for (int kk = 0; kk < 256; ++kk) o += ps[128 + kk] * bf2f(PCx[(size_t)(b * CTX + kk) * NPC + PC_VA + h * 64 + lane]);
        OA[(size_t)m * 2048 + h * 64 + lane] = (bf16_t)f2bf(o / sum);
        __builtin_amdgcn_s_waitcnt(0xc07f); asm volatile("" ::: "memory");
    }
}

__device__ __forceinline__ void mla_naive(const Params& p, unsigned char* lds) {
    int tid_ = threadIdx.x; asm volatile("" : "+v"(tid_)); const int tid = tid_, lane = tid & 63, wid = tid >> 6;
    const bf16_t* QM = (const bf16_t*)(p.ws + WS_QM); const bf16_t* KVM = (const bf16_t*)(p.ws + WS_KVM); const bf16_t* KPE = (const bf16_t*)(p.ws + WS_KPE);
    bf16_t* OB = (bf16_t*)(p.ws + WS_OB);
    float* qs = (float*)lds + wid * (192 + 2304);
    float* ps = qs + 192;
    for (int it = blockIdx.x; it < NB * 8 * (SEQ / 8); it += gridDim.x) {
        const int qg = it % (SEQ / 8), bh = it / (SEQ / 8), h = bh & 7, b = bh >> 3;
        const int m = b * SEQ + qg * 8 + wid;
#pragma unroll
        for (int i = 0; i < 3; ++i) qs[lane + 64 * i] = bf2f(QM[(size_t)m * MQW + h * 192 + lane + 64 * i]);
        __builtin_amdgcn_s_waitcnt(0xc07f); asm volatile("" ::: "memory");
        float mx = -INFINITY;
        for (int i = 0; i < 36; ++i) {
            const int kk = lane + 64 * i;
            const int krow = kk < SEQ ? b * SEQ + kk : TL + b * CTX + (kk - SEQ);
            const bf16_t* kn = KVM + (size_t)krow * MKVW + h * 256; const bf16_t* kp = KPE + (size_t)krow * 64;
            float d = 0.f;
#pragma unroll
            for (int e = 0; e < 16; ++e) d += dot_bf16x8(*(const bf16x8*)(kn + e * 8), qs + e * 8);
#pragma unroll
            for (int e = 0; e < 8; ++e) d += dot_bf16x8(*(const bf16x8*)(kp + e * 8), qs + 128 + e * 8);
            ps[kk] = d; mx = fmaxf(mx, d);
        }
        mx = wave_max(mx);
        float sum = 0.f;
        for (int i = 0; i < 36; ++i) { const float e = exp2f(ps[lane + 64 * i] - mx); sum += e; ps[lane + 64 * i] = e; }
        sum = wave_sum(sum);
        __builtin_amdgcn_s_waitcnt(0xc07f); asm volatile("" ::: "memory");
        float o0 = 0.f, o1 = 0.f;
        const bf16_t* vb = KVM + h * 256 + 128 + lane;
        for (int kk = 0; kk < SEQ; ++kk) { const bf16_t* vp = vb + (size_t)(b * SEQ + kk) * MKVW; const float pp = ps[kk]; o0 += pp * bf2f(vp[0]); o1 += pp * bf2f(vp[64]); }
        for (int kk = 0; kk < CTX; ++kk) { const bf16_t* vp = vb + (size_t)(TL + b * CTX + kk) * MKVW; const float pp = ps[SEQ + kk]; o0 += pp * bf2f(vp[0]); o1 += pp * bf2f(vp[64]); }
        const float inv = 1.f / sum;
        OB[(size_t)m * 2048 + h * 128 + lane] = (bf16_t)f2bf(o0 * inv);
        OB[(size_t)m * 2048 + h * 128 + 64 + lane] = (bf16_t)f2bf(o1 * inv);
        __builtin_amdgcn_s_waitcnt(0xc07f); asm volatile("" ::: "memory");
    }
}


typedef float f32x16 __attribute__((ext_vector_type(16)));
typedef short s16x4 __attribute__((ext_vector_type(4)));
typedef float f32x2_t __attribute__((ext_vector_type(2)));
typedef __bf16 bf16x2_t __attribute__((ext_vector_type(2)));
#define LAS3 __attribute__((address_space(3)))
__device__ __forceinline__ unsigned cvtpk(float lo, float hi) { f32x2_t v = {lo, hi}; bf16x2_t b = __builtin_convertvector(v, bf16x2_t); return __builtin_bit_cast(unsigned, b); }
__device__ __forceinline__ s16x4 vtr(const LAS3 unsigned char* p) { return __builtin_bit_cast(s16x4, __builtin_amdgcn_ds_read_tr16_b64_v4i16((LAS3 s16x4*)p)); }
__device__ __forceinline__ float max16(const f32x16& a) {
    float m0 = fmaxf(fmaxf(a[0], a[1]), fmaxf(a[2], a[3])), m1 = fmaxf(fmaxf(a[4], a[5]), fmaxf(a[6], a[7]));
    float m2 = fmaxf(fmaxf(a[8], a[9]), fmaxf(a[10], a[11])), m3 = fmaxf(fmaxf(a[12], a[13]), fmaxf(a[14], a[15]));
    return fmaxf(fmaxf(m0, m1), fmaxf(m2, m3));
}
__device__ __forceinline__ bf16x8 pfrag(const f32x16& a, int s) {
    u32x4 w; w.x = cvtpk(a[8 * s + 0], a[8 * s + 1]); w.y = cvtpk(a[8 * s + 2], a[8 * s + 3]); w.z = cvtpk(a[8 * s + 4], a[8 * s + 5]); w.w = cvtpk(a[8 * s + 6], a[8 * s + 7]);
    return __builtin_bit_cast(bf16x8, w);
}

__device__ __forceinline__ void mla_flash(const Params& p, unsigned char* lds_) {
    int tid_ = threadIdx.x; asm volatile("" : "+v"(tid_)); const int tid = tid_, lane = tid & 63, wid = tid >> 6, r32 = lane & 31, hi = lane >> 5;
    LAS3 unsigned char* lds = (LAS3 unsigned char*)lds_;
    constexpr int KP = 400, VP = 320, KBYTES = 64 * KP, VBYTES = 64 * VP, STG = KBYTES + VBYTES, NT = (SEQ + CTX) / 64;
    const bf16_t* QM = (const bf16_t*)(p.ws + WS_QM); const bf16_t* KVM = (const bf16_t*)(p.ws + WS_KVM); const bf16_t* KPE = (const bf16_t*)(p.ws + WS_KPE);
    bf16_t* OB = (bf16_t*)(p.ws + WS_OB);
    const int G = gridDim.x, vcu = (G % 8 == 0) ? (blockIdx.x % 8) * (G / 8) + blockIdx.x / 8 : blockIdx.x;
    const int skey = tid >> 4, spc = tid & 15, pkey = tid >> 3, ppc = tid & 7;
    const int vb = (4 * hi + ((lane & 15) >> 2)) * VP + (16 * ((lane >> 4) & 1) + 4 * (lane & 3)) * 2;
    for (int unit = vcu; unit < NB * 8 * 8; unit += G) {
        const int bh = unit >> 3, qt = unit & 7, b = bh >> 3, h = bh & 7;
        const int qrow = b * SEQ + qt * 256 + wid * 32 + r32;
        bf16x8 qf[12];
#pragma unroll
        for (int s = 0; s < 12; ++s) qf[s] = *(const bf16x8*)(QM + (size_t)qrow * MQW + h * 192 + 16 * s + 8 * hi);
        f32x16 o[4];
#pragma unroll
        for (int d = 0; d < 4; ++d)
#pragma unroll
            for (int r = 0; r < 16; ++r) o[d][r] = 0.f;
        float m = -1e30f, l = 0.f;
        u32x4 g0, g1, g2, g3, g4;
#define MLA_LOAD(t) do { const int kr_ = (t) < 32 ? b * SEQ + 64 * (t) : TL + b * CTX + 64 * ((t) - 32); \
            const bf16_t* kp_ = KVM + (size_t)(kr_ + skey) * MKVW + h * 256 + spc * 8; \
            g0 = *(const u32x4*)kp_; g1 = *(const u32x4*)(kp_ + (size_t)32 * MKVW); g2 = *(const u32x4*)(kp_ + 128); g3 = *(const u32x4*)(kp_ + (size_t)32 * MKVW + 128); \
            g4 = *(const u32x4*)(KPE + (size_t)(kr_ + pkey) * 64 + ppc * 8); } while (0)
#define MLA_STORE(buf) do { LAS3 unsigned char* kb_ = lds + (buf) * STG; LAS3 unsigned char* vb_ = kb_ + KBYTES; \
            *(LAS3 u32x4*)(kb_ + skey * KP + spc * 16) = g0; *(LAS3 u32x4*)(kb_ + (skey + 32) * KP + spc * 16) = g1; \
            *(LAS3 u32x4*)(vb_ + skey * VP + spc * 16) = g2; *(LAS3 u32x4*)(vb_ + (skey + 32) * VP + spc * 16) = g3; \
            *(LAS3 u32x4*)(kb_ + pkey * KP + 256 + ppc * 16) = g4; } while (0)
        MLA_LOAD(0); MLA_STORE(0);
#pragma unroll
        for (int s = 0; s < 12; ++s) asm volatile("" : "+v"(qf[s]));
        __syncthreads();
        for (int t = 0; t < NT; ++t) {
            const int cur = t & 1;
            if (t + 1 < NT) MLA_LOAD(t + 1);
            const LAS3 unsigned char* Kb = lds + cur * STG; const LAS3 unsigned char* Vb = Kb + KBYTES;
            f32x16 s0, s1;
#pragma unroll
            for (int r = 0; r < 16; ++r) { s0[r] = 0.f; s1[r] = 0.f; }
            const LAS3 unsigned char* ka = Kb + r32 * KP + 16 * hi;
#pragma unroll
            for (int s = 0; s < 12; ++s) {
                const bf16x8 a0 = *(const LAS3 bf16x8*)(ka + 32 * s), a1 = *(const LAS3 bf16x8*)(ka + 32 * KP + 32 * s);
                s0 = __builtin_amdgcn_mfma_f32_32x32x16_bf16(a0, qf[s], s0, 0, 0, 0);
                s1 = __builtin_amdgcn_mfma_f32_32x32x16_bf16(a1, qf[s], s1, 0, 0, 0);
            }
            float mx = fmaxf(max16(s0), max16(s1));
            mx = fmaxf(mx, __shfl_xor(mx, 32));
            const float mn = fmaxf(m, mx);
            if (__builtin_amdgcn_ballot_w64(mx > m) != 0ull) {
                const float alpha = __builtin_amdgcn_exp2f(m - mn);
                l *= alpha;
#pragma unroll
                for (int d = 0; d < 4; ++d) o[d] = o[d] * alpha;
            }
            m = mn;
            float rs = 0.f;
#pragma unroll
            for (int r = 0; r < 16; ++r) { s0[r] = __builtin_amdgcn_exp2f(s0[r] - mn); s1[r] = __builtin_amdgcn_exp2f(s1[r] - mn); rs += s0[r] + s1[r]; }
            l += rs;
            bf16x8 pf[4];
            pf[0] = pfrag(s0, 0); pf[1] = pfrag(s0, 1); pf[2] = pfrag(s1, 0); pf[3] = pfrag(s1, 1);
            const LAS3 unsigned char* va = Vb + vb;
#pragma unroll
            for (int ks = 0; ks < 4; ++ks)
#pragma unroll
                for (int d = 0; d < 4; ++d) {
                    const s16x4 lo = vtr(va + (16 * ks) * VP + 64 * d), hh = vtr(va + (16 * ks + 8) * VP + 64 * d);
                    const bf16x8 vf = {lo[0], lo[1], lo[2], lo[3], hh[0], hh[1], hh[2], hh[3]};
                    o[d] = __builtin_amdgcn_mfma_f32_32x32x16_bf16(vf, pf[ks], o[d], 0, 0, 0);
                }
            if (t + 1 < NT) MLA_STORE(cur ^ 1);
            __syncthreads();
        }
#undef MLA_LOAD
#undef MLA_STORE
        l += __shfl_xor(l, 32);
        const float inv = 1.f / l;
        bf16_t* op = OB + (size_t)qrow * 2048 + h * 128 + 4 * hi;
#pragma unroll
        for (int d = 0; d < 4; ++d)
#pragma unroll
            for (int g = 0; g < 4; ++g) {
                const f32x4 v = {o[d][4 * g] * inv, o[d][4 * g + 1] * inv, o[d][4 * g + 2] * inv, o[d][4 * g + 3] * inv};
                store_bf4(op + 32 * d + 8 * g, v);
            }
    }
}


__device__ __forceinline__ void mla_flash2(const Params& p, unsigned char* lds_) {
    int tid_ = threadIdx.x; asm volatile("" : "+v"(tid_)); const int tid = tid_, wid = __builtin_amdgcn_readfirstlane(tid >> 6);
    LAS3 unsigned char* lds = (LAS3 unsigned char*)lds_;
    constexpr int KP = 400, VP = 320, KBYTES = 64 * KP, VBYTES = 64 * VP, NT = (SEQ + CTX) / 64, NQR = 7, QPP = 32 * (12 - NQR) + 16;
    const bf16_t* KVM = (const bf16_t*)(p.ws + WS_KVM); const bf16_t* KPE = (const bf16_t*)(p.ws + WS_KPE);
    bf16_t* OB = (bf16_t*)(p.ws + WS_OB);
    const int G = gridDim.x, vcu = (G % 8 == 0) ? (blockIdx.x % 8) * (G / 8) + blockIdx.x / 8 : blockIdx.x;
    for (int unit = vcu; unit < NB * 8 * 8; unit += G) {
        int tq = tid; asm volatile("" : "+v"(tq));
        const unsigned char* wsq = p.ws; asm volatile("" : "+s"(wsq));
        const bf16_t* QM = (const bf16_t*)(wsq + WS_QM);
        const int lane = tq & 63, r32 = tq & 31, hi = (tq >> 5) & 1;
        const int skey = tq >> 4, spc = tq & 15, pkey = tq >> 3, ppc = tq & 7;
        const int vb = (4 * hi + ((lane & 15) >> 2)) * VP + (16 * ((lane >> 4) & 1) + 4 * (lane & 3)) * 2;
        const int bh = unit >> 3, qt = unit & 7, b = bh >> 3, h = bh & 7;
        const int qrow = b * SEQ + qt * 256 + wid * 32 + r32;
        bf16x8 qf[NQR];
#pragma unroll
        for (int s = 0; s < NQR; ++s) qf[s] = *(const bf16x8*)(QM + (size_t)qrow * MQW + h * 192 + 16 * s + 8 * hi);
        LAS3 unsigned char* qpe = lds + 2 * KBYTES + 3 * VBYTES + wid * (32 * QPP) + r32 * QPP + 16 * hi;
#pragma unroll
        for (int s = 0; s < 12 - NQR; ++s) *(LAS3 bf16x8*)(qpe + 32 * s) = *(const bf16x8*)(QM + (size_t)qrow * MQW + h * 192 + 16 * (NQR + s) + 8 * hi);
        f32x16 o[4];
#pragma unroll
        for (int d = 0; d < 4; ++d)
#pragma unroll
            for (int r = 0; r < 16; ++r) o[d][r] = 0.f;
        float m = -1e30f, l = 0.f, alA = 1.f, alB = 1.f;
        u32x4 g0, g1, g2, g3, g4;
        f32x16 sA0, sA1, sB0, sB1;
        bf16x8 pf[4];
#define M2_LOAD(t) do { const int kr_ = (t) < 32 ? b * SEQ + 64 * (t) : TL + b * CTX + 64 * ((t) - 32); \
            const bf16_t* kp_ = KVM + (size_t)(kr_ + skey) * MKVW + h * 256 + spc * 8; \
            g0 = *(const u32x4*)kp_; g1 = *(const u32x4*)(kp_ + (size_t)32 * MKVW); g2 = *(const u32x4*)(kp_ + 128); g3 = *(const u32x4*)(kp_ + (size_t)32 * MKVW + 128); \
            g4 = *(const u32x4*)(KPE + (size_t)(kr_ + pkey) * 64 + ppc * 8); } while (0)
#define M2_STORE(kbi, vbo) do { LAS3 unsigned char* kb_ = lds + (kbi) * KBYTES; LAS3 unsigned char* vb_ = lds + 2 * KBYTES + (vbo); \
            *(LAS3 u32x4*)(kb_ + skey * KP + spc * 16) = g0; *(LAS3 u32x4*)(kb_ + (skey + 32) * KP + spc * 16) = g1; \
            *(LAS3 u32x4*)(vb_ + skey * VP + spc * 16) = g2; *(LAS3 u32x4*)(vb_ + (skey + 32) * VP + spc * 16) = g3; \
            *(LAS3 u32x4*)(kb_ + pkey * KP + 256 + ppc * 16) = g4; } while (0)
#define SB_() __builtin_amdgcn_sched_barrier(0)
#define M2_QKZ(S0, S1) do { _Pragma("unroll") for (int r = 0; r < 16; ++r) { S0[r] = 0.f; S1[r] = 0.f; } } while (0)
#define M2_QKG(S0, S1, kbi, s_lo) do { const LAS3 unsigned char* ka = lds + (kbi) * KBYTES + r32 * KP + 16 * hi; \
            _Pragma("unroll") for (int s = (s_lo); s < (s_lo) + 2; ++s) { \
                const bf16x8 a0 = *(const LAS3 bf16x8*)(ka + 32 * s), a1 = *(const LAS3 bf16x8*)(ka + 32 * KP + 32 * s); \
                const bf16x8 qq = s < NQR ? qf[s < NQR ? s : 0] : *(const LAS3 bf16x8*)(qpe + 32 * (s - NQR)); \
                S0 = __builtin_amdgcn_mfma_f32_32x32x16_bf16(a0, qq, S0, 0, 0, 0); \
                S1 = __builtin_amdgcn_mfma_f32_32x32x16_bf16(a1, qq, S1, 0, 0, 0); } } while (0)
#define M2_QK_FIN(X0, X1, kbi, Y0, Y1, ALY) do { \
            SB_(); M2_QKZ(X0, X1); M2_QKG(X0, X1, kbi, 0); \
            _Pragma("unroll") for (int r = 0; r < 8; ++r) Y1[r] = __builtin_amdgcn_exp2f(Y1[r]); \
            SB_(); M2_QKG(X0, X1, kbi, 2); \
            _Pragma("unroll") for (int r = 8; r < 16; ++r) Y1[r] = __builtin_amdgcn_exp2f(Y1[r]); \
            SB_(); M2_QKG(X0, X1, kbi, 4); \
            { float rs = 0.f; _Pragma("unroll") for (int r = 0; r < 16; ++r) rs += Y0[r] + Y1[r]; l = l * ALY + rs; } \
            SB_(); M2_QKG(X0, X1, kbi, 6); \
            pf[0] = pfrag(Y0, 0); pf[1] = pfrag(Y0, 1); \
            SB_(); M2_QKG(X0, X1, kbi, 8); \
            pf[2] = pfrag(Y1, 0); pf[3] = pfrag(Y1, 1); \
            SB_(); M2_QKG(X0, X1, kbi, 10); \
            SB_(); } while (0)
#define M2_QK_ONLY(X0, X1, kbi) do { SB_(); M2_QKZ(X0, X1); M2_QKG(X0, X1, kbi, 0); SB_(); M2_QKG(X0, X1, kbi, 2); SB_(); M2_QKG(X0, X1, kbi, 4); SB_(); M2_QKG(X0, X1, kbi, 6); SB_(); M2_QKG(X0, X1, kbi, 8); SB_(); M2_QKG(X0, X1, kbi, 10); SB_(); } while (0)
#define M2_FIN_ONLY(Y0, Y1, ALY) do { float rs = 0.f; \
            _Pragma("unroll") for (int r = 0; r < 16; ++r) { Y1[r] = __builtin_amdgcn_exp2f(Y1[r]); rs += Y0[r] + Y1[r]; } \
            l = l * ALY + rs; \
            pf[0] = pfrag(Y0, 0); pf[1] = pfrag(Y0, 1); pf[2] = pfrag(Y1, 0); pf[3] = pfrag(Y1, 1); } while (0)
#define M2_PVG(vbo, ks) do { const LAS3 unsigned char* va = lds + 2 * KBYTES + (vbo) + vb; \
            _Pragma("unroll") for (int d = 0; d < 4; ++d) { \
                const s16x4 lo = vtr(va + (16 * (ks)) * VP + 64 * d), hh = vtr(va + (16 * (ks) + 8) * VP + 64 * d); \
                const bf16x8 vf = {lo[0], lo[1], lo[2], lo[3], hh[0], hh[1], hh[2], hh[3]}; \
                o[d] = __builtin_amdgcn_mfma_f32_32x32x16_bf16(vf, pf[ks], o[d], 0, 0, 0); } } while (0)
#define M2_PART_A(X0, X1, ALX, MN) do { float mx = fmaxf(max16(X0), max16(X1)); \
            { auto rr = __builtin_amdgcn_permlane32_swap(__float_as_uint(mx), __float_as_uint(mx), false, false); mx = fmaxf(__uint_as_float(rr[0]), __uint_as_float(rr[1])); } \
            MN = fmaxf(m, mx); ALX = 1.f; \
            if (__builtin_amdgcn_ballot_w64(mx > m) != 0ull) ALX = __builtin_amdgcn_exp2f(m - MN); \
            m = MN; } while (0)
#define M2_PV_PART(vbo, X0, X1, ALX) do { float mn_; \
            SB_(); M2_PVG(vbo, 0); M2_PART_A(X0, X1, ALX, mn_); \
            SB_(); M2_PVG(vbo, 1); _Pragma("unroll") for (int r = 0; r < 16; ++r) X0[r] = __builtin_amdgcn_exp2f(X0[r] - mn_); \
            SB_(); M2_PVG(vbo, 2); _Pragma("unroll") for (int r = 0; r < 16; ++r) X1[r] = X1[r] - mn_; \
            SB_(); M2_PVG(vbo, 3); SB_(); } while (0)
#define M2_PART_ONLY(X0, X1, ALX) do { float mn_; M2_PART_A(X0, X1, ALX, mn_); \
            _Pragma("unroll") for (int r = 0; r < 16; ++r) { X0[r] = __builtin_amdgcn_exp2f(X0[r] - mn_); X1[r] = X1[r] - mn_; } } while (0)
#define M2_RESC(AL) do { if (__builtin_amdgcn_ballot_w64(AL != 1.f) != 0ull) { _Pragma("unroll") for (int d = 0; d < 4; ++d) o[d] = o[d] * AL; } } while (0)
#define M2_STEP(X0, X1, ALX, Y0, Y1, ALY, j) do { \
            M2_QK_FIN(X0, X1, (j) & 1, Y0, Y1, ALY); \
            if ((j) + 1 < NT) M2_LOAD((j) + 1); \
            M2_PV_PART(vr, X0, X1, ALX); \
            if ((j) + 1 < NT) M2_STORE(((j) + 1) & 1, vw); \
            M2_RESC(ALX); \
            vr = vr == 2 * VBYTES ? 0 : vr + VBYTES; vw = vw == 2 * VBYTES ? 0 : vw + VBYTES; \
            __syncthreads(); } while (0)
        M2_LOAD(0); M2_STORE(0, 0);
#pragma unroll
        for (int s = 0; s < NQR; ++s) asm volatile("" : "+v"(qf[s]));
        __syncthreads();
        M2_QK_ONLY(sA0, sA1, 0);
        M2_LOAD(1);
        M2_PART_ONLY(sA0, sA1, alA);
        M2_STORE(1, VBYTES);
        __syncthreads();
        int vr = 0, vw = 2 * VBYTES;
        for (int j = 1; j + 1 < NT; j += 2) {
            M2_STEP(sB0, sB1, alB, sA0, sA1, alA, j);
            M2_STEP(sA0, sA1, alA, sB0, sB1, alB, j + 1);
        }
        M2_STEP(sB0, sB1, alB, sA0, sA1, alA, NT - 1);
        M2_FIN_ONLY(sB0, sB1, alB);
        SB_(); M2_PVG(vr, 0); SB_(); M2_PVG(vr, 1); SB_(); M2_PVG(vr, 2); SB_(); M2_PVG(vr, 3); SB_();
        __syncthreads();
#undef M2_LOAD
#undef M2_STORE
        l += __shfl_xor(l, 32);
        const float inv = 1.f / l;
        int te = tid; asm volatile("" : "+v"(te));
        bf16_t* op = OB + (size_t)(b * SEQ + qt * 256 + wid * 32 + (te & 31)) * 2048 + h * 128 + 4 * ((te >> 5) & 1);
#pragma unroll
        for (int d = 0; d < 4; ++d)
#pragma unroll
            for (int g = 0; g < 4; ++g) {
                const f32x4 v = {o[d][4 * g] * inv, o[d][4 * g + 1] * inv, o[d][4 * g + 2] * inv, o[d][4 * g + 3] * inv};
                store_bf4(op + 32 * d + 8 * g, v);
            }
    }
}

__device__ __forceinline__ void na_flash(const Params& p, unsigned char* lds_) {
    int tid_ = threadIdx.x; asm volatile("" : "+v"(tid_)); const int tid = tid_, lane = tid & 63, wid = tid >> 6, r32 = lane & 31, hi = lane >> 5;
    constexpr int VP = 192, WB = 12800;
    LAS3 unsigned char* vl = (LAS3 unsigned char*)lds_ + wid * WB;
    LAS3 float* tbl = (LAS3 float*)(vl + 64 * VP);
    tbl[lane] = 0.f; tbl[lane + 64] = 0.f;
    const bf16_t* PL = (const bf16_t*)(p.ws + WS_PL); const bf16_t* PCx = (const bf16_t*)(p.ws + WS_PC);
    bf16_t* OA = (bf16_t*)(p.ws + WS_OA);
    const float* rpb = p.in[11];
    const int G = gridDim.x, vcu = (G % 8 == 0) ? (blockIdx.x % 8) * (G / 8) + blockIdx.x / 8 : blockIdx.x;
    const int vb = (4 * hi + ((lane & 15) >> 2)) * VP + (16 * ((lane >> 4) & 1) + 4 * (lane & 3)) * 2;
    constexpr float SC = NA_SCALE * LOG2E;
    for (int wu = vcu * NWAVES + wid; wu < NB * GROWS * 16 * 2; wu += G * NWAVES) {
        const int half = wu & 1, h = (wu >> 1) & 15, br = wu >> 5, r = br & 31, b = br >> 5;
        const int qc = 32 * half + r32;
        int w0 = qc - 8; w0 = w0 < 0 ? 0 : (w0 > GW - 16 ? GW - 16 : w0);
        int r0 = r - 4; r0 = r0 < 0 ? 0 : (r0 > GROWS - 8 ? GROWS - 8 : r0);
        const int qtok = b * SEQ + r * 64 + qc;
        bf16x8 qf[4];
#pragma unroll
        for (int s = 0; s < 4; ++s) qf[s] = *(const bf16x8*)(PL + (size_t)qtok * NP + PC_QA + h * 64 + 16 * s + 8 * hi);
        f32x16 o[2];
#pragma unroll
        for (int d = 0; d < 2; ++d)
#pragma unroll
            for (int e = 0; e < 16; ++e) o[d][e] = 0.f;
        float m = -1e30f, l = 0.f;
        bf16x8 kf[2][4]; u32x4 vg[8];
#define NA_LOAD(t, WHAT) do { const bf16_t* kb_; size_t pitch_; \
            if ((t) < 8) { kb_ = PL + (size_t)(b * SEQ + (r0 + (t)) * 64) * NP + PC_KA + h * 64; pitch_ = NP; } \
            else { kb_ = PCx + (size_t)(b * CTX + 64 * ((t) - 8)) * NPC + PC_KA + h * 64; pitch_ = NPC; } \
            if (WHAT & 1) { _Pragma("unroll") for (int kb = 0; kb < 2; ++kb) _Pragma("unroll") for (int s = 0; s < 4; ++s) kf[kb][s] = *(const bf16x8*)(kb_ + (size_t)(32 * kb + r32) * pitch_ + 16 * s + 8 * hi); } \
            if (WHAT & 2) { _Pragma("unroll") for (int i = 0; i < 8; ++i) vg[i] = *(const u32x4*)(kb_ + (size_t)((lane >> 3) + 8 * i) * pitch_ + 1024 + (lane & 7) * 8); } } while (0)
#define NA_STORE(t) do { _Pragma("unroll") for (int i = 0; i < 8; ++i) *(LAS3 u32x4*)(vl + ((lane >> 3) + 8 * i) * VP + (lane & 7) * 16) = vg[i]; \
            if ((t) < 8 && lane < 31) tbl[48 + lane] = rpb[(h * 15 + (r0 + (t) - r + 7)) * 31 + lane] * LOG2E; } while (0)
        NA_LOAD(0, 3); NA_STORE(0);
#pragma nounroll
        for (int t = 0; t < 12; ++t) {
            f32x16 s0, s1;
#pragma unroll
            for (int e = 0; e < 16; ++e) { s0[e] = 0.f; s1[e] = 0.f; }
#pragma unroll
            for (int s = 0; s < 4; ++s) {
                s0 = __builtin_amdgcn_mfma_f32_32x32x16_bf16(kf[0][s], qf[s], s0, 0, 0, 0);
                s1 = __builtin_amdgcn_mfma_f32_32x32x16_bf16(kf[1][s], qf[s], s1, 0, 0, 0);
            }
            __builtin_amdgcn_sched_barrier(0);
            if (t + 1 < 12) NA_LOAD(t + 1, 1);
            __builtin_amdgcn_sched_barrier(0);
            if (t < 8) {
                int w0v = w0 - 4 * hi, tb = 4 * hi - qc + 63; asm volatile("" : "+v"(w0v), "+v"(tb));
                const LAS3 float* tp = tbl + tb;
#pragma unroll
                for (int e = 0; e < 16; ++e) {
                    const int c0 = (e & 3) + 8 * (e >> 2), c1 = c0 + 32;
                    const bool ok0 = (unsigned)(c0 - w0v) < 16u, ok1 = (unsigned)(c1 - w0v) < 16u;
                    const float v0 = s0[e] * SC + tp[c0], v1 = s1[e] * SC + tp[c1];
                    s0[e] = ok0 ? v0 : -1e30f;
                    s1[e] = ok1 ? v1 : -1e30f;
                }
            } else {
#pragma unroll
                for (int e = 0; e < 16; ++e) { s0[e] *= SC; s1[e] *= SC; }
            }
            float mx = fmaxf(max16(s0), max16(s1));
            mx = fmaxf(mx, __shfl_xor(mx, 32));
            const float mn = fmaxf(m, mx), alpha = __builtin_amdgcn_exp2f(m - mn);
            m = mn; l *= alpha;
            o[0] = o[0] * alpha; o[1] = o[1] * alpha;
            float rs = 0.f;
#pragma unroll
            for (int e = 0; e < 16; ++e) { s0[e] = __builtin_amdgcn_exp2f(s0[e] - mn); s1[e] = __builtin_amdgcn_exp2f(s1[e] - mn); rs += s0[e] + s1[e]; }
            l += rs;
            __builtin_amdgcn_sched_barrier(0);
            if (t + 1 < 12) NA_LOAD(t + 1, 2);
            bf16x8 pf[4];
            pf[0] = pfrag(s0, 0); pf[1] = pfrag(s0, 1); pf[2] = pfrag(s1, 0); pf[3] = pfrag(s1, 1);
            const LAS3 unsigned char* va = vl + vb;
#pragma unroll
            for (int ks = 0; ks < 4; ++ks)
#pragma unroll
                for (int d = 0; d < 2; ++d) {
                    const s16x4 lo = vtr(va + (16 * ks) * VP + 64 * d), hh = vtr(va + (16 * ks + 8) * VP + 64 * d);
                    const bf16x8 vf = {lo[0], lo[1], lo[2], lo[3], hh[0], hh[1], hh[2], hh[3]};
                    o[d] = __builtin_amdgcn_mfma_f32_32x32x16_bf16(vf, pf[ks], o[d], 0, 0, 0);
                }
            __builtin_amdgcn_sched_barrier(0);
            if (t + 1 < 12) NA_STORE(t + 1);
        }
#undef NA_LOAD
#undef NA_STORE
        l += __shfl_xor(l, 32);
        const float inv = 1.f / l;
        bf16_t* op = OA + (size_t)qtok * 2048 + h * 64 + 4 * hi;
#pragma unroll
        for (int d = 0; d < 2; ++d)
#pragma unroll
            for (int g = 0; g < 4; ++g) {
                const f32x4 v = {o[d][4 * g] * inv, o[d][4 * g + 1] * inv, o[d][4 * g + 2] * inv, o[d][4 * g + 3] * inv};
                store_bf4(op + 32 * d + 8 * g, v);
            }
    }
}


template <bool LAT, int HALF>
__device__ __forceinline__ void na_tile(const LAS3 unsigned char* Kb, const LAS3 unsigned char* Vb, const LAS3 float* tbl, const bf16x8 (&qf)[4], f32x16 (&o)[2], float& m, float& l,
                                        int r32, int hi, int qc, int w0, int vb) {
    constexpr int KP = 144, VP = 192;
    constexpr float SC = NA_SCALE * LOG2E;
    constexpr int L0 = (LAT && HALF == 1) ? 12 : 0;
    constexpr int H1 = (LAT && HALF == 0) ? 4 : 16;
    f32x16 s0, s1;
#pragma unroll
    for (int e = 0; e < 16; ++e) { s0[e] = 0.f; s1[e] = 0.f; }
    const LAS3 unsigned char* ka = Kb + r32 * KP + 16 * hi;
#pragma unroll
    for (int s = 0; s < 4; ++s) {
        const bf16x8 a0 = *(const LAS3 bf16x8*)(ka + 32 * s), a1 = *(const LAS3 bf16x8*)(ka + 32 * KP + 32 * s);
        s0 = __builtin_amdgcn_mfma_f32_32x32x16_bf16(a0, qf[s], s0, 0, 0, 0);
        s1 = __builtin_amdgcn_mfma_f32_32x32x16_bf16(a1, qf[s], s1, 0, 0, 0);
    }
    if constexpr (LAT) {
        int w0v = w0 - 4 * hi, tb = 4 * hi - qc + 63; asm volatile("" : "+v"(w0v), "+v"(tb));
        const LAS3 float* tp = tbl + tb;
#pragma unroll
        for (int e = 0; e < 16; ++e) {
            const int c0 = (e & 3) + 8 * (e >> 2), c1 = c0 + 32;
            if (e >= L0) { const float p0 = (float)((unsigned)(c0 - w0v) & 0xFFFFFFF0u); s0[e] = fmaf(p0, -1e28f, fmaf(s0[e], SC, tp[c0])); }
            if (e < H1) { const float p1 = (float)((unsigned)(c1 - w0v) & 0xFFFFFFF0u); s1[e] = fmaf(p1, -1e28f, fmaf(s1[e], SC, tp[c1])); }
        }
    } else {
#pragma unroll
        for (int e = 0; e < 16; ++e) { s0[e] *= SC; s1[e] *= SC; }
    }
    float mx = -1e30f;
#pragma unroll
    for (int e = 0; e < 16; ++e) { if (e >= L0) mx = fmaxf(mx, s0[e]); if (e < H1) mx = fmaxf(mx, s1[e]); }
    mx = fmaxf(mx, __shfl_xor(mx, 32));
    const float mn = fmaxf(m, mx);
    if (__builtin_amdgcn_ballot_w64(mx > m) != 0ull) {
        const float alpha = __builtin_amdgcn_exp2f(m - mn);
        l *= alpha; o[0] = o[0] * alpha; o[1] = o[1] * alpha;
    }
    m = mn;
    float rs = 0.f;
#pragma unroll
    for (int e = 0; e < 16; ++e) {
        if (e >= L0) { s0[e] = __builtin_amdgcn_exp2f(s0[e] - mn); rs += s0[e]; } else s0[e] = 0.f;
        if (e < H1) { s1[e] = __builtin_amdgcn_exp2f(s1[e] - mn); rs += s1[e]; } else s1[e] = 0.f;
    }
    l += rs;
    bf16x8 pf[4];
    pf[0] = pfrag(s0, 0); pf[1] = pfrag(s0, 1); pf[2] = pfrag(s1, 0); pf[3] = pfrag(s1, 1);
    const LAS3 unsigned char* va = Vb + vb;
#pragma unroll
    for (int ks = 0; ks < 4; ++ks) {
        if (LAT && ((HALF == 0 && ks == 3) || (HALF == 1 && ks == 0))) continue;
#pragma unroll
        for (int d = 0; d < 2; ++d) {
            const s16x4 lo = vtr(va + (16 * ks) * VP + 64 * d), hh = vtr(va + (16 * ks + 8) * VP + 64 * d);
            const bf16x8 vf = {lo[0], lo[1], lo[2], lo[3], hh[0], hh[1], hh[2], hh[3]};
            o[d] = __builtin_amdgcn_mfma_f32_32x32x16_bf16(vf, pf[ks], o[d], 0, 0, 0);
        }
    }
}
__device__ __forceinline__ void na_coop(const Params& p, unsigned char* lds_) {
    int tid_ = threadIdx.x; asm volatile("" : "+v"(tid_)); const int tid = tid_, lane = tid & 63, wid = tid >> 6, r32 = lane & 31, hi = lane >> 5;
    constexpr int KP = 144, VP = 192, KT = 64 * KP, VT = 64 * VP, STG = KT + VT;
    LAS3 unsigned char* lds = (LAS3 unsigned char*)lds_;
    LAS3 float* tbl = (LAS3 float*)(lds + 2 * STG) + wid * 128;
    tbl[lane] = 0.f; tbl[lane + 64] = 0.f;
    const bf16_t* PL = (const bf16_t*)(p.ws + WS_PL); const bf16_t* PCx = (const bf16_t*)(p.ws + WS_PC);
    bf16_t* OA = (bf16_t*)(p.ws + WS_OA);
    const float* rpb = p.in[11];
    const int G = gridDim.x, vcu = (G % 8 == 0) ? (blockIdx.x % 8) * (G / 8) + blockIdx.x / 8 : blockIdx.x;
    const int vb = (4 * hi + ((lane & 15) >> 2)) * VP + (16 * ((lane >> 4) & 1) + 4 * (lane & 3)) * 2;
    const int half = wid & 1, rw = wid >> 1, skey = tid >> 3, spc = tid & 7;
    constexpr float SC = NA_SCALE * LOG2E;
    for (int unit = vcu; unit < NB * 16 * (GROWS / 4); unit += G) {
        const int rg = unit & 7, h = (unit >> 3) & 15, b = unit >> 7;
        const int R = rg * 4, r = R + rw;
        int r0w = r - 4; r0w = r0w < 0 ? 0 : (r0w > GROWS - 8 ? GROWS - 8 : r0w);
        int kr_lo = R - 4; kr_lo = kr_lo < 0 ? 0 : (kr_lo > GROWS - 8 ? GROWS - 8 : kr_lo);
        int kr_hi = R - 1; kr_hi = (kr_hi < 0 ? 0 : (kr_hi > GROWS - 8 ? GROWS - 8 : kr_hi)) + 7;
        const int nlat = kr_hi - kr_lo + 1, NT = nlat + 4;
        const int qc = 32 * half + r32;
        int w0 = qc - 8; w0 = w0 < 0 ? 0 : (w0 > GW - 16 ? GW - 16 : w0);
        const int qtok = b * SEQ + r * 64 + qc;
        bf16x8 qf[4];
#pragma unroll
        for (int s = 0; s < 4; ++s) qf[s] = *(const bf16x8*)(PL + (size_t)qtok * NP + PC_QA + h * 64 + 16 * s + 8 * hi);
        f32x16 o[2];
#pragma unroll
        for (int d = 0; d < 2; ++d)
#pragma unroll
            for (int e = 0; e < 16; ++e) o[d][e] = 0.f;
        float m = -1e30f, l = 0.f;
        float brow[8];
#pragma unroll
        for (int i = 0; i < 8; ++i) brow[i] = lane < 31 ? rpb[(h * 15 + (r0w - r + 7 + i)) * 31 + lane] * LOG2E : 0.f;
        u32x4 gk, gv;
#define NC_LOAD(t) do { const bf16_t* kp_ = (t) < nlat ? PL + (size_t)(b * SEQ + (kr_lo + (t)) * 64 + skey) * NP + PC_KA + h * 64 + spc * 8 \
                                                      : PCx + (size_t)(b * CTX + 64 * ((t) - nlat) + skey) * NPC + PC_KA + h * 64 + spc * 8; \
            gk = *(const u32x4*)kp_; gv = *(const u32x4*)(kp_ + 1024); } while (0)
#define NC_STORE(buf) do { *(LAS3 u32x4*)(lds + (buf) * STG + skey * KP + spc * 16) = gk; *(LAS3 u32x4*)(lds + (buf) * STG + KT + skey * VP + spc * 16) = gv; } while (0)
        __syncthreads();
        NC_LOAD(0); NC_STORE(0);
#pragma unroll
        for (int s = 0; s < 4; ++s) asm volatile("" : "+v"(qf[s]));
#pragma unroll
        for (int i = 0; i < 8; ++i) asm volatile("" : "+v"(brow[i]));
        __syncthreads();
#pragma nounroll
        for (int t = 0; t < NT; ++t) {
            const int cur = t & 1;
            if (t + 1 < NT) NC_LOAD(t + 1);
            const bool lat = t < nlat; const int kr = kr_lo + t;
            if (!lat || (kr >= r0w && kr < r0w + 8)) {
                const LAS3 unsigned char* Kb = lds + cur * STG; const LAS3 unsigned char* Vb = Kb + KT;
                if (lat) { const int bi_ = kr - r0w; float bv = brow[0];
#pragma unroll
                    for (int i = 1; i < 8; ++i) bv = bi_ == i ? brow[i] : bv;
                    if (lane < 31) tbl[48 + lane] = bv; }
                if (!lat) na_tile<false, 0>(Kb, Vb, tbl, qf, o, m, l, r32, hi, qc, w0, vb);
                else if (half == 0) na_tile<true, 0>(Kb, Vb, tbl, qf, o, m, l, r32, hi, qc, w0, vb);
                else na_tile<true, 1>(Kb, Vb, tbl, qf, o, m, l, r32, hi, qc, w0, vb);
            }
            if (t + 1 < NT) NC_STORE(cur ^ 1);
            __syncthreads();
        }
#undef NC_LOAD
#undef NC_STORE
        l += __shfl_xor(l, 32);
        const float inv = 1.f / l;
        bf16_t* op = OA + (size_t)qtok * 2048 + h * 64 + 4 * hi;
#pragma unroll
        for (int d = 0; d < 2; ++d)
#pragma unroll
            for (int g = 0; g < 4; ++g) {
                const f32x4 v = {o[d][4 * g] * inv, o[d][4 * g + 1] * inv, o[d][4 * g + 2] * inv, o[d][4 * g + 3] * inv};
                store_bf4(op + 32 * d + 8 * g, v);
            }
    }
}

__device__ __forceinline__ void phase7(const Params& p) {
    int tid_ = threadIdx.x; asm volatile("" : "+v"(tid_)); const int tid = tid_, lane = tid & 63, wid = tid >> 6;
    const int gw = blockIdx.x * NWAVES + wid, NGW = gridDim.x * NWAVES;
    const float* mod = (const float*)(p.ws + WS_MOD);
    const bf16_t* Z = (const bf16_t*)(p.ws + WS_Z); bf16_t* H = (bf16_t*)(p.ws + WS_H);
    const float* gpm = p.in[7]; const float* gpf = p.in[8];
    const int per = (TL + NGW - 1) / NGW;
    int curb = -1; f32x4 A[8], B[8], C[8];
    for (int i = 0; i < per; ++i) {
        const int m = gw * per + i; if (m >= TL) break;
        const int b = m / SEQ;
        if (b != curb) { curb = b; const float* mb = mod + (size_t)b * 12288;
#pragma unroll
            for (int j = 0; j < 8; ++j) { const int c = j * 256 + lane * 4;
                A[j] = *(const f32x4*)(mb + 4096 + c) * *(const f32x4*)(gpm + c); B[j] = *(const f32x4*)(gpf + c) * (*(const f32x4*)(mb + 8192 + c) + 1.f); C[j] = *(const f32x4*)(mb + 6144 + c); } }
        f32x4 z[8]; float ss = 0.f;
#pragma unroll
        for (int j = 0; j < 8; ++j) {
            const u32x2 w = *(const u32x2*)(Z + (size_t)m * DM + j * 256 + lane * 4);
            z[j] = (f32x4){__uint_as_float(w.x << 16), __uint_as_float(w.x & 0xffff0000u), __uint_as_float(w.y << 16), __uint_as_float(w.y & 0xffff0000u)};
            ss += z[j][0] * z[j][0] + z[j][1] * z[j][1] + z[j][2] * z[j][2] + z[j][3] * z[j][3];
        }
        f32x4 xv[8];
#pragma unroll
        for (int j = 0; j < 8; ++j) xv[j] = *(const f32x4*)(p.in[0] + (size_t)m * DM + j * 256 + lane * 4);
        const float rz = rsqrtf(wave_sum_dpp(ss) * (1.f / DM) + EPS);
        float s2 = 0.f;
#pragma unroll
        for (int j = 0; j < 8; ++j) {
            const f32x4 x1 = xv[j] + (z[j] * rz) * A[j];
            *(f32x4*)(p.out + (size_t)m * DM + j * 256 + lane * 4) = x1;
            z[j] = x1; s2 += x1[0] * x1[0] + x1[1] * x1[1] + x1[2] * x1[2] + x1[3] * x1[3];
        }
        const float rx = rsqrtf(wave_sum_dpp(s2) * (1.f / DM) + EPS);
#pragma unroll
        for (int j = 0; j < 8; ++j) store_bf4(H + (size_t)m * DM + j * 256 + lane * 4, (z[j] * rx) * B[j] + C[j]);
    }
}

template <int NPER>
__device__ __forceinline__ void wave_top16(float (&v)[NPER], const int (&idx)[NPER], float& outv, int& outi, int lane) {
    outv = -INFINITY; outi = 0;
#pragma nounroll
    for (int r = 0; r < 16; ++r) {
        float bv = v[0]; int bi = idx[0];
#pragma unroll
        for (int e = 1; e < NPER; ++e) if (v[e] > bv || (v[e] == bv && idx[e] < bi)) { bv = v[e]; bi = idx[e]; }
#pragma unroll
        for (int o = 32; o >= 1; o >>= 1) {
            const float ov = __shfl_xor(bv, o); const int oi = __shfl_xor(bi, o);
            if (ov > bv || (ov == bv && oi < bi)) { bv = ov; bi = oi; }
        }
#pragma unroll
        for (int e = 0; e < NPER; ++e) if (idx[e] == bi) v[e] = -INFINITY;
        if (lane == r) { outv = bv; outi = bi; }
    }
}

__device__ __forceinline__ void peer_topk_naive(const Params& p, unsigned char* lds) {
    int tid_ = threadIdx.x; asm volatile("" : "+v"(tid_)); const int tid = tid_, lane = tid & 63, wid = tid >> 6;
    const int gw = blockIdx.x * NWAVES + wid, NGW = gridDim.x * NWAVES;
    const bf16_t* QP = (const bf16_t*)(p.ws + WS_QP); const bf16_t* SK = (const bf16_t*)(p.ws + WS_SUBK);
    float* TKV = (float*)(p.ws + WS_TKV); int* TKI = (int*)(p.ws + WS_TKI);
    float* qs = (float*)lds + wid * 128;
    for (int it = gw; it < TL * 16; it += NGW) {
        const int hp = it & 15, m = it >> 4;
        qs[lane] = bf2f(QP[(size_t)m * DM + hp * 128 + lane]); qs[lane + 64] = bf2f(QP[(size_t)m * DM + hp * 128 + 64 + lane]);
        __builtin_amdgcn_s_waitcnt(0xc07f); asm volatile("" ::: "memory");
        float v[2]; int idx[2];
#pragma unroll
        for (int i = 0; i < 2; ++i) {
            const int n = lane + 64 * i; const bf16_t* kp = SK + (size_t)(hp * 128 + n) * 128;
            float d = 0.f;
#pragma unroll
            for (int e = 0; e < 16; ++e) d += dot_bf16x8(*(const bf16x8*)(kp + e * 8), qs + e * 8);
            v[i] = d; idx[i] = n;
        }
        float ov; int oi; wave_top16<2>(v, idx, ov, oi, lane);
        if (lane < 16) { TKV[(size_t)it * 16 + lane] = ov; TKI[(size_t)it * 16 + lane] = oi; }
        __builtin_amdgcn_s_waitcnt(0xc07f); asm volatile("" ::: "memory");
    }
}

__device__ __forceinline__ void peer_final_naive(const Params& p, unsigned char* lds) {
    int tid_ = threadIdx.x; asm volatile("" : "+v"(tid_)); const int tid = tid_, lane = tid & 63, wid = tid >> 6;
    const float* TKV = (const float*)(p.ws + WS_TKV); const int* TKI = (const int*)(p.ws + WS_TKI);
    const bf16_t* H = (const bf16_t*)(p.ws + WS_H);
    const float* U = p.in[21]; const float* V = p.in[22];
    const float* mod = (const float*)(p.ws + WS_MOD); const float* gpo = p.in[9];
    float* part = (float*)lds;
    float* red = part + 8 * 2048;
    for (int m = blockIdx.x; m < TL; m += gridDim.x) {
        const int b = m / SEQ, h = wid;
        const float* v1 = TKV + ((size_t)m * 16 + h * 2) * 16; const float* v2 = v1 + 16;
        const int* i1 = TKI + ((size_t)m * 16 + h * 2) * 16; const int* i2 = i1 + 16;
        float cv[4]; int ci[4];
        const float v2j = v2[lane & 15];
#pragma unroll
        for (int e = 0; e < 4; ++e) { const int i = (lane >> 4) + 4 * e; cv[e] = v1[i] + v2j; ci[e] = i * 16 + (lane & 15); }
        float tv; int tc; wave_top16<4>(cv, ci, tv, tc, lane);
        int eid = 0; float gate = 0.f;
        if (lane < 16) eid = i1[tc >> 4] * 128 + i2[tc & 15];
        const float mx = __shfl(tv, 0);
        const float ex = lane < 16 ? __expf(tv - mx) : 0.f;
        gate = ex / wave_sum(ex);
        f32x4 hv[8];
#pragma unroll
        for (int j = 0; j < 8; ++j) { const u32x2 w = *(const u32x2*)(H + (size_t)m * DM + j * 256 + lane * 4);
            hv[j] = (f32x4){__uint_as_float(w.x << 16), __uint_as_float(w.x & 0xffff0000u), __uint_as_float(w.y << 16), __uint_as_float(w.y & 0xffff0000u)}; }
        f32x4 acc[8];
#pragma unroll
        for (int j = 0; j < 8; ++j) acc[j] = (f32x4){0.f, 0.f, 0.f, 0.f};
        for (int k = 0; k < 16; ++k) {
            const int e = __shfl(eid, k); const float g = __shfl(gate, k);
#ifdef PEER_NAIVE_BF16
            const bf16_t* ur = (const bf16_t*)(p.ws + WS_UB) + (size_t)e * DM + lane * 4; const bf16_t* vr = (const bf16_t*)(p.ws + WS_VB) + (size_t)e * DM + lane * 4;
            float d = 0.f;
#pragma unroll
            for (int j = 0; j < 8; ++j) { const u32x2 w = *(const u32x2*)(ur + j * 256); const f32x4 u = {__uint_as_float(w.x << 16), __uint_as_float(w.x & 0xffff0000u), __uint_as_float(w.y << 16), __uint_as_float(w.y & 0xffff0000u)};
                d += u[0] * hv[j][0] + u[1] * hv[j][1] + u[2] * hv[j][2] + u[3] * hv[j][3]; }
            d = wave_sum(d);
            const float coef = g * gelu_as(d);
#pragma unroll
            for (int j = 0; j < 8; ++j) { const u32x2 w = *(const u32x2*)(vr + j * 256); const f32x4 vv = {__uint_as_float(w.x << 16), __uint_as_float(w.x & 0xffff0000u), __uint_as_float(w.y << 16), __uint_as_float(w.y & 0xffff0000u)};
                acc[j] += vv * coef; }
#else
            const float* ur = U + (size_t)e * DM + lane * 4; const float* vr = V + (size_t)e * DM + lane * 4;
            float d = 0.f;
#pragma unroll
            for (int j = 0; j < 8; ++j) { const f32x4 u = *(const f32x4*)(ur + j * 256); d += u[0] * hv[j][0] + u[1] * hv[j][1] + u[2] * hv[j][2] + u[3] * hv[j][3]; }
            d = wave_sum(d);
            const float coef = g * gelu_erf(d);
#pragma unroll
            for (int j = 0; j < 8; ++j) acc[j] += *(const f32x4*)(vr + j * 256) * coef;
#endif
        }
        __syncthreads();
#pragma unroll
        for (int j = 0; j < 8; ++j) *(f32x4*)(part + wid * 2048 + j * 256 + lane * 4) = acc[j];
        __syncthreads();
        f32x4 y = (f32x4){0.f, 0.f, 0.f, 0.f};
#pragma unroll
        for (int w = 0; w < 8; ++w) y += *(const f32x4*)(part + w * 2048 + tid * 4);
        float ss = wave_sum(y[0] * y[0] + y[1] * y[1] + y[2] * y[2] + y[3] * y[3]);
        if (lane == 0) red[wid] = ss;
        __syncthreads();
        float tot = 0.f;
#pragma unroll
        for (int w = 0; w < 8; ++w) tot += red[w];
        const float rstd = rsqrtf(tot * (1.f / DM) + EPS);
        const int c = tid * 4;
        const f32x4 gt2 = *(const f32x4*)(mod + (size_t)b * 12288 + 10240 + c);
        float* op = p.out + (size_t)m * DM + c;
        const f32x4 x1 = *(const f32x4*)op;
        *(f32x4*)op = x1 + gt2 * (y * rstd * *(const f32x4*)(gpo + c));
    }
}


__device__ __forceinline__ void peer_topk_mfma(const Params& p, unsigned char* lds_) {
    int tid_ = threadIdx.x; asm volatile("" : "+v"(tid_)); const int tid = tid_, lane = tid & 63, wid = tid >> 6, r32 = lane & 31, hi = lane >> 5;
    LAS3 unsigned char* lds = (LAS3 unsigned char*)lds_;
    constexpr int SP = 272;
    const bf16_t* QP = (const bf16_t*)(p.ws + WS_QP); const bf16_t* SK = (const bf16_t*)(p.ws + WS_SUBK);
    float* TKV = (float*)(p.ws + WS_TKV); int* TKI = (int*)(p.ws + WS_TKI);
    for (int bi = blockIdx.x; bi < 256; bi += gridDim.x) {
        const int hp = bi & 15, sub = bi >> 4;
        __syncthreads();
        for (int c = tid; c < 2048; c += NTHREADS) { const int row = c >> 4, pc = c & 15;
            *(LAS3 u32x4*)(lds + row * SP + pc * 16) = *(const u32x4*)(SK + ((size_t)hp * 128 + row) * 128 + pc * 8); }
        __syncthreads();
        for (int g = wid; g < 32; g += NWAVES) {
            const int tok = (sub * 32 + g) * 32 + r32;
            bf16x8 qf[8];
#pragma unroll
            for (int s = 0; s < 8; ++s) qf[s] = *(const bf16x8*)(QP + (size_t)tok * DM + hp * 128 + 16 * s + 8 * hi);
            f32x16 sc[4];
#pragma unroll
            for (int kb = 0; kb < 4; ++kb) {
#pragma unroll
                for (int e = 0; e < 16; ++e) sc[kb][e] = 0.f;
#pragma unroll
                for (int s = 0; s < 8; ++s) {
                    const bf16x8 a = *(const LAS3 bf16x8*)(lds + (32 * kb + r32) * SP + 32 * s + 16 * hi);
                    sc[kb] = __builtin_amdgcn_mfma_f32_32x32x16_bf16(a, qf[s], sc[kb], 0, 0, 0);
                }
            }
#pragma unroll
            for (int kb = 0; kb < 4; ++kb)
#pragma unroll
                for (int e = 0; e < 16; ++e) {
                    const unsigned key = 32 * kb + (e & 3) + 8 * (e >> 2) + 4 * hi;
                    sc[kb][e] = __uint_as_float((__float_as_uint(sc[kb][e]) & 0xFFFFFF80u) | key);
                }
            float ov[16];
#pragma unroll
            for (int r = 0; r < 16; ++r) {
                float mx = -INFINITY;
#pragma unroll
                for (int kb = 0; kb < 4; ++kb) mx = fmaxf(mx, max16(sc[kb]));
                const float w = fmaxf(mx, __shfl_xor(mx, 32));
                ov[r] = w;
#pragma unroll
                for (int kb = 0; kb < 4; ++kb)
#pragma unroll
                    for (int e = 0; e < 16; ++e) sc[kb][e] = sc[kb][e] == w ? -INFINITY : sc[kb][e];
            }
            if (hi == 0) {
                float* vp = TKV + ((size_t)tok * 16 + hp) * 16; int* ip = TKI + ((size_t)tok * 16 + hp) * 16;
#pragma unroll
                for (int q = 0; q < 4; ++q) {
                    f32x4 vv; u32x4 ii;
#pragma unroll
                    for (int e = 0; e < 4; ++e) { const unsigned u = __float_as_uint(ov[4 * q + e]); vv[e] = __uint_as_float(u & 0xFFFFFF80u); ii[e] = u & 127u; }
                    *(f32x4*)(vp + 4 * q) = vv; *(u32x4*)(ip + 4 * q) = ii;
                }
            }
        }
    }
}


constexpr int cand_jmax(int i) { return 16 / (i + 1); }
constexpr int cand_off(int i) { int t = 0; for (int k = 0; k < i; ++k) t += 16 / (k + 1); return t; }
static_assert(cand_off(16) == 50, "candidate count");
template <int N> __device__ __forceinline__ void bitonic_sort_desc(float (&a)[N]) {
#pragma unroll
    for (int k = 2; k <= N; k <<= 1)
#pragma unroll
        for (int j = k >> 1; j > 0; j >>= 1)
#pragma unroll
            for (int i = 0; i < N; ++i) { const int l = i ^ j; if (l > i) { const bool up = (i & k) == 0; const float x = a[i], y = a[l];
                a[i] = up ? fmaxf(x, y) : fminf(x, y); a[l] = up ? fminf(x, y) : fmaxf(x, y); } }
}
template <int N> __device__ __forceinline__ void bitonic_merge_desc(float (&a)[N]) {
#pragma unroll
    for (int j = N >> 1; j > 0; j >>= 1)
#pragma unroll
        for (int i = 0; i < N; ++i) { const int l = i ^ j; if (l > i) { const float x = a[i], y = a[l]; a[i] = fmaxf(x, y); a[l] = fminf(x, y); } }
}
__device__ __forceinline__ void top16_merge(float (&a)[16], const float (&b)[16]) {
#pragma unroll
    for (int i = 0; i < 16; ++i) a[i] = fmaxf(a[i], b[15 - i]);
    bitonic_merge_desc<16>(a);
}
__device__ __forceinline__ void top16_of_64(float (&g0)[16], float (&g1)[16], float (&g2)[16], float (&g3)[16]) {
    bitonic_sort_desc<16>(g0); bitonic_sort_desc<16>(g1); bitonic_sort_desc<16>(g2); bitonic_sort_desc<16>(g3);
    top16_merge(g0, g1); top16_merge(g2, g3); top16_merge(g0, g2);
}
__device__ __forceinline__ void topk_stage1(const LAS3 unsigned char* skl, const bf16_t* __restrict__ qrow, int r32, int hi, float (&ov)[16]) {
    constexpr int SP = 272;
    bf16x8 qf[8];
#pragma unroll
    for (int s = 0; s < 8; ++s) qf[s] = *(const bf16x8*)(qrow + 16 * s + 8 * hi);
    f32x16 sc[4];
#pragma unroll
    for (int kb = 0; kb < 4; ++kb) {
#pragma unroll
        for (int e = 0; e < 16; ++e) sc[kb][e] = 0.f;
#pragma unroll
        for (int s = 0; s < 8; ++s) {
            const bf16x8 a = *(const LAS3 bf16x8*)(skl + (32 * kb + r32) * SP + 32 * s + 16 * hi);
            sc[kb] = __builtin_amdgcn_mfma_f32_32x32x16_bf16(a, qf[s], sc[kb], 0, 0, 0);
        }
    }
    float g1[16], g2[16], g3[16];
#pragma unroll
    for (int e = 0; e < 16; ++e) {
        const unsigned key = (e & 3) + 8 * (e >> 2) + 4 * hi;
        ov[e] = __uint_as_float((__float_as_uint(sc[0][e]) & 0xFFFFFF80u) | key);
        g1[e] = __uint_as_float((__float_as_uint(sc[1][e]) & 0xFFFFFF80u) | (key + 32u));
        g2[e] = __uint_as_float((__float_as_uint(sc[2][e]) & 0xFFFFFF80u) | (key + 64u));
        g3[e] = __uint_as_float((__float_as_uint(sc[3][e]) & 0xFFFFFF80u) | (key + 96u));
    }
    top16_of_64(ov, g1, g2, g3);
    float pb[16];
#pragma unroll
    for (int e = 0; e < 16; ++e) pb[e] = __shfl_xor(ov[e], 32);
    top16_merge(ov, pb);
}
__device__ __forceinline__ void peer_tables_q8(const Params& p, int gw, int NGW, int lane);
__device__ __forceinline__ void peer_select_mfma(const Params& p, unsigned char* lds_, int mode = 0) {
    int tid_ = threadIdx.x; asm volatile("" : "+v"(tid_)); const int tid = tid_, lane = tid & 63, wid = tid >> 6, r32 = lane & 31, hi = lane >> 5;
    LAS3 unsigned char* lds = (LAS3 unsigned char*)lds_;
    constexpr int SP = 272;
    LAS3 unsigned* ktab = (LAS3 unsigned*)(lds + 256 * SP) + wid * 2048 + lane;
    const bf16_t* QP = (const bf16_t*)(p.ws + WS_QP); const bf16_t* SK = (const bf16_t*)(p.ws + WS_SUBK);
    int* SE = (int*)(p.ws + WS_TKI); float* SG = (float*)(p.ws + WS_TKV);
    for (int bi = blockIdx.x; bi < 256; bi += gridDim.x) {
        const int h = bi & 7, sub = bi >> 3;
        __syncthreads();
        for (int c = tid; c < 4096; c += NTHREADS) { const int row = c >> 4, pc = c & 15;
            *(LAS3 u32x4*)(lds + row * SP + pc * 16) = *(const u32x4*)(SK + ((size_t)h * 256 + row) * 128 + pc * 8); }
        __syncthreads();
#ifdef SEL_SPLIT
        if (wid >= 4) { if (bi == (int)blockIdx.x && mode != 1) peer_tables_q8(p, blockIdx.x * 4 + (wid - 4), gridDim.x * 4, lane); continue; }
        if (mode == 2) continue;
        for (int g = wid; g < 16; g += 4) {
#else
        if (mode == 2) continue;
        for (int g = wid; g < 16; g += NWAVES) {
#endif
            const int tok = (sub * 16 + g) * 32 + r32;
            float ov0[16], ov1[16];
            int lo0 = 0, lo1 = 128 * SP; asm volatile("" : "+v"(lo0), "+v"(lo1));
            topk_stage1(lds + lo0, QP + (size_t)tok * DM + h * 256, r32, hi, ov0);
            topk_stage1(lds + lo1, QP + (size_t)tok * DM + h * 256 + 128, r32, hi, ov1);
#pragma unroll
            for (int q = 0; q < 16; ++q) { ktab[q * 64] = __float_as_uint(ov0[q]) & 127u; ktab[(16 + q) * 64] = __float_as_uint(ov1[q]) & 127u; }
            float c0[16], c1[16], c2[16], c3[16];
#pragma unroll
            for (int e = 0; e < 16; ++e) { c0[e] = -INFINITY; c1[e] = -INFINITY; c2[e] = -INFINITY; c3[e] = -INFINITY; }
#pragma unroll
            for (int i = 0; i < 16; ++i) {
                const float a = __uint_as_float(__float_as_uint(ov0[i]) & 0xFFFFFF80u);
#pragma unroll
                for (int j = 0; j < 16; ++j) if (j < cand_jmax(i)) {
                    const float bb = __uint_as_float(__float_as_uint(ov1[j]) & 0xFFFFFF80u);
                    const float cv = __uint_as_float((__float_as_uint(a + bb) & 0xFFFFFF00u) | (unsigned)(i * 16 + j));
                    const int n = cand_off(i) + j;
                    if (n < 16) c0[n & 15] = cv; else if (n < 32) c1[n & 15] = cv; else if (n < 48) c2[n & 15] = cv; else c3[n & 15] = cv;
                }
            }
            top16_of_64(c0, c1, c2, c3);
            float tv[16]; unsigned te[16];
#pragma unroll
            for (int r = 0; r < 16; ++r) {
                const unsigned ij = __float_as_uint(c0[r]) & 255u;
                te[r] = ktab[(ij >> 4) * 64] * 128u + ktab[(16 + (ij & 15u)) * 64];
                tv[r] = __uint_as_float(__float_as_uint(c0[r]) & 0xFFFFFF00u);
            }
            const float tmax = tv[0]; float sum = 0.f;
#pragma unroll
            for (int r = 0; r < 16; ++r) { tv[r] = __expf(tv[r] - tmax); sum += tv[r]; }
            const float rinv = 1.f / sum;
#pragma unroll
            for (int r = 0; r < 16; ++r) tv[r] *= rinv;
            if (hi == 0) {
                int* ep = SE + (size_t)tok * 128 + h * 16; float* gp = SG + (size_t)tok * 128 + h * 16;
#pragma unroll
                for (int q = 0; q < 4; ++q) { *(u32x4*)(ep + 4 * q) = (u32x4){te[4 * q], te[4 * q + 1], te[4 * q + 2], te[4 * q + 3]}; *(f32x4*)(gp + 4 * q) = (f32x4){tv[4 * q], tv[4 * q + 1], tv[4 * q + 2], tv[4 * q + 3]}; }
            }
        }
#ifndef SEL_SPLIT
        if (bi == (int)blockIdx.x && mode != 1) peer_tables_q8(p, blockIdx.x * NWAVES + wid, gridDim.x * NWAVES, lane);
#endif
    }
}

__device__ __forceinline__ void peer_tables_bf16(const Params& p) {
    const size_t gt = (size_t)blockIdx.x * NTHREADS + threadIdx.x, NGT = (size_t)gridDim.x * NTHREADS;
    const float* U = p.in[21]; const float* V = p.in[22];
    bf16_t* UB = (bf16_t*)(p.ws + WS_UB); bf16_t* VB = (bf16_t*)(p.ws + WS_VB);
    for (size_t i = gt; i < (size_t)16384 * DM / 8; i += NGT) {
        const f32x4 a0 = *(const f32x4*)(U + i * 8), a1 = *(const f32x4*)(U + i * 8 + 4), b0 = *(const f32x4*)(V + i * 8), b1 = *(const f32x4*)(V + i * 8 + 4);
        u32x4 w; w.x = pk2(a0[0], a0[1]); w.y = pk2(a0[2], a0[3]); w.z = pk2(a1[0], a1[1]); w.w = pk2(a1[2], a1[3]);
        *(u32x4*)(UB + i * 8) = w;
        w.x = pk2(b0[0], b0[1]); w.y = pk2(b0[2], b0[3]); w.z = pk2(b1[0], b1[1]); w.w = pk2(b1[2], b1[3]);
        *(u32x4*)(VB + i * 8) = w;
    }
}

typedef short s16x2 __attribute__((ext_vector_type(2)));
__device__ __forceinline__ float dot2_bf16(unsigned a, unsigned b, float acc) { return __builtin_amdgcn_fdot2_f32_bf16(__builtin_bit_cast(s16x2, a), __builtin_bit_cast(s16x2, b), acc, false); }
__device__ __forceinline__ float dot8_bf16(const u32x4 a, const u32x4 b, float acc) {
    const unsigned a0 = a[0], a1 = a[1], a2 = a[2], a3 = a[3], b0 = b[0], b1 = b[1], b2 = b[2], b3 = b[3];
    acc = dot2_bf16(a0, b0, acc); acc = dot2_bf16(a1, b1, acc); acc = dot2_bf16(a2, b2, acc); acc = dot2_bf16(a3, b3, acc);
    return acc;
}
__device__ __forceinline__ void peer_select(const float* __restrict__ TKV, const int* __restrict__ TKI, int m, int lane, int& eA, int& eB, float& gA, float& gB) {
    eA = 0; eB = 0; gA = 0.f; gB = 0.f;
#pragma nounroll
    for (int h = 0; h < 8; ++h) {
        const float* v1 = TKV + ((size_t)m * 16 + h * 2) * 16; const float* v2 = v1 + 16;
        const int* i1 = TKI + ((size_t)m * 16 + h * 2) * 16; const int* i2 = i1 + 16;
        float cv[4]; int ci[4];
        const float v2j = v2[lane & 15];
#pragma unroll
        for (int e = 0; e < 4; ++e) { const int i = (lane >> 4) + 4 * e; cv[e] = v1[i] + v2j; ci[e] = i * 16 + (lane & 15); }
        float tv; int tc; wave_top16<4>(cv, ci, tv, tc, lane);
        int eid = 0;
        if (lane < 16) eid = i1[tc >> 4] * 128 + i2[tc & 15];
        const float mx = __shfl(tv, 0);
        const float ex = lane < 16 ? __expf(tv - mx) : 0.f;
        const float gate = ex / wave_sum(ex);
        const int es = __shfl(eid, lane & 15); const float gs = __shfl(gate, lane & 15);
        if ((lane >> 4) == (h & 3)) { if (h < 4) { eA = es; gA = gs; } else { eB = es; gB = gs; } }
    }
}
__device__ __forceinline__ void peer_gather(const Params& p, bool dry = false) {
    int tid_ = threadIdx.x; asm volatile("" : "+v"(tid_)); const int tid = tid_, lane = tid & 63, wid = tid >> 6;
    const int gw = blockIdx.x * NWAVES + wid, NGW = gridDim.x * NWAVES;
    const float* TKV = (const float*)(p.ws + WS_TKV); const int* TKI = (const int*)(p.ws + WS_TKI);
    const bf16_t* H = (const bf16_t*)(p.ws + WS_H);
    const bf16_t* UB = (const bf16_t*)(p.ws + WS_UB); const bf16_t* VB = (const bf16_t*)(p.ws + WS_VB);
    const float* mod = (const float*)(p.ws + WS_MOD); const float* gpo = p.in[9];
    for (int m = gw; m < TL; m += NGW) {
        int eA, eB; float gA, gB;
        peer_select(TKV, TKI, m, lane, eA, eB, gA, gB);
        asm volatile("" : "+v"(eA), "+v"(eB), "+v"(gA), "+v"(gB));
        u32x4 us[2][4], vs[2][4];
#define PG_LOAD(S, k) do { const int e_ = __builtin_amdgcn_readlane((k) < 64 ? eA : eB, (k) & 63); \
            const bf16_t* up_ = UB + (size_t)e_ * DM + lane * 8; const bf16_t* vp_ = VB + (size_t)e_ * DM + lane * 8; \
            _Pragma("unroll") for (int i = 0; i < 4; ++i) { us[S][i] = *(const u32x4*)(up_ + i * 512); vs[S][i] = *(const u32x4*)(vp_ + i * 512); } } while (0)
        PG_LOAD(0, 0); PG_LOAD(1, 1);
        u32x4 hq[4];
#pragma unroll
        for (int i = 0; i < 4; ++i) hq[i] = *(const u32x4*)(H + (size_t)m * DM + i * 512 + lane * 8);
        float acc[4][8];
#pragma unroll
        for (int i = 0; i < 4; ++i)
#pragma unroll
            for (int e = 0; e < 8; ++e) acc[i][e] = 0.f;
#define PG_USE(S, k) do { float d_ = 0.f; \
            _Pragma("unroll") for (int i = 0; i < 4; ++i) d_ = dot8_bf16(us[S][i], hq[i], d_); \
            d_ = wave_sum(d_); \
            const float g_ = __uint_as_float((unsigned)__builtin_amdgcn_readlane((int)__float_as_uint((k) < 64 ? gA : gB), (k) & 63)); \
            const float cf_ = g_ * gelu_as(d_); \
            _Pragma("unroll") for (int i = 0; i < 4; ++i) { const u32x4 w_ = vs[S][i]; \
                acc[i][0] += cf_ * __uint_as_float(w_.x << 16); acc[i][1] += cf_ * __uint_as_float(w_.x & 0xffff0000u); \
                acc[i][2] += cf_ * __uint_as_float(w_.y << 16); acc[i][3] += cf_ * __uint_as_float(w_.y & 0xffff0000u); \
                acc[i][4] += cf_ * __uint_as_float(w_.z << 16); acc[i][5] += cf_ * __uint_as_float(w_.z & 0xffff0000u); \
                acc[i][6] += cf_ * __uint_as_float(w_.w << 16); acc[i][7] += cf_ * __uint_as_float(w_.w & 0xffff0000u); } } while (0)
#pragma nounroll
        for (int k = 0; k < 128; k += 2) {
            PG_USE(0, k);     if (k + 2 < 128) PG_LOAD(0, k + 2);
            PG_USE(1, k + 1); if (k + 3 < 128) PG_LOAD(1, k + 3);
        }
#undef PG_LOAD
#undef PG_USE
        float ss = 0.f;
#pragma unroll
        for (int i = 0; i < 4; ++i)
#pragma unroll
            for (int e = 0; e < 8; ++e) ss += acc[i][e] * acc[i][e];
        const float rstd = rsqrtf(wave_sum(ss) * (1.f / DM) + EPS);
        const int b = m / SEQ;
#pragma unroll
        for (int i = 0; i < 4; ++i)
#pragma unroll
            for (int q = 0; q < 2; ++q) {
                const int c = i * 512 + lane * 8 + q * 4;
                const f32x4 gt2 = *(const f32x4*)(mod + (size_t)b * 12288 + 10240 + c), gg = *(const f32x4*)(gpo + c);
                float* op = p.out + (size_t)m * DM + c;
                const f32x4 x1 = *(const f32x4*)op;
                const f32x4 y = {acc[i][4 * q], acc[i][4 * q + 1], acc[i][4 * q + 2], acc[i][4 * q + 3]};
                const f32x4 res = x1 + gt2 * (y * rstd * gg);
                if (!dry) *(f32x4*)op = res; else asm volatile("" :: "v"(res));
            }
    }
}


__device__ __forceinline__ void peer_q8_row(const Params& p, int r, const f32x4 (&v)[8], int lane) {
    unsigned char* UQ = p.ws + WS_UQ; unsigned char* VQ = p.ws + WS_VQ; float* USC = (float*)(p.ws + WS_USC); float* VSC = (float*)(p.ws + WS_VSC);
    const bool isv = r >= 16384; const int e = isv ? r - 16384 : r;
    float mx = 0.f;
#pragma unroll
    for (int j = 0; j < 8; ++j) mx = fmaxf(mx, fmaxf(fmaxf(fabsf(v[j][0]), fabsf(v[j][1])), fmaxf(fabsf(v[j][2]), fabsf(v[j][3]))));
    mx = fmaxf(wave_max(mx), 1e-30f);
    const float sc = mx * (1.f / 127.f), inv = 127.f / mx;
    unsigned char* dst = (isv ? VQ : UQ) + (size_t)e * DM;
    const int zp = isv ? 128 : 0;
#pragma unroll
    for (int j = 0; j < 8; ++j) {
        unsigned w = 0;
#pragma unroll
        for (int c = 0; c < 4; ++c) { const int q = (int)rintf(v[j][c] * inv) + zp; w |= ((unsigned)q & 0xffu) << (8 * c); }
        *(unsigned*)(dst + j * 256 + lane * 4) = w;
    }
    if (lane == 0) (isv ? VSC : USC)[e] = sc;
}
__device__ __forceinline__ void peer_tables_q8(const Params& p, int gw, int NGW, int lane) {
    f32x4 va[8], vb[8];
#define Q8_LOAD(dst, r) do { const float* s_ = ((r) >= 16384 ? p.in[22] + (size_t)((r) - 16384) * DM : p.in[21] + (size_t)(r) * DM); \
        _Pragma("unroll") for (int j = 0; j < 8; ++j) dst[j] = *(const f32x4*)(s_ + j * 256 + lane * 4); } while (0)
    int r = gw;
    if (r < 2 * 16384) Q8_LOAD(va, r);
    for (; r < 2 * 16384; r += 2 * NGW) {
        const int r1 = r + NGW, r2 = r + 2 * NGW;
        if (r1 < 2 * 16384) Q8_LOAD(vb, r1);
        peer_q8_row(p, r, va, lane);
        if (r2 < 2 * 16384) Q8_LOAD(va, r2);
        if (r1 < 2 * 16384) peer_q8_row(p, r1, vb, lane);
    }
#undef Q8_LOAD
}

__device__ __forceinline__ void peer_gather_q8(const Params& p, unsigned char* lds_, bool dry = false, int emask = 0x3fff) {
    int tid_ = threadIdx.x; asm volatile("" : "+v"(tid_)); const int tid = tid_, lane = tid & 63, wid = tid >> 6;
    LAS3 int* srt = (LAS3 int*)lds_ + wid * 256;
    const int gw = blockIdx.x * NWAVES + wid, NGW = gridDim.x * NWAVES;
    const float* TKV = (const float*)(p.ws + WS_TKV); const int* TKI = (const int*)(p.ws + WS_TKI);
    const bf16_t* H = (const bf16_t*)(p.ws + WS_H);
    const unsigned char* UQ = p.ws + WS_UQ; const unsigned char* VQ = p.ws + WS_VQ; const float* USC = (const float*)(p.ws + WS_USC); const float* VSC = (const float*)(p.ws + WS_VSC);
    const float* mod = (const float*)(p.ws + WS_MOD); const float* gpo = p.in[9];
    const int rounds = (TL + NGW - 1) / NGW;
    for (int it = 0; it < rounds; ++it) {
        const int m = gw + it * NGW;
#ifndef GATHER_UNSORTED
        __syncthreads();
#endif
        if (m >= TL) continue;
        int eA, eB; float gA, gB;
#if defined(TOPK_NAIVE) || defined(TOPK_STAGE1)
        peer_select(TKV, TKI, m, lane, eA, eB, gA, gB);
#else
        eA = TKI[(size_t)m * 128 + lane]; eB = TKI[(size_t)m * 128 + 64 + lane]; gA = TKV[(size_t)m * 128 + lane]; gB = TKV[(size_t)m * 128 + 64 + lane];
#endif
#ifndef GATHER_UNSORTED
        {
            int rA = 0, rB = 0;
#pragma nounroll
            for (int j = 0; j < 64; ++j) {
                const int ea = __builtin_amdgcn_readlane(eA, j), eb = __builtin_amdgcn_readlane(eB, j);
                rA += (ea < eA || (ea == eA && j < lane)) ? 1 : 0; rA += (eb < eA) ? 1 : 0;
                rB += (ea < eB || ea == eB) ? 1 : 0; rB += (eb < eB || (eb == eB && j < lane)) ? 1 : 0;
            }
            srt[rA] = eA; srt[128 + rA] = __float_as_int(gA); srt[rB] = eB; srt[128 + rB] = __float_as_int(gB);
            eA = srt[lane]; eB = srt[64 + lane]; gA = __int_as_float(srt[128 + lane]); gB = __int_as_float(srt[192 + lane]);
        }
#endif
        asm volatile("" : "+v"(eA), "+v"(eB), "+v"(gA), "+v"(gB));
        unsigned hq[2][4]; float hscale;
        {
            u32x4 hw[2][2]; float mx = 0.f;
#pragma unroll
            for (int i = 0; i < 2; ++i)
#pragma unroll
                for (int q = 0; q < 2; ++q) { hw[i][q] = *(const u32x4*)(H + (size_t)m * DM + i * 1024 + lane * 16 + q * 8);
#pragma unroll
                    for (int c = 0; c < 4; ++c) { const unsigned w = hw[i][q][c]; mx = fmaxf(mx, fmaxf(fabsf(__uint_as_float(w << 16)), fabsf(__uint_as_float(w & 0xffff0000u)))); } }
            mx = fmaxf(wave_max(mx), 1e-30f);
            hscale = mx * (1.f / 127.f); const float inv = 127.f / mx;
#pragma unroll
            for (int i = 0; i < 2; ++i)
#pragma unroll
                for (int q = 0; q < 2; ++q)
#pragma unroll
                    for (int c2 = 0; c2 < 2; ++c2) {
                        const unsigned w0 = hw[i][q][2 * c2], w1 = hw[i][q][2 * c2 + 1];
                        const int q0 = (int)rintf(__uint_as_float(w0 << 16) * inv), q1 = (int)rintf(__uint_as_float(w0 & 0xffff0000u) * inv);
                        const int q2 = (int)rintf(__uint_as_float(w1 << 16) * inv), q3 = (int)rintf(__uint_as_float(w1 & 0xffff0000u) * inv);
                        hq[i][2 * q + c2] = ((unsigned)q0 & 0xffu) | (((unsigned)q1 & 0xffu) << 8) | (((unsigned)q2 & 0xffu) << 16) | (((unsigned)q3 & 0xffu) << 24);
                    }
        }
        float cA = 0.f, cB = 0.f; float csum = 0.f;
        {
            u32x4 us[8][2]; float usc[8], vsc[8];
#define PU_LOAD(S, k) do { const int e_ = __builtin_amdgcn_readlane((k) < 64 ? eA : eB, (k) & 63) & emask; int ev_ = e_; asm volatile("" : "+v"(ev_)); \
                const unsigned char* up_ = UQ + (size_t)e_ * DM + lane * 16; us[S][0] = *(const u32x4*)up_; us[S][1] = *(const u32x4*)(up_ + 1024); usc[S] = USC[ev_]; vsc[S] = VSC[ev_]; } while (0)
#define PU_COEF(S, k) do { int id_ = 0; \
                _Pragma("unroll") for (int i = 0; i < 2; ++i) _Pragma("unroll") for (int c = 0; c < 4; ++c) { const unsigned uw_ = us[S][i][c]; id_ = __builtin_amdgcn_sdot4((int)uw_, (int)hq[i][c], id_, false); } \
                const float d_ = wave_sum_dpp((float)id_) * (hscale * usc[S]); \
                const float g_ = __uint_as_float((unsigned)__builtin_amdgcn_readlane((int)__float_as_uint((k) < 64 ? gA : gB), (k) & 63)); \
                const float cf_ = g_ * gelu_as(d_) * vsc[S]; csum += cf_; \
                if ((k) < 64) cA = lane == ((k) & 63) ? cf_ : cA; else cB = lane == ((k) & 63) ? cf_ : cB; } while (0)
            PU_LOAD(0, 0); PU_LOAD(1, 1); PU_LOAD(2, 2); PU_LOAD(3, 3);
#pragma nounroll
            for (int k = 0; k < 128; k += 4) {
                const int kn = k + 4 < 128 ? k + 4 : 124;
                PU_COEF(0, k + 0); PU_COEF(1, k + 1); PU_COEF(2, k + 2); PU_COEF(3, k + 3);
                PU_LOAD(0, kn + 0); PU_LOAD(1, kn + 1); PU_LOAD(2, kn + 2); PU_LOAD(3, kn + 3);
            }
#undef PU_LOAD
#undef PU_COEF
        }
        float acc[2][16];
#pragma unroll
        for (int i = 0; i < 2; ++i)
#pragma unroll
            for (int e = 0; e < 16; ++e) acc[i][e] = 0.f;
        {
            u32x4 vs[8][2];
#define PV_LOAD(S, k) do { const int e_ = __builtin_amdgcn_readlane((k) < 64 ? eA : eB, (k) & 63) & emask; \
                const unsigned char* vp_ = VQ + (size_t)e_ * DM + lane * 16; vs[S][0] = *(const u32x4*)vp_; vs[S][1] = *(const u32x4*)(vp_ + 1024); } while (0)
#define PV_ACC(S, k) do { const float cf_ = __uint_as_float((unsigned)__builtin_amdgcn_readlane((int)__float_as_uint((k) < 64 ? cA : cB), (k) & 63)); \
                _Pragma("unroll") for (int i = 0; i < 2; ++i) _Pragma("unroll") for (int c = 0; c < 4; ++c) { const unsigned w_ = vs[S][i][c]; \
                    acc[i][4 * c + 0] += cf_ * (float)(w_ & 0xffu); acc[i][4 * c + 1] += cf_ * (float)((w_ >> 8) & 0xffu); \
                    acc[i][4 * c + 2] += cf_ * (float)((w_ >> 16) & 0xffu); acc[i][4 * c + 3] += cf_ * (float)(w_ >> 24); } } while (0)
            PV_LOAD(0, 0); PV_LOAD(1, 1);
#pragma nounroll
            for (int k = 0; k < 128; k += 2) {
                const int kn = k + 2 < 128 ? k + 2 : 126;
                PV_ACC(0, k); PV_ACC(1, k + 1);
                PV_LOAD(0, kn); PV_LOAD(1, kn + 1);
            }
#undef PV_LOAD
#undef PV_ACC
        }
        const float zoff = 128.f * csum;
        float ss = 0.f;
#pragma unroll
        for (int i = 0; i < 2; ++i)
#pragma unroll
            for (int e = 0; e < 16; ++e) { acc[i][e] -= zoff; ss += acc[i][e] * acc[i][e]; }
        const float rstd = rsqrtf(wave_sum(ss) * (1.f / DM) + EPS);
        const int b = m / SEQ;
#pragma unroll
        for (int i = 0; i < 2; ++i)
#pragma unroll
            for (int q = 0; q < 4; ++q) {
                const int c = i * 1024 + lane * 16 + q * 4;
                const f32x4 gt2 = *(const f32x4*)(mod + (size_t)b * 12288 + 10240 + c), gg = *(const f32x4*)(gpo + c);
                float* op = p.out + (size_t)m * DM + c;
                const f32x4 x1 = *(const f32x4*)op;
                const f32x4 y = {acc[i][4 * q], acc[i][4 * q + 1], acc[i][4 * q + 2], acc[i][4 * q + 3]};
                const f32x4 res = x1 + gt2 * (y * rstd * gg);
                if (!dry) *(f32x4*)op = res; else asm volatile("" :: "v"(res));
            }
    }
}


#define LAS __attribute__((address_space(3)))
#define XB_TMO      128
#define XB_XCNT(j)  (256  + 64 * (j))
#define XB_XSUB(j)  (1280 + 64 * (j))
#define XB_XGEN(j)  (2304 + 64 * (j))
#define XB_TOP      3328
#define XB_TOPGEN   3392
#define XCD_BAR_WORDS 3456
#define XB_SPIN_CAP (1u << 18)

__device__ __forceinline__ unsigned xb_ld(unsigned* p)              { return __hip_atomic_load(p, __ATOMIC_RELAXED, __HIP_MEMORY_SCOPE_AGENT); }
__device__ __forceinline__ unsigned xb_add(unsigned* p, unsigned v) { return __hip_atomic_fetch_add(p, v, __ATOMIC_RELAXED, __HIP_MEMORY_SCOPE_AGENT); }
__device__ __forceinline__ unsigned xb_xcc_id() { return (unsigned)__builtin_amdgcn_s_getreg((3 << 11) | 20) & 0xFu; }
#define XB_SPIN(cond, bar) do { unsigned _sp = 0; while (cond) { __builtin_amdgcn_s_sleep(1); \
    if ((++_sp & 255u) == 0u) { if (xb_ld(&(bar)[XB_TMO])) break; if (_sp > XB_SPIN_CAP) { atomicAdd(&(bar)[XB_TMO], 1u); break; } } } } while (0)

struct XcdBarrier {
    unsigned* bar; unsigned x;
    volatile LAS unsigned* st;
};

__device__ __forceinline__ XcdBarrier xcd_barrier_post(unsigned* bar, volatile LAS unsigned* st) {
    XcdBarrier b; b.bar = bar; b.x = xb_xcc_id(); b.st = st;
    if (threadIdx.x == 0) (void)xb_add(&bar[XB_XCNT(b.x)], 1u);
    return b;
}
__device__ __forceinline__ void xcd_barrier_complete(unsigned* bar, unsigned x, unsigned& nloc, unsigned& nx) {
    const unsigned G = gridDim.x * gridDim.y * gridDim.z;
    unsigned sum, cnt, mine, sp = 0u;
    for (;;) {
        sum = 0u; cnt = 0u; mine = 0u;
#pragma unroll
        for (unsigned j = 0; j < 16; ++j) { const unsigned c = xb_ld(&bar[XB_XCNT(j)]); sum += c; cnt += (c > 0u) ? 1u : 0u; mine = (j == x) ? c : mine; }
        if (sum == G) break;
        __builtin_amdgcn_s_sleep(1);
        if ((++sp & 255u) == 0u) { if (xb_ld(&bar[XB_TMO])) break; if (sp > XB_SPIN_CAP) { atomicAdd(&bar[XB_TMO], 1u); break; } }
    }
    nloc = mine > 0u ? mine : 1u; nx = cnt > 0u ? cnt : 1u;
}

__device__ __forceinline__ void xcd_barrier(const XcdBarrier& b) {
    asm volatile("s_waitcnt vmcnt(0)" ::: "memory");
    __syncthreads();
    if (threadIdx.x == 0) {
        unsigned* bar = b.bar;
        __builtin_amdgcn_s_waitcnt(0);
        unsigned nloc = b.st[0], nx = b.st[1];
        if (nloc == 0u) { xcd_barrier_complete(bar, b.x, nloc, nx); b.st[0] = nloc; b.st[1] = nx; }
        const unsigned old = xb_add(&bar[XB_XSUB(b.x)], 1u);
        const unsigned gen = old / nloc;
        if (old + 1u == (gen + 1u) * nloc) {
            __builtin_amdgcn_fence(__ATOMIC_RELEASE, "agent");
            asm volatile("s_waitcnt vmcnt(0)" ::: "memory");
            const unsigned og = xb_add(&bar[XB_TOP], 1u);
            const unsigned tg = og / nx;
            if (og + 1u == (tg + 1u) * nx) xb_add(&bar[XB_TOPGEN], 1u);
            else XB_SPIN(xb_ld(&bar[XB_TOPGEN]) == tg, bar);
            __builtin_amdgcn_fence(__ATOMIC_ACQUIRE, "agent");
            xb_add(&bar[XB_XGEN(b.x)], 1u);
            asm volatile("s_waitcnt vmcnt(0)" ::: "memory");
        } else {
            XB_SPIN(xb_ld(&bar[XB_XGEN(b.x)]) == gen, bar);
            __builtin_amdgcn_fence(__ATOMIC_ACQUIRE, "agent");
            asm volatile("s_waitcnt vmcnt(0)" ::: "memory");
        }
    }
    __syncthreads();
}


__global__ void __launch_bounds__(NTHREADS, 2) mega(Params p) {
    extern __shared__ __attribute__((aligned(16))) unsigned char lds[];
    cg::grid_group grid = cg::this_grid();
    unsigned char* ws = p.ws;
    bf16_t* H = (bf16_t*)(ws + WS_H); bf16_t* PL = (bf16_t*)(ws + WS_PL); bf16_t* PCx = (bf16_t*)(ws + WS_PC);
    const int lo = p.ph_lo, hi = p.ph_hi;
    volatile LAS unsigned* bst = (volatile LAS unsigned*)((LAS unsigned char*)lds + (LDS_BYTES - 64));
    unsigned* barw = (unsigned*)(ws + WS_BAR);
    if (threadIdx.x < 2) bst[threadIdx.x] = 0u;
    if (blockIdx.x == 0) for (int i = threadIdx.x; i < XCD_BAR_WORDS; i += NTHREADS) barw[i] = 0u;
    __syncthreads();
    XcdBarrier xbar; xbar.bar = barw; xbar.x = 0; xbar.st = bst;
#ifdef PHONLY
#define IN(k) ((k) == PHONLY && lo <= (k) && (k) < hi)
#else
#define IN(k) (lo <= (k) && (k) < hi)
#endif
#ifndef DUP
#define DUP -1
#endif
#define REP(k) for (int rep_ = 0; rep_ < ((k) == DUP ? 2 : 1); ++rep_)
#define SEAM(k) do { if (IN(k) && IN((k) + 1)) { \
        if ((k) == 0) { asm volatile("s_waitcnt vmcnt(0) lgkmcnt(0)" ::: "memory"); grid.sync(); \
            if (threadIdx.x < 64) { __builtin_amdgcn_fence(__ATOMIC_ACQUIRE, "agent"); asm volatile("s_waitcnt vmcnt(0)" ::: "memory"); } __syncthreads(); \
            xbar = xcd_barrier_post(barw, bst); } \
        else xcd_barrier(xbar); } } while (0)
    if (IN(0)) { phase0(p, lds); __syncthreads(); if (DUP == 0) { phase0(p, lds); __syncthreads(); } }
    SEAM(0);
    if (IN(1)) REP(1) phase1(p);
    SEAM(1);
    if (IN(2)) REP(2) {
        { EpiInproj e{PL, NP, PC_GA}; run_gemm<EpiInproj, false>(lds, H, DM, (const bf16_t*)(ws + WS_WIN), DM, TL, NP, DM, e); }
        { EpiInproj e{PCx, NPC, 1 << 30}; run_gemm<EpiInproj, false>(lds, H + (size_t)TL * DM, DM, (const bf16_t*)(ws + WS_WIN), DM, TC, NPC, DM, e, 128); }
    }
    SEAM(2);
    if (IN(3)) {
#ifndef NO_P3_GEMM
        { EpiMlaQ e{(bf16_t*)(ws + WS_QM), (const float*)(ws + WS_ROPE)}; run_gemm<EpiMlaQ, true>(lds, PL + PC_CQ, NP, (const bf16_t*)(ws + WS_WQB), QR, TL, MQW, QR, e); }
        { EpiMlaKV e{(bf16_t*)(ws + WS_KVM), 0}; run_gemm<EpiMlaKV, true>(lds, PL + PC_CKV, NP, (const bf16_t*)(ws + WS_WKVB), KVR, TL, MKVW, KVR, e); }
        { EpiMlaKV e{(bf16_t*)(ws + WS_KVM), TL}; run_gemm<EpiMlaKV, true>(lds, PCx + PC_CKV, NPC, (const bf16_t*)(ws + WS_WKVB), KVR, TC, MKVW, KVR, e, 128); __syncthreads(); }
        if (DUP == 31) {
        { EpiMlaQ e{(bf16_t*)(ws + WS_QM), (const float*)(ws + WS_ROPE)}; run_gemm<EpiMlaQ, true>(lds, PL + PC_CQ, NP, (const bf16_t*)(ws + WS_WQB), QR, TL, MQW, QR, e); }
        { EpiMlaKV e{(bf16_t*)(ws + WS_KVM), 0}; run_gemm<EpiMlaKV, true>(lds, PL + PC_CKV, NP, (const bf16_t*)(ws + WS_WKVB), KVR, TL, MKVW, KVR, e); }
        { EpiMlaKV e{(bf16_t*)(ws + WS_KVM), TL}; run_gemm<EpiMlaKV, true>(lds, PCx + PC_CKV, NPC, (const bf16_t*)(ws + WS_WKVB), KVR, TC, MKVW, KVR, e, 128); __syncthreads(); }
        }
#endif
        kpe_pass(p);
#ifdef NA_NAIVE
        na_naive(p, lds);
#else
#ifdef NA_PERWAVE
        na_flash(p, lds);
        if (DUP == 30) na_flash(p, lds);
#else
        na_coop(p, lds);
        if (DUP == 30) na_coop(p, lds);
#endif
#endif
    }
    SEAM(3);
#ifdef MLA_NAIVE
    if (IN(4)) mla_naive(p, lds);
#else
    if (IN(4)) REP(4) mla_flash2(p, lds);
#endif
    SEAM(4);
    if (IN(5)) REP(5) {
        { EpiMergeF e{H, PL}; run_gemm<EpiMergeF, false>(lds, (const bf16_t*)(ws + WS_OA), DM, (const bf16_t*)(ws + WS_WA), DM, TL, DM, DM, e); }
    }
    SEAM(5);
    if (IN(6)) REP(6) { EpiStore e{(bf16_t*)(ws + WS_Z), DM}; run_gemm<EpiStore, false>(lds, H, DM, (const bf16_t*)(ws + WS_WO), DM, TL, DM, DM, e); }
    SEAM(6);
    if (IN(7)) REP(7) phase7(p);
    SEAM(7);
    if (IN(8)) REP(8) { EpiStore e{(bf16_t*)(ws + WS_QP), DM}; run_gemm<EpiStore, false>(lds, H, DM, (const bf16_t*)(ws + WS_WPQ), DM, TL, DM, DM, e); }
    SEAM(8);
    if (IN(9)) REP(9) {
#if defined(TOPK_NAIVE)
        peer_topk_naive(p, lds);
#elif defined(TOPK_STAGE1)
        peer_topk_mfma(p, lds);
#else
        peer_select_mfma(p, lds);
        if (DUP == 90) peer_select_mfma(p, lds, 1);
        if (DUP == 91) peer_select_mfma(p, lds, 2);
#endif
#ifdef PEER_BF16
        peer_tables_bf16(p);
#endif
    }
    SEAM(9);
#ifdef PEER_NAIVE
    if (IN(10)) peer_final_naive(p, lds);
#else
#ifdef PEER_BF16
    if (IN(10)) { if (DUP == 10) peer_gather(p, true); peer_gather(p); }
#else
    if (IN(10)) { if (DUP == 10) peer_gather_q8(p, lds, true); if (DUP == 100) peer_gather_q8(p, lds, true, 1023); if (DUP == 101) peer_gather_q8(p, lds, true, 127); peer_gather_q8(p, lds); }
#endif
#endif
#undef IN
#undef SEAM
}

extern "C" void kernel_launch(void* const* d_in, const int* in_sizes, int n_in, void* d_out, int out_size, void* d_ws, size_t ws_size, hipStream_t stream) {
    static int grid = 0;
    if (grid == 0) {
        int dev = 0, cus = 0, per_cu = 0;
        (void)hipGetDevice(&dev);
        (void)hipDeviceGetAttribute(&cus, hipDeviceAttributeMultiprocessorCount, dev);
        (void)hipFuncSetAttribute((const void*)mega, hipFuncAttributeMaxDynamicSharedMemorySize, LDS_BYTES);
        (void)hipOccupancyMaxActiveBlocksPerMultiprocessor(&per_cu, (const void*)mega, NTHREADS, LDS_BYTES);
        if (per_cu < 1) { fprintf(stderr, "occupancy query says %d blocks per CU\n", per_cu); per_cu = 1; }
        grid = cus * 1;
        (void)hipGetLastError();
        if (n_in != 23 || ws_size < WS_END) fprintf(stderr, "kernel_launch: unexpected n_in %d or ws %zu\n", n_in, ws_size);
    }
    Params p{};
    for (int i = 0; i < 23; ++i) p.in[i] = (const float*)d_in[i];
    p.out = (float*)d_out; p.ws = (unsigned char*)d_ws; p.ph_lo = 0; p.ph_hi = 11;
    void* args[] = {&p};
    hipError_t e = hipLaunchCooperativeKernel((const void*)mega, dim3(grid), dim3(NTHREADS), args, LDS_BYTES, stream);
    if (e != hipSuccess) fprintf(stderr, "cooperative launch failed: %s (grid %d)\n", hipGetErrorString(e), grid);
}
```

```cpp
#define SEL_SPLIT 1
#include <hip/hip_runtime.h>
#include <hip/hip_cooperative_groups.h>
#include <cstdio>
#include <cstdint>
namespace cg = cooperative_groups;
#ifndef INPROJ_I8
#define INPROJ_I8 2
#endif
#ifndef PEERQ_I8
#define PEERQ_I8 1
#endif

typedef unsigned short bf16_t;
typedef short bf16x8 __attribute__((ext_vector_type(8)));
typedef float f32x4 __attribute__((ext_vector_type(4)));
typedef unsigned u32x4 __attribute__((ext_vector_type(4)));
typedef unsigned u32x2 __attribute__((ext_vector_type(2)));

constexpr int DM = 2048, NB = 8, SEQ = 2048, CTX = 256, GW = 64, GROWS = 32;
constexpr int TL = NB * SEQ;
constexpr int TC = NB * CTX;
constexpr int TA = TL + TC;
constexpr int IN_COLS = 8512;
constexpr int NP = 8704;
constexpr int NPC = 2816;
constexpr int PC_KA = 0, PC_VA = 1024, PC_CKV = 2048, PC_KPE = 2560, PC_QA = 2816, PC_CQ = 3840, PC_GA = 4608, PC_GB = 6656;
constexpr int QR = 768, KVR = 512;
constexpr int MQW = 1536, MKVW = 2048;
constexpr float EPS = 1e-6f;
constexpr float LOG2E = 1.4426950408889634f;
constexpr float MLA_QSCALE = 0.07216878364870322f * LOG2E;
constexpr float NA_SCALE = 0.125f;

constexpr size_t al256(size_t x) { return (x + 255) & ~(size_t)255; }
constexpr size_t WS_MOD = 0;
constexpr size_t WS_ROPE = al256(WS_MOD + 9 * 12288 * 4);
constexpr size_t WS_BAR = al256(WS_ROPE + (size_t)SEQ * 32 * 2 * 4);
constexpr size_t WS_WIN = al256(WS_BAR + 3456 * 4);
constexpr size_t WS_WQB = WS_WIN + (size_t)NP * DM * 2;
constexpr size_t WS_WKVB = WS_WQB + (size_t)MQW * QR * 2;
constexpr size_t WS_WA = WS_WKVB + (size_t)MKVW * KVR * 2;
constexpr size_t WS_WB = WS_WA + (size_t)DM * 1024 * 2;
constexpr size_t WS_WO = WS_WB + (size_t)DM * 1024 * 2;
constexpr size_t WS_WPQ = WS_WO + (size_t)DM * DM * 2;
constexpr size_t WS_SUBK = WS_WPQ + (size_t)DM * DM * 2;
constexpr size_t WS_H = WS_SUBK + (size_t)262144 * 2;
constexpr size_t WS_PL = WS_H + (size_t)TA * DM * 2;
constexpr size_t WS_PC = WS_PL + (size_t)TL * NP * 2;
constexpr size_t WS_QM = WS_PC + (size_t)TC * NPC * 2;
constexpr size_t WS_KVM = WS_QM + (size_t)TL * MQW * 2;
constexpr size_t WS_KPE = WS_KVM + (size_t)TA * MKVW * 2;
constexpr size_t WS_OA = WS_KPE + (size_t)TA * 64 * 2;
constexpr size_t WS_OB = WS_OA + 1024 * 2;
constexpr size_t WS_END = WS_OA + (size_t)TL * 2048 * 2;
constexpr size_t WS_Z = WS_PL;
constexpr size_t WS_QP = WS_PL + (size_t)TL * DM * 2;
constexpr size_t WS_TKV = WS_QP + (size_t)TL * DM * 2;
constexpr size_t WS_TKI = WS_TKV + (size_t)TL * 256 * 4;
constexpr size_t WS_H8G = WS_QM;
constexpr size_t WS_HSG = WS_H8G + (size_t)TA * DM;
constexpr size_t WS_WG8 = WS_KVM;
constexpr size_t WS_WGS = WS_WG8 + (size_t)NP * DM;
static_assert(WS_HSG + (size_t)TA * 4 <= WS_KVM && WS_WGS + (size_t)NP * 4 <= WS_KPE, "int8 in-projection operands");
constexpr size_t WS_H8P = WS_H;
constexpr size_t WS_HSP = WS_H8P + (size_t)TL * DM;
constexpr size_t WS_UB = WS_QM;
constexpr size_t WS_VB = WS_UB + (size_t)16384 * DM * 2;
constexpr size_t WS_UQ = WS_QM;
constexpr size_t WS_VQ = WS_UQ + (size_t)16384 * DM;
constexpr size_t WS_USC = WS_VQ + (size_t)16384 * DM;
constexpr size_t WS_VSC = WS_USC + 16384 * 4;
constexpr size_t WS_URS = WS_VSC + 16384 * 4;
static_assert(WS_URS + 16384 * 4 <= WS_END, "URS");
static_assert(WS_TKI + (size_t)TL * 256 * 4 <= WS_PC, "overlay");
constexpr size_t WS_GTG = al256(WS_END);
constexpr size_t WS_END2 = WS_GTG + 8 * 2048 * 4;
static_assert(WS_END2 <= 650307648ull, "workspace");
static_assert(WS_VB + (size_t)16384 * DM * 2 <= WS_END, "expert table overlay");

constexpr int NTHREADS = 512, NWAVES = 8;
constexpr int LDS_BYTES = 157824;

struct Params {
    const float* in[23];
    float* out;
    unsigned char* ws;
    int ph_lo, ph_hi;
};

__device__ __forceinline__ float bf2f(bf16_t v) { return __uint_as_float((unsigned)v << 16); }
__device__ __forceinline__ unsigned f2bf(float f) { unsigned u = __float_as_uint(f); return (u + 0x7fffu + ((u >> 16) & 1u)) >> 16; }
typedef float pk_f32x2 __attribute__((ext_vector_type(2)));
typedef __bf16 pk_bf16x2 __attribute__((ext_vector_type(2)));
__device__ __forceinline__ unsigned pk2(float lo, float hi) { pk_f32x2 v = {lo, hi}; pk_bf16x2 b = __builtin_convertvector(v, pk_bf16x2); return __builtin_bit_cast(unsigned, b); }
__device__ __forceinline__ float wave_sum(float v) {
#pragma unroll
    for (int o = 1; o < 64; o <<= 1) v += __shfl_xor(v, o);
    return v;
}
__device__ __forceinline__ float wave_sum_dpp(float v) {
    v += __builtin_bit_cast(float, __builtin_amdgcn_update_dpp(0, __builtin_bit_cast(int, v), 0xB1, 0xF, 0xF, false));
    v += __builtin_bit_cast(float, __builtin_amdgcn_update_dpp(0, __builtin_bit_cast(int, v), 0x4E, 0xF, 0xF, false));
    v += __builtin_bit_cast(float, __builtin_amdgcn_update_dpp(0, __builtin_bit_cast(int, v), 0x141, 0xF, 0xF, false));
    v += __builtin_bit_cast(float, __builtin_amdgcn_update_dpp(0, __builtin_bit_cast(int, v), 0x140, 0xF, 0xF, false));
    v += __builtin_bit_cast(float, __builtin_amdgcn_update_dpp(0, __builtin_bit_cast(int, v), 0x142, 0xA, 0xF, false));
    v += __builtin_bit_cast(float, __builtin_amdgcn_update_dpp(0, __builtin_bit_cast(int, v), 0x143, 0xC, 0xF, false));
    return __builtin_bit_cast(float, __builtin_amdgcn_readlane(__builtin_bit_cast(int, v), 63));
}
__device__ __forceinline__ float wave_max(float v) {
#pragma unroll
    for (int o = 1; o < 64; o <<= 1) v = fmaxf(v, __shfl_xor(v, o));
    return v;
}
__device__ __forceinline__ float sigmoidf_(float x) { return __builtin_amdgcn_rcpf(1.f + __expf(-x)); }
__device__ __forceinline__ float silu_(float x) { return x / (1.f + __expf(-x)); }
__device__ __forceinline__ float gelu_erf(float x) { return 0.5f * x * (1.f + erff(x * 0.70710678118654752f)); }

__device__ __forceinline__ float gelu_as(float v) {
    const float t = __builtin_amdgcn_rcpf(fabsf(v) * 0.2316418882f + 1.0f);
    float q = t * 0.5307027145f + (-0.7265760135f); q = q * t + 0.7107068705f; q = q * t + (-0.142248368f); q = q * t + 0.127414796f; q = q * t;
    const float e = __builtin_amdgcn_exp2f((v * v) * (-0.72134752044f));
    const float mm = v * (q * e);
    return v < 0.f ? mm : v - mm;
}
__device__ __forceinline__ void rope_cs(int s, int j, float& c, float& sn) {
    const int gr = s >> 6, gc = s & 63;
    const int i = j & 15;
    const float invf = exp2f(-(float)i * (13.287712379549449f / 16.f));
    const float ang = (float)(j < 16 ? gr : gc) * invf;
    sincosf(ang, &sn, &c);
}

template <class Epi>
__device__ __forceinline__ void ngemm(const bf16_t* __restrict__ A, int lda, const bf16_t* __restrict__ Bt, int ldb, int M, int N, int K, const Epi& epi, float* rs = nullptr) {
    int tid_ = threadIdx.x; asm volatile("" : "+v"(tid_)); const int tid = tid_, wid = tid >> 6, lane = tid & 63, fr = lane & 15, fq = lane >> 4;
    const int tilesM = M / 128, tilesN = N / 256, nt = tilesM * tilesN;
    for (int t = blockIdx.x; t < nt; t += gridDim.x) {
        const int tm = t % tilesM, tn = t / tilesM;
        const int row0 = tm * 128 + (wid >> 2) * 64, col0 = tn * 256 + (wid & 3) * 64;
        if (Epi::PRO) {
            __syncthreads();
            const int r = tid >> 2, part = tid & 3, len = K >> 2;
            const bf16_t* ar = A + (size_t)(tm * 128 + r) * lda + part * len;
            float ss = 0.f;
            for (int k = 0; k < len; k += 8) { const bf16x8 v = *(const bf16x8*)(ar + k);
#pragma unroll
                for (int e = 0; e < 8; ++e) { const float f = bf2f((bf16_t)v[e]); ss += f * f; } }
            ss += __shfl_xor(ss, 1); ss += __shfl_xor(ss, 2);
            if (part == 0) rs[r] = rsqrtf(ss / (float)K + EPS);
            __syncthreads();
        }
        f32x4 acc[4][4];
#pragma unroll
        for (int i = 0; i < 4; ++i)
#pragma unroll
            for (int j = 0; j < 4; ++j) acc[i][j] = (f32x4){0.f, 0.f, 0.f, 0.f};
        const bf16_t* ap = A + (size_t)(row0 + fr) * lda + fq * 8;
        const bf16_t* bp = Bt + (size_t)(col0 + fr) * ldb + fq * 8;
        for (int k0 = 0; k0 < K; k0 += 32) {
            bf16x8 a[4], b[4];
#pragma unroll
            for (int i = 0; i < 4; ++i) a[i] = *(const bf16x8*)(ap + (size_t)i * 16 * lda + k0);
#pragma unroll
            for (int j = 0; j < 4; ++j) b[j] = *(const bf16x8*)(bp + (size_t)j * 16 * ldb + k0);
#pragma unroll
            for (int i = 0; i < 4; ++i)
#pragma unroll
                for (int j = 0; j < 4; ++j) acc[i][j] = __builtin_amdgcn_mfma_f32_16x16x32_bf16(b[j], a[i], acc[i][j], 0, 0, 0);
        }
#pragma unroll
        for (int i = 0; i < 4; ++i) {
            const int row = row0 + i * 16 + fr;
            const float rstd = Epi::PRO ? rs[row - tm * 128] : 1.f;
#pragma unroll
            for (int j = 0; j < 4; ++j) epi.quad(row, col0 + j * 16 + 4 * fq, acc[i][j] * rstd);
        }
    }
}

__device__ __forceinline__ void store_bf4(bf16_t* p, f32x4 v) { u32x2 w; w.x = pk2(v[0], v[1]); w.y = pk2(v[2], v[3]); *(u32x2*)p = w; }
__device__ __forceinline__ void store_bf8(bf16_t* p, f32x4 a, f32x4 b) { u32x4 w; w.x = pk2(a[0], a[1]); w.y = pk2(a[2], a[3]); w.z = pk2(b[0], b[1]); w.w = pk2(b[2], b[3]); *(u32x4*)p = w; }
__device__ __forceinline__ void load_bf8(const bf16_t* p, f32x4& a, f32x4& b) { const u32x4 g = *(const u32x4*)p;
    a = (f32x4){__uint_as_float(g.x << 16), __uint_as_float(g.x & 0xffff0000u), __uint_as_float(g.y << 16), __uint_as_float(g.y & 0xffff0000u)};
    b = (f32x4){__uint_as_float(g.z << 16), __uint_as_float(g.z & 0xffff0000u), __uint_as_float(g.w << 16), __uint_as_float(g.w & 0xffff0000u)}; }

struct EpiInproj {
    static constexpr bool MID = false, PRO = false;
    bf16_t* P; int ldp; int gate0;
    __device__ __forceinline__ void quad(int row, int col, f32x4 v) const {
        if (col >= gate0) { v[0] = sigmoidf_(v[0]); v[1] = sigmoidf_(v[1]); v[2] = sigmoidf_(v[2]); v[3] = sigmoidf_(v[3]); }
        store_bf4(P + (size_t)row * ldp + col, v);
    }
    __device__ __forceinline__ void oct(int row, int col, f32x4 a, f32x4 b) const {
        if (col >= gate0) {
#pragma unroll
            for (int e = 0; e < 4; ++e) { a[e] = sigmoidf_(a[e]); b[e] = sigmoidf_(b[e]); } }
        store_bf8(P + (size_t)row * ldp + col, a, b);
    }
};
struct EpiMlaQ {
    static constexpr bool MID = false, PRO = true;
    bf16_t* Q; const float* rope;
    __device__ __forceinline__ void quad(int row, int col, f32x4 v) const {
        v = v * MLA_QSCALE;
        const int d = col % 192;
        if (d >= 128) {
            const int j = (d - 128) >> 1, s = row & (SEQ - 1);
            const f32x4 cs = *(const f32x4*)(rope + ((size_t)s * 32 + j) * 2);
            const f32x4 o = {v[0] * cs[0] - v[1] * cs[1], v[0] * cs[1] + v[1] * cs[0], v[2] * cs[2] - v[3] * cs[3], v[2] * cs[3] + v[3] * cs[2]};
            v = o;
        }
        store_bf4(Q + (size_t)row * MQW + col, v);
    }
    __device__ __forceinline__ void oct(int row, int col, f32x4 a, f32x4 b) const {
        a = a * MLA_QSCALE; b = b * MLA_QSCALE;
        const int d = col % 192;
        if (d >= 128) {
            const int j = (d - 128) >> 1, s = row & (SEQ - 1);
            const f32x4 c0 = *(const f32x4*)(rope + ((size_t)s * 32 + j) * 2), c1 = *(const f32x4*)(rope + ((size_t)s * 32 + j + 2) * 2);
            const f32x4 oa = {a[0] * c0[0] - a[1] * c0[1], a[0] * c0[1] + a[1] * c0[0], a[2] * c0[2] - a[3] * c0[3], a[2] * c0[3] + a[3] * c0[2]};
            const f32x4 ob = {b[0] * c1[0] - b[1] * c1[1], b[0] * c1[1] + b[1] * c1[0], b[2] * c1[2] - b[3] * c1[3], b[2] * c1[3] + b[3] * c1[2]};
            a = oa; b = ob;
        }
        store_bf8(Q + (size_t)row * MQW + col, a, b);
    }
};
struct EpiMlaKV {
    static constexpr bool MID = false, PRO = true;
    bf16_t* KV; int row_off;
    __device__ __forceinline__ void quad(int row, int col, f32x4 v) const { store_bf4(KV + (size_t)(row_off + row) * MKVW + col, v); }
    __device__ __forceinline__ void oct(int row, int col, f32x4 a, f32x4 b) const { store_bf8(KV + (size_t)(row_off + row) * MKVW + col, a, b); }
};
template <int STEP> struct EpiMerge {
    static constexpr bool MID = false, PRO = false;
    bf16_t* Y; const bf16_t* P;
    __device__ __forceinline__ void quad(int row, int col, f32x4 v) const {
        const u32x2 g = *(const u32x2*)(P + (size_t)row * NP + (STEP == 0 ? PC_GA : PC_GB) + col);
        const f32x4 gv = {__uint_as_float(g.x << 16), __uint_as_float(g.x & 0xffff0000u), __uint_as_float(g.y << 16), __uint_as_float(g.y & 0xffff0000u)};
        v = v * gv;
        if (STEP == 1) {
            const u32x2 y = *(const u32x2*)(Y + (size_t)row * DM + col);
            v[0] += __uint_as_float(y.x << 16); v[1] += __uint_as_float(y.x & 0xffff0000u); v[2] += __uint_as_float(y.y << 16); v[3] += __uint_as_float(y.y & 0xffff0000u);
        }
        store_bf4(Y + (size_t)row * DM + col, v);
    }
};
struct EpiMergeF {
    static constexpr bool MID = true, PRO = false;
    bf16_t* Y; const bf16_t* P;
    __device__ __forceinline__ static f32x4 ld4(const bf16_t* q) { const u32x2 g = *(const u32x2*)q;
        return (f32x4){__uint_as_float(g.x << 16), __uint_as_float(g.x & 0xffff0000u), __uint_as_float(g.y << 16), __uint_as_float(g.y & 0xffff0000u)}; }
    __device__ __forceinline__ void midquad(int row, int col, f32x4& v) const {
        const f32x4 ga = ld4(P + (size_t)row * NP + PC_GA + col), gb = ld4(P + (size_t)row * NP + PC_GB + col);
#pragma unroll
        for (int e = 0; e < 4; ++e) v[e] *= ga[e] * __builtin_amdgcn_rcpf(fmaxf(gb[e], 1e-30f));
    }
    __device__ __forceinline__ void quad(int row, int col, f32x4 v) const { store_bf4(Y + (size_t)row * DM + col, v * ld4(P + (size_t)row * NP + PC_GB + col)); }
    __device__ __forceinline__ void midload(int row, int col, u32x4& ga, u32x4& gb) const { ga = *(const u32x4*)(P + (size_t)row * NP + PC_GA + col); gb = *(const u32x4*)(P + (size_t)row * NP + PC_GB + col); }
    __device__ __forceinline__ static void midapply(const u32x4 ga, const u32x4 gb, f32x4& a, f32x4& b) {
        const unsigned a0 = ga[0], a1 = ga[1], a2 = ga[2], a3 = ga[3], b0 = gb[0], b1 = gb[1], b2 = gb[2], b3 = gb[3];
        const f32x4 sa0 = {__uint_as_float(a0 << 16), __uint_as_float(a0 & 0xffff0000u), __uint_as_float(a1 << 16), __uint_as_float(a1 & 0xffff0000u)};
        const f32x4 sa1 = {__uint_as_float(a2 << 16), __uint_as_float(a2 & 0xffff0000u), __uint_as_float(a3 << 16), __uint_as_float(a3 & 0xffff0000u)};
        const f32x4 sb0 = {__uint_as_float(b0 << 16), __uint_as_float(b0 & 0xffff0000u), __uint_as_float(b1 << 16), __uint_as_float(b1 & 0xffff0000u)};
        const f32x4 sb1 = {__uint_as_float(b2 << 16), __uint_as_float(b2 & 0xffff0000u), __uint_as_float(b3 << 16), __uint_as_float(b3 & 0xffff0000u)};
#pragma unroll
        for (int e = 0; e < 4; ++e) { a[e] *= sa0[e] * __builtin_amdgcn_rcpf(fmaxf(sb0[e], 1e-30f)); b[e] *= sa1[e] * __builtin_amdgcn_rcpf(fmaxf(sb1[e], 1e-30f)); }
    }
    __device__ __forceinline__ void oct(int row, int col, f32x4 a, f32x4 b) const { f32x4 g0, g1; load_bf8(P + (size_t)row * NP + PC_GB + col, g0, g1); store_bf8(Y + (size_t)row * DM + col, a * g0, b * g1); }
};
struct EpiStore {
    static constexpr bool MID = false, PRO = false;
    bf16_t* O; int ldo;
    __device__ __forceinline__ void quad(int row, int col, f32x4 v) const { store_bf4(O + (size_t)row * ldo + col, v); }
    __device__ __forceinline__ void oct(int row, int col, f32x4 a, f32x4 b) const { store_bf8(O + (size_t)row * ldo + col, a, b); }
};

namespace pg8 {
#define PG8_LAS __attribute__((address_space(3)))
constexpr int BM = 256, BK = 64, HALF = 128, HTB = HALF * BK * 2  , STAGE_BYTES = 8 * HTB, NXCD = 8, WGM = 4;

__host__ __device__ __forceinline__ int lds_byte(int r, int c) { const int st = (r >> 4) * 2 + (c >> 5), rr = r & 15, cc = c & 31, ob = rr * 64 + cc * 2; return st * 1024 + (ob ^ (((ob >> 9) & 1) << 5)); }
__host__ __device__ __forceinline__ void stage_rc(int b, int& R, int& C) { const int st = b / 1024, sb = b % 1024, swz = sb ^ (((sb >> 9) & 1) << 5); R = (st >> 1) * 16 + swz / 64; C = (st & 1) * 32 + (swz % 64) / 2; }
__host__ __device__ __forceinline__ int perm32(int rho) { const int n = rho >> 4, i = rho & 15; return 8 * (i >> 2) + 4 * n + (i & 3); }

typedef int i32x4_t __attribute__((ext_vector_type(4)));
struct Unit { int pm, pn, ui; };
struct Gemm { const bf16_t* A; const bf16_t* Bt; int M, N, K, lda, ldb; };

struct StaticOrder {
    int nM, nN, nwg, G, c;
    __host__ __device__ void init(int M, int N, int G_, int c_) { nM = M / BM; nN = N / BM; nwg = nM * nN; G = G_; c = c_; }
    __host__ __device__ bool next(int i, Unit& u) const {
        const long L = (long)i * G + c; if (L >= nwg) return false;
        int wgid = (int)L; { const int q = nwg / NXCD, r = nwg % NXCD, xcd = wgid % NXCD, off = wgid / NXCD; wgid = (xcd < r ? xcd * (q + 1) : r * (q + 1) + (xcd - r) * q) + off; }
        const int nig = WGM * nN, gid = wgid / nig, fm = gid * WGM, gsz = (nM - fm) < WGM ? (nM - fm) : WGM;
        u.pm = fm + ((wgid % nig) % gsz); u.pn = (wgid % nig) / gsz; u.ui = i; return true;
    }
    __device__ __forceinline__ void a_ready(const Unit&) const {}
    __device__ __forceinline__ void done(const Unit&) const {}
};
template <class Epi, class Sched, bool ALIGN_EPI = false, bool SP2 = false>
__device__ __forceinline__ void gemm_phase(PG8_LAS unsigned char* lds, const Gemm g, const Sched& S, const Epi& E) {
    int tid_ = threadIdx.x; asm volatile("" : "+v"(tid_)); const int tid = tid_, wid = __builtin_amdgcn_readfirstlane(tid >> 6), lane = tid & 63, wr = wid >> 2, wc = wid & 3, fr = lane & 15, fq = lane >> 4;
    const int K = g.K, nt = K / BK;
    unsigned voffA[2], voffB[2];
#pragma unroll
    for (int i = 0; i < 2; ++i) { int R, C; stage_rc(tid * 16 + i * 8192, R, C); const int Rb = Epi::PERM ? ((R & ~31) + perm32(R & 31)) : R;
        voffA[i] = (unsigned)(R * g.lda + C) * 2u; voffB[i] = (unsigned)(Rb * g.ldb + C) * 2u; }
    const size_t kstep = (size_t)(BK * 2);
    const size_t hstepA = (size_t)HALF * g.lda * 2, hstepB = (size_t)HALF * g.ldb * 2;
    const size_t tstepA = 2 * hstepA, tstepB = 2 * hstepB;
    const unsigned ldsw = (unsigned)wid * 1024u;
    const int aoff = lds_byte(wr * 64 + fr, fq * 8), boff = lds_byte(wc * 32 + fr, fq * 8);
#define PG8_SA(b, h) (((b) * 2 + (h)) * HTB)
#define PG8_SB(b, h) ((4 + (b) * 2 + (h)) * HTB)
#define PG8_STAGE(bufoff, gbase, voff) do { _Pragma("unroll") for (int _i = 0; _i < 2; ++_i) \
        __builtin_amdgcn_global_load_lds((const unsigned*)((const char*)(gbase) + (voff)[_i]), (PG8_LAS unsigned*)(lds + (bufoff) + ldsw + _i * 8192), 16, 0, 0); } while (0)
#define PG8_LDA(dst, b, h) do { _Pragma("unroll") for (int m = 0; m < 4; ++m) _Pragma("unroll") for (int k = 0; k < 2; ++k) dst[m][k] = *(const PG8_LAS bf16x8*)(lds + PG8_SA(b, h) + aoff + m * 2048 + k * 1024); } while (0)
#define PG8_LDB(dst, b, h) do { _Pragma("unroll") for (int n = 0; n < 2; ++n) _Pragma("unroll") for (int k = 0; k < 2; ++k) dst[n][k] = *(const PG8_LAS bf16x8*)(lds + PG8_SB(b, h) + boff + n * 2048 + k * 1024); } while (0)
#define PG8_MMA(ai, bj, At, Bt) do { __builtin_amdgcn_s_setprio(1); _Pragma("unroll") for (int m = 0; m < 4; ++m) _Pragma("unroll") for (int n = 0; n < 2; ++n) _Pragma("unroll") for (int k = 0; k < 2; ++k) \
        { if constexpr (Epi::I8) acc[ai][bj][m][n] = __builtin_bit_cast(f32x4, __builtin_amdgcn_mfma_i32_16x16x64_i8(__builtin_bit_cast(i32x4_t, Bt[n][k]), __builtin_bit_cast(i32x4_t, At[m][k]), __builtin_bit_cast(i32x4_t, acc[ai][bj][m][n]), 0, 0, 0)); \
          else acc[ai][bj][m][n] = __builtin_amdgcn_mfma_f32_16x16x32_bf16(Bt[n][k], At[m][k], acc[ai][bj][m][n], 0, 0, 0); } __builtin_amdgcn_s_setprio(0); } while (0)
#define PG8_WAIT_V(n) asm volatile("s_waitcnt vmcnt(" #n ")" ::: "memory")
#define PG8_WAIT_L(n) asm volatile("s_waitcnt lgkmcnt(" #n ")" ::: "memory")
#define PG8_BAR __builtin_amdgcn_s_barrier()
#define PG8_SCHED __builtin_amdgcn_sched_barrier(0)
    Unit cur, nxt; int ui = 0;
    if (!S.next(0, cur)) return;
    f32x4 acc[2][2][4][2];
#pragma unroll
    for (int a = 0; a < 2; ++a)
#pragma unroll
        for (int b = 0; b < 2; ++b)
#pragma unroll
            for (int m = 0; m < 4; ++m)
#pragma unroll
                for (int n = 0; n < 2; ++n) acc[a][b][m][n] = (f32x4){0.f, 0.f, 0.f, 0.f};
    bf16x8 At[4][2], B0[2][2], B1[2][2];
    const char* cA = (const char*)g.A + (size_t)cur.pm * tstepA; const char* cB = (const char*)g.Bt + (size_t)cur.pn * tstepB;
    S.a_ready(cur);
    if constexpr (SP2) {
        PG8_STAGE(PG8_SB(0, 0), cB, voffB); PG8_STAGE(PG8_SB(0, 1), cB + hstepB, voffB); PG8_STAGE(PG8_SA(0, 0), cA, voffA); PG8_STAGE(PG8_SA(0, 1), cA + hstepA, voffA);
        if (wr == 1) PG8_BAR;
        PG8_WAIT_V(2); PG8_BAR;
        PG8_STAGE(PG8_SB(1, 0), cB + kstep, voffB); PG8_STAGE(PG8_SA(1, 0), cA + kstep, voffA); PG8_STAGE(PG8_SB(1, 1), cB + hstepB + kstep, voffB);
        PG8_WAIT_V(6); PG8_BAR;
    } else {
        PG8_STAGE(PG8_SB(0, 0), cB, voffB); PG8_STAGE(PG8_SA(0, 0), cA, voffA); PG8_STAGE(PG8_SB(0, 1), cB + hstepB, voffB); PG8_STAGE(PG8_SA(0, 1), cA + hstepA, voffA);
        if (wr == 1) PG8_BAR;
        PG8_WAIT_V(4); PG8_BAR;
        PG8_STAGE(PG8_SB(1, 0), cB + kstep, voffB); PG8_STAGE(PG8_SA(1, 0), cA + kstep, voffA); PG8_STAGE(PG8_SB(1, 1), cB + hstepB + kstep, voffB);
        PG8_WAIT_V(6); PG8_BAR;
    }
    for (;;) {
        const bool has_next = S.next(ui + 1, nxt);
        const char* nA = has_next ? (const char*)g.A + (size_t)nxt.pm * tstepA : cA; const char* nB = has_next ? (const char*)g.Bt + (size_t)nxt.pn * tstepB : cB;
        for (int t = 0; t < nt; t += 2) {
            if constexpr (Epi::MID) { if (t == (nt >> 1)) { E.mid(acc, cur, wr, wc, fr, fq); } }
            const bool last = (t == nt - 2);
            const char* a1 = cA + (size_t)(t + 1) * kstep;
            const char* a2 = last ? nA : cA + (size_t)(t + 2) * kstep; const char* b2 = last ? nB : cB + (size_t)(t + 2) * kstep;
            const char* a3 = a2 + kstep; const char* b3 = b2 + kstep;
            if (last && has_next) S.a_ready(nxt);
            if constexpr (SP2) {
            PG8_LDB(B0, 0, 0); PG8_LDB(B1, 0, 1); PG8_SCHED; PG8_LDA(At, 0, 0); PG8_STAGE(PG8_SA(1, 1), a1 + hstepA, voffA);
            PG8_WAIT_V(8); PG8_WAIT_L(0); PG8_BAR; PG8_MMA(0, 0, At, B0); PG8_MMA(0, 1, At, B1); PG8_BAR; PG8_SCHED;
            PG8_LDA(At, 0, 1); PG8_STAGE(PG8_SB(0, 0), b2, voffB); PG8_STAGE(PG8_SB(0, 1), b2 + hstepB, voffB); PG8_STAGE(PG8_SA(0, 0), a2, voffA);
            PG8_WAIT_V(8); PG8_WAIT_L(0); PG8_BAR; PG8_MMA(1, 0, At, B0); PG8_MMA(1, 1, At, B1); PG8_BAR; PG8_SCHED;
            PG8_LDB(B0, 1, 0); PG8_LDB(B1, 1, 1); PG8_SCHED; PG8_LDA(At, 1, 0); PG8_STAGE(PG8_SA(0, 1), a2 + hstepA, voffA);
            PG8_WAIT_V(8); PG8_WAIT_L(0); PG8_BAR; PG8_MMA(0, 0, At, B0); PG8_MMA(0, 1, At, B1); PG8_BAR; PG8_SCHED;
            PG8_LDA(At, 1, 1); PG8_STAGE(PG8_SB(1, 0), b3, voffB); PG8_STAGE(PG8_SB(1, 1), b3 + hstepB, voffB); PG8_STAGE(PG8_SA(1, 0), a3, voffA);
            PG8_WAIT_V(8); PG8_WAIT_L(0); PG8_BAR; PG8_MMA(1, 0, At, B0); PG8_MMA(1, 1, At, B1); PG8_BAR; PG8_SCHED;
            } else {
            PG8_LDB(B0, 0, 0); PG8_SCHED; PG8_LDA(At, 0, 0); PG8_STAGE(PG8_SA(1, 1), a1 + hstepA, voffA);
            PG8_WAIT_L(8); PG8_BAR; PG8_WAIT_L(0); PG8_MMA(0, 0, At, B0); PG8_BAR; PG8_SCHED;
            PG8_LDB(B1, 0, 1); PG8_STAGE(PG8_SB(0, 0), b2, voffB);
            PG8_BAR; PG8_WAIT_L(0); PG8_MMA(0, 1, At, B1); PG8_BAR;
            PG8_LDA(At, 0, 1); PG8_STAGE(PG8_SA(0, 0), a2, voffA);
            PG8_BAR; PG8_WAIT_L(0); PG8_MMA(1, 0, At, B0); PG8_BAR; PG8_SCHED;
            PG8_STAGE(PG8_SB(0, 1), b2 + hstepB, voffB);
            PG8_WAIT_V(6); PG8_BAR; PG8_MMA(1, 1, At, B1); PG8_BAR;
            PG8_LDB(B0, 1, 0); PG8_SCHED; PG8_LDA(At, 1, 0); PG8_STAGE(PG8_SA(0, 1), a2 + hstepA, voffA);
            PG8_WAIT_L(8); PG8_BAR; PG8_WAIT_L(0); PG8_MMA(0, 0, At, B0); PG8_BAR; PG8_SCHED;
            PG8_LDB(B1, 1, 1); PG8_STAGE(PG8_SB(1, 0), b3, voffB);
            PG8_BAR; PG8_WAIT_L(0); PG8_MMA(0, 1, At, B1); PG8_BAR;
            PG8_LDA(At, 1, 1); PG8_STAGE(PG8_SA(1, 0), a3, voffA);
            PG8_BAR; PG8_WAIT_L(0); PG8_MMA(1, 0, At, B0); PG8_BAR; PG8_SCHED;
            PG8_STAGE(PG8_SB(1, 1), b3 + hstepB, voffB);
            PG8_WAIT_V(6); PG8_BAR; PG8_MMA(1, 1, At, B1); PG8_BAR;
            }
        }
        if constexpr (ALIGN_EPI) { if (wr == 0) PG8_BAR; }
        if constexpr (!Epi::AFTER_DRAIN) { E(acc, cur, wr, wc, fr, fq); S.done(cur); }
        if (!has_next) break;
#pragma unroll
        for (int a = 0; a < 2; ++a)
#pragma unroll
            for (int b = 0; b < 2; ++b)
#pragma unroll
                for (int m = 0; m < 4; ++m)
#pragma unroll
                    for (int n = 0; n < 2; ++n) acc[a][b][m][n] = (f32x4){0.f, 0.f, 0.f, 0.f};
        cur = nxt; cA = nA; cB = nB; ++ui;
        if constexpr (ALIGN_EPI) { if (wr == 1) PG8_BAR; }
    }
    PG8_WAIT_V(0);
    if constexpr (!ALIGN_EPI) { if (wr == 0) PG8_BAR; }
    PG8_BAR;
    if constexpr (Epi::AFTER_DRAIN) { E.fused(acc, cur, wr, wc, fr, fq, lds, wid, lane); S.done(cur); }
#undef PG8_SA
#undef PG8_SB
#undef PG8_STAGE
#undef PG8_LDA
#undef PG8_LDB
#undef PG8_MMA
#undef PG8_WAIT_V
#undef PG8_WAIT_L
#undef PG8_BAR
#undef PG8_SCHED
}
}

template <class Q, bool RS, bool I8_ = false> struct EpiQuad {
    static constexpr bool PERM = true, AFTER_DRAIN = false, MID = Q::MID, I8 = I8_;
    Q q; const float* rs;
    __device__ __forceinline__ void mid(f32x4 (&acc)[2][2][4][2], const pg8::Unit& u, int wr, int wc, int fr, int fq, bool inv = false) const {
        if constexpr (Q::MID) {
            asm volatile("" : "+v"(fr), "+v"(fq));
#pragma unroll
            for (int ai = 0; ai < 2; ++ai) {
                u32x4 ga[4][2], gb[4][2];
#pragma unroll
                for (int m = 0; m < 4; ++m)
#pragma unroll
                    for (int bj = 0; bj < 2; ++bj) q.midload(u.pm * 256 + ai * 128 + wr * 64 + m * 16 + fr, u.pn * 256 + bj * 128 + wc * 32 + 8 * fq, ga[m][bj], gb[m][bj]);
#pragma unroll
                for (int m = 0; m < 4; ++m)
#pragma unroll
                    for (int bj = 0; bj < 2; ++bj) { if (!inv) q.midapply(ga[m][bj], gb[m][bj], acc[ai][bj][m][0], acc[ai][bj][m][1]); else q.midapply(gb[m][bj], ga[m][bj], acc[ai][bj][m][0], acc[ai][bj][m][1]); }
                __builtin_amdgcn_sched_barrier(0);
            }
        }
    }
    __device__ __forceinline__ void operator()(const f32x4 (&acc)[2][2][4][2], const pg8::Unit& u, int wr, int wc, int fr, int fq) const {
        if constexpr (Q::MID) asm volatile("" : "+v"(fr), "+v"(fq));
#pragma unroll
        for (int ai = 0; ai < 2; ++ai)
#pragma unroll
            for (int m = 0; m < 4; ++m) {
                const int rl = ai * 128 + wr * 64 + m * 16 + fr, row = u.pm * 256 + rl;
                const float r = RS ? rs[u.ui * 256 + rl] : 1.f;
#pragma unroll
                for (int bj = 0; bj < 2; ++bj) {
                    f32x4 a0 = acc[ai][bj][m][0], a1 = acc[ai][bj][m][1];
                    if constexpr (I8_) {
#pragma unroll
                        for (int e = 0; e < 4; ++e) { a0[e] = (float)__float_as_int(a0[e]); a1[e] = (float)__float_as_int(a1[e]); } }
                    q.oct(row, u.pn * 256 + bj * 128 + wc * 32 + 8 * fq, a0 * r, a1 * r);
                }
            }
    }
};
__device__ __forceinline__ void unit_row_rstd(const bf16_t* __restrict__ A, int lda, int K, const pg8::StaticOrder& S, float* rs) {
    pg8::Unit u;
    int tid_ = threadIdx.x; asm volatile("" : "+v"(tid_)); const int tid = tid_, r = tid >> 1, part = tid & 1, len = K >> 1;
    for (int i = 0; S.next(i, u); ++i) {
        const bf16_t* ar = A + (size_t)(u.pm * 256 + r) * lda + part * len;
        float ss = 0.f;
        for (int k = 0; k < len; k += 8) { const bf16x8 v = *(const bf16x8*)(ar + k);
#pragma unroll
            for (int e = 0; e < 8; ++e) { const float f = bf2f((bf16_t)v[e]); ss += f * f; } }
        ss += __shfl_xor(ss, 1);
        if (part == 0) rs[i * 256 + r] = rsqrtf(ss / (float)K + EPS);
    }
    __syncthreads();
}
template <class Q, bool RS>
__device__ __forceinline__ void run_gemm(unsigned char* lds, const bf16_t* A, int lda, const bf16_t* Bt, int ldb, int M, int N, int K, const Q& q, int rot = 0) {
    pg8::Gemm g{A, Bt, M, N, K, lda, ldb};
    int cb_ = (int)blockIdx.x - rot; if (cb_ < 0) cb_ += (int)gridDim.x; if (cb_ < 0) cb_ = (int)blockIdx.x;
    pg8::StaticOrder S; S.init(M, N, (int)gridDim.x, cb_);
    float* rs = (float*)(lds + 131072);
    if (RS) unit_row_rstd(A, lda, K, S, rs);
    EpiQuad<Q, RS> E{q, rs};
    pg8::gemm_phase<EpiQuad<Q, RS>, pg8::StaticOrder, true, true>((PG8_LAS unsigned char*)lds, g, S, E);
}

struct EpiGateI8 {
    static constexpr bool MID = false, PRO = false;
    bf16_t* P; int ldp; const float* wsc; int gate0;
    __device__ __forceinline__ void quad(int row, int col, f32x4 v) const {
        v = v * *(const f32x4*)(wsc + col);
        if (col >= gate0) { v[0] = sigmoidf_(v[0]); v[1] = sigmoidf_(v[1]); v[2] = sigmoidf_(v[2]); v[3] = sigmoidf_(v[3]); }
        store_bf4(P + (size_t)row * ldp + col, v);
    }
    __device__ __forceinline__ void oct(int row, int col, f32x4 a, f32x4 b) const {
        a = a * *(const f32x4*)(wsc + col); b = b * *(const f32x4*)(wsc + col + 4);
        if (col >= gate0) {
#pragma unroll
            for (int e = 0; e < 4; ++e) { a[e] = sigmoidf_(a[e]); b[e] = sigmoidf_(b[e]); } }
        store_bf8(P + (size_t)row * ldp + col, a, b);
    }
};
template <class Q>
__device__ __forceinline__ void run_gemm_i8(unsigned char* lds, const unsigned char* A8, const unsigned char* B8, int M, int N, int Kb, const float* rowscale, const Q& q, int rot = 0) {
    pg8::Gemm g{(const bf16_t*)A8, (const bf16_t*)B8, M, N, Kb / 2, Kb / 2, Kb / 2};
    int cb_ = (int)blockIdx.x - rot; if (cb_ < 0) cb_ += (int)gridDim.x; if (cb_ < 0) cb_ = (int)blockIdx.x;
    pg8::StaticOrder S; S.init(M, N, (int)gridDim.x, cb_);
    float* rs = (float*)(lds + 131072);
    { pg8::Unit u; int tid_ = threadIdx.x; asm volatile("" : "+v"(tid_));
      for (int i = 0; S.next(i, u); ++i) if (tid_ < 256) rs[i * 256 + tid_] = rowscale[u.pm * 256 + tid_];
      __syncthreads(); }
    EpiQuad<Q, true, true> E{q, rs};
    pg8::gemm_phase<EpiQuad<Q, true, true>, pg8::StaticOrder, true, true>((PG8_LAS unsigned char*)lds, g, S, E);
}

__device__ __forceinline__ int win_dest_row(int n) {
    if (n < 1024) return PC_QA + n;
    if (n < 2048) return PC_KA + (n - 1024);
    if (n < 3072) return PC_VA + (n - 2048);
    if (n < 3840) return PC_CQ + (n - 3072);
    if (n < 4352) return PC_CKV + (n - 3840);
    if (n < 4416) { const int r = n - 4352; return PC_KPE + (r < 32 ? 2 * r : 2 * (r - 32) + 1); }
    if (n < 6464) return PC_GA + (n - 4416);
    return PC_GB + (n - 6464);
}
__device__ __forceinline__ int wq_dest_row(int n) {
    const int h = n / 192, d = n % 192;
    if (d < 128) return n;
    const int r = d - 128;
    return h * 192 + 128 + (r < 32 ? 2 * r : 2 * (r - 32) + 1);
}
template <int MODE>
__device__ __forceinline__ void transpose_item(const float* __restrict__ W, int K, int N, bf16_t* __restrict__ WT, const float* __restrict__ kscale, float* scr, int item, int lane, int ldt = 0, int koff = 0) {
    if (ldt == 0) ldt = K;
    const int nblk = N / 32, kb = item / nblk, nb = item % nblk, k0 = 64 * kb, n0 = 32 * nb;
#pragma unroll
    for (int i = 0; i < 8; ++i) { const int kk = 8 * i + (lane >> 3), n4 = (lane & 7) * 4;
        f32x4 w = *(const f32x4*)(W + (size_t)(k0 + kk) * N + n0 + n4); if (kscale) w = w * kscale[k0 + kk];
        scr[kk * 33 + n4] = w[0]; scr[kk * 33 + n4 + 1] = w[1]; scr[kk * 33 + n4 + 2] = w[2]; scr[kk * 33 + n4 + 3] = w[3]; }
    __builtin_amdgcn_s_waitcnt(0xc07f); asm volatile("" ::: "memory");
    const int c = lane & 7;
#pragma unroll
    for (int j = 0; j < 4; ++j) {
        const int n = (lane >> 3) + 8 * j; const float* s = scr + (8 * c) * 33 + n;
        u32x4 o; o.x = pk2(s[0 * 33], s[1 * 33]); o.y = pk2(s[2 * 33], s[3 * 33]); o.z = pk2(s[4 * 33], s[5 * 33]); o.w = pk2(s[6 * 33], s[7 * 33]);
        const int ns = n0 + n;
        const int dr = MODE == 1 ? win_dest_row(ns) : (MODE == 2 ? wq_dest_row(ns) : ns);
        *(u32x4*)(WT + (size_t)dr * ldt + koff + k0 + 8 * c) = o;
    }
    __builtin_amdgcn_s_waitcnt(0xc07f); asm volatile("" ::: "memory");
}

__device__ __forceinline__ void phase0(const Params& p, unsigned char* lds) {
    int tid_ = threadIdx.x; asm volatile("" : "+v"(tid_)); const int tid = tid_, lane = tid & 63, wid = tid >> 6;
    unsigned char* ws = p.ws;
    {
        float* sl = (float*)lds;
        float* red = sl + 9 * 2048;
        const float* c = p.in[1]; const float* cctx = p.in[3]; const float* wada = p.in[4]; const float* bada = p.in[5];
        float* mod = (float*)(ws + WS_MOD);
        if (blockIdx.x < 192) {
            for (int i = tid; i < 9 * 2048; i += NTHREADS) { const int r = i >> 11, k = i & 2047; const float v = r < 8 ? c[r * DM + k] : cctx[k]; sl[i] = silu_(v); }
            __syncthreads();
            for (int it = blockIdx.x; it < 192; it += gridDim.x) {
                const int kq = tid >> 4, c4 = tid & 15, col = it * 64 + c4 * 4;
                f32x4 acc[9];
#pragma unroll
                for (int r = 0; r < 9; ++r) acc[r] = (f32x4){0.f, 0.f, 0.f, 0.f};
#pragma unroll 8
                for (int i = 0; i < 64; ++i) {
                    const int k = kq + 32 * i;
                    const f32x4 w = *(const f32x4*)(wada + (size_t)k * 12288 + col);
#pragma unroll
                    for (int r = 0; r < 9; ++r) acc[r] += w * sl[r * 2048 + k];
                }
#pragma unroll
                for (int r = 0; r < 9; ++r) {
#pragma unroll
                    for (int e = 0; e < 4; ++e) { float v = acc[r][e]; v += __shfl_xor(v, 16); v += __shfl_xor(v, 32); acc[r][e] = v; }
                    if (lane < 16) *(f32x4*)(red + (wid * 9 + r) * 64 + c4 * 4) = acc[r];
                }
                __syncthreads();
                for (int o = tid; o < 9 * 64; o += NTHREADS) {
                    const int r = o >> 6, cc = o & 63;
                    float sum = bada[it * 64 + cc];
                    for (int q = 0; q < 8; ++q) sum += red[(q * 9 + r) * 64 + cc];
                    mod[(size_t)r * 12288 + it * 64 + cc] = sum;
                }
                __syncthreads();
            }
        }
        __syncthreads();
    }
    {
        float* scr = (float*)lds + wid * (64 * 33);
        const int gw = blockIdx.x * NWAVES + wid, NGW = gridDim.x * NWAVES;
        constexpr int I_IN = 32 * (IN_COLS / 32), I_QB = 12 * 48, I_KVB = 8 * 64, I_AB = 16 * 64, I_OO = 32 * 64;
        constexpr int NITEMS = I_IN + I_QB + I_KVB + 2 * I_AB + 2 * I_OO;
        for (int it = gw; it < NITEMS; it += NGW) {
            int r = it;
            if (r < I_IN) { transpose_item<1>(p.in[10], DM, IN_COLS, (bf16_t*)(ws + WS_WIN), nullptr, scr, r, lane); continue; } r -= I_IN;
            if (r < I_QB) { transpose_item<2>(p.in[13], QR, MQW, (bf16_t*)(ws + WS_WQB), p.in[12], scr, r, lane); continue; } r -= I_QB;
            if (r < I_KVB) { transpose_item<0>(p.in[15], KVR, MKVW, (bf16_t*)(ws + WS_WKVB), p.in[14], scr, r, lane); continue; } r -= I_KVB;
            if (r < I_AB) { transpose_item<0>(p.in[16], 1024, DM, (bf16_t*)(ws + WS_WA), nullptr, scr, r, lane, 2048, 0); continue; } r -= I_AB;
            if (r < I_AB) { transpose_item<0>(p.in[17], 1024, DM, (bf16_t*)(ws + WS_WA), nullptr, scr, r, lane, 2048, 1024); continue; } r -= I_AB;
            if (r < I_OO) { transpose_item<0>(p.in[18], DM, DM, (bf16_t*)(ws + WS_WO), nullptr, scr, r, lane); continue; } r -= I_OO;
            transpose_item<0>(p.in[19], DM, DM, (bf16_t*)(ws + WS_WPQ), nullptr, scr, r, lane);
        }
    }
    {
        const size_t gt = (size_t)blockIdx.x * NTHREADS + tid, NGT = (size_t)gridDim.x * NTHREADS;
        u32x4* padp = (u32x4*)(ws + WS_WIN + (size_t)(PC_KPE + 64) * DM * 2);
        for (size_t i = gt; i < (size_t)192 * DM * 2 / 16; i += NGT) padp[i] = (u32x4){0u, 0u, 0u, 0u};
        float* rope = (float*)(ws + WS_ROPE);
        for (size_t i = gt; i < (size_t)SEQ * 32; i += NGT) { float c, sn; rope_cs((int)(i >> 5), (int)(i & 31), c, sn); rope[i * 2] = c; rope[i * 2 + 1] = sn; }
        const float* sk = p.in[20]; bf16_t* skb = (bf16_t*)(ws + WS_SUBK);
        for (size_t i = gt; i < 262144 / 4; i += NGT) { const f32x4 v = *(const f32x4*)(sk + i * 4); store_bf4(skb + i * 4, v); }
    }
}

__device__ __forceinline__ void quant_rows_s8(const bf16_t* __restrict__ W, int NR, unsigned char* __restrict__ Q8, float* __restrict__ SC, int gw, int NGW, int lane) {
    for (int n = gw; n < NR; n += NGW) {
        const bf16_t* wr_ = W + (size_t)n * DM + lane * 32;
        u32x4 w4[4]; float mx = 0.f;
#pragma unroll
        for (int q = 0; q < 4; ++q) { w4[q] = *(const u32x4*)(wr_ + q * 8);
#pragma unroll
            for (int c = 0; c < 4; ++c) { const unsigned w = w4[q][c]; mx = fmaxf(mx, fmaxf(fabsf(__uint_as_float(w << 16)), fabsf(__uint_as_float(w & 0xffff0000u)))); } }
        mx = fmaxf(wave_max(mx), 1e-30f);
        const float qi = 127.f / mx;
        u32x4 o0, o1;
#pragma unroll
        for (int q = 0; q < 4; ++q)
#pragma unroll
            for (int c2 = 0; c2 < 2; ++c2) {
                const unsigned wa = w4[q][2 * c2], wb = w4[q][2 * c2 + 1];
                const int q0 = (int)rintf(__uint_as_float(wa << 16) * qi), q1 = (int)rintf(__uint_as_float(wa & 0xffff0000u) * qi);
                const int q2 = (int)rintf(__uint_as_float(wb << 16) * qi), q3 = (int)rintf(__uint_as_float(wb & 0xffff0000u) * qi);
                const unsigned pk = ((unsigned)q0 & 0xffu) | (((unsigned)q1 & 0xffu) << 8) | (((unsigned)q2 & 0xffu) << 16) | (((unsigned)q3 & 0xffu) << 24);
                if (q < 2) o0[2 * q + c2] = pk; else o1[2 * (q - 2) + c2] = pk;
            }
        unsigned char* dst = Q8 + (size_t)n * DM + lane * 32;
        *(u32x4*)dst = o0; *(u32x4*)(dst + 16) = o1;
        if (lane == 0) SC[n] = mx * (1.f / 127.f);
    }
}
__device__ __forceinline__ void phase1(const Params& p) {
    int tid_ = threadIdx.x; asm volatile("" : "+v"(tid_)); const int tid = tid_, lane = tid & 63, wid = tid >> 6;
    const int gw = blockIdx.x * NWAVES + wid, NGW = gridDim.x * NWAVES;
    const float* mod = (const float*)(p.ws + WS_MOD); const float* g = p.in[6];
    bf16_t* H = (bf16_t*)(p.ws + WS_H);
    if (gw < NB) {
        float* GTG = (float*)(p.ws + WS_GTG);
#pragma unroll
        for (int j = 0; j < 8; ++j) { const int c = j * 256 + lane * 4; *(f32x4*)(GTG + (size_t)gw * 2048 + c) = *(const f32x4*)(mod + (size_t)gw * 12288 + 10240 + c) * *(const f32x4*)(p.in[9] + c); }
    }
    const int per = (TA + NGW - 1) / NGW;
    int curb = -1; f32x4 G[8], S[8];
    for (int i = 0; i < per; ++i) {
        const int m = gw * per + i; if (m >= TA) break;
        const float* xr = m < TL ? p.in[0] + (size_t)m * DM : p.in[2] + (size_t)(m - TL) * DM;
        const int mr = m < TL ? m / SEQ : 8;
        if (mr != curb) { curb = mr; const float* sh = mod + (size_t)mr * 12288, * sc = sh + 2048;
#pragma unroll
            for (int j = 0; j < 8; ++j) { const int c = j * 256 + lane * 4; G[j] = *(const f32x4*)(g + c) * (*(const f32x4*)(sc + c) + 1.f); S[j] = *(const f32x4*)(sh + c); } }
        f32x4 v[8]; float ss = 0.f;
#pragma unroll
        for (int j = 0; j < 8; ++j) { v[j] = *(const f32x4*)(xr + j * 256 + lane * 4); ss += v[j][0] * v[j][0] + v[j][1] * v[j][1] + v[j][2] * v[j][2] + v[j][3] * v[j][3]; }
        const float rstd = rsqrtf(wave_sum_dpp(ss) * (1.f / DM) + EPS);
        float hmx = 0.f;
#pragma unroll
        for (int j = 0; j < 8; ++j) { v[j] = (v[j] * rstd) * G[j] + S[j]; if (INPROJ_I8 != 2) store_bf4(H + (size_t)m * DM + j * 256 + lane * 4, v[j]);
            hmx = fmaxf(hmx, fmaxf(fmaxf(fabsf(v[j][0]), fabsf(v[j][1])), fmaxf(fabsf(v[j][2]), fabsf(v[j][3])))); }
        {
            hmx = fmaxf(wave_max(hmx), 1e-30f);
            const float qi = 127.f / hmx;
#pragma unroll
            for (int j = 0; j < 8; ++j) {
                const int q0 = (int)rintf(v[j][0] * qi), q1 = (int)rintf(v[j][1] * qi), q2 = (int)rintf(v[j][2] * qi), q3 = (int)rintf(v[j][3] * qi);
                *(unsigned*)(p.ws + WS_H8G + (size_t)m * DM + j * 256 + lane * 4) = ((unsigned)q0 & 0xffu) | (((unsigned)q1 & 0xffu) << 8) | (((unsigned)q2 & 0xffu) << 16) | (((unsigned)q3 & 0xffu) << 24);
            }
            if (lane == 0) ((float*)(p.ws + WS_HSG))[m] = hmx * (1.f / 127.f);
        }
    }
    quant_rows_s8((const bf16_t*)(p.ws + WS_WIN), NP, p.ws + WS_WG8, (float*)(p.ws + WS_WGS), gw, NGW, lane);
}

__device__ __forceinline__ void kpe_pass(const Params& p) {
    const size_t gt = (size_t)blockIdx.x * NTHREADS + threadIdx.x, NGT = (size_t)gridDim.x * NTHREADS;
    const bf16_t* PL = (const bf16_t*)(p.ws + WS_PL); const bf16_t* PCx = (const bf16_t*)(p.ws + WS_PC);
    bf16_t* KPE = (bf16_t*)(p.ws + WS_KPE); const float* rope = (const float*)(p.ws + WS_ROPE);
    for (size_t i = gt; i < (size_t)TA * 32; i += NGT) {
        const int m = (int)(i >> 5), j = (int)(i & 31);
        unsigned w;
        if (m < TL) {
            w = *(const unsigned*)(PL + (size_t)m * NP + PC_KPE + 2 * j);
            const float x1 = __uint_as_float(w << 16), x2 = __uint_as_float(w & 0xffff0000u);
            const float c = rope[((size_t)(m & (SEQ - 1)) * 32 + j) * 2], s = rope[((size_t)(m & (SEQ - 1)) * 32 + j) * 2 + 1];
            w = pk2(x1 * c - x2 * s, x1 * s + x2 * c);
        } else w = *(const unsigned*)(PCx + (size_t)(m - TL) * NPC + PC_KPE + 2 * j);
        *(unsigned*)(KPE + (size_t)m * 64 + 2 * j) = w;
    }
}

__device__ __forceinline__ float dot_bf16x8(const bf16x8 k, const float* q) {
    float s = 0.f;
#pragma unroll
    for (int e = 0; e < 8; ++e) s += q[e] * bf2f((bf16_t)k[e]);
    return s;
}

__device__ __forceinline__ void na_naive(const Params& p, unsigned char* lds) {
    int tid_ = threadIdx.x; asm volatile("" : "+v"(tid_)); const int tid = tid_, lane = tid & 63, wid = tid >> 6;
    const int gw = blockIdx.x * NWAVES + wid, NGW = gridDim.x * NWAVES;
    const bf16_t* PL = (const bf16_t*)(p.ws + WS_PL); const bf16_t* PCx = (const bf16_t*)(p.ws + WS_PC);
    bf16_t* OA = (bf16_t*)(p.ws + WS_OA);
    const float* rpb = p.in[11];
    float* qs = (float*)lds + wid * 512;
    float* ps = qs + 64;
    for (int it = gw; it < TL * 16; it += NGW) {
        const int h = it & 15, m = it >> 4, b = m / SEQ, s = m % SEQ, r = s >> 6, qc = s & 63;
        int r0 = r - 4; r0 = r0 < 0 ? 0 : (r0 > GROWS - 8 ? GROWS - 8 : r0);
        int w0 = qc - 8; w0 = w0 < 0 ? 0 : (w0 > GW - 16 ? GW - 16 : w0);
        qs[lane] = bf2f(PL[(size_t)m * NP + PC_QA + h * 64 + lane]);
        __builtin_amdgcn_s_waitcnt(0xc07f); asm volatile("" ::: "memory");
        float sc[6];
#pragma unroll
        for (int i = 0; i < 6; ++i) {
            const int kk = lane + 64 * i;
            const bf16_t* kp; float bias = 0.f;
            if (i < 2) { const int dy = kk >> 4, dx = kk & 15, kr = r0 + dy, kc = w0 + dx;
                kp = PL + (size_t)(b * SEQ + kr * 64 + kc) * NP + PC_KA + h * 64;
                bias = rpb[(h * 15 + (kr - r + 7)) * 31 + (kc - qc + 15)]; }
            else kp = PCx + (size_t)(b * CTX + (kk - 128)) * NPC + PC_KA + h * 64;
            float d = 0.f;
#pragma unroll
            for (int e = 0; e < 8; ++e) d += dot_bf16x8(*(const bf16x8*)(kp + e * 8), qs + e * 8);
            sc[i] = d * NA_SCALE + bias;
        }
        float mx = sc[0];
#pragma unroll
        for (int i = 1; i < 6; ++i) mx = fmaxf(mx, sc[i]);
        mx = wave_max(mx);
        float sum = 0.f;
#pragma unroll
        for (int i = 0; i < 6; ++i) { sc[i] = __expf(sc[i] - mx); sum += sc[i]; ps[lane + 64 * i] = sc[i]; }
        sum = wave_sum(sum);
        __builtin_amdgcn_s_waitcnt(0xc07f); asm volatile("" ::: "memory");
        float o = 0.f;
        for (int kk = 0; kk < 128; ++kk) { const int kr = r0 + (kk >> 4), kc = w0 + (kk & 15);
            o += ps[kk] * bf2f(PL[(size_t)(b * SEQ + kr * 64 + kc) * NP + PC_VA + h * 64 + lane]); }
        for (int kk = 0; kk < 256; ++kk) o += ps[128 + kk] * bf2f(PCx[(size_t)(b * CTX + kk) * NPC + PC_VA + h * 64 + lane]);
        OA[(size_t)m * 2048 + h * 64 + lane] = (bf16_t)f2bf(o / sum);
        __builtin_amdgcn_s_waitcnt(0xc07f); asm volatile("" ::: "memory");
    }
}

__device__ __forceinline__ void mla_naive(const Params& p, unsigned char* lds) {
    int tid_ = threadIdx.x; asm volatile("" : "+v"(tid_)); const int tid = tid_, lane = tid & 63, wid = tid >> 6;
    const bf16_t* QM = (const bf16_t*)(p.ws + WS_QM); const bf16_t* KVM = (const bf16_t*)(p.ws + WS_KVM); const bf16_t* KPE = (const bf16_t*)(p.ws + WS_KPE);
    bf16_t* OB = (bf16_t*)(p.ws + WS_OB);
    float* qs = (float*)lds + wid * (192 + 2304);
    float* ps = qs + 192;
    for (int it = blockIdx.x; it < NB * 8 * (SEQ / 8); it += gridDim.x) {
        const int qg = it % (SEQ / 8), bh = it / (SEQ / 8), h = bh & 7, b = bh >> 3;
        const int m = b * SEQ + qg * 8 + wid;
#pragma unroll
        for (int i = 0; i < 3; ++i) qs[lane + 64 * i] = bf2f(QM[(size_t)m * MQW + h * 192 + lane + 64 * i]);
        __builtin_amdgcn_s_waitcnt(0xc07f); asm volatile("" ::: "memory");
        float mx = -INFINITY;
        for (int i = 0; i < 36; ++i) {
            const int kk = lane + 64 * i;
            const int krow = kk < SEQ ? b * SEQ + kk : TL + b * CTX + (kk - SEQ);
            const bf16_t* kn = KVM + (size_t)krow * MKVW + h * 256; const bf16_t* kp = KPE + (size_t)krow * 64;
            float d = 0.f;
#pragma unroll
            for (int e = 0; e < 16; ++e) d += dot_bf16x8(*(const bf16x8*)(kn + e * 8), qs + e * 8);
#pragma unroll
            for (int e = 0; e < 8; ++e) d += dot_bf16x8(*(const bf16x8*)(kp + e * 8), qs + 128 + e * 8);
            ps[kk] = d; mx = fmaxf(mx, d);
        }
        mx = wave_max(mx);
        float sum = 0.f;
        for (int i = 0; i < 36; ++i) { const float e = exp2f(ps[lane + 64 * i] - mx); sum += e; ps[lane + 64 * i] = e; }
        sum = wave_sum(sum);
        __builtin_amdgcn_s_waitcnt(0xc07f); asm volatile("" ::: "memory");
        float o0 = 0.f, o1 = 0.f;
        const bf16_t* vb = KVM + h * 256 + 128 + lane;
        for (int kk = 0; kk < SEQ; ++kk) { const bf16_t* vp = vb + (size_t)(b * SEQ + kk) * MKVW; const float pp = ps[kk]; o0 += pp * bf2f(vp[0]); o1 += pp * bf2f(vp[64]); }
        for (int kk = 0; kk < CTX; ++kk) { const bf16_t* vp = vb + (size_t)(TL + b * CTX + kk) * MKVW; const float pp = ps[SEQ + kk]; o0 += pp * bf2f(vp[0]); o1 += pp * bf2f(vp[64]); }
        const float inv = 1.f / sum;
        OB[(size_t)m * 2048 + h * 128 + lane] = (bf16_t)f2bf(o0 * inv);
        OB[(size_t)m * 2048 + h * 128 + 64 + lane] = (bf16_t)f2bf(o1 * inv);
        __builtin_amdgcn_s_waitcnt(0xc07f); asm volatile("" ::: "memory");
    }
}


typedef float f32x16 __attribute__((ext_vector_type(16)));
typedef short s16x4 __attribute__((ext_vector_type(4)));
typedef float f32x2_t __attribute__((ext_vector_type(2)));
typedef __bf16 bf16x2_t __attribute__((ext_vector_type(2)));
#define LAS3 __attribute__((address_space(3)))
__device__ __forceinline__ unsigned cvtpk(float lo, float hi) { f32x2_t v = {lo, hi}; bf16x2_t b = __builtin_convertvector(v, bf16x2_t); return __builtin_bit_cast(unsigned, b); }
__device__ __forceinline__ s16x4 vtr(const LAS3 unsigned char* p) { return __builtin_bit_cast(s16x4, __builtin_amdgcn_ds_read_tr16_b64_v4i16((LAS3 s16x4*)p)); }
__device__ __forceinline__ float max16(const f32x16& a) {
    float m0 = fmaxf(fmaxf(a[0], a[1]), fmaxf(a[2], a[3])), m1 = fmaxf(fmaxf(a[4], a[5]), fmaxf(a[6], a[7]));
    float m2 = fmaxf(fmaxf(a[8], a[9]), fmaxf(a[10], a[11])), m3 = fmaxf(fmaxf(a[12], a[13]), fmaxf(a[14], a[15]));
    return fmaxf(fmaxf(m0, m1), fmaxf(m2, m3));
}
__device__ __forceinline__ bf16x8 pfrag(const f32x16& a, int s) {
    u32x4 w; w.x = cvtpk(a[8 * s + 0], a[8 * s + 1]); w.y = cvtpk(a[8 * s + 2], a[8 * s + 3]); w.z = cvtpk(a[8 * s + 4], a[8 * s + 5]); w.w = cvtpk(a[8 * s + 6], a[8 * s + 7]);
    return __builtin_bit_cast(bf16x8, w);
}

__device__ __forceinline__ void mla_flash(const Params& p, unsigned char* lds_) {
    int tid_ = threadIdx.x; asm volatile("" : "+v"(tid_)); const int tid = tid_, lane = tid & 63, wid = tid >> 6, r32 = lane & 31, hi = lane >> 5;
    LAS3 unsigned char* lds = (LAS3 unsigned char*)lds_;
    constexpr int KP = 400, VP = 320, KBYTES = 64 * KP, VBYTES = 64 * VP, STG = KBYTES + VBYTES, NT = (SEQ + CTX) / 64;
    const bf16_t* QM = (const bf16_t*)(p.ws + WS_QM); const bf16_t* KVM = (const bf16_t*)(p.ws + WS_KVM); const bf16_t* KPE = (const bf16_t*)(p.ws + WS_KPE);
    bf16_t* OB = (bf16_t*)(p.ws + WS_OB);
    const int G = gridDim.x, vcu = (G % 8 == 0) ? (blockIdx.x % 8) * (G / 8) + blockIdx.x / 8 : blockIdx.x;
    const int skey = tid >> 4, spc = tid & 15, pkey = tid >> 3, ppc = tid & 7;
    const int vb = (4 * hi + ((lane & 15) >> 2)) * VP + (16 * ((lane >> 4) & 1) + 4 * (lane & 3)) * 2;
    for (int unit = vcu; unit < NB * 8 * 8; unit += G) {
        const int bh = unit >> 3, qt = unit & 7, b = bh >> 3, h = bh & 7;
        const int qrow = b * SEQ + qt * 256 + wid * 32 + r32;
        bf16x8 qf[12];
#pragma unroll
        for (int s = 0; s < 12; ++s) qf[s] = *(const bf16x8*)(QM + (size_t)qrow * MQW + h * 192 + 16 * s + 8 * hi);
        f32x16 o[4];
#pragma unroll
        for (int d = 0; d < 4; ++d)
#pragma unroll
            for (int r = 0; r < 16; ++r) o[d][r] = 0.f;
        float m = -1e30f, l = 0.f;
        u32x4 g0, g1, g2, g3, g4;
#define MLA_LOAD(t) do { const int kr_ = (t) < 32 ? b * SEQ + 64 * (t) : TL + b * CTX + 64 * ((t) - 32); \
            const bf16_t* kp_ = KVM + (size_t)(kr_ + skey) * MKVW + h * 256 + spc * 8; \
            g0 = *(const u32x4*)kp_; g1 = *(const u32x4*)(kp_ + (size_t)32 * MKVW); g2 = *(const u32x4*)(kp_ + 128); g3 = *(const u32x4*)(kp_ + (size_t)32 * MKVW + 128); \
            g4 = *(const u32x4*)(KPE + (size_t)(kr_ + pkey) * 64 + ppc * 8); } while (0)
#define MLA_STORE(buf) do { LAS3 unsigned char* kb_ = lds + (buf) * STG; LAS3 unsigned char* vb_ = kb_ + KBYTES; \
            *(LAS3 u32x4*)(kb_ + skey * KP + spc * 16) = g0; *(LAS3 u32x4*)(kb_ + (skey + 32) * KP + spc * 16) = g1; \
            *(LAS3 u32x4*)(vb_ + skey * VP + spc * 16) = g2; *(LAS3 u32x4*)(vb_ + (skey + 32) * VP + spc * 16) = g3; \
            *(LAS3 u32x4*)(kb_ + pkey * KP + 256 + ppc * 16) = g4; } while (0)
        MLA_LOAD(0); MLA_STORE(0);
#pragma unroll
        for (int s = 0; s < 12; ++s) asm volatile("" : "+v"(qf[s]));
        __syncthreads();
        for (int t = 0; t < NT; ++t) {
            const int cur = t & 1;
            if (t + 1 < NT) MLA_LOAD(t + 1);
            const LAS3 unsigned char* Kb = lds + cur * STG; const LAS3 unsigned char* Vb = Kb + KBYTES;
            f32x16 s0, s1;
#pragma unroll
            for (int r = 0; r < 16; ++r) { s0[r] = 0.f; s1[r] = 0.f; }
            const LAS3 unsigned char* ka = Kb + r32 * KP + 16 * hi;
#pragma unroll
            for (int s = 0; s < 12; ++s) {
                const bf16x8 a0 = *(const LAS3 bf16x8*)(ka + 32 * s), a1 = *(const LAS3 bf16x8*)(ka + 32 * KP + 32 * s);
                s0 = __builtin_amdgcn_mfma_f32_32x32x16_bf16(a0, qf[s], s0, 0, 0, 0);
                s1 = __builtin_amdgcn_mfma_f32_32x32x16_bf16(a1, qf[s], s1, 0, 0, 0);
            }
            float mx = fmaxf(max16(s0), max16(s1));
            mx = fmaxf(mx, __shfl_xor(mx, 32));
            const float mn = fmaxf(m, mx);
            if (__builtin_amdgcn_ballot_w64(mx > m) != 0ull) {
                const float alpha = __builtin_amdgcn_exp2f(m - mn);
                l *= alpha;
#pragma unroll
                for (int d = 0; d < 4; ++d) o[d] = o[d] * alpha;
            }
            m = mn;
            float rs = 0.f;
#pragma unroll
            for (int r = 0; r < 16; ++r) { s0[r] = __builtin_amdgcn_exp2f(s0[r] - mn); s1[r] = __builtin_amdgcn_exp2f(s1[r] - mn); rs += s0[r] + s1[r]; }
            l += rs;
            bf16x8 pf[4];
            pf[0] = pfrag(s0, 0); pf[1] = pfrag(s0, 1); pf[2] = pfrag(s1, 0); pf[3] = pfrag(s1, 1);
            const LAS3 unsigned char* va = Vb + vb;
#pragma unroll
            for (int ks = 0; ks < 4; ++ks)
#pragma unroll
                for (int d = 0; d < 4; ++d) {
                    const s16x4 lo = vtr(va + (16 * ks) * VP + 64 * d), hh = vtr(va + (16 * ks + 8) * VP + 64 * d);
                    const bf16x8 vf = {lo[0], lo[1], lo[2], lo[3], hh[0], hh[1], hh[2], hh[3]};
                    o[d] = __builtin_amdgcn_mfma_f32_32x32x16_bf16(vf, pf[ks], o[d], 0, 0, 0);
                }
            if (t + 1 < NT) MLA_STORE(cur ^ 1);
            __syncthreads();
        }
#undef MLA_LOAD
#undef MLA_STORE
        l += __shfl_xor(l, 32);
        const float inv = 1.f / l;
        bf16_t* op = OB + (size_t)qrow * 2048 + h * 128 + 4 * hi;
#pragma unroll
        for (int d = 0; d < 4; ++d)
#pragma unroll
            for (int g = 0; g < 4; ++g) {
                const f32x4 v = {o[d][4 * g] * inv, o[d][4 * g + 1] * inv, o[d][4 * g + 2] * inv, o[d][4 * g + 3] * inv};
                store_bf4(op + 32 * d + 8 * g, v);
            }
    }
}


__device__ __forceinline__ void mla_flash2(const Params& p, unsigned char* lds_) {
    int tid_ = threadIdx.x; asm volatile("" : "+v"(tid_)); const int tid = tid_, wid = __builtin_amdgcn_readfirstlane(tid >> 6);
    LAS3 unsigned char* lds = (LAS3 unsigned char*)lds_;
    constexpr int KP = 400, VP = 320, KBYTES = 64 * KP, VBYTES = 64 * VP, NT = (SEQ + CTX) / 64, NQR = 7, QPP = 32 * (12 - NQR) + 16;
    const bf16_t* KVM = (const bf16_t*)(p.ws + WS_KVM); const bf16_t* KPE = (const bf16_t*)(p.ws + WS_KPE);
    bf16_t* OB = (bf16_t*)(p.ws + WS_OB);
    const int G = gridDim.x, vcu = (G % 8 == 0) ? (blockIdx.x % 8) * (G / 8) + blockIdx.x / 8 : blockIdx.x;
    for (int unit = vcu; unit < NB * 8 * 8; unit += G) {
        int tq = tid; asm volatile("" : "+v"(tq));
        const unsigned char* wsq = p.ws; asm volatile("" : "+s"(wsq));
        const bf16_t* QM = (const bf16_t*)(wsq + WS_QM);
        const int lane = tq & 63, r32 = tq & 31, hi = (tq >> 5) & 1;
        const int skey = tq >> 4, spc = tq & 15, pkey = tq >> 3, ppc = tq & 7;
        const int vb = (4 * hi + ((lane & 15) >> 2)) * VP + (16 * ((lane >> 4) & 1) + 4 * (lane & 3)) * 2;
        const int bh = unit >> 3, qt = unit & 7, b = bh >> 3, h = bh & 7;
        const int qrow = b * SEQ + qt * 256 + wid * 32 + r32;
        bf16x8 qf[NQR];
#pragma unroll
        for (int s = 0; s < NQR; ++s) qf[s] = *(const bf16x8*)(QM + (size_t)qrow * MQW + h * 192 + 16 * s + 8 * hi);
        LAS3 unsigned char* qpe = lds + 2 * KBYTES + 3 * VBYTES + wid * (32 * QPP) + r32 * QPP + 16 * hi;
#pragma unroll
        for (int s = 0; s < 12 - NQR; ++s) *(LAS3 bf16x8*)(qpe + 32 * s) = *(const bf16x8*)(QM + (size_t)qrow * MQW + h * 192 + 16 * (NQR + s) + 8 * hi);
        f32x16 o[4];
#pragma unroll
        for (int d = 0; d < 4; ++d)
#pragma unroll
            for (int r = 0; r < 16; ++r) o[d][r] = 0.f;
        float m = -1e30f, l = 0.f, alA = 1.f, alB = 1.f;
        u32x4 g0, g1, g2, g3, g4;
        f32x16 sA0, sA1, sB0, sB1;
        bf16x8 pf[4];
#define M2_LOAD(t) do { const int kr_ = (t) < 32 ? b * SEQ + 64 * (t) : TL + b * CTX + 64 * ((t) - 32); \
            const bf16_t* kp_ = KVM + (size_t)(kr_ + skey) * MKVW + h * 256 + spc * 8; \
            g0 = *(const u32x4*)kp_; g1 = *(const u32x4*)(kp_ + (size_t)32 * MKVW); g2 = *(const u32x4*)(kp_ + 128); g3 = *(const u32x4*)(kp_ + (size_t)32 * MKVW + 128); \
            g4 = *(const u32x4*)(KPE + (size_t)(kr_ + pkey) * 64 + ppc * 8); } while (0)
#define M2_STORE(kbi, vbo) do { LAS3 unsigned char* kb_ = lds + (kbi) * KBYTES; LAS3 unsigned char* vb_ = lds + 2 * KBYTES + (vbo); \
            *(LAS3 u32x4*)(kb_ + skey * KP + spc * 16) = g0; *(LAS3 u32x4*)(kb_ + (skey + 32) * KP + spc * 16) = g1; \
            *(LAS3 u32x4*)(vb_ + skey * VP + spc * 16) = g2; *(LAS3 u32x4*)(vb_ + (skey + 32) * VP + spc * 16) = g3; \
            *(LAS3 u32x4*)(kb_ + pkey * KP + 256 + ppc * 16) = g4; } while (0)
#define SB_() __builtin_amdgcn_sched_barrier(0)
#define M2_QKZ(S0, S1) do { _Pragma("unroll") for (int r = 0; r < 16; ++r) { S0[r] = 0.f; S1[r] = 0.f; } } while (0)
#define M2_QKG(S0, S1, kbi, s_lo) do { const LAS3 unsigned char* ka = lds + (kbi) * KBYTES + r32 * KP + 16 * hi; \
            _Pragma("unroll") for (int s = (s_lo); s < (s_lo) + 2; ++s) { \
                const bf16x8 a0 = *(const LAS3 bf16x8*)(ka + 32 * s), a1 = *(const LAS3 bf16x8*)(ka + 32 * KP + 32 * s); \
                const bf16x8 qq = s < NQR ? qf[s < NQR ? s : 0] : *(const LAS3 bf16x8*)(qpe + 32 * (s - NQR)); \
                S0 = __builtin_amdgcn_mfma_f32_32x32x16_bf16(a0, qq, S0, 0, 0, 0); \
                S1 = __builtin_amdgcn_mfma_f32_32x32x16_bf16(a1, qq, S1, 0, 0, 0); } } while (0)
#define M2_QK_FIN(X0, X1, kbi, Y0, Y1, ALY) do { \
            SB_(); M2_QKZ(X0, X1); M2_QKG(X0, X1, kbi, 0); \
            _Pragma("unroll") for (int r = 0; r < 8; ++r) Y1[r] = __builtin_amdgcn_exp2f(Y1[r]); \
            SB_(); M2_QKG(X0, X1, kbi, 2); \
            _Pragma("unroll") for (int r = 8; r < 16; ++r) Y1[r] = __builtin_amdgcn_exp2f(Y1[r]); \
            SB_(); M2_QKG(X0, X1, kbi, 4); \
            { float rs = 0.f; _Pragma("unroll") for (int r = 0; r < 16; ++r) rs += Y0[r] + Y1[r]; l = l * ALY + rs; } \
            SB_(); M2_QKG(X0, X1, kbi, 6); \
            pf[0] = pfrag(Y0, 0); pf[1] = pfrag(Y0, 1); \
            SB_(); M2_QKG(X0, X1, kbi, 8); \
            pf[2] = pfrag(Y1, 0); pf[3] = pfrag(Y1, 1); \
            SB_(); M2_QKG(X0, X1, kbi, 10); \
            SB_(); } while (0)
#define M2_QK_ONLY(X0, X1, kbi) do { SB_(); M2_QKZ(X0, X1); M2_QKG(X0, X1, kbi, 0); SB_(); M2_QKG(X0, X1, kbi, 2); SB_(); M2_QKG(X0, X1, kbi, 4); SB_(); M2_QKG(X0, X1, kbi, 6); SB_(); M2_QKG(X0, X1, kbi, 8); SB_(); M2_QKG(X0, X1, kbi, 10); SB_(); } while (0)
#define M2_FIN_ONLY(Y0, Y1, ALY) do { float rs = 0.f; \
            _Pragma("unroll") for (int r = 0; r < 16; ++r) { Y1[r] = __builtin_amdgcn_exp2f(Y1[r]); rs += Y0[r] + Y1[r]; } \
            l = l * ALY + rs; \
            pf[0] = pfrag(Y0, 0); pf[1] = pfrag(Y0, 1); pf[2] = pfrag(Y1, 0); pf[3] = pfrag(Y1, 1); } while (0)
#define M2_PVG(vbo, ks) do { const LAS3 unsigned char* va = lds + 2 * KBYTES + (vbo) + vb; \
            _Pragma("unroll") for (int d = 0; d < 4; ++d) { \
                const s16x4 lo = vtr(va + (16 * (ks)) * VP + 64 * d), hh = vtr(va + (16 * (ks) + 8) * VP + 64 * d); \
                const bf16x8 vf = {lo[0], lo[1], lo[2], lo[3], hh[0], hh[1], hh[2], hh[3]}; \
                o[d] = __builtin_amdgcn_mfma_f32_32x32x16_bf16(vf, pf[ks], o[d], 0, 0, 0); } } while (0)
#define M2_PART_A(X0, X1, ALX, MN) do { float mx = fmaxf(max16(X0), max16(X1)); \
            { auto rr = __builtin_amdgcn_permlane32_swap(__float_as_uint(mx), __float_as_uint(mx), false, false); mx = fmaxf(__uint_as_float(rr[0]), __uint_as_float(rr[1])); } \
            MN = fmaxf(m, mx); ALX = 1.f; \
            if (__builtin_amdgcn_ballot_w64(mx > m) != 0ull) ALX = __builtin_amdgcn_exp2f(m - MN); \
            m = MN; } while (0)
#define M2_PV_PART(vbo, X0, X1, ALX) do { float mn_; \
            SB_(); M2_PVG(vbo, 0); M2_PART_A(X0, X1, ALX, mn_); \
            SB_(); M2_PVG(vbo, 1); _Pragma("unroll") for (int r = 0; r < 16; ++r) X0[r] = __builtin_amdgcn_exp2f(X0[r] - mn_); \
            SB_(); M2_PVG(vbo, 2); _Pragma("unroll") for (int r = 0; r < 16; ++r) X1[r] = X1[r] - mn_; \
            SB_(); M2_PVG(vbo, 3); SB_(); } while (0)
#define M2_PART_ONLY(X0, X1, ALX) do { float mn_; M2_PART_A(X0, X1, ALX, mn_); \
            _Pragma("unroll") for (int r = 0; r < 16; ++r) { X0[r] = __builtin_amdgcn_exp2f(X0[r] - mn_); X1[r] = X1[r] - mn_; } } while (0)
#define M2_RESC(AL) do { if (__builtin_amdgcn_ballot_w64(AL != 1.f) != 0ull) { _Pragma("unroll") for (int d = 0; d < 4; ++d) o[d] = o[d] * AL; } } while (0)
#define M2_STEP(X0, X1, ALX, Y0, Y1, ALY, j) do { \
            M2_QK_FIN(X0, X1, (j) & 1, Y0, Y1, ALY); \
            if ((j) + 1 < NT) M2_LOAD((j) + 1); \
            M2_PV_PART(vr, X0, X1, ALX); \
            if ((j) + 1 < NT) M2_STORE(((j) + 1) & 1, vw); \
            M2_RESC(ALX); \
            vr = vr == 2 * VBYTES ? 0 : vr + VBYTES; vw = vw == 2 * VBYTES ? 0 : vw + VBYTES; \
            __syncthreads(); } while (0)
        M2_LOAD(0); M2_STORE(0, 0);
#pragma unroll
        for (int s = 0; s < NQR; ++s) asm volatile("" : "+v"(qf[s]));
        __syncthreads();
        M2_QK_ONLY(sA0, sA1, 0);
        M2_LOAD(1);
        M2_PART_ONLY(sA0, sA1, alA);
        M2_STORE(1, VBYTES);
        __syncthreads();
        int vr = 0, vw = 2 * VBYTES;
        for (int j = 1; j + 1 < NT; j += 2) {
            M2_STEP(sB0, sB1, alB, sA0, sA1, alA, j);
            M2_STEP(sA0, sA1, alA, sB0, sB1, alB, j + 1);
        }
        M2_STEP(sB0, sB1, alB, sA0, sA1, alA, NT - 1);
        M2_FIN_ONLY(sB0, sB1, alB);
        SB_(); M2_PVG(vr, 0); SB_(); M2_PVG(vr, 1); SB_(); M2_PVG(vr, 2); SB_(); M2_PVG(vr, 3); SB_();
        __syncthreads();
#undef M2_LOAD
#undef M2_STORE
        l += __shfl_xor(l, 32);
        const float inv = 1.f / l;
        int te = tid; asm volatile("" : "+v"(te));
        bf16_t* op = OB + (size_t)(b * SEQ + qt * 256 + wid * 32 + (te & 31)) * 2048 + h * 128 + 4 * ((te >> 5) & 1);
#pragma unroll
        for (int d = 0; d < 4; ++d)
#pragma unroll
            for (int g = 0; g < 4; ++g) {
                const f32x4 v = {o[d][4 * g] * inv, o[d][4 * g + 1] * inv, o[d][4 * g + 2] * inv, o[d][4 * g + 3] * inv};
                store_bf4(op + 32 * d + 8 * g, v);
            }
    }
}

__device__ __forceinline__ void na_flash(const Params& p, unsigned char* lds_) {
    int tid_ = threadIdx.x; asm volatile("" : "+v"(tid_)); const int tid = tid_, lane = tid & 63, wid = tid >> 6, r32 = lane & 31, hi = lane >> 5;
    constexpr int VP = 192, WB = 12800;
    LAS3 unsigned char* vl = (LAS3 unsigned char*)lds_ + wid * WB;
    LAS3 float* tbl = (LAS3 float*)(vl + 64 * VP);
    tbl[lane] = 0.f; tbl[lane + 64] = 0.f;
    const bf16_t* PL = (const bf16_t*)(p.ws + WS_PL); const bf16_t* PCx = (const bf16_t*)(p.ws + WS_PC);
    bf16_t* OA = (bf16_t*)(p.ws + WS_OA);
    const float* rpb = p.in[11];
    const int G = gridDim.x, vcu = (G % 8 == 0) ? (blockIdx.x % 8) * (G / 8) + blockIdx.x / 8 : blockIdx.x;
    const int vb = (4 * hi + ((lane & 15) >> 2)) * VP + (16 * ((lane >> 4) & 1) + 4 * (lane & 3)) * 2;
    constexpr float SC = NA_SCALE * LOG2E;
    for (int wu = vcu * NWAVES + wid; wu < NB * GROWS * 16 * 2; wu += G * NWAVES) {
        const int half = wu & 1, h = (wu >> 1) & 15, br = wu >> 5, r = br & 31, b = br >> 5;
        const int qc = 32 * half + r32;
        int w0 = qc - 8; w0 = w0 < 0 ? 0 : (w0 > GW - 16 ? GW - 16 : w0);
        int r0 = r - 4; r0 = r0 < 0 ? 0 : (r0 > GROWS - 8 ? GROWS - 8 : r0);
        const int qtok = b * SEQ + r * 64 + qc;
        bf16x8 qf[4];
#pragma unroll
        for (int s = 0; s < 4; ++s) qf[s] = *(const bf16x8*)(PL + (size_t)qtok * NP + PC_QA + h * 64 + 16 * s + 8 * hi);
        f32x16 o[2];
#pragma unroll
        for (int d = 0; d < 2; ++d)
#pragma unroll
            for (int e = 0; e < 16; ++e) o[d][e] = 0.f;
        float m = -1e30f, l = 0.f;
        bf16x8 kf[2][4]; u32x4 vg[8];
#define NA_LOAD(t, WHAT) do { const bf16_t* kb_; size_t pitch_; \
            if ((t) < 8) { kb_ = PL + (size_t)(b * SEQ + (r0 + (t)) * 64) * NP + PC_KA + h * 64; pitch_ = NP; } \
            else { kb_ = PCx + (size_t)(b * CTX + 64 * ((t) - 8)) * NPC + PC_KA + h * 64; pitch_ = NPC; } \
            if (WHAT & 1) { _Pragma("unroll") for (int kb = 0; kb < 2; ++kb) _Pragma("unroll") for (int s = 0; s < 4; ++s) kf[kb][s] = *(const bf16x8*)(kb_ + (size_t)(32 * kb + r32) * pitch_ + 16 * s + 8 * hi); } \
            if (WHAT & 2) { _Pragma("unroll") for (int i = 0; i < 8; ++i) vg[i] = *(const u32x4*)(kb_ + (size_t)((lane >> 3) + 8 * i) * pitch_ + 1024 + (lane & 7) * 8); } } while (0)
#define NA_STORE(t) do { _Pragma("unroll") for (int i = 0; i < 8; ++i) *(LAS3 u32x4*)(vl + ((lane >> 3) + 8 * i) * VP + (lane & 7) * 16) = vg[i]; \
            if ((t) < 8 && lane < 31) tbl[48 + lane] = rpb[(h * 15 + (r0 + (t) - r + 7)) * 31 + lane] * LOG2E; } while (0)
        NA_LOAD(0, 3); NA_STORE(0);
#pragma nounroll
        for (int t = 0; t < 12; ++t) {
            f32x16 s0, s1;
#pragma unroll
            for (int e = 0; e < 16; ++e) { s0[e] = 0.f; s1[e] = 0.f; }
#pragma unroll
            for (int s = 0; s < 4; ++s) {
                s0 = __builtin_amdgcn_mfma_f32_32x32x16_bf16(kf[0][s], qf[s], s0, 0, 0, 0);
                s1 = __builtin_amdgcn_mfma_f32_32x32x16_bf16(kf[1][s], qf[s], s1, 0, 0, 0);
            }
            __builtin_amdgcn_sched_barrier(0);
            if (t + 1 < 12) NA_LOAD(t + 1, 1);
            __builtin_amdgcn_sched_barrier(0);
            if (t < 8) {
                int w0v = w0 - 4 * hi, tb = 4 * hi - qc + 63; asm volatile("" : "+v"(w0v), "+v"(tb));
                const LAS3 float* tp = tbl + tb;
#pragma unroll
                for (int e = 0; e < 16; ++e) {
                    const int c0 = (e & 3) + 8 * (e >> 2), c1 = c0 + 32;
                    const bool ok0 = (unsigned)(c0 - w0v) < 16u, ok1 = (unsigned)(c1 - w0v) < 16u;
                    const float v0 = s0[e] * SC + tp[c0], v1 = s1[e] * SC + tp[c1];
                    s0[e] = ok0 ? v0 : -1e30f;
                    s1[e] = ok1 ? v1 : -1e30f;
                }
            } else {
#pragma unroll
                for (int e = 0; e < 16; ++e) { s0[e] *= SC; s1[e] *= SC; }
            }
            float mx = fmaxf(max16(s0), max16(s1));
            mx = fmaxf(mx, __shfl_xor(mx, 32));
            const float mn = fmaxf(m, mx), alpha = __builtin_amdgcn_exp2f(m - mn);
            m = mn; l *= alpha;
            o[0] = o[0] * alpha; o[1] = o[1] * alpha;
            float rs = 0.f;
#pragma unroll
            for (int e = 0; e < 16; ++e) { s0[e] = __builtin_amdgcn_exp2f(s0[e] - mn); s1[e] = __builtin_amdgcn_exp2f(s1[e] - mn); rs += s0[e] + s1[e]; }
            l += rs;
            __builtin_amdgcn_sched_barrier(0);
            if (t + 1 < 12) NA_LOAD(t + 1, 2);
            bf16x8 pf[4];
            pf[0] = pfrag(s0, 0); pf[1] = pfrag(s0, 1); pf[2] = pfrag(s1, 0); pf[3] = pfrag(s1, 1);
            const LAS3 unsigned char* va = vl + vb;
#pragma unroll
            for (int ks = 0; ks < 4; ++ks)
#pragma unroll
                for (int d = 0; d < 2; ++d) {
                    const s16x4 lo = vtr(va + (16 * ks) * VP + 64 * d), hh = vtr(va + (16 * ks + 8) * VP + 64 * d);
                    const bf16x8 vf = {lo[0], lo[1], lo[2], lo[3], hh[0], hh[1], hh[2], hh[3]};
                    o[d] = __builtin_amdgcn_mfma_f32_32x32x16_bf16(vf, pf[ks], o[d], 0, 0, 0);
                }
            __builtin_amdgcn_sched_barrier(0);
            if (t + 1 < 12) NA_STORE(t + 1);
        }
#undef NA_LOAD
#undef NA_STORE
        l += __shfl_xor(l, 32);
        const float inv = 1.f / l;
        bf16_t* op = OA + (size_t)qtok * 2048 + h * 64 + 4 * hi;
#pragma unroll
        for (int d = 0; d < 2; ++d)
#pragma unroll
            for (int g = 0; g < 4; ++g) {
                const f32x4 v = {o[d][4 * g] * inv, o[d][4 * g + 1] * inv, o[d][4 * g + 2] * inv, o[d][4 * g + 3] * inv};
                store_bf4(op + 32 * d + 8 * g, v);
            }
    }
}


template <bool LAT, int HALF>
__device__ __forceinline__ void na_tile(const LAS3 unsigned char* Kb, const LAS3 unsigned char* Vb, const LAS3 float* tbl, const bf16x8 (&qf)[4], f32x16 (&o)[2], float& m, float& l,
                                        int r32, int hi, int qc, int w0, int vb) {
    constexpr int KP = 144, VP = 192;
    constexpr float SC = NA_SCALE * LOG2E;
    constexpr int L0 = (LAT && HALF == 1) ? 12 : 0;
    constexpr int H1 = (LAT && HALF == 0) ? 4 : 16;
    f32x16 s0, s1;
#pragma unroll
    for (int e = 0; e < 16; ++e) { s0[e] = 0.f; s1[e] = 0.f; }
    const LAS3 unsigned char* ka = Kb + r32 * KP + 16 * hi;
#pragma unroll
    for (int s = 0; s < 4; ++s) {
        const bf16x8 a0 = *(const LAS3 bf16x8*)(ka + 32 * s), a1 = *(const LAS3 bf16x8*)(ka + 32 * KP + 32 * s);
        s0 = __builtin_amdgcn_mfma_f32_32x32x16_bf16(a0, qf[s], s0, 0, 0, 0);
        s1 = __builtin_amdgcn_mfma_f32_32x32x16_bf16(a1, qf[s], s1, 0, 0, 0);
    }
    if constexpr (LAT) {
        int w0v = w0 - 4 * hi, tb = 4 * hi - qc + 63; asm volatile("" : "+v"(w0v), "+v"(tb));
        const LAS3 float* tp = tbl + tb;
#pragma unroll
        for (int e = 0; e < 16; ++e) {
            const int c0 = (e & 3) + 8 * (e >> 2), c1 = c0 + 32;
            if (e >= L0) { const float p0 = (float)((unsigned)(c0 - w0v) & 0xFFFFFFF0u); s0[e] = fmaf(p0, -1e28f, fmaf(s0[e], SC, tp[c0])); }
            if (e < H1) { const float p1 = (float)((unsigned)(c1 - w0v) & 0xFFFFFFF0u); s1[e] = fmaf(p1, -1e28f, fmaf(s1[e], SC, tp[c1])); }
        }
    } else {
#pragma unroll
        for (int e = 0; e < 16; ++e) { s0[e] *= SC; s1[e] *= SC; }
    }
    float mx = -1e30f;
#pragma unroll
    for (int e = 0; e < 16; ++e) { if (e >= L0) mx = fmaxf(mx, s0[e]); if (e < H1) mx = fmaxf(mx, s1[e]); }
    mx = fmaxf(mx, __shfl_xor(mx, 32));
    const float mn = fmaxf(m, mx);
    if (__builtin_amdgcn_ballot_w64(mx > m) != 0ull) {
        const float alpha = __builtin_amdgcn_exp2f(m - mn);
        l *= alpha; o[0] = o[0] * alpha; o[1] = o[1] * alpha;
    }
    m = mn;
    float rs = 0.f;
#pragma unroll
    for (int e = 0; e < 16; ++e) {
        if (e >= L0) { s0[e] = __builtin_amdgcn_exp2f(s0[e] - mn); rs += s0[e]; } else s0[e] = 0.f;
        if (e < H1) { s1[e] = __builtin_amdgcn_exp2f(s1[e] - mn); rs += s1[e]; } else s1[e] = 0.f;
    }
    l += rs;
    bf16x8 pf[4];
    pf[0] = pfrag(s0, 0); pf[1] = pfrag(s0, 1); pf[2] = pfrag(s1, 0); pf[3] = pfrag(s1, 1);
    const LAS3 unsigned char* va = Vb + vb;
#pragma unroll
    for (int ks = 0; ks < 4; ++ks) {
        if (LAT && ((HALF == 0 && ks == 3) || (HALF == 1 && ks == 0))) continue;
#pragma unroll
        for (int d = 0; d < 2; ++d) {
            const s16x4 lo = vtr(va + (16 * ks) * VP + 64 * d), hh = vtr(va + (16 * ks + 8) * VP + 64 * d);
            const bf16x8 vf = {lo[0], lo[1], lo[2], lo[3], hh[0], hh[1], hh[2], hh[3]};
            o[d] = __builtin_amdgcn_mfma_f32_32x32x16_bf16(vf, pf[ks], o[d], 0, 0, 0);
        }
    }
}
__device__ __forceinline__ void na_coop(const Params& p, unsigned char* lds_) {
    int tid_ = threadIdx.x; asm volatile("" : "+v"(tid_)); const int tid = tid_, lane = tid & 63, wid = tid >> 6, r32 = lane & 31, hi = lane >> 5;
    constexpr int KP = 144, VP = 192, KT = 64 * KP, VT = 64 * VP, STG = KT + VT;
    LAS3 unsigned char* lds = (LAS3 unsigned char*)lds_;
    LAS3 float* tbl = (LAS3 float*)(lds + 2 * STG) + wid * 128;
    tbl[lane] = 0.f; tbl[lane + 64] = 0.f;
    const bf16_t* PL = (const bf16_t*)(p.ws + WS_PL); const bf16_t* PCx = (const bf16_t*)(p.ws + WS_PC);
    bf16_t* OA = (bf16_t*)(p.ws + WS_OA);
    const float* rpb = p.in[11];
    const int G = gridDim.x, vcu = (G % 8 == 0) ? (blockIdx.x % 8) * (G / 8) + blockIdx.x / 8 : blockIdx.x;
    const int vb = (4 * hi + ((lane & 15) >> 2)) * VP + (16 * ((lane >> 4) & 1) + 4 * (lane & 3)) * 2;
    const int half = wid & 1, rw = wid >> 1, skey = tid >> 3, spc = tid & 7;
    constexpr float SC = NA_SCALE * LOG2E;
    for (int unit = vcu; unit < NB * 16 * (GROWS / 4); unit += G) {
        const int rg = unit & 7, h = (unit >> 3) & 15, b = unit >> 7;
        const int R = rg * 4, r = R + rw;
        int r0w = r - 4; r0w = r0w < 0 ? 0 : (r0w > GROWS - 8 ? GROWS - 8 : r0w);
        int kr_lo = R - 4; kr_lo = kr_lo < 0 ? 0 : (kr_lo > GROWS - 8 ? GROWS - 8 : kr_lo);
        int kr_hi = R - 1; kr_hi = (kr_hi < 0 ? 0 : (kr_hi > GROWS - 8 ? GROWS - 8 : kr_hi)) + 7;
        const int nlat = kr_hi - kr_lo + 1, NT = nlat + 4;
        const int qc = 32 * half + r32;
        int w0 = qc - 8; w0 = w0 < 0 ? 0 : (w0 > GW - 16 ? GW - 16 : w0);
        const int qtok = b * SEQ + r * 64 + qc;
        bf16x8 qf[4];
#pragma unroll
        for (int s = 0; s < 4; ++s) qf[s] = *(const bf16x8*)(PL + (size_t)qtok * NP + PC_QA + h * 64 + 16 * s + 8 * hi);
        f32x16 o[2];
#pragma unroll
        for (int d = 0; d < 2; ++d)
#pragma unroll
            for (int e = 0; e < 16; ++e) o[d][e] = 0.f;
        float m = -1e30f, l = 0.f;
        float brow[8];
#pragma unroll
        for (int i = 0; i < 8; ++i) brow[i] = lane < 31 ? rpb[(h * 15 + (r0w - r + 7 + i)) * 31 + lane] * LOG2E : 0.f;
        u32x4 gk, gv;
#define NC_LOAD(t) do { const bf16_t* kp_ = (t) < nlat ? PL + (size_t)(b * SEQ + (kr_lo + (t)) * 64 + skey) * NP + PC_KA + h * 64 + spc * 8 \
                                                      : PCx + (size_t)(b * CTX + 64 * ((t) - nlat) + skey) * NPC + PC_KA + h * 64 + spc * 8; \
            gk = *(const u32x4*)kp_; gv = *(const u32x4*)(kp_ + 1024); } while (0)
#define NC_STORE(buf) do { *(LAS3 u32x4*)(lds + (buf) * STG + skey * KP + spc * 16) = gk; *(LAS3 u32x4*)(lds + (buf) * STG + KT + skey * VP + spc * 16) = gv; } while (0)
        __syncthreads();
        NC_LOAD(0); NC_STORE(0);
#pragma unroll
        for (int s = 0; s < 4; ++s) asm volatile("" : "+v"(qf[s]));
#pragma unroll
        for (int i = 0; i < 8; ++i) asm volatile("" : "+v"(brow[i]));
        __syncthreads();
#pragma nounroll
        for (int t = 0; t < NT; ++t) {
            const int cur = t & 1;
            if (t + 1 < NT) NC_LOAD(t + 1);
            const bool lat = t < nlat; const int kr = kr_lo + t;
            if (!lat || (kr >= r0w && kr < r0w + 8)) {
                const LAS3 unsigned char* Kb = lds + cur * STG; const LAS3 unsigned char* Vb = Kb + KT;
                if (lat) { const int bi_ = kr - r0w; float bv = brow[0];
#pragma unroll
                    for (int i = 1; i < 8; ++i) bv = bi_ == i ? brow[i] : bv;
                    if (lane < 31) tbl[48 + lane] = bv; }
                if (!lat) na_tile<false, 0>(Kb, Vb, tbl, qf, o, m, l, r32, hi, qc, w0, vb);
                else if (half == 0) na_tile<true, 0>(Kb, Vb, tbl, qf, o, m, l, r32, hi, qc, w0, vb);
                else na_tile<true, 1>(Kb, Vb, tbl, qf, o, m, l, r32, hi, qc, w0, vb);
            }
            if (t + 1 < NT) NC_STORE(cur ^ 1);
            __syncthreads();
        }
#undef NC_LOAD
#undef NC_STORE
        l += __shfl_xor(l, 32);
        const float inv = 1.f / l;
        bf16_t* op = OA + (size_t)qtok * 2048 + h * 64 + 4 * hi;
#pragma unroll
        for (int d = 0; d < 2; ++d)
#pragma unroll
            for (int g = 0; g < 4; ++g) {
                const f32x4 v = {o[d][4 * g] * inv, o[d][4 * g + 1] * inv, o[d][4 * g + 2] * inv, o[d][4 * g + 3] * inv};
                store_bf4(op + 32 * d + 8 * g, v);
            }
    }
}

__device__ __forceinline__ void phase7(const Params& p) {
    int tid_ = threadIdx.x; asm volatile("" : "+v"(tid_)); const int tid = tid_, lane = tid & 63, wid = tid >> 6;
    const int gw = blockIdx.x * NWAVES + wid, NGW = gridDim.x * NWAVES;
    const float* mod = (const float*)(p.ws + WS_MOD);
    const bf16_t* Z = (const bf16_t*)(p.ws + WS_Z); bf16_t* H = (bf16_t*)(p.ws + WS_H);
    const float* gpm = p.in[7]; const float* gpf = p.in[8];
    const int per = (TL + NGW - 1) / NGW;
    int curb = -1; f32x4 A[8], B[8], C[8];
    for (int i = 0; i < per; ++i) {
        const int m = gw * per + i; if (m >= TL) break;
        const int b = m / SEQ;
        if (b != curb) { curb = b; const float* mb = mod + (size_t)b * 12288;
#pragma unroll
            for (int j = 0; j < 8; ++j) { const int c = j * 256 + lane * 4;
                A[j] = *(const f32x4*)(mb + 4096 + c) * *(const f32x4*)(gpm + c); B[j] = *(const f32x4*)(gpf + c) * (*(const f32x4*)(mb + 8192 + c) + 1.f); C[j] = *(const f32x4*)(mb + 6144 + c); } }
        f32x4 z[8]; float ss = 0.f;
#pragma unroll
        for (int j = 0; j < 8; ++j) {
            const u32x2 w = *(const u32x2*)(Z + (size_t)m * DM + j * 256 + lane * 4);
            z[j] = (f32x4){__uint_as_float(w.x << 16), __uint_as_float(w.x & 0xffff0000u), __uint_as_float(w.y << 16), __uint_as_float(w.y & 0xffff0000u)};
            ss += z[j][0] * z[j][0] + z[j][1] * z[j][1] + z[j][2] * z[j][2] + z[j][3] * z[j][3];
        }
        f32x4 xv[8];
#pragma unroll
        for (int j = 0; j < 8; ++j) xv[j] = *(const f32x4*)(p.in[0] + (size_t)m * DM + j * 256 + lane * 4);
        const float rz = rsqrtf(wave_sum_dpp(ss) * (1.f / DM) + EPS);
        float s2 = 0.f;
#pragma unroll
        for (int j = 0; j < 8; ++j) {
            const f32x4 x1 = xv[j] + (z[j] * rz) * A[j];
            store_bf4((bf16_t*)(p.ws + WS_Z) + (size_t)m * DM + j * 256 + lane * 4, x1);
            z[j] = x1; s2 += x1[0] * x1[0] + x1[1] * x1[1] + x1[2] * x1[2] + x1[3] * x1[3];
        }
        const float rx = rsqrtf(wave_sum_dpp(s2) * (1.f / DM) + EPS);
        float hmx = 0.f;
#pragma unroll
        for (int j = 0; j < 8; ++j) { z[j] = (z[j] * rx) * B[j] + C[j]; if (!PEERQ_I8) store_bf4(H + (size_t)m * DM + j * 256 + lane * 4, z[j]);
            hmx = fmaxf(hmx, fmaxf(fmaxf(fabsf(z[j][0]), fabsf(z[j][1])), fmaxf(fabsf(z[j][2]), fabsf(z[j][3])))); }
        {
            hmx = fmaxf(wave_max(hmx), 1e-30f);
            const float qi = 127.f / hmx;
#pragma unroll
            for (int j = 0; j < 8; ++j) {
                const int q0 = (int)rintf(z[j][0] * qi), q1 = (int)rintf(z[j][1] * qi), q2 = (int)rintf(z[j][2] * qi), q3 = (int)rintf(z[j][3] * qi);
                *(unsigned*)(p.ws + WS_H8P + (size_t)m * DM + j * 256 + lane * 4) = ((unsigned)q0 & 0xffu) | (((unsigned)q1 & 0xffu) << 8) | (((unsigned)q2 & 0xffu) << 16) | (((unsigned)q3 & 0xffu) << 24);
            }
            if (lane == 0) ((float*)(p.ws + WS_HSP))[m] = hmx * (1.f / 127.f);
        }
    }
    quant_rows_s8((const bf16_t*)(p.ws + WS_WPQ), DM, p.ws + WS_WG8, (float*)(p.ws + WS_WGS), gw, NGW, lane);
}

template <int NPER>
__device__ __forceinline__ void wave_top16(float (&v)[NPER], const int (&idx)[NPER], float& outv, int& outi, int lane) {
    outv = -INFINITY; outi = 0;
#pragma nounroll
    for (int r = 0; r < 16; ++r) {
        float bv = v[0]; int bi = idx[0];
#pragma unroll
        for (int e = 1; e < NPER; ++e) if (v[e] > bv || (v[e] == bv && idx[e] < bi)) { bv = v[e]; bi = idx[e]; }
#pragma unroll
        for (int o = 32; o >= 1; o >>= 1) {
            const float ov = __shfl_xor(bv, o); const int oi = __shfl_xor(bi, o);
            if (ov > bv || (ov == bv && oi < bi)) { bv = ov; bi = oi; }
        }
#pragma unroll
        for (int e = 0; e < NPER; ++e) if (idx[e] == bi) v[e] = -INFINITY;
        if (lane == r) { outv = bv; outi = bi; }
    }
}

__device__ __forceinline__ void peer_topk_naive(const Params& p, unsigned char* lds) {
    int tid_ = threadIdx.x; asm volatile("" : "+v"(tid_)); const int tid = tid_, lane = tid & 63, wid = tid >> 6;
    const int gw = blockIdx.x * NWAVES + wid, NGW = gridDim.x * NWAVES;
    const bf16_t* QP = (const bf16_t*)(p.ws + WS_QP); const bf16_t* SK = (const bf16_t*)(p.ws + WS_SUBK);
    float* TKV = (float*)(p.ws + WS_TKV); int* TKI = (int*)(p.ws + WS_TKI);
    float* qs = (float*)lds + wid * 128;
    for (int it = gw; it < TL * 16; it += NGW) {
        const int hp = it & 15, m = it >> 4;
        qs[lane] = bf2f(QP[(size_t)m * DM + hp * 128 + lane]); qs[lane + 64] = bf2f(QP[(size_t)m * DM + hp * 128 + 64 + lane]);
        __builtin_amdgcn_s_waitcnt(0xc07f); asm volatile("" ::: "memory");
        float v[2]; int idx[2];
#pragma unroll
        for (int i = 0; i < 2; ++i) {
            const int n = lane + 64 * i; const bf16_t* kp = SK + (size_t)(hp * 128 + n) * 128;
            float d = 0.f;
#pragma unroll
            for (int e = 0; e < 16; ++e) d += dot_bf16x8(*(const bf16x8*)(kp + e * 8), qs + e * 8);
            v[i] = d; idx[i] = n;
        }
        float ov; int oi; wave_top16<2>(v, idx, ov, oi, lane);
        if (lane < 16) { TKV[(size_t)it * 16 + lane] = ov; TKI[(size_t)it * 16 + lane] = oi; }
        __builtin_amdgcn_s_waitcnt(0xc07f); asm volatile("" ::: "memory");
    }
}

__device__ __forceinline__ void peer_final_naive(const Params& p, unsigned char* lds) {
    int tid_ = threadIdx.x; asm volatile("" : "+v"(tid_)); const int tid = tid_, lane = tid & 63, wid = tid >> 6;
    const float* TKV = (const float*)(p.ws + WS_TKV); const int* TKI = (const int*)(p.ws + WS_TKI);
    const bf16_t* H = (const bf16_t*)(p.ws + WS_H);
    const float* U = p.in[21]; const float* V = p.in[22];
    const float* mod = (const float*)(p.ws + WS_MOD); const float* gpo = p.in[9];
    float* part = (float*)lds;
    float* red = part + 8 * 2048;
    for (int m = blockIdx.x; m < TL; m += gridDim.x) {
        const int b = m / SEQ, h = wid;
        const float* v1 = TKV + ((size_t)m * 16 + h * 2) * 16; const float* v2 = v1 + 16;
        const int* i1 = TKI + ((size_t)m * 16 + h * 2) * 16; const int* i2 = i1 + 16;
        float cv[4]; int ci[4];
        const float v2j = v2[lane & 15];
#pragma unroll
        for (int e = 0; e < 4; ++e) { const int i = (lane >> 4) + 4 * e; cv[e] = v1[i] + v2j; ci[e] = i * 16 + (lane & 15); }
        float tv; int tc; wave_top16<4>(cv, ci, tv, tc, lane);
        int eid = 0; float gate = 0.f;
        if (lane < 16) eid = i1[tc >> 4] * 128 + i2[tc & 15];
        const float mx = __shfl(tv, 0);
        const float ex = lane < 16 ? __expf(tv - mx) : 0.f;
        gate = ex / wave_sum(ex);
        f32x4 hv[8];
#pragma unroll
        for (int j = 0; j < 8; ++j) { const u32x2 w = *(const u32x2*)(H + (size_t)m * DM + j * 256 + lane * 4);
            hv[j] = (f32x4){__uint_as_float(w.x << 16), __uint_as_float(w.x & 0xffff0000u), __uint_as_float(w.y << 16), __uint_as_float(w.y & 0xffff0000u)}; }
        f32x4 acc[8];
#pragma unroll
        for (int j = 0; j < 8; ++j) acc[j] = (f32x4){0.f, 0.f, 0.f, 0.f};
        for (int k = 0; k < 16; ++k) {
            const int e = __shfl(eid, k); const float g = __shfl(gate, k);
#ifdef PEER_NAIVE_BF16
            const bf16_t* ur = (const bf16_t*)(p.ws + WS_UB) + (size_t)e * DM + lane * 4; const bf16_t* vr = (const bf16_t*)(p.ws + WS_VB) + (size_t)e * DM + lane * 4;
            float d = 0.f;
#pragma unroll
            for (int j = 0; j < 8; ++j) { const u32x2 w = *(const u32x2*)(ur + j * 256); const f32x4 u = {__uint_as_float(w.x << 16), __uint_as_float(w.x & 0xffff0000u), __uint_as_float(w.y << 16), __uint_as_float(w.y & 0xffff0000u)};
                d += u[0] * hv[j][0] + u[1] * hv[j][1] + u[2] * hv[j][2] + u[3] * hv[j][3]; }
            d = wave_sum(d);
            const float coef = g * gelu_as(d);
#pragma unroll
            for (int j = 0; j < 8; ++j) { const u32x2 w = *(const u32x2*)(vr + j * 256); const f32x4 vv = {__uint_as_float(w.x << 16), __uint_as_float(w.x & 0xffff0000u), __uint_as_float(w.y << 16), __uint_as_float(w.y & 0xffff0000u)};
                acc[j] += vv * coef; }
#else
            const float* ur = U + (size_t)e * DM + lane * 4; const float* vr = V + (size_t)e * DM + lane * 4;
            float d = 0.f;
#pragma unroll
            for (int j = 0; j < 8; ++j) { const f32x4 u = *(const f32x4*)(ur + j * 256); d += u[0] * hv[j][0] + u[1] * hv[j][1] + u[2] * hv[j][2] + u[3] * hv[j][3]; }
            d = wave_sum(d);
            const float coef = g * gelu_erf(d);
#pragma unroll
            for (int j = 0; j < 8; ++j) acc[j] += *(const f32x4*)(vr + j * 256) * coef;
#endif
        }
        __syncthreads();
#pragma unroll
        for (int j = 0; j < 8; ++j) *(f32x4*)(part + wid * 2048 + j * 256 + lane * 4) = acc[j];
        __syncthreads();
        f32x4 y = (f32x4){0.f, 0.f, 0.f, 0.f};
#pragma unroll
        for (int w = 0; w < 8; ++w) y += *(const f32x4*)(part + w * 2048 + tid * 4);
        float ss = wave_sum(y[0] * y[0] + y[1] * y[1] + y[2] * y[2] + y[3] * y[3]);
        if (lane == 0) red[wid] = ss;
        __syncthreads();
        float tot = 0.f;
#pragma unroll
        for (int w = 0; w < 8; ++w) tot += red[w];
        const float rstd = rsqrtf(tot * (1.f / DM) + EPS);
        const int c = tid * 4;
        const f32x4 gt2 = *(const f32x4*)(mod + (size_t)b * 12288 + 10240 + c);
        float* op = p.out + (size_t)m * DM + c;
        const f32x4 x1 = *(const f32x4*)op;
        *(f32x4*)op = x1 + gt2 * (y * rstd * *(const f32x4*)(gpo + c));
    }
}


__device__ __forceinline__ void peer_topk_mfma(const Params& p, unsigned char* lds_) {
    int tid_ = threadIdx.x; asm volatile("" : "+v"(tid_)); const int tid = tid_, lane = tid & 63, wid = tid >> 6, r32 = lane & 31, hi = lane >> 5;
    LAS3 unsigned char* lds = (LAS3 unsigned char*)lds_;
    constexpr int SP = 272;
    const bf16_t* QP = (const bf16_t*)(p.ws + WS_QP); const bf16_t* SK = (const bf16_t*)(p.ws + WS_SUBK);
    float* TKV = (float*)(p.ws + WS_TKV); int* TKI = (int*)(p.ws + WS_TKI);
    for (int bi = blockIdx.x; bi < 256; bi += gridDim.x) {
        const int hp = bi & 15, sub = bi >> 4;
        __syncthreads();
        for (int c = tid; c < 2048; c += NTHREADS) { const int row = c >> 4, pc = c & 15;
            *(LAS3 u32x4*)(lds + row * SP + pc * 16) = *(const u32x4*)(SK + ((size_t)hp * 128 + row) * 128 + pc * 8); }
        __syncthreads();
        for (int g = wid; g < 32; g += NWAVES) {
            const int tok = (sub * 32 + g) * 32 + r32;
            bf16x8 qf[8];
#pragma unroll
            for (int s = 0; s < 8; ++s) qf[s] = *(const bf16x8*)(QP + (size_t)tok * DM + hp * 128 + 16 * s + 8 * hi);
            f32x16 sc[4];
#pragma unroll
            for (int kb = 0; kb < 4; ++kb) {
#pragma unroll
                for (int e = 0; e < 16; ++e) sc[kb][e] = 0.f;
#pragma unroll
                for (int s = 0; s < 8; ++s) {
                    const bf16x8 a = *(const LAS3 bf16x8*)(lds + (32 * kb + r32) * SP + 32 * s + 16 * hi);
                    sc[kb] = __builtin_amdgcn_mfma_f32_32x32x16_bf16(a, qf[s], sc[kb], 0, 0, 0);
                }
            }
#pragma unroll
            for (int kb = 0; kb < 4; ++kb)
#pragma unroll
                for (int e = 0; e < 16; ++e) {
                    const unsigned key = 32 * kb + (e & 3) + 8 * (e >> 2) + 4 * hi;
                    sc[kb][e] = __uint_as_float((__float_as_uint(sc[kb][e]) & 0xFFFFFF80u) | key);
                }
            float ov[16];
#pragma unroll
            for (int r = 0; r < 16; ++r) {
                float mx = -INFINITY;
#pragma unroll
                for (int kb = 0; kb < 4; ++kb) mx = fmaxf(mx, max16(sc[kb]));
                const float w = fmaxf(mx, __shfl_xor(mx, 32));
                ov[r] = w;
#pragma unroll
                for (int kb = 0; kb < 4; ++kb)
#pragma unroll
                    for (int e = 0; e < 16; ++e) sc[kb][e] = sc[kb][e] == w ? -INFINITY : sc[kb][e];
            }
            if (hi == 0) {
                float* vp = TKV + ((size_t)tok * 16 + hp) * 16; int* ip = TKI + ((size_t)tok * 16 + hp) * 16;
#pragma unroll
                for (int q = 0; q < 4; ++q) {
                    f32x4 vv; u32x4 ii;
#pragma unroll
                    for (int e = 0; e < 4; ++e) { const unsigned u = __float_as_uint(ov[4 * q + e]); vv[e] = __uint_as_float(u & 0xFFFFFF80u); ii[e] = u & 127u; }
                    *(f32x4*)(vp + 4 * q) = vv; *(u32x4*)(ip + 4 * q) = ii;
                }
            }
        }
    }
}


constexpr int cand_jmax(int i) { return 16 / (i + 1); }
constexpr int cand_off(int i) { int t = 0; for (int k = 0; k < i; ++k) t += 16 / (k + 1); return t; }
static_assert(cand_off(16) == 50, "candidate count");
template <int N> __device__ __forceinline__ void bitonic_sort_desc(float (&a)[N]) {
#pragma unroll
    for (int k = 2; k <= N; k <<= 1)
#pragma unroll
        for (int j = k >> 1; j > 0; j >>= 1)
#pragma unroll
            for (int i = 0; i < N; ++i) { const int l = i ^ j; if (l > i) { const bool up = (i & k) == 0; const float x = a[i], y = a[l];
                a[i] = up ? fmaxf(x, y) : fminf(x, y); a[l] = up ? fminf(x, y) : fmaxf(x, y); } }
}
template <int N> __device__ __forceinline__ void bitonic_merge_desc(float (&a)[N]) {
#pragma unroll
    for (int j = N >> 1; j > 0; j >>= 1)
#pragma unroll
        for (int i = 0; i < N; ++i) { const int l = i ^ j; if (l > i) { const float x = a[i], y = a[l]; a[i] = fmaxf(x, y); a[l] = fminf(x, y); } }
}
__device__ __forceinline__ void top16_merge(float (&a)[16], const float (&b)[16]) {
#pragma unroll
    for (int i = 0; i < 16; ++i) a[i] = fmaxf(a[i], b[15 - i]);
    bitonic_merge_desc<16>(a);
}
__device__ __forceinline__ void top16_of_64(float (&g0)[16], float (&g1)[16], float (&g2)[16], float (&g3)[16]) {
    bitonic_sort_desc<16>(g0); bitonic_sort_desc<16>(g1); bitonic_sort_desc<16>(g2); bitonic_sort_desc<16>(g3);
    top16_merge(g0, g1); top16_merge(g2, g3); top16_merge(g0, g2);
}
__device__ __forceinline__ void topk_stage1(const LAS3 unsigned char* skl, const bf16_t* __restrict__ qrow, int r32, int hi, float (&ov)[16]) {
    constexpr int SP = 272;
    bf16x8 qf[8];
#pragma unroll
    for (int s = 0; s < 8; ++s) qf[s] = *(const bf16x8*)(qrow + 16 * s + 8 * hi);
    f32x16 sc[4];
#pragma unroll
    for (int kb = 0; kb < 4; ++kb) {
#pragma unroll
        for (int e = 0; e < 16; ++e) sc[kb][e] = 0.f;
#pragma unroll
        for (int s = 0; s < 8; ++s) {
            const bf16x8 a = *(const LAS3 bf16x8*)(skl + (32 * kb + r32) * SP + 32 * s + 16 * hi);
            sc[kb] = __builtin_amdgcn_mfma_f32_32x32x16_bf16(a, qf[s], sc[kb], 0, 0, 0);
        }
    }
    float g1[16], g2[16], g3[16];
#pragma unroll
    for (int e = 0; e < 16; ++e) {
        const unsigned key = (e & 3) + 8 * (e >> 2) + 4 * hi;
        ov[e] = __uint_as_float((__float_as_uint(sc[0][e]) & 0xFFFFFF80u) | key);
        g1[e] = __uint_as_float((__float_as_uint(sc[1][e]) & 0xFFFFFF80u) | (key + 32u));
        g2[e] = __uint_as_float((__float_as_uint(sc[2][e]) & 0xFFFFFF80u) | (key + 64u));
        g3[e] = __uint_as_float((__float_as_uint(sc[3][e]) & 0xFFFFFF80u) | (key + 96u));
    }
    top16_of_64(ov, g1, g2, g3);
    float pb[16];
#pragma unroll
    for (int e = 0; e < 16; ++e) pb[e] = __shfl_xor(ov[e], 32);
    top16_merge(ov, pb);
}
__device__ __forceinline__ void peer_tables_q8(const Params& p, int gw, int NGW, int lane);
__device__ __forceinline__ void peer_select_mfma(const Params& p, unsigned char* lds_, int mode = 0) {
    int tid_ = threadIdx.x; asm volatile("" : "+v"(tid_)); const int tid = tid_, lane = tid & 63, wid = tid >> 6, r32 = lane & 31, hi = lane >> 5;
    LAS3 unsigned char* lds = (LAS3 unsigned char*)lds_;
    constexpr int SP = 272;
    LAS3 unsigned* ktab = (LAS3 unsigned*)(lds + 256 * SP) + wid * 2048 + lane;
    const bf16_t* QP = (const bf16_t*)(p.ws + WS_QP); const bf16_t* SK = (const bf16_t*)(p.ws + WS_SUBK);
    int* SE = (int*)(p.ws + WS_TKI); float* SG = (float*)(p.ws + WS_TKV);
    for (int bi = blockIdx.x; bi < 256; bi += gridDim.x) {
        const int h = bi & 7, sub = bi >> 3;
        __syncthreads();
        for (int c = tid; c < 4096; c += NTHREADS) { const int row = c >> 4, pc = c & 15;
            *(LAS3 u32x4*)(lds + row * SP + pc * 16) = *(const u32x4*)(SK + ((size_t)h * 256 + row) * 128 + pc * 8); }
        __syncthreads();
#ifdef SEL_SPLIT
        if (wid >= 4) { if (bi == (int)blockIdx.x && mode != 1) peer_tables_q8(p, blockIdx.x * 4 + (wid - 4), gridDim.x * 4, lane); continue; }
        if (mode == 2) continue;
        for (int g = wid; g < 16; g += 4) {
#else
        if (mode == 2) continue;
        for (int g = wid; g < 16; g += NWAVES) {
#endif
            const int tok = (sub * 16 + g) * 32 + r32;
            float ov0[16], ov1[16];
            int lo0 = 0, lo1 = 128 * SP; asm volatile("" : "+v"(lo0), "+v"(lo1));
            topk_stage1(lds + lo0, QP + (size_t)tok * DM + h * 256, r32, hi, ov0);
            topk_stage1(lds + lo1, QP + (size_t)tok * DM + h * 256 + 128, r32, hi, ov1);
#pragma unroll
            for (int q = 0; q < 16; ++q) { ktab[q * 64] = __float_as_uint(ov0[q]) & 127u; ktab[(16 + q) * 64] = __float_as_uint(ov1[q]) & 127u; }
            float c0[16], c1[16], c2[16], c3[16];
#pragma unroll
            for (int e = 0; e < 16; ++e) { c0[e] = -INFINITY; c1[e] = -INFINITY; c2[e] = -INFINITY; c3[e] = -INFINITY; }
#pragma unroll
            for (int i = 0; i < 16; ++i) {
                const float a = __uint_as_float(__float_as_uint(ov0[i]) & 0xFFFFFF80u);
#pragma unroll
                for (int j = 0; j < 16; ++j) if (j < cand_jmax(i)) {
                    const float bb = __uint_as_float(__float_as_uint(ov1[j]) & 0xFFFFFF80u);
                    const float cv = __uint_as_float((__float_as_uint(a + bb) & 0xFFFFFF00u) | (unsigned)(i * 16 + j));
                    const int n = cand_off(i) + j;
                    if (n < 16) c0[n & 15] = cv; else if (n < 32) c1[n & 15] = cv; else if (n < 48) c2[n & 15] = cv; else c3[n & 15] = cv;
                }
            }
            top16_of_64(c0, c1, c2, c3);
            float tv[16]; unsigned te[16];
#pragma unroll
            for (int r = 0; r < 16; ++r) {
                const unsigned ij = __float_as_uint(c0[r]) & 255u;
                te[r] = ktab[(ij >> 4) * 64] * 128u + ktab[(16 + (ij & 15u)) * 64];
                tv[r] = __uint_as_float(__float_as_uint(c0[r]) & 0xFFFFFF00u);
            }
            const float tmax = tv[0]; float sum = 0.f;
#pragma unroll
            for (int r = 0; r < 16; ++r) { tv[r] = __expf(tv[r] - tmax); sum += tv[r]; }
            const float rinv = 1.f / sum;
#pragma unroll
            for (int r = 0; r < 16; ++r) tv[r] *= rinv;
            if (hi == 0) {
                int* ep = SE + (size_t)tok * 128 + h * 16; float* gp = SG + (size_t)tok * 128 + h * 16;
#pragma unroll
                for (int q = 0; q < 4; ++q) { *(u32x4*)(ep + 4 * q) = (u32x4){te[4 * q], te[4 * q + 1], te[4 * q + 2], te[4 * q + 3]}; *(f32x4*)(gp + 4 * q) = (f32x4){tv[4 * q], tv[4 * q + 1], tv[4 * q + 2], tv[4 * q + 3]}; }
            }
        }
#ifndef SEL_SPLIT
        if (bi == (int)blockIdx.x && mode != 1) peer_tables_q8(p, blockIdx.x * NWAVES + wid, gridDim.x * NWAVES, lane);
#endif
    }
}

__device__ __forceinline__ void peer_tables_bf16(const Params& p) {
    const size_t gt = (size_t)blockIdx.x * NTHREADS + threadIdx.x, NGT = (size_t)gridDim.x * NTHREADS;
    const float* U = p.in[21]; const float* V = p.in[22];
    bf16_t* UB = (bf16_t*)(p.ws + WS_UB); bf16_t* VB = (bf16_t*)(p.ws + WS_VB);
    for (size_t i = gt; i < (size_t)16384 * DM / 8; i += NGT) {
        const f32x4 a0 = *(const f32x4*)(U + i * 8), a1 = *(const f32x4*)(U + i * 8 + 4), b0 = *(const f32x4*)(V + i * 8), b1 = *(const f32x4*)(V + i * 8 + 4);
        u32x4 w; w.x = pk2(a0[0], a0[1]); w.y = pk2(a0[2], a0[3]); w.z = pk2(a1[0], a1[1]); w.w = pk2(a1[2], a1[3]);
        *(u32x4*)(UB + i * 8) = w;
        w.x = pk2(b0[0], b0[1]); w.y = pk2(b0[2], b0[3]); w.z = pk2(b1[0], b1[1]); w.w = pk2(b1[2], b1[3]);
        *(u32x4*)(VB + i * 8) = w;
    }
}

typedef short s16x2 __attribute__((ext_vector_type(2)));
__device__ __forceinline__ float dot2_bf16(unsigned a, unsigned b, float acc) { return __builtin_amdgcn_fdot2_f32_bf16(__builtin_bit_cast(s16x2, a), __builtin_bit_cast(s16x2, b), acc, false); }
__device__ __forceinline__ float dot8_bf16(const u32x4 a, const u32x4 b, float acc) {
    const unsigned a0 = a[0], a1 = a[1], a2 = a[2], a3 = a[3], b0 = b[0], b1 = b[1], b2 = b[2], b3 = b[3];
    acc = dot2_bf16(a0, b0, acc); acc = dot2_bf16(a1, b1, acc); acc = dot2_bf16(a2, b2, acc); acc = dot2_bf16(a3, b3, acc);
    return acc;
}
__device__ __forceinline__ void peer_select(const float* __restrict__ TKV, const int* __restrict__ TKI, int m, int lane, int& eA, int& eB, float& gA, float& gB) {
    eA = 0; eB = 0; gA = 0.f; gB = 0.f;
#pragma nounroll
    for (int h = 0; h < 8; ++h) {
        const float* v1 = TKV + ((size_t)m * 16 + h * 2) * 16; const float* v2 = v1 + 16;
        const int* i1 = TKI + ((size_t)m * 16 + h * 2) * 16; const int* i2 = i1 + 16;
        float cv[4]; int ci[4];
        const float v2j = v2[lane & 15];
#pragma unroll
        for (int e = 0; e < 4; ++e) { const int i = (lane >> 4) + 4 * e; cv[e] = v1[i] + v2j; ci[e] = i * 16 + (lane & 15); }
        float tv; int tc; wave_top16<4>(cv, ci, tv, tc, lane);
        int eid = 0;
        if (lane < 16) eid = i1[tc >> 4] * 128 + i2[tc & 15];
        const float mx = __shfl(tv, 0);
        const float ex = lane < 16 ? __expf(tv - mx) : 0.f;
        const float gate = ex / wave_sum(ex);
        const int es = __shfl(eid, lane & 15); const float gs = __shfl(gate, lane & 15);
        if ((lane >> 4) == (h & 3)) { if (h < 4) { eA = es; gA = gs; } else { eB = es; gB = gs; } }
    }
}
__device__ __forceinline__ void peer_gather(const Params& p, bool dry = false) {
    int tid_ = threadIdx.x; asm volatile("" : "+v"(tid_)); const int tid = tid_, lane = tid & 63, wid = tid >> 6;
    const int gw = blockIdx.x * NWAVES + wid, NGW = gridDim.x * NWAVES;
    const float* TKV = (const float*)(p.ws + WS_TKV); const int* TKI = (const int*)(p.ws + WS_TKI);
    const bf16_t* H = (const bf16_t*)(p.ws + WS_H);
    const bf16_t* UB = (const bf16_t*)(p.ws + WS_UB); const bf16_t* VB = (const bf16_t*)(p.ws + WS_VB);
    const float* mod = (const float*)(p.ws + WS_MOD); const float* gpo = p.in[9];
    for (int m = gw; m < TL; m += NGW) {
        int eA, eB; float gA, gB;
        peer_select(TKV, TKI, m, lane, eA, eB, gA, gB);
        asm volatile("" : "+v"(eA), "+v"(eB), "+v"(gA), "+v"(gB));
        u32x4 us[2][4], vs[2][4];
#define PG_LOAD(S, k) do { const int e_ = __builtin_amdgcn_readlane((k) < 64 ? eA : eB, (k) & 63); \
            const bf16_t* up_ = UB + (size_t)e_ * DM + lane * 8; const bf16_t* vp_ = VB + (size_t)e_ * DM + lane * 8; \
            _Pragma("unroll") for (int i = 0; i < 4; ++i) { us[S][i] = *(const u32x4*)(up_ + i * 512); vs[S][i] = *(const u32x4*)(vp_ + i * 512); } } while (0)
        PG_LOAD(0, 0); PG_LOAD(1, 1);
        u32x4 hq[4];
#pragma unroll
        for (int i = 0; i < 4; ++i) hq[i] = *(const u32x4*)(H + (size_t)m * DM + i * 512 + lane * 8);
        float acc[4][8];
#pragma unroll
        for (int i = 0; i < 4; ++i)
#pragma unroll
            for (int e = 0; e < 8; ++e) acc[i][e] = 0.f;
#define PG_USE(S, k) do { float d_ = 0.f; \
            _Pragma("unroll") for (int i = 0; i < 4; ++i) d_ = dot8_bf16(us[S][i], hq[i], d_); \
            d_ = wave_sum(d_); \
            const float g_ = __uint_as_float((unsigned)__builtin_amdgcn_readlane((int)__float_as_uint((k) < 64 ? gA : gB), (k) & 63)); \
            const float cf_ = g_ * gelu_as(d_); \
            _Pragma("unroll") for (int i = 0; i < 4; ++i) { const u32x4 w_ = vs[S][i]; \
                acc[i][0] += cf_ * __uint_as_float(w_.x << 16); acc[i][1] += cf_ * __uint_as_float(w_.x & 0xffff0000u); \
                acc[i][2] += cf_ * __uint_as_float(w_.y << 16); acc[i][3] += cf_ * __uint_as_float(w_.y & 0xffff0000u); \
                acc[i][4] += cf_ * __uint_as_float(w_.z << 16); acc[i][5] += cf_ * __uint_as_float(w_.z & 0xffff0000u); \
                acc[i][6] += cf_ * __uint_as_float(w_.w << 16); acc[i][7] += cf_ * __uint_as_float(w_.w & 0xffff0000u); } } while (0)
#pragma nounroll
        for (int k = 0; k < 128; k += 2) {
            PG_USE(0, k);     if (k + 2 < 128) PG_LOAD(0, k + 2);
            PG_USE(1, k + 1); if (k + 3 < 128) PG_LOAD(1, k + 3);
        }
#undef PG_LOAD
#undef PG_USE
        float ss = 0.f;
#pragma unroll
        for (int i = 0; i < 4; ++i)
#pragma unroll
            for (int e = 0; e < 8; ++e) ss += acc[i][e] * acc[i][e];
        const float rstd = rsqrtf(wave_sum(ss) * (1.f / DM) + EPS);
        const int b = m / SEQ;
#pragma unroll
        for (int i = 0; i < 4; ++i)
#pragma unroll
            for (int q = 0; q < 2; ++q) {
                const int c = i * 512 + lane * 8 + q * 4;
                const f32x4 gt2 = *(const f32x4*)(mod + (size_t)b * 12288 + 10240 + c), gg = *(const f32x4*)(gpo + c);
                float* op = p.out + (size_t)m * DM + c;
                const f32x4 x1 = *(const f32x4*)op;
                const f32x4 y = {acc[i][4 * q], acc[i][4 * q + 1], acc[i][4 * q + 2], acc[i][4 * q + 3]};
                const f32x4 res = x1 + gt2 * (y * rstd * gg);
                if (!dry) *(f32x4*)op = res; else asm volatile("" :: "v"(res));
            }
    }
}


#ifndef GV3
#define GV3 1
#endif
#ifndef U4
#define U4 1
#endif
#ifndef V4
#define V4 1
#endif
constexpr int UROW = U4 ? 1024 : 2048, VROW = V4 ? 1024 : 2048;
__device__ __forceinline__ void peer_q8_row(const Params& p, int r, const f32x4 (&v)[8], int lane) {
    unsigned char* UQ = p.ws + WS_UQ; unsigned char* VQ = p.ws + WS_VQ; float* USC = (float*)(p.ws + WS_USC); float* VSC = (float*)(p.ws + WS_VSC);
    const bool isv = r >= 16384; const int e = isv ? r - 16384 : r;
    const bool n4 = isv ? (V4 != 0) : (U4 != 0);
    if (n4) {
        float ss = 0.f;
#pragma unroll
        for (int j = 0; j < 8; ++j) ss += v[j][0] * v[j][0] + v[j][1] * v[j][1] + v[j][2] * v[j][2] + v[j][3] * v[j][3];
        ss = wave_sum(ss);
        const float step = fmaxf(0.335f * sqrtf(ss * (1.f / DM)), 1e-30f), inv = 1.f / step;
        unsigned char* dst = (isv ? VQ : UQ) + (size_t)e * 1024;
        int nsum = 0;
#pragma unroll
        for (int j = 0; j < 4; ++j) {
            unsigned w = 0;
#pragma unroll
            for (int c = 0; c < 4; ++c) {
                const int lo = (int)__builtin_amdgcn_fmed3f(fmaf(v[j][c], inv, 8.f), 0.f, 15.5f), hi = (int)__builtin_amdgcn_fmed3f(fmaf(v[j + 4][c], inv, 8.f), 0.f, 15.5f);
                w |= ((unsigned)(lo | (hi << 4))) << (8 * c); nsum += lo + hi;
            }
            *(unsigned*)(dst + j * 256 + lane * 4) = w;
        }
        if (!isv) { const float rs = wave_sum((float)nsum); if (lane == 0) ((int*)(p.ws + WS_URS))[e] = (int)rs; }
        if (lane == 0) (isv ? VSC : USC)[e] = step;
        return;
    }
    float mx = 0.f;
#pragma unroll
    for (int j = 0; j < 8; ++j) mx = fmaxf(mx, fmaxf(fmaxf(fabsf(v[j][0]), fabsf(v[j][1])), fmaxf(fabsf(v[j][2]), fabsf(v[j][3]))));
    mx = fmaxf(wave_max(mx), 1e-30f);
    const float sc = mx * (1.f / 127.f), inv = 127.f / mx;
    unsigned char* dst = (isv ? VQ : UQ) + (size_t)e * DM;
    const int zp = (isv && !GV3) ? 128 : 0;
#pragma unroll
    for (int j = 0; j < 8; ++j) {
        unsigned w = 0;
#pragma unroll
        for (int c = 0; c < 4; ++c) { const int q = (int)rintf(v[j][c] * inv) + zp; w |= ((unsigned)q & 0xffu) << (8 * c); }
        *(unsigned*)(dst + j * 256 + lane * 4) = w;
    }
    if (lane == 0) (isv ? VSC : USC)[e] = sc;
}
__device__ __forceinline__ void peer_tables_q8(const Params& p, int gw, int NGW, int lane) {
    f32x4 va[8], vb[8];
#define Q8_LOAD(dst, r) do { const float* s_ = ((r) >= 16384 ? p.in[22] + (size_t)((r) - 16384) * DM : p.in[21] + (size_t)(r) * DM); \
        _Pragma("unroll") for (int j = 0; j < 8; ++j) dst[j] = *(const f32x4*)(s_ + j * 256 + lane * 4); } while (0)
    int r = gw;
    if (r < 2 * 16384) Q8_LOAD(va, r);
    for (; r < 2 * 16384; r += 2 * NGW) {
        const int r1 = r + NGW, r2 = r + 2 * NGW;
        if (r1 < 2 * 16384) Q8_LOAD(vb, r1);
        peer_q8_row(p, r, va, lane);
        if (r2 < 2 * 16384) Q8_LOAD(va, r2);
        if (r1 < 2 * 16384) peer_q8_row(p, r1, vb, lane);
    }
#undef Q8_LOAD
}

__device__ __forceinline__ void peer_gather_q8(const Params& p, unsigned char* lds_, bool dry = false, int emask = 0x3fff) {
    int tid_ = threadIdx.x; asm volatile("" : "+v"(tid_)); const int tid = tid_, lane = tid & 63, wid = tid >> 6;
    LAS3 int* srt = (LAS3 int*)lds_ + wid * 256;
    const int gw = blockIdx.x * NWAVES + wid, NGW = gridDim.x * NWAVES;
    const float* TKV = (const float*)(p.ws + WS_TKV); const int* TKI = (const int*)(p.ws + WS_TKI);
    const bf16_t* H = (const bf16_t*)(p.ws + WS_H);
    const unsigned char* UQ = p.ws + WS_UQ; const unsigned char* VQ = p.ws + WS_VQ; const float* USC = (const float*)(p.ws + WS_USC); const float* VSC = (const float*)(p.ws + WS_VSC);
    const float* mod = (const float*)(p.ws + WS_MOD); const float* gpo = p.in[9];
    const int rounds = (TL + NGW - 1) / NGW;
    for (int it = 0; it < rounds; ++it) {
        const int m = gw + it * NGW;
#ifndef GATHER_UNSORTED
        __syncthreads();
#endif
        if (m >= TL) continue;
        int eA, eB; float gA, gB;
#if defined(TOPK_NAIVE) || defined(TOPK_STAGE1)
        peer_select(TKV, TKI, m, lane, eA, eB, gA, gB);
#else
        eA = TKI[(size_t)m * 128 + lane]; eB = TKI[(size_t)m * 128 + 64 + lane]; gA = TKV[(size_t)m * 128 + lane]; gB = TKV[(size_t)m * 128 + 64 + lane];
#endif
#ifndef GATHER_UNSORTED
        {
            int rA = 0, rB = 0;
#pragma nounroll
            for (int j = 0; j < 64; ++j) {
                const int ea = __builtin_amdgcn_readlane(eA, j), eb = __builtin_amdgcn_readlane(eB, j);
                rA += (ea < eA || (ea == eA && j < lane)) ? 1 : 0; rA += (eb < eA) ? 1 : 0;
                rB += (ea < eB || ea == eB) ? 1 : 0; rB += (eb < eB || (eb == eB && j < lane)) ? 1 : 0;
            }
            srt[rA] = eA; srt[128 + rA] = __float_as_int(gA); srt[rB] = eB; srt[128 + rB] = __float_as_int(gB);
            eA = srt[lane]; eB = srt[64 + lane]; gA = __int_as_float(srt[128 + lane]); gB = __int_as_float(srt[192 + lane]);
        }
#endif
        asm volatile("" : "+v"(eA), "+v"(eB), "+v"(gA), "+v"(gB));
        unsigned hq[2][4]; float hscale; int hsi = 0;
        {
            u32x4 hw[2][2]; float mx = 0.f;
#pragma unroll
            for (int i = 0; i < 2; ++i)
#pragma unroll
                for (int q = 0; q < 2; ++q) { hw[i][q] = *(const u32x4*)(H + (size_t)m * DM + i * 1024 + lane * 16 + q * 8);
#pragma unroll
                    for (int c = 0; c < 4; ++c) { const unsigned w = hw[i][q][c]; mx = fmaxf(mx, fmaxf(fabsf(__uint_as_float(w << 16)), fabsf(__uint_as_float(w & 0xffff0000u)))); } }
            mx = fmaxf(wave_max(mx), 1e-30f);
            hscale = mx * (1.f / 127.f); const float inv = 127.f / mx;
#pragma unroll
            for (int i = 0; i < 2; ++i)
#pragma unroll
                for (int q = 0; q < 2; ++q)
#pragma unroll
                    for (int c2 = 0; c2 < 2; ++c2) {
                        const unsigned w0 = hw[i][q][2 * c2], w1 = hw[i][q][2 * c2 + 1];
                        const int q0 = (int)rintf(__uint_as_float(w0 << 16) * inv), q1 = (int)rintf(__uint_as_float(w0 & 0xffff0000u) * inv);
                        const int q2 = (int)rintf(__uint_as_float(w1 << 16) * inv), q3 = (int)rintf(__uint_as_float(w1 & 0xffff0000u) * inv);
                        hq[i][2 * q + c2] = ((unsigned)q0 & 0xffu) | (((unsigned)q1 & 0xffu) << 8) | (((unsigned)q2 & 0xffu) << 16) | (((unsigned)q3 & 0xffu) << 24);
                        hsi += q0 + q1 + q2 + q3;
                    }
        }
        const float hz = U4 ? 7.5f * wave_sum((float)hsi) : 0.f;
        float cA = 0.f, cB = 0.f; float csum = 0.f;
        {
            u32x4 us[8][2]; float usc[8], vsc[8];
#define PU_LOAD(S, k) do { const int e_ = __builtin_amdgcn_readlane((k) < 64 ? eA : eB, (k) & 63) & emask; int ev_ = e_; asm volatile("" : "+v"(ev_)); \
                const unsigned char* up_ = UQ + (size_t)e_ * UROW + lane * 16; us[S][0] = *(const u32x4*)up_; if (!U4) us[S][1] = *(const u32x4*)(up_ + 1024); usc[S] = USC[ev_]; vsc[S] = VSC[ev_]; } while (0)
#define PU_COEF(S, k) do { int id_ = 0; \
                if (U4) { _Pragma("unroll") for (int c = 0; c < 4; ++c) { const unsigned uw_ = us[S][0][c]; \
                    id_ = __builtin_amdgcn_sdot4((int)(uw_ & 0x0f0f0f0fu), (int)hq[0][c], id_, false); id_ = __builtin_amdgcn_sdot4((int)((uw_ >> 4) & 0x0f0f0f0fu), (int)hq[1][c], id_, false); } } \
                else { _Pragma("unroll") for (int i = 0; i < 2; ++i) _Pragma("unroll") for (int c = 0; c < 4; ++c) { const unsigned uw_ = us[S][i][c]; id_ = __builtin_amdgcn_sdot4((int)uw_, (int)hq[i][c], id_, false); } } \
                const float d_ = (wave_sum_dpp((float)id_) - hz) * (hscale * usc[S]); \
                const float g_ = __uint_as_float((unsigned)__builtin_amdgcn_readlane((int)__float_as_uint((k) < 64 ? gA : gB), (k) & 63)); \
                const float cf_ = g_ * gelu_as(d_) * vsc[S]; csum += cf_; \
                if ((k) < 64) cA = lane == ((k) & 63) ? cf_ : cA; else cB = lane == ((k) & 63) ? cf_ : cB; } while (0)
            PU_LOAD(0, 0); PU_LOAD(1, 1); PU_LOAD(2, 2); PU_LOAD(3, 3);
#pragma nounroll
            for (int k = 0; k < 128; k += 4) {
                const int kn = k + 4 < 128 ? k + 4 : 124;
                PU_COEF(0, k + 0); PU_COEF(1, k + 1); PU_COEF(2, k + 2); PU_COEF(3, k + 3);
                PU_LOAD(0, kn + 0); PU_LOAD(1, kn + 1); PU_LOAD(2, kn + 2); PU_LOAD(3, kn + 3);
            }
#undef PU_LOAD
#undef PU_COEF
        }
        float acc[2][16];
#pragma unroll
        for (int i = 0; i < 2; ++i)
#pragma unroll
            for (int e = 0; e < 16; ++e) acc[i][e] = 0.f;
        {
            u32x4 vs[8][2];
#define PV_LOAD(S, k) do { const int e_ = __builtin_amdgcn_readlane((k) < 64 ? eA : eB, (k) & 63) & emask; \
                const unsigned char* vp_ = VQ + (size_t)e_ * VROW + lane * 16; vs[S][0] = *(const u32x4*)vp_; if (!V4) vs[S][1] = *(const u32x4*)(vp_ + 1024); } while (0)
#define PV_ACC(S, k) do { const float cf_ = __uint_as_float((unsigned)__builtin_amdgcn_readlane((int)__float_as_uint((k) < 64 ? cA : cB), (k) & 63)); \
                _Pragma("unroll") for (int i = 0; i < 2; ++i) _Pragma("unroll") for (int c = 0; c < 4; ++c) { \
                    const unsigned w_ = V4 ? ((i == 0 ? vs[S][0][c] : vs[S][0][c] >> 4) & 0x0f0f0f0fu) : vs[S][i][c]; \
                    acc[i][4 * c + 0] += cf_ * (float)(w_ & 0xffu); acc[i][4 * c + 1] += cf_ * (float)((w_ >> 8) & 0xffu); \
                    acc[i][4 * c + 2] += cf_ * (float)((w_ >> 16) & 0xffu); acc[i][4 * c + 3] += cf_ * (float)(w_ >> 24); } } while (0)
#if V4
            PV_LOAD(0, 0); PV_LOAD(1, 1); PV_LOAD(2, 2); PV_LOAD(3, 3);
#pragma nounroll
            for (int k = 0; k < 128; k += 4) {
                const int kn = k + 4 < 128 ? k + 4 : 124;
                PV_ACC(0, k); PV_ACC(1, k + 1);
                PV_LOAD(0, kn); PV_LOAD(1, kn + 1);
                PV_ACC(2, k + 2); PV_ACC(3, k + 3);
                PV_LOAD(2, kn + 2); PV_LOAD(3, kn + 3);
            }
#else
            PV_LOAD(0, 0); PV_LOAD(1, 1);
#pragma nounroll
            for (int k = 0; k < 128; k += 2) {
                const int kn = k + 2 < 128 ? k + 2 : 126;
                PV_ACC(0, k); PV_ACC(1, k + 1);
                PV_LOAD(0, kn); PV_LOAD(1, kn + 1);
            }
#endif
#undef PV_LOAD
#undef PV_ACC
        }
        const float zoff = (V4 ? 7.5f : 128.f) * csum;
        float ss = 0.f;
#pragma unroll
        for (int i = 0; i < 2; ++i)
#pragma unroll
            for (int e = 0; e < 16; ++e) { acc[i][e] -= zoff; ss += acc[i][e] * acc[i][e]; }
        const float rstd = rsqrtf(wave_sum(ss) * (1.f / DM) + EPS);
        const int b = m / SEQ;
#pragma unroll
        for (int i = 0; i < 2; ++i)
#pragma unroll
            for (int q = 0; q < 4; ++q) {
                const int c = i * 1024 + lane * 16 + q * 4;
                const f32x4 gt2 = *(const f32x4*)(mod + (size_t)b * 12288 + 10240 + c), gg = *(const f32x4*)(gpo + c);
                float* op = p.out + (size_t)m * DM + c;
                const f32x4 x1 = *(const f32x4*)op;
                const f32x4 y = {acc[i][4 * q], acc[i][4 * q + 1], acc[i][4 * q + 2], acc[i][4 * q + 3]};
                const f32x4 res = x1 + gt2 * (y * rstd * gg);
                if (!dry) *(f32x4*)op = res; else asm volatile("" :: "v"(res));
            }
    }
}


__device__ __forceinline__ int u_dots64(const unsigned char* UQ, int eX, int emask, int lane, const unsigned (&hq)[2][4], int off2) {
    int pd[64];
    u32x4 ua[4][2];
#if U4
#define U3_LOAD(S, k) do { const int e_ = __builtin_amdgcn_readlane(eX, (k)) & emask; ua[S][0] = *(const u32x4*)(UQ + (size_t)e_ * UROW + lane * 16); } while (0)
#define U3_DOT(S, k) do { unsigned ah_ = 0u, al_ = 0u; \
        _Pragma("unroll") for (int c = 0; c < 4; ++c) { const unsigned w_ = ua[S][0][c]; \
            ah_ = __builtin_amdgcn_udot8(w_, hq[0][c], ah_, false); al_ = __builtin_amdgcn_udot8(w_, hq[1][c], al_, false); } \
        pd[k] = (int)(ah_ * 16u + al_); } while (0)
#else
#define U3_LOAD(S, k) do { const int e_ = __builtin_amdgcn_readlane(eX, (k)) & emask; const unsigned char* up_ = UQ + (size_t)e_ * DM + lane * 16; \
        ua[S][0] = *(const u32x4*)up_; ua[S][1] = *(const u32x4*)(up_ + off2); } while (0)
#define U3_DOT(S, k) do { int id_ = 0; \
        _Pragma("unroll") for (int i = 0; i < 2; ++i) _Pragma("unroll") for (int c = 0; c < 4; ++c) id_ = __builtin_amdgcn_sdot4((int)ua[S][i][c], (int)hq[i][c], id_, false); \
        pd[k] = id_; } while (0)
#endif
    U3_LOAD(0, 0); U3_LOAD(1, 1); U3_LOAD(2, 2); U3_LOAD(3, 3);
#pragma unroll
    for (int g = 0; g < 16; ++g) {
        __builtin_amdgcn_sched_barrier(0);
        U3_DOT(0, 4 * g + 0); if (g < 15) U3_LOAD(0, 4 * g + 4);
        U3_DOT(1, 4 * g + 1); if (g < 15) U3_LOAD(1, 4 * g + 5);
        U3_DOT(2, 4 * g + 2); if (g < 15) U3_LOAD(2, 4 * g + 6);
        U3_DOT(3, 4 * g + 3); if (g < 15) U3_LOAD(3, 4 * g + 7);
    }
#undef U3_LOAD
#undef U3_DOT
    __builtin_amdgcn_sched_barrier(0);
#pragma unroll
    for (int k = 0; k < 32; ++k) { auto r = __builtin_amdgcn_permlane32_swap((unsigned)pd[k], (unsigned)pd[k + 32], false, false); pd[k] = (int)r[0] + (int)r[1]; }
#pragma unroll
    for (int k = 0; k < 16; ++k) { auto r = __builtin_amdgcn_permlane16_swap((unsigned)pd[k], (unsigned)pd[k + 16], false, false); pd[k] = (int)r[0] + (int)r[1]; }
#pragma unroll
    for (int sh = 8; sh >= 1; sh >>= 1) {
        const bool up = (lane & sh) != 0;
#pragma unroll
        for (int k = 0; k < sh; ++k) { const int a = pd[k], b = pd[k + sh]; const int t = up ? a : b, keep = up ? b : a; pd[k] = keep + __shfl_xor(t, sh); }
    }
    return pd[0];
}

__device__ __forceinline__ void peer_gather_v3(const Params& p, unsigned char* lds_, bool dry = false, int emask = 0x3fff, int off2 = 1024) {
    int tid_ = threadIdx.x; asm volatile("" : "+v"(tid_)); const int tid = tid_, lane = tid & 63, wid = tid >> 6;
    LAS3 int* srt = (LAS3 int*)lds_ + wid * 256;
    const int gw = blockIdx.x * NWAVES + wid, NGW = gridDim.x * NWAVES;
    const float* TKV = (const float*)(p.ws + WS_TKV); const int* TKI = (const int*)(p.ws + WS_TKI);
    const bf16_t* H = (const bf16_t*)(p.ws + WS_H);
    const unsigned char* UQ = p.ws + WS_UQ; const unsigned char* VQ = p.ws + WS_VQ; const float* USC = (const float*)(p.ws + WS_USC); const float* VSC = (const float*)(p.ws + WS_VSC);
    const float* mod = (const float*)(p.ws + WS_MOD); const float* gpo = p.in[9];
    const int rounds = (TL + NGW - 1) / NGW;
    for (int it = 0; it < rounds; ++it) {
        const int m0 = gw + it * NGW; const bool live = m0 < TL; const int m = live ? m0 : TL - 1;
        __syncthreads();
        int eA, eB; float gA, gB;
        eA = TKI[(size_t)m * 128 + lane]; eB = TKI[(size_t)m * 128 + 64 + lane]; gA = TKV[(size_t)m * 128 + lane]; gB = TKV[(size_t)m * 128 + 64 + lane];
        {
            const int bA = eA >> 10, bB = eB >> 10;
            int rA = 0, rB = 0, base = 0;
#pragma unroll
            for (int k = 0; k < 16; ++k) {
                const unsigned long long ma = __builtin_amdgcn_ballot_w64(bA == k), mb = __builtin_amdgcn_ballot_w64(bB == k);
                const int na = __popcll(ma);
                const int pa = (int)__builtin_amdgcn_mbcnt_hi((unsigned)(ma >> 32), __builtin_amdgcn_mbcnt_lo((unsigned)ma, 0u));
                const int pb = (int)__builtin_amdgcn_mbcnt_hi((unsigned)(mb >> 32), __builtin_amdgcn_mbcnt_lo((unsigned)mb, 0u));
                rA = bA == k ? base + pa : rA; rB = bB == k ? base + na + pb : rB;
                base += na + __popcll(mb);
            }
            srt[rA] = eA; srt[128 + rA] = __float_as_int(gA); srt[rB] = eB; srt[128 + rB] = __float_as_int(gB);
            eA = srt[lane]; eB = srt[64 + lane]; gA = __int_as_float(srt[128 + lane]); gB = __int_as_float(srt[192 + lane]);
        }
        asm volatile("" : "+v"(eA), "+v"(eB), "+v"(gA), "+v"(gB));
        const float uscA = USC[eA & emask], uscB = USC[eB & emask], vscA = VSC[eA & emask], vscB = VSC[eB & emask];
        unsigned hq[2][4]; float hscale; int hsi = 0;
#if PEERQ_I8
        {
            const u32x4 h0 = *(const u32x4*)(p.ws + WS_H8P + (size_t)m * DM + lane * 16), h1 = *(const u32x4*)(p.ws + WS_H8P + (size_t)m * DM + 1024 + lane * 16);
#pragma unroll
            for (int c = 0; c < 4; ++c) { hq[0][c] = h0[c]; hq[1][c] = h1[c]; hsi = __builtin_amdgcn_sdot4((int)h0[c], 0x01010101, hsi, false); hsi = __builtin_amdgcn_sdot4((int)h1[c], 0x01010101, hsi, false); }
            hscale = ((const float*)(p.ws + WS_HSP))[m];
        }
#else
        {
            u32x4 hw[2][2]; float mx = 0.f;
#pragma unroll
            for (int i = 0; i < 2; ++i)
#pragma unroll
                for (int q = 0; q < 2; ++q) { hw[i][q] = *(const u32x4*)(H + (size_t)m * DM + i * 1024 + lane * 16 + q * 8);
#pragma unroll
                    for (int c = 0; c < 4; ++c) { const unsigned w = hw[i][q][c]; mx = fmaxf(mx, fmaxf(fabsf(__uint_as_float(w << 16)), fabsf(__uint_as_float(w & 0xffff0000u)))); } }
            mx = fmaxf(wave_max(mx), 1e-30f);
            hscale = mx * (1.f / 127.f); const float inv = 127.f / mx;
#pragma unroll
            for (int i = 0; i < 2; ++i)
#pragma unroll
                for (int q = 0; q < 2; ++q)
#pragma unroll
                    for (int c2 = 0; c2 < 2; ++c2) {
                        const unsigned w0 = hw[i][q][2 * c2], w1 = hw[i][q][2 * c2 + 1];
                        const int q0 = (int)rintf(__uint_as_float(w0 << 16) * inv), q1 = (int)rintf(__uint_as_float(w0 & 0xffff0000u) * inv);
                        const int q2 = (int)rintf(__uint_as_float(w1 << 16) * inv), q3 = (int)rintf(__uint_as_float(w1 & 0xffff0000u) * inv);
                        hq[i][2 * q + c2] = ((unsigned)q0 & 0xffu) | (((unsigned)q1 & 0xffu) << 8) | (((unsigned)q2 & 0xffu) << 16) | (((unsigned)q3 & 0xffu) << 24);
                        hsi += q0 + q1 + q2 + q3;
                    }
        }
#endif
        const float hz = U4 ? 7.5f * wave_sum((float)hsi) : 0.f;
        int rsA = 0, rsB = 0;
        if (U4) {
            rsA = ((const int*)(p.ws + WS_URS))[eA & emask]; rsB = ((const int*)(p.ws + WS_URS))[eB & emask];
#pragma unroll
            for (int c = 0; c < 4; ++c) { const unsigned u0 = hq[0][c] ^ 0x80808080u, u1 = hq[1][c] ^ 0x80808080u;
                hq[0][c] = ((u0 >> 4) & 0x0f0f0f0fu) | (u1 & 0xf0f0f0f0u); hq[1][c] = (u0 & 0x0f0f0f0fu) | ((u1 << 4) & 0xf0f0f0f0u); }
        }
        const int dA = u_dots64(UQ, eA, emask, lane, hq, off2) - 128 * rsA;
        __syncthreads();
        const int dB = u_dots64(UQ, eB, emask, lane, hq, off2) - 128 * rsB;
        const float cA = gA * gelu_as(((float)dA - hz) * (hscale * uscA)) * vscA, cB = gB * gelu_as(((float)dB - hz) * (hscale * uscB)) * vscB;
        f32x4 ex1[2][4], egt[2][4];
        { const float* gtg = (const float*)(p.ws + WS_GTG) + (size_t)(m / SEQ) * 2048;
#pragma unroll
          for (int i = 0; i < 2; ++i)
#pragma unroll
              for (int q = 0; q < 4; ++q) { const int c = i * 1024 + lane * 16 + q * 4; { const u32x2 w_ = *(const u32x2*)((const bf16_t*)(p.ws + WS_Z) + (size_t)m * DM + c); ex1[i][q] = (f32x4){__uint_as_float(w_.x << 16), __uint_as_float(w_.x & 0xffff0000u), __uint_as_float(w_.y << 16), __uint_as_float(w_.y & 0xffff0000u)}; } egt[i][q] = *(const f32x4*)(gtg + c); } }
        __syncthreads();
        const float cmx = fmaxf(wave_max(fmaxf(fabsf(cA), fabsf(cB))), 1e-30f);
        const float cqs = 127.f / cmx;
        int pkA, pkB; float cz = 0.f;
        { const int qa_ = (int)rintf(cA * cqs), qb_ = (int)rintf(cB * cqs); if (V4) cz = 7.5f * wave_sum((float)(qa_ + qb_));
          const int qa = qa_ & 0xff, qb = qb_ & 0xff;
          pkA = qa | (__shfl_down(qa, 1) << 8) | (__shfl_down(qa, 2) << 16) | (__shfl_down(qa, 3) << 24);
          pkB = qb | (__shfl_down(qb, 1) << 8) | (__shfl_down(qb, 2) << 16) | (__shfl_down(qb, 3) << 24); }
        int acc[2][16];
#pragma unroll
        for (int i = 0; i < 2; ++i)
#pragma unroll
            for (int e = 0; e < 16; ++e) acc[i][e] = 0;
        {
            u32x4 v0[4][2], v1[4][2];
#if V4
#define V3_LOAD(B, eX, g) do { _Pragma("unroll") for (int s_ = 0; s_ < 4; ++s_) { const int e_ = __builtin_amdgcn_readlane(eX, 4 * (g) + s_) & emask; \
                B[s_][0] = *(const u32x4*)(VQ + (size_t)e_ * VROW + lane * 16); } } while (0)
#define V3_W(B, s_, i, c) ((i == 0 ? B[s_][0][c] : B[s_][0][c] >> 4) & 0x0f0f0f0fu)
#else
#define V3_LOAD(B, eX, g) do { _Pragma("unroll") for (int s_ = 0; s_ < 4; ++s_) { const int e_ = __builtin_amdgcn_readlane(eX, 4 * (g) + s_) & emask; \
                const unsigned char* vp_ = VQ + (size_t)e_ * DM + lane * 16; B[s_][0] = *(const u32x4*)vp_; B[s_][1] = *(const u32x4*)(vp_ + off2); } } while (0)
#define V3_W(B, s_, i, c) (B[s_][i][c])
#endif
#if V4
#define V3_ACC(B, pkX, g) do { const int cp_ = __builtin_amdgcn_readlane(pkX, 4 * (g)); \
                _Pragma("unroll") for (int c = 0; c < 4; ++c) { \
                    const unsigned w0_ = B[0][0][c], w1_ = B[1][0][c], w2_ = B[2][0][c], w3_ = B[3][0][c]; \
                    const unsigned a0_ = __builtin_amdgcn_perm(w1_, w0_, 0x05010400u), a1_ = __builtin_amdgcn_perm(w1_, w0_, 0x07030602u); \
                    const unsigned b0_ = __builtin_amdgcn_perm(w3_, w2_, 0x05010400u), b1_ = __builtin_amdgcn_perm(w3_, w2_, 0x07030602u); \
                    const unsigned t0_ = __builtin_amdgcn_perm(b0_, a0_, 0x05040100u), t1_ = __builtin_amdgcn_perm(b0_, a0_, 0x07060302u); \
                    const unsigned t2_ = __builtin_amdgcn_perm(b1_, a1_, 0x05040100u), t3_ = __builtin_amdgcn_perm(b1_, a1_, 0x07060302u); \
                    acc[0][4 * c + 0] = __builtin_amdgcn_sdot4((int)(t0_ & 0x0f0f0f0fu), cp_, acc[0][4 * c + 0], false); acc[1][4 * c + 0] = __builtin_amdgcn_sdot4((int)((t0_ >> 4) & 0x0f0f0f0fu), cp_, acc[1][4 * c + 0], false); \
                    acc[0][4 * c + 1] = __builtin_amdgcn_sdot4((int)(t1_ & 0x0f0f0f0fu), cp_, acc[0][4 * c + 1], false); acc[1][4 * c + 1] = __builtin_amdgcn_sdot4((int)((t1_ >> 4) & 0x0f0f0f0fu), cp_, acc[1][4 * c + 1], false); \
                    acc[0][4 * c + 2] = __builtin_amdgcn_sdot4((int)(t2_ & 0x0f0f0f0fu), cp_, acc[0][4 * c + 2], false); acc[1][4 * c + 2] = __builtin_amdgcn_sdot4((int)((t2_ >> 4) & 0x0f0f0f0fu), cp_, acc[1][4 * c + 2], false); \
                    acc[0][4 * c + 3] = __builtin_amdgcn_sdot4((int)(t3_ & 0x0f0f0f0fu), cp_, acc[0][4 * c + 3], false); acc[1][4 * c + 3] = __builtin_amdgcn_sdot4((int)((t3_ >> 4) & 0x0f0f0f0fu), cp_, acc[1][4 * c + 3], false); } } while (0)
#else
#define V3_ACC(B, pkX, g) do { const int cp_ = __builtin_amdgcn_readlane(pkX, 4 * (g)); \
                _Pragma("unroll") for (int i = 0; i < 2; ++i) _Pragma("unroll") for (int c = 0; c < 4; ++c) { \
                    const unsigned w0_ = V3_W(B, 0, i, c), w1_ = V3_W(B, 1, i, c), w2_ = V3_W(B, 2, i, c), w3_ = V3_W(B, 3, i, c); \
                    const unsigned a0_ = __builtin_amdgcn_perm(w1_, w0_, 0x05010400u), a1_ = __builtin_amdgcn_perm(w1_, w0_, 0x07030602u); \
                    const unsigned b0_ = __builtin_amdgcn_perm(w3_, w2_, 0x05010400u), b1_ = __builtin_amdgcn_perm(w3_, w2_, 0x07030602u); \
                    acc[i][4 * c + 0] = __builtin_amdgcn_sdot4((int)__builtin_amdgcn_perm(b0_, a0_, 0x05040100u), cp_, acc[i][4 * c + 0], false); \
                    acc[i][4 * c + 1] = __builtin_amdgcn_sdot4((int)__builtin_amdgcn_perm(b0_, a0_, 0x07060302u), cp_, acc[i][4 * c + 1], false); \
                    acc[i][4 * c + 2] = __builtin_amdgcn_sdot4((int)__builtin_amdgcn_perm(b1_, a1_, 0x05040100u), cp_, acc[i][4 * c + 2], false); \
                    acc[i][4 * c + 3] = __builtin_amdgcn_sdot4((int)__builtin_amdgcn_perm(b1_, a1_, 0x07060302u), cp_, acc[i][4 * c + 3], false); } } while (0)
#endif
#define V3_HALF(eX, pkX) do { V3_LOAD(v0, eX, 0); V3_LOAD(v1, eX, 1); \
                _Pragma("nounroll") for (int g = 0; g < 16; g += 2) { const int gn0 = g + 2 < 16 ? g + 2 : 14, gn1 = g + 3 < 16 ? g + 3 : 15; \
                    V3_ACC(v0, pkX, g); V3_LOAD(v0, eX, gn0); V3_ACC(v1, pkX, g + 1); V3_LOAD(v1, eX, gn1); } } while (0)
            V3_HALF(eA, pkA);
            __syncthreads();
            V3_HALF(eB, pkB);
#undef V3_LOAD
#undef V3_W
#undef V3_ACC
#undef V3_HALF
        }
        const float osc = cmx * (1.f / 127.f);
        float y[2][16]; float ss = 0.f;
#pragma unroll
        for (int i = 0; i < 2; ++i)
#pragma unroll
            for (int e = 0; e < 16; ++e) { y[i][e] = ((float)acc[i][e] - cz) * osc; ss += y[i][e] * y[i][e]; }
        const float rstd = rsqrtf(wave_sum(ss) * (1.f / DM) + EPS);
        const int b = m / SEQ;
#pragma unroll
        for (int i = 0; i < 2; ++i)
#pragma unroll
            for (int q = 0; q < 4; ++q) {
                const int c = i * 1024 + lane * 16 + q * 4;
                float* op = p.out + (size_t)m * DM + c;
                const f32x4 yy = {y[i][4 * q], y[i][4 * q + 1], y[i][4 * q + 2], y[i][4 * q + 3]};
                const f32x4 res = ex1[i][q] + egt[i][q] * (yy * rstd);
                if (!dry && live) *(f32x4*)op = res; else asm volatile("" :: "v"(res));
            }
    }
}

#define LAS __attribute__((address_space(3)))
#define XB_TMO      128
#define XB_XCNT(j)  (256  + 64 * (j))
#define XB_XSUB(j)  (1280 + 64 * (j))
#define XB_XGEN(j)  (2304 + 64 * (j))
#define XB_TOP      3328
#define XB_TOPGEN   3392
#define XCD_BAR_WORDS 3456
#define XB_SPIN_CAP (1u << 18)

__device__ __forceinline__ unsigned xb_ld(unsigned* p)              { return __hip_atomic_load(p, __ATOMIC_RELAXED, __HIP_MEMORY_SCOPE_AGENT); }
__device__ __forceinline__ unsigned xb_add(unsigned* p, unsigned v) { return __hip_atomic_fetch_add(p, v, __ATOMIC_RELAXED, __HIP_MEMORY_SCOPE_AGENT); }
__device__ __forceinline__ unsigned xb_xcc_id() { return (unsigned)__builtin_amdgcn_s_getreg((3 << 11) | 20) & 0xFu; }
#define XB_SPIN(cond, bar) do { unsigned _sp = 0; while (cond) { __builtin_amdgcn_s_sleep(1); \
    if ((++_sp & 255u) == 0u) { if (xb_ld(&(bar)[XB_TMO])) break; if (_sp > XB_SPIN_CAP) { atomicAdd(&(bar)[XB_TMO], 1u); break; } } } } while (0)

struct XcdBarrier {
    unsigned* bar; unsigned x;
    volatile LAS unsigned* st;
};

__device__ __forceinline__ XcdBarrier xcd_barrier_post(unsigned* bar, volatile LAS unsigned* st) {
    XcdBarrier b; b.bar = bar; b.x = xb_xcc_id(); b.st = st;
    if (threadIdx.x == 0) (void)xb_add(&bar[XB_XCNT(b.x)], 1u);
    return b;
}
__device__ __forceinline__ void xcd_barrier_complete(unsigned* bar, unsigned x, unsigned& nloc, unsigned& nx) {
    const unsigned G = gridDim.x * gridDim.y * gridDim.z;
    unsigned sum, cnt, mine, sp = 0u;
    for (;;) {
        sum = 0u; cnt = 0u; mine = 0u;
#pragma unroll
        for (unsigned j = 0; j < 16; ++j) { const unsigned c = xb_ld(&bar[XB_XCNT(j)]); sum += c; cnt += (c > 0u) ? 1u : 0u; mine = (j == x) ? c : mine; }
        if (sum == G) break;
        __builtin_amdgcn_s_sleep(1);
        if ((++sp & 255u) == 0u) { if (xb_ld(&bar[XB_TMO])) break; if (sp > XB_SPIN_CAP) { atomicAdd(&bar[XB_TMO], 1u); break; } }
    }
    nloc = mine > 0u ? mine : 1u; nx = cnt > 0u ? cnt : 1u;
}

__device__ __forceinline__ void xcd_barrier(const XcdBarrier& b) {
    asm volatile("s_waitcnt vmcnt(0)" ::: "memory");
    __syncthreads();
    if (threadIdx.x == 0) {
        unsigned* bar = b.bar;
        __builtin_amdgcn_s_waitcnt(0);
        unsigned nloc = b.st[0], nx = b.st[1];
        if (nloc == 0u) { xcd_barrier_complete(bar, b.x, nloc, nx); b.st[0] = nloc; b.st[1] = nx; }
        const unsigned old = xb_add(&bar[XB_XSUB(b.x)], 1u);
        const unsigned gen = old / nloc;
        if (old + 1u == (gen + 1u) * nloc) {
            __builtin_amdgcn_fence(__ATOMIC_RELEASE, "agent");
            asm volatile("s_waitcnt vmcnt(0)" ::: "memory");
            const unsigned og = xb_add(&bar[XB_TOP], 1u);
            const unsigned tg = og / nx;
            if (og + 1u == (tg + 1u) * nx) xb_add(&bar[XB_TOPGEN], 1u);
            else XB_SPIN(xb_ld(&bar[XB_TOPGEN]) == tg, bar);
            __builtin_amdgcn_fence(__ATOMIC_ACQUIRE, "agent");
            xb_add(&bar[XB_XGEN(b.x)], 1u);
            asm volatile("s_waitcnt vmcnt(0)" ::: "memory");
        } else {
            XB_SPIN(xb_ld(&bar[XB_XGEN(b.x)]) == gen, bar);
            __builtin_amdgcn_fence(__ATOMIC_ACQUIRE, "agent");
            asm volatile("s_waitcnt vmcnt(0)" ::: "memory");
        }
    }
    __syncthreads();
}


__global__ void __launch_bounds__(NTHREADS, 2) mega(Params p) {
    extern __shared__ __attribute__((aligned(16))) unsigned char lds[];
    cg::grid_group grid = cg::this_grid();
    unsigned char* ws = p.ws;
    bf16_t* H = (bf16_t*)(ws + WS_H); bf16_t* PL = (bf16_t*)(ws + WS_PL); bf16_t* PCx = (bf16_t*)(ws + WS_PC);
    const int lo = p.ph_lo, hi = p.ph_hi;
    volatile LAS unsigned* bst = (volatile LAS unsigned*)((LAS unsigned char*)lds + (LDS_BYTES - 64));
    unsigned* barw = (unsigned*)(ws + WS_BAR);
    if (threadIdx.x < 2) bst[threadIdx.x] = 0u;
    if (blockIdx.x == 0) for (int i = threadIdx.x; i < XCD_BAR_WORDS; i += NTHREADS) barw[i] = 0u;
    __syncthreads();
    XcdBarrier xbar; xbar.bar = barw; xbar.x = 0; xbar.st = bst;
#ifdef PHONLY
#define IN(k) ((k) == PHONLY && lo <= (k) && (k) < hi)
#else
#define IN(k) (lo <= (k) && (k) < hi)
#endif
#ifndef DUP
#define DUP -1
#endif
#define REP(k) for (int rep_ = 0; rep_ < ((k) == DUP ? 2 : 1); ++rep_)
#define SEAM(k) do { if (IN(k) && IN((k) + 1)) { \
        if ((k) == 0) { asm volatile("s_waitcnt vmcnt(0) lgkmcnt(0)" ::: "memory"); grid.sync(); \
            if (threadIdx.x < 64) { __builtin_amdgcn_fence(__ATOMIC_ACQUIRE, "agent"); asm volatile("s_waitcnt vmcnt(0)" ::: "memory"); } __syncthreads(); \
            xbar = xcd_barrier_post(barw, bst); } \
        else xcd_barrier(xbar); } } while (0)
    if (IN(0)) { phase0(p, lds); __syncthreads(); if (DUP == 0) { phase0(p, lds); __syncthreads(); } }
    SEAM(0);
    if (IN(1)) REP(1) phase1(p);
    SEAM(1);
    if (IN(2)) REP(2) {
        if (INPROJ_I8 == 2) {
            { EpiGateI8 e{PL, NP, (const float*)(ws + WS_WGS), PC_GA}; run_gemm_i8<EpiGateI8>(lds, ws + WS_H8G, ws + WS_WG8, TL, NP, DM, (const float*)(ws + WS_HSG), e); }
            { EpiGateI8 e{PCx, NPC, (const float*)(ws + WS_WGS), 1 << 30}; run_gemm_i8<EpiGateI8>(lds, ws + WS_H8G + (size_t)TL * DM, ws + WS_WG8, TC, NPC, DM, (const float*)(ws + WS_HSG) + TL, e, 128); }
        } else if (INPROJ_I8 == 1) {
            { EpiInproj e{PL, NP, 1 << 30}; run_gemm<EpiInproj, false>(lds, H, DM, (const bf16_t*)(ws + WS_WIN), DM, TL, PC_GA, DM, e); }
            { EpiGateI8 e{PL + PC_GA, NP, (const float*)(ws + WS_WGS) + PC_GA, 0}; run_gemm_i8<EpiGateI8>(lds, ws + WS_H8G, ws + WS_WG8 + (size_t)PC_GA * DM, TL, 4096, DM, (const float*)(ws + WS_HSG), e); }
        } else
        { EpiInproj e{PL, NP, PC_GA}; run_gemm<EpiInproj, false>(lds, H, DM, (const bf16_t*)(ws + WS_WIN), DM, TL, NP, DM, e); }
        if (INPROJ_I8 != 2)
        { EpiInproj e{PCx, NPC, 1 << 30}; run_gemm<EpiInproj, false>(lds, H + (size_t)TL * DM, DM, (const bf16_t*)(ws + WS_WIN), DM, TC, NPC, DM, e, 128); }
    }
    SEAM(2);
    if (IN(3)) {
#ifndef NO_P3_GEMM
        { EpiMlaQ e{(bf16_t*)(ws + WS_QM), (const float*)(ws + WS_ROPE)}; run_gemm<EpiMlaQ, true>(lds, PL + PC_CQ, NP, (const bf16_t*)(ws + WS_WQB), QR, TL, MQW, QR, e); }
        { EpiMlaKV e{(bf16_t*)(ws + WS_KVM), 0}; run_gemm<EpiMlaKV, true>(lds, PL + PC_CKV, NP, (const bf16_t*)(ws + WS_WKVB), KVR, TL, MKVW, KVR, e); }
        { EpiMlaKV e{(bf16_t*)(ws + WS_KVM), TL}; run_gemm<EpiMlaKV, true>(lds, PCx + PC_CKV, NPC, (const bf16_t*)(ws + WS_WKVB), KVR, TC, MKVW, KVR, e, 128); __syncthreads(); }
        if (DUP == 31) {
        { EpiMlaQ e{(bf16_t*)(ws + WS_QM), (const float*)(ws + WS_ROPE)}; run_gemm<EpiMlaQ, true>(lds, PL + PC_CQ, NP, (const bf16_t*)(ws + WS_WQB), QR, TL, MQW, QR, e); }
        { EpiMlaKV e{(bf16_t*)(ws + WS_KVM), 0}; run_gemm<EpiMlaKV, true>(lds, PL + PC_CKV, NP, (const bf16_t*)(ws + WS_WKVB), KVR, TL, MKVW, KVR, e); }
        { EpiMlaKV e{(bf16_t*)(ws + WS_KVM), TL}; run_gemm<EpiMlaKV, true>(lds, PCx + PC_CKV, NPC, (const bf16_t*)(ws + WS_WKVB), KVR, TC, MKVW, KVR, e, 128); __syncthreads(); }
        }
#endif
        kpe_pass(p);
#ifdef NA_NAIVE
        na_naive(p, lds);
#else
#ifdef NA_PERWAVE
        na_flash(p, lds);
        if (DUP == 30) na_flash(p, lds);
#else
        na_coop(p, lds);
        if (DUP == 30) na_coop(p, lds);
#endif
#endif
    }
    SEAM(3);
#ifdef MLA_NAIVE
    if (IN(4)) mla_naive(p, lds);
#else
    if (IN(4)) REP(4) mla_flash2(p, lds);
#endif
    SEAM(4);
    if (IN(5)) REP(5) {
        { EpiMergeF e{H, PL}; run_gemm<EpiMergeF, false>(lds, (const bf16_t*)(ws + WS_OA), DM, (const bf16_t*)(ws + WS_WA), DM, TL, DM, DM, e); }
    }
    SEAM(5);
    if (IN(6)) REP(6) { EpiStore e{(bf16_t*)(ws + WS_Z), DM}; run_gemm<EpiStore, false>(lds, H, DM, (const bf16_t*)(ws + WS_WO), DM, TL, DM, DM, e); }
    SEAM(6);
    if (IN(7)) REP(7) phase7(p);
    SEAM(7);
    if (IN(8)) REP(8) {
        if (PEERQ_I8) { EpiGateI8 e{(bf16_t*)(ws + WS_QP), DM, (const float*)(ws + WS_WGS), 1 << 30}; run_gemm_i8<EpiGateI8>(lds, ws + WS_H8P, ws + WS_WG8, TL, DM, DM, (const float*)(ws + WS_HSP), e); }
        else { EpiStore e{(bf16_t*)(ws + WS_QP), DM}; run_gemm<EpiStore, false>(lds, H, DM, (const bf16_t*)(ws + WS_WPQ), DM, TL, DM, DM, e); }
    }
    SEAM(8);
    if (IN(9)) REP(9) {
#if defined(TOPK_NAIVE)
        peer_topk_naive(p, lds);
#elif defined(TOPK_STAGE1)
        peer_topk_mfma(p, lds);
#else
        peer_select_mfma(p, lds);
        if (DUP == 90) peer_select_mfma(p, lds, 1);
        if (DUP == 91) peer_select_mfma(p, lds, 2);
#endif
#ifdef PEER_BF16
        peer_tables_bf16(p);
#endif
    }
    SEAM(9);
#ifdef PEER_NAIVE
    if (IN(10)) peer_final_naive(p, lds);
#else
#ifdef PEER_BF16
    if (IN(10)) { if (DUP == 10) peer_gather(p, true); peer_gather(p); }
#else
    if (IN(10)) { if (DUP == 10) peer_gather_v3(p, lds, true); if (DUP == 100) peer_gather_v3(p, lds, true, 1023); if (DUP == 101) peer_gather_v3(p, lds, true, 127); if (DUP == 102) peer_gather_v3(p, lds, true, 0x3fff, 0); peer_gather_v3(p, lds); }
#endif
#endif
#undef IN
#undef SEAM
}

extern "C" void kernel_launch(void* const* d_in, const int* in_sizes, int n_in, void* d_out, int out_size, void* d_ws, size_t ws_size, hipStream_t stream) {
    static int grid = 0;
    if (grid == 0) {
        int dev = 0, cus = 0, per_cu = 0;
        (void)hipGetDevice(&dev);
        (void)hipDeviceGetAttribute(&cus, hipDeviceAttributeMultiprocessorCount, dev);
        (void)hipFuncSetAttribute((const void*)mega, hipFuncAttributeMaxDynamicSharedMemorySize, LDS_BYTES);
        (void)hipOccupancyMaxActiveBlocksPerMultiprocessor(&per_cu, (const void*)mega, NTHREADS, LDS_BYTES);
        if (per_cu < 1) { fprintf(stderr, "occupancy query says %d blocks per CU\n", per_cu); per_cu = 1; }
        grid = cus * 1;
        (void)hipGetLastError();
        if (n_in != 23 || ws_size < WS_END2) fprintf(stderr, "kernel_launch: unexpected n_in %d or ws %zu\n", n_in, ws_size);
    }
    Params p{};
    for (int i = 0; i < 23; ++i) p.in[i] = (const float*)d_in[i];
    p.out = (float*)d_out; p.ws = (unsigned char*)d_ws; p.ph_lo = 0; p.ph_hi = 11;
    void* args[] = {&p};
    hipError_t e = hipLaunchCooperativeKernel((const void*)mega, dim3(grid), dim3(NTHREADS), args, LDS_BYTES, stream);
    if (e != hipSuccess) fprintf(stderr, "cooperative launch failed: %s (grid %d)\n", hipGetErrorString(e), grid);
}
```
